# Optimizing an MI355X kernel written in HIP

```python
import jax, jax.numpy as jnp
from jax import lax
import numpy as np

D_MODEL = 1024
BATCH = 16
SEQ = 2048
DEPTH = 4

CTX_LEN = 256
GRID_W = 64
HEAD_DIM = 64
A_HEADS = 8
A_KV_HEADS = 2
A_WINDOW = 128
A_BLOCK = 128
B_HEADS = 8
NA_KH = 8
NA_KW = 16
NA_QCOLS = 16
NA_BAND = 32
C_HEADS = 4
C_DK = 128
C_DV = 128
D_HEADS = 4
D_DK = 64
D_DV = 128
D_GATE_RANK = 16
D_GATE_NORM = 16.0
CHUNK = 32
N_BRANCH = 4
D_FF = 4 * D_MODEL
ROPE_BASE = 10000.0
EPS = 1e-6
NEG_INF = -1e30

A_QW = A_HEADS * HEAD_DIM
A_KVW = A_KV_HEADS * HEAD_DIM
B_W = B_HEADS * HEAD_DIM
C_KW = C_HEADS * C_DK
C_VW = C_HEADS * C_DV
D_KW = D_HEADS * D_DK
D_VW = D_HEADS * D_DV
BRANCH_W = 512
IN_NAMES = ('a_q', 'a_k', 'a_v', 'b_q', 'b_k', 'b_v', 'c_q', 'c_f_fwd', 'c_f_bwd', 'c_i', 'c_g',
            'd_q', 'd_k', 'd_v', 'd_gk_fwd', 'd_gk_bwd', 'd_g', 'merge')
IN_SIZES = (A_QW, A_KVW, A_KVW, B_W, B_W, B_W, C_KW, C_KW, C_KW, C_VW, C_VW,
            D_KW, D_KW, D_VW, D_GATE_RANK, D_GATE_RANK, D_VW, N_BRANCH * D_MODEL)
IN_WIDTH = sum(IN_SIZES)

kernel_name = 'hybrid_bidir_diffusion_trunk'


def rms_norm(x, g):
    xf = x.astype(jnp.float32)
    y = xf * lax.rsqrt(jnp.mean(jnp.square(xf), axis=-1, keepdims=True) + EPS)
    return (y * g.astype(jnp.float32)).astype(x.dtype)


def heads(t, nh):
    return t.reshape(t.shape[:-1] + (nh, t.shape[-1] // nh))


def flip(t):
    return t[:, ::-1]


def split_in(z):
    out = {}
    off = 0
    for name, size in zip(IN_NAMES, IN_SIZES):
        out[name] = z[..., off:off + size]
        off += size
    return out


def axial_angles(n):
    t = jnp.arange(n)
    row = (t // GRID_W).astype(jnp.float32)
    col = (t % GRID_W).astype(jnp.float32)
    half = HEAD_DIM // 2
    inv = ROPE_BASE ** (-jnp.arange(0, half, 2, dtype=jnp.float32) / half)
    return row[:, None] * inv, col[:, None] * inv


def rope_1d(x, ang):
    f = x.shape[-1] // 2
    cos = jnp.cos(ang)[:, None, :].astype(x.dtype)
    sin = jnp.sin(ang)[:, None, :].astype(x.dtype)
    x1, x2 = x[..., :f], x[..., f:]
    return jnp.concatenate([x1 * cos - x2 * sin, x2 * cos + x1 * sin], axis=-1)


def axial_rope(x, ang_r, ang_c):
    half = HEAD_DIM // 2
    return jnp.concatenate([rope_1d(x[..., :half], ang_r), rope_1d(x[..., half:], ang_c)], axis=-1)


def ctx_attention(q, k, v, sink):
    bsz, L, nh, hd = q.shape
    nkv = k.shape[2]
    grp = nh // nkv
    qg = q.reshape(bsz, L, nkv, grp, hd)
    s = jnp.einsum('bqkgd,bskd->bkgqs', qg, k).astype(jnp.float32) * (hd ** -0.5)
    if sink is not None:
        s_sink = jnp.broadcast_to(sink.reshape(nkv, grp)[None, :, :, None, None].astype(jnp.float32), (bsz, nkv, grp, L, 1))
        s = jnp.concatenate([s, s_sink], axis=-1)
    p = jax.nn.softmax(s, axis=-1)[..., :L].astype(v.dtype)
    o = jnp.einsum('bkgqs,bskd->bqkgd', p, v)
    return o.reshape(bsz, L, nh * hd)


def window_attention(q, k, v, kc, vc, sink):
    bsz, n, nh, hd = q.shape
    nkv = k.shape[2]
    grp = nh // nkv
    nb = n // A_BLOCK
    L = kc.shape[1]
    scale = hd ** -0.5
    qb = q.reshape(bsz, nb, A_BLOCK, nkv, grp, hd).swapaxes(0, 1)

    def bands(t):
        tp = jnp.pad(t, ((0, 0), (A_BLOCK, A_BLOCK), (0, 0), (0, 0))).reshape(bsz, nb + 2, A_BLOCK, nkv, hd)
        return jnp.concatenate([tp[:, :-2], tp[:, 1:-1], tp[:, 2:]], axis=2).swapaxes(0, 1)

    kb, vb = bands(k), bands(v)
    blk = jnp.arange(nb)[:, None, None]
    qpos = blk * A_BLOCK + jnp.arange(A_BLOCK)[None, :, None]
    kpos = (blk - 1) * A_BLOCK + jnp.arange(3 * A_BLOCK)[None, None, :]
    valid = (jnp.abs(kpos - qpos) <= A_WINDOW) & (kpos >= 0) & (kpos < n)
    sink_s = jnp.broadcast_to(sink.reshape(nkv, grp)[None, :, :, None, None].astype(jnp.float32),
                              (bsz, nkv, grp, A_BLOCK, 1))
    wlen = 3 * A_BLOCK

    def block(args):
        qi, ki, vi, mi = args
        s_win = jnp.einsum('bqkgd,bskd->bkgqs', qi, ki).astype(jnp.float32) * scale
        s_win = jnp.where(mi, s_win, NEG_INF)
        s_ctx = jnp.einsum('bqkgd,bckd->bkgqc', qi, kc).astype(jnp.float32) * scale
        p = jax.nn.softmax(jnp.concatenate([s_win, s_ctx, sink_s], axis=-1), axis=-1).astype(v.dtype)
        o = (jnp.einsum('bkgqs,bskd->bqkgd', p[..., :wlen], vi)
             + jnp.einsum('bkgqc,bckd->bqkgd', p[..., wlen:wlen + L], vc))
        return o.reshape(bsz, A_BLOCK, nh * hd)

    out = lax.map(block, (qb, kb, vb, valid))
    return out.swapaxes(0, 1).reshape(bsz, n, nh * hd)


def neighbourhood_attention(q, k, v, kc, vc, rel_bias):
    bsz, n, nh, hd = q.shape
    rows = n // GRID_W
    kh = min(NA_KH, rows)
    ncb = GRID_W // NA_QCOLS
    band_starts = [min(max(j * NA_QCOLS - NA_KW // 2, 0), GRID_W - NA_BAND) for j in range(ncb)]
    scale = hd ** -0.5
    qr_all = q.reshape(bsz, rows, ncb, NA_QCOLS, nh, hd).swapaxes(0, 1)
    kg = k.reshape(bsz, rows, GRID_W, nh, hd)
    vg = v.reshape(bsz, rows, GRID_W, nh, hd)
    qcol = (jnp.arange(ncb)[:, None] * NA_QCOLS + jnp.arange(NA_QCOLS)[None, :])[:, :, None]
    kcol = jnp.asarray(band_starts, dtype=jnp.int32)[:, None, None] + jnp.arange(NA_BAND)[None, None, :]
    cstart = jnp.clip(qcol - NA_KW // 2, 0, GRID_W - NA_KW)
    col_ok = (kcol >= cstart) & (kcol < cstart + NA_KW)
    dc_idx = jnp.clip(kcol - qcol, -(NA_KW - 1), NA_KW - 1) + (NA_KW - 1)
    wlen = kh * NA_BAND

    def row_block(args):
        r, qr = args
        r0 = jnp.clip(r - kh // 2, 0, rows - kh)
        kr = lax.dynamic_slice_in_dim(kg, r0, kh, axis=1)
        vr = lax.dynamic_slice_in_dim(vg, r0, kh, axis=1)
        kb = jnp.stack([kr[:, :, s:s + NA_BAND] for s in band_starts], axis=1)
        vb = jnp.stack([vr[:, :, s:s + NA_BAND] for s in band_starts], axis=1)
        dr_idx = r0 + jnp.arange(kh) - r + (NA_KH - 1)
        bias = rel_bias[:, dr_idx[None, None, :, None], dc_idx[:, :, None, :]]
        s_loc = jnp.einsum('bjqhd,bjrchd->bhjqrc', qr, kb).astype(jnp.float32) * scale
        s_loc = jnp.where(col_ok[:, :, None, :], s_loc + bias[None].astype(jnp.float32), NEG_INF)
        s_loc = s_loc.reshape(bsz, nh, ncb, NA_QCOLS, wlen)
        s_ctx = jnp.einsum('bjqhd,bchd->bhjqc', qr, kc).astype(jnp.float32) * scale
        p = jax.nn.softmax(jnp.concatenate([s_loc, s_ctx], axis=-1), axis=-1).astype(v.dtype)
        o = (jnp.einsum('bhjqs,bjshd->bjqhd', p[..., :wlen], vb.reshape(bsz, ncb, wlen, nh, hd))
             + jnp.einsum('bhjqc,bchd->bjqhd', p[..., wlen:], vc))
        return o.reshape(bsz, GRID_W, nh * hd)

    out = lax.map(row_block, (jnp.arange(rows), qr_all))
    return out.swapaxes(0, 1).reshape(bsz, n, nh * hd)


def chunk_scan(q, k, v, g, s0):
    bsz, n, nh, dk = k.shape
    dv = v.shape[-1]
    nc = n // CHUNK
    f32 = jnp.float32
    if s0 is None:
        s0 = jnp.zeros((bsz, nh, dk, dv), f32)

    def chunks(t):
        return t.astype(f32).reshape(bsz, nc, CHUNK, nh, t.shape[-1]).transpose(1, 0, 3, 2, 4)

    tri = jnp.tril(jnp.ones((CHUNK, CHUNK), dtype=bool))[:, :, None]

    def step(state, inp):
        qi, ki, vi, gi = inp
        cum = jnp.cumsum(gi, axis=2)
        rel = jnp.exp(jnp.where(tri, cum[:, :, :, None, :] - cum[:, :, None, :, :], NEG_INF))
        attn = jnp.einsum('bhtk,bhsk,bhtsk->bhts', qi, ki, rel)
        o = jnp.einsum('bhts,bhsv->bhtv', attn, vi) + jnp.einsum('bhtk,bhkv->bhtv', qi * jnp.exp(cum), state)
        last = cum[:, :, -1:, :]
        new_state = (jnp.exp(last[:, :, 0, :, None]) * state
                     + jnp.einsum('bhsk,bhsv->bhkv', ki * jnp.exp(last - cum), vi))
        return new_state, o

    s_fin, o = lax.scan(step, s0, (chunks(q), chunks(k), chunks(v), chunks(g)))
    return o.transpose(1, 0, 3, 2, 4).reshape(bsz, n, nh, dv).astype(v.dtype), s_fin


def final_state(k, v, g):
    cum = jnp.cumsum(g.astype(jnp.float32), axis=1)
    w = k.astype(jnp.float32) * jnp.exp(cum[:, -1:] - cum)
    return jnp.einsum('bnhk,bnhv->bhkv', w, v.astype(jnp.float32))


def bidir_recurrence(lat_f, lat_b, ctx_f, ctx_b, need_ctx):
    if need_ctx:
        oc_f, s_f = chunk_scan(*ctx_f, None)
        oc_b, s_b = chunk_scan(*[flip(t) for t in ctx_b], None)
        o_ctx = oc_f + flip(oc_b)
    else:
        s_f = final_state(*ctx_f[1:])
        s_b = final_state(*[flip(t) for t in ctx_b[1:]])
        o_ctx = None
    o_f, _ = chunk_scan(*lat_f, s_f)
    o_b, _ = chunk_scan(*[flip(t) for t in lat_b], s_b)
    return o_f + flip(o_b), o_ctx


def gated_group_norm(o, gain, gate_raw, nh):
    y = rms_norm(o, gain) * jax.nn.silu(heads(gate_raw, nh)).astype(o.dtype)
    return y.reshape(y.shape[:-2] + (-1,))


def merge_branches(branches, gate_logits, w_branch, w_out):
    g = heads(gate_logits, N_BRANCH)
    acc = None
    for j, yb in enumerate(branches):
        t = jax.nn.sigmoid(g[..., j, :]) * (yb @ w_branch[j])
        acc = t if acc is None else acc + t
    return acc @ w_out


def channel_mlp(h, w1, w2):
    return jnp.square(jax.nn.relu(h @ w1)) @ w2


def token_mixer(h, hc, w_in, a_sink, b_rel_bias, lb, c_norm, d_gate_up, d_gate_bias, d_norm,
                w_branch, w_out, need_ctx):
    n = h.shape[1]
    f32 = jnp.float32
    z = split_in(h @ w_in)
    zc = split_in(hc @ w_in)

    ang_r, ang_c = axial_angles(n)
    aq = axial_rope(heads(z['a_q'], A_HEADS), ang_r, ang_c)
    ak = axial_rope(heads(z['a_k'], A_KV_HEADS), ang_r, ang_c)
    akc, avc = heads(zc['a_k'], A_KV_HEADS), heads(zc['a_v'], A_KV_HEADS)
    y_a = window_attention(aq, ak, heads(z['a_v'], A_KV_HEADS), akc, avc, a_sink)

    bkc, bvc = heads(zc['b_k'], B_HEADS), heads(zc['b_v'], B_HEADS)
    y_b = neighbourhood_attention(heads(z['b_q'], B_HEADS), heads(z['b_k'], B_HEADS),
                                  heads(z['b_v'], B_HEADS), bkc, bvc, b_rel_bias)

    lbh = lb.reshape(C_HEADS, C_DK)

    def hgrn_forget(zf):
        zf = heads(zf, C_HEADS).astype(f32)
        log_f = jnp.log(lbh + (1.0 - lbh) * jax.nn.sigmoid(zf))
        key = (1.0 - lbh) * jax.nn.sigmoid(-zf)
        return key, log_f

    def hgrn_inputs(zz):
        q = jax.nn.silu(heads(zz['c_q'], C_HEADS))
        v = heads(zz['c_i'], C_HEADS)
        kf, gf = hgrn_forget(zz['c_f_fwd'])
        kb, gb = hgrn_forget(zz['c_f_bwd'])
        return (q, kf, v, gf), (q, kb, v, gb)

    lat_cf, lat_cb = hgrn_inputs(z)
    ctx_cf, ctx_cb = hgrn_inputs(zc)
    o_c, oc_c = bidir_recurrence(lat_cf, lat_cb, ctx_cf, ctx_cb, need_ctx)
    y_c = gated_group_norm(o_c, c_norm, z['c_g'], C_HEADS)

    def gla_inputs(zz):
        q = heads(zz['d_q'], D_HEADS) * (D_DK ** -0.5)
        k = heads(zz['d_k'], D_HEADS)
        v = heads(zz['d_v'], D_HEADS)

        def gate(zd, j):
            return heads(jax.nn.log_sigmoid((zd @ d_gate_up[j] + d_gate_bias[j]).astype(f32)) / D_GATE_NORM, D_HEADS)

        return (q, k, v, gate(zz['d_gk_fwd'], 0)), (q, k, v, gate(zz['d_gk_bwd'], 1))

    lat_df, lat_db = gla_inputs(z)
    ctx_df, ctx_db = gla_inputs(zc)
    o_d, oc_d = bidir_recurrence(lat_df, lat_db, ctx_df, ctx_db, need_ctx)
    y_d = gated_group_norm(o_d, d_norm, z['d_g'], D_HEADS)

    y = merge_branches([y_a, y_b, y_c, y_d], z['merge'], w_branch, w_out)
    if need_ctx:
        yc_a = ctx_attention(heads(zc['a_q'], A_HEADS), akc, avc, a_sink)
        yc_b = ctx_attention(heads(zc['b_q'], B_HEADS), bkc, bvc, None)
        yc_c = gated_group_norm(oc_c, c_norm, zc['c_g'], C_HEADS)
        yc_d = gated_group_norm(oc_d, d_norm, zc['d_g'], D_HEADS)
        y_ctx = merge_branches([yc_a, yc_b, yc_c, yc_d], zc['merge'], w_branch, w_out)
    else:
        y_ctx = None
    return y, y_ctx


def setup_inputs(seed: int = 0) -> dict:
    key = jax.random.key(seed)
    ks = jax.random.split(key, 20)
    f32 = jnp.float32

    def nrm(k, shape, s):
        return jax.random.normal(k, shape, f32) * s

    return {
        'x': nrm(ks[0], (BATCH, SEQ, D_MODEL), 1.0),
        'c': nrm(ks[1], (BATCH, D_MODEL), 1.0),
        'ctx': nrm(ks[2], (BATCH, CTX_LEN, D_MODEL), 1.0),
        'c_ctx': nrm(ks[3], (D_MODEL,), 1.0),
        'w_mod': nrm(ks[4], (DEPTH, D_MODEL, 6 * D_MODEL), 0.5 * D_MODEL ** -0.5),
        'b_mod': nrm(ks[5], (DEPTH, 6 * D_MODEL), 0.02),
        'norm_gains': 1.0 + nrm(ks[6], (DEPTH, 4, D_MODEL), 0.1),
        'w_in': nrm(ks[7], (DEPTH, D_MODEL, IN_WIDTH), D_MODEL ** -0.5),
        'a_sink': nrm(ks[8], (DEPTH, A_HEADS), 0.5),
        'b_rel_bias': nrm(ks[9], (DEPTH, B_HEADS, 2 * NA_KH - 1, 2 * NA_KW - 1), 0.5),
        'c_lower_bounds': nrm(ks[10], (DEPTH, C_KW), 0.1),
        'c_norm': 1.0 + nrm(ks[11], (DEPTH, C_DV), 0.1),
        'd_gate_up': nrm(ks[12], (DEPTH, 2, D_GATE_RANK, D_KW), D_GATE_RANK ** -0.5),
        'd_gate_bias': nrm(ks[13], (DEPTH, 2, D_KW), 0.1),
        'd_norm': 1.0 + nrm(ks[14], (DEPTH, D_DV), 0.1),
        'w_branch': nrm(ks[15], (DEPTH, N_BRANCH, BRANCH_W, D_MODEL), BRANCH_W ** -0.5),
        'w_out': nrm(ks[16], (DEPTH, D_MODEL, D_MODEL), D_MODEL ** -0.5),
        'w_ff1': nrm(ks[17], (DEPTH, D_MODEL, D_FF), D_MODEL ** -0.5),
        'w_ff2': nrm(ks[18], (DEPTH, D_FF, D_MODEL), D_FF ** -0.5),
    }


def reference(x, c, ctx, c_ctx, w_mod, b_mod, norm_gains, w_in, a_sink, b_rel_bias, c_lower_bounds,
              c_norm, d_gate_up, d_gate_bias, d_norm, w_branch, w_out, w_ff1, w_ff2):
    lb_soft = jax.nn.softmax(c_lower_bounds.astype(jnp.float32), axis=0)
    lb_all = jnp.cumsum(lb_soft, axis=0) - lb_soft[0:1]
    xc = ctx
    for l in range(DEPTH):
        need_ctx = l < DEPTH - 1
        ng = norm_gains[l]
        mod = jax.nn.silu(c) @ w_mod[l] + b_mod[l]
        mod_c = jax.nn.silu(c_ctx) @ w_mod[l] + b_mod[l]
        sh1, sc1, g1, sh2, sc2, g2 = jnp.split(mod[:, None, :], 6, axis=-1)
        csh1, csc1, cg1, csh2, csc2, cg2 = jnp.split(mod_c, 6, axis=-1)
        h = rms_norm(x, ng[0]) * (1.0 + sc1) + sh1
        hc = rms_norm(xc, ng[0]) * (1.0 + csc1) + csh1
        y, y_ctx = token_mixer(h, hc, w_in[l], a_sink[l], b_rel_bias[l], lb_all[l], c_norm[l],
                               d_gate_up[l], d_gate_bias[l], d_norm[l], w_branch[l], w_out[l], need_ctx)
        x = x + g1 * rms_norm(y, ng[1])
        h2 = rms_norm(x, ng[2]) * (1.0 + sc2) + sh2
        x = x + g2 * rms_norm(channel_mlp(h2, w_ff1[l], w_ff2[l]), ng[3])
        if need_ctx:
            xc = xc + cg1 * rms_norm(y_ctx, ng[1])
            hc2 = rms_norm(xc, ng[2]) * (1.0 + csc2) + csh2
            xc = xc + cg2 * rms_norm(channel_mlp(hc2, w_ff1[l], w_ff2[l]), ng[3])
    return x
```

```cpp
#include <hip/hip_runtime.h>
#include <hip/hip_cooperative_groups.h>
#include <cstdio>
namespace cg = cooperative_groups;
__device__ __forceinline__ int ltid() { int t = (int)threadIdx.x; asm volatile("" : "+v"(t)); return t; }
namespace pg8 {
#define PG8_LAS __attribute__((address_space(3)))
typedef unsigned short bf16_t;
typedef short bf16x8 __attribute__((ext_vector_type(8)));
typedef float f32x4 __attribute__((ext_vector_type(4)));
typedef unsigned u32x4 __attribute__((ext_vector_type(4)));
constexpr int BM = 256, BK = 64, HALF = 128, HTB = HALF * BK * 2  , STAGE_BYTES = 8 * HTB, NXCD = 8, WGM = 8;

__host__ __device__ __forceinline__ int lds_byte(int r, int c) { const int st = (r >> 4) * 2 + (c >> 5), rr = r & 15, cc = c & 31, ob = rr * 64 + cc * 2; return st * 1024 + (ob ^ (((ob >> 9) & 1) << 5)); }
__host__ __device__ __forceinline__ void stage_rc(int b, int& R, int& C) { const int st = b / 1024, sb = b % 1024, swz = sb ^ (((sb >> 9) & 1) << 5); R = (st >> 1) * 16 + swz / 64; C = (st & 1) * 32 + (swz % 64) / 2; }
__host__ __device__ __forceinline__ int perm32(int rho) { const int n = rho >> 4, i = rho & 15; return 8 * (i >> 2) + 4 * n + (i & 3); }

struct Unit { int pm, pn; };
struct Gemm { const bf16_t* A; const bf16_t* Bt; int M, N, K; };

struct StaticOrder {
    int nM, nN, nwg, G, c;
    __host__ __device__ void init(int M, int N, int G_, int c_) { nM = M / BM; nN = N / BM; nwg = nM * nN; G = G_; c = c_; }
    __host__ __device__ bool next(int i, Unit& u) const {
        const long L = (long)i * G + c; if (L >= nwg) return false;
        int wgid = (int)L; { const int q = nwg / NXCD, r = nwg % NXCD, xcd = wgid % NXCD, off = wgid / NXCD; wgid = (xcd < r ? xcd * (q + 1) : r * (q + 1) + (xcd - r) * q) + off; }
        const int nig = WGM * nN, gid = wgid / nig, fm = gid * WGM, gsz = (nM - fm) < WGM ? (nM - fm) : WGM;
        u.pm = fm + ((wgid % nig) % gsz); u.pn = (wgid % nig) / gsz; return true;
    }
    __device__ __forceinline__ void a_ready(const Unit&) const {}
    __device__ __forceinline__ void done(const Unit&) const {}
};
__device__ __forceinline__ unsigned cvt_pk_bf16(float lo, float hi) { unsigned r; asm volatile("v_cvt_pk_bf16_f32 %0, %1, %2" : "=v"(r) : "v"(lo), "v"(hi)); return r; }
struct EpiF32 {
    static constexpr bool PERM = false, AFTER_DRAIN = false;
    float* C; int ldc; const float* bias;
    __device__ __forceinline__ void operator()(const f32x4 (&acc)[2][2][4][2], const Unit& u, int wr, int wc, int fr, int fq) const {
        const int row0 = u.pm * BM + wr * 64 + fr, col0 = u.pn * BM + wc * 32 + 4 * fq;
        f32x4 bv[2][2];
#pragma unroll
        for (int bj = 0; bj < 2; ++bj)
#pragma unroll
            for (int n = 0; n < 2; ++n) bv[bj][n] = bias ? *(const f32x4*)(bias + col0 + bj * HALF + n * 16) : (f32x4){0.f, 0.f, 0.f, 0.f};
#pragma unroll
        for (int ai = 0; ai < 2; ++ai)
#pragma unroll
            for (int m = 0; m < 4; ++m) { float* rowp = C + (size_t)(row0 + ai * HALF + m * 16) * ldc + col0;
#pragma unroll
                for (int bj = 0; bj < 2; ++bj)
#pragma unroll
                    for (int n = 0; n < 2; ++n) *(f32x4*)(rowp + bj * HALF + n * 16) = acc[ai][bj][m][n] + bv[bj][n]; }
    }
};
template <class Epi, class Sched, bool STAMP = false>
__device__ __forceinline__ void gemm_phase(PG8_LAS unsigned char* lds, const Gemm g, const Sched& S, const Epi& E, unsigned long long* stamps) {
    const int tid = ltid(), wid = __builtin_amdgcn_readfirstlane(tid >> 6), lane = tid & 63, wr = wid >> 2, wc = wid & 3, fr = lane & 15, fq = lane >> 4;
    const int K = g.K, nt = K / BK;
    int ts_lo = 0, ts_hi = 0, nts = 0; const unsigned long long rt_entry = STAMP ? (unsigned long long)wall_clock64() : 0ull;
#define PG8_STAMP() do { if (STAMP && wid == 0 && nts < 64) { const unsigned long long _c = (unsigned long long)clock64(); \
        ts_lo = (lane == nts) ? (int)(unsigned)_c : ts_lo; ts_hi = (lane == nts) ? (int)(unsigned)(_c >> 32) : ts_hi; ++nts; } } while (0)
    PG8_STAMP();
    unsigned voffA[2], voffB[2];
#pragma unroll
    for (int i = 0; i < 2; ++i) { int R, C; stage_rc(tid * 16 + i * 8192, R, C); const int Rb = Epi::PERM ? ((R & ~31) + perm32(R & 31)) : R;
        voffA[i] = (unsigned)(R * K + C) * 2u; voffB[i] = (unsigned)(Rb * K + C) * 2u; }
    const size_t kstep = (size_t)(BK * 2);
    const size_t hstep = (size_t)HALF * K * 2;
    const size_t tstep = 2 * hstep;
    const unsigned ldsw = (unsigned)wid * 1024u;
    const int aoff = lds_byte(wr * 64 + fr, fq * 8), boff = lds_byte(wc * 32 + fr, fq * 8);
#define PG8_SA(b, h) (((b) * 2 + (h)) * HTB)
#define PG8_SB(b, h) ((4 + (b) * 2 + (h)) * HTB)
#define PG8_STAGE(bufoff, gbase, voff) do { _Pragma("unroll") for (int _i = 0; _i < 2; ++_i) \
        __builtin_amdgcn_global_load_lds((const unsigned*)((const char*)(gbase) + (voff)[_i]), (PG8_LAS unsigned*)(lds + (bufoff) + ldsw + _i * 8192), 16, 0, 0); } while (0)
#define PG8_LDA(dst, b, h) do { _Pragma("unroll") for (int m = 0; m < 4; ++m) _Pragma("unroll") for (int k = 0; k < 2; ++k) dst[m][k] = *(const PG8_LAS bf16x8*)(lds + PG8_SA(b, h) + aoff + m * 2048 + k * 1024); } while (0)
#define PG8_LDB(dst, b, h) do { _Pragma("unroll") for (int n = 0; n < 2; ++n) _Pragma("unroll") for (int k = 0; k < 2; ++k) dst[n][k] = *(const PG8_LAS bf16x8*)(lds + PG8_SB(b, h) + boff + n * 2048 + k * 1024); } while (0)
#define PG8_MMA(ai, bj, At, Bt) do { __builtin_amdgcn_s_setprio(1); _Pragma("unroll") for (int m = 0; m < 4; ++m) _Pragma("unroll") for (int n = 0; n < 2; ++n) _Pragma("unroll") for (int k = 0; k < 2; ++k) \
        acc[ai][bj][m][n] = __builtin_amdgcn_mfma_f32_16x16x32_bf16(Bt[n][k], At[m][k], acc[ai][bj][m][n], 0, 0, 0); __builtin_amdgcn_s_setprio(0); } while (0)
#define PG8_WAIT_V(n) asm volatile("s_waitcnt vmcnt(" #n ")" ::: "memory")
#define PG8_WAIT_L(n) asm volatile("s_waitcnt lgkmcnt(" #n ")" ::: "memory")
#define PG8_BAR __builtin_amdgcn_s_barrier()
#define PG8_SCHED __builtin_amdgcn_sched_barrier(0)
    Unit cur, nxt; int ui = 0;
    if (!S.next(0, cur)) return;
    f32x4 acc[2][2][4][2];
#pragma unroll
    for (int a = 0; a < 2; ++a)
#pragma unroll
        for (int b = 0; b < 2; ++b)
#pragma unroll
            for (int m = 0; m < 4; ++m)
#pragma unroll
                for (int n = 0; n < 2; ++n) acc[a][b][m][n] = (f32x4){0.f, 0.f, 0.f, 0.f};
    bf16x8 At[4][2], B0[2][2], B1[2][2];
    const char* cA = (const char*)g.A + (size_t)cur.pm * tstep; const char* cB = (const char*)g.Bt + (size_t)cur.pn * tstep;
    S.a_ready(cur);
    PG8_STAGE(PG8_SB(0, 0), cB, voffB); PG8_STAGE(PG8_SA(0, 0), cA, voffA); PG8_STAGE(PG8_SB(0, 1), cB + hstep, voffB); PG8_STAGE(PG8_SA(0, 1), cA + hstep, voffA);
    if (wr == 1) PG8_BAR;
    PG8_WAIT_V(4); PG8_BAR;
    PG8_STAGE(PG8_SB(1, 0), cB + kstep, voffB); PG8_STAGE(PG8_SA(1, 0), cA + kstep, voffA); PG8_STAGE(PG8_SB(1, 1), cB + hstep + kstep, voffB);
    PG8_WAIT_V(6); PG8_BAR;
    PG8_STAMP();
    for (;;) {
        const bool has_next = S.next(ui + 1, nxt);
        const char* nA = has_next ? (const char*)g.A + (size_t)nxt.pm * tstep : cA; const char* nB = has_next ? (const char*)g.Bt + (size_t)nxt.pn * tstep : cB;
        for (int t = 0; t < nt; t += 2) {
            const bool last = (t == nt - 2);
            const char* a1 = cA + (size_t)(t + 1) * kstep;
            const char* a2 = last ? nA : cA + (size_t)(t + 2) * kstep; const char* b2 = last ? nB : cB + (size_t)(t + 2) * kstep;
            const char* a3 = a2 + kstep; const char* b3 = b2 + kstep;
            if (last && has_next) S.a_ready(nxt);
            PG8_LDB(B0, 0, 0); PG8_SCHED; PG8_LDA(At, 0, 0); PG8_STAGE(PG8_SA(1, 1), a1 + hstep, voffA);
            PG8_WAIT_L(8); PG8_BAR; PG8_WAIT_L(0); PG8_MMA(0, 0, At, B0); PG8_BAR; PG8_SCHED;
            PG8_LDB(B1, 0, 1); PG8_STAGE(PG8_SB(0, 0), b2, voffB);
            PG8_BAR; PG8_WAIT_L(0); PG8_MMA(0, 1, At, B1); PG8_BAR;
            PG8_LDA(At, 0, 1); PG8_STAGE(PG8_SA(0, 0), a2, voffA);
            PG8_BAR; PG8_WAIT_L(0); PG8_MMA(1, 0, At, B0); PG8_BAR; PG8_SCHED;
            PG8_STAGE(PG8_SB(0, 1), b2 + hstep, voffB);
            PG8_WAIT_V(6); PG8_BAR; PG8_MMA(1, 1, At, B1); PG8_BAR;
            PG8_LDB(B0, 1, 0); PG8_SCHED; PG8_LDA(At, 1, 0); PG8_STAGE(PG8_SA(0, 1), a2 + hstep, voffA);
            PG8_WAIT_L(8); PG8_BAR; PG8_WAIT_L(0); PG8_MMA(0, 0, At, B0); PG8_BAR; PG8_SCHED;
            PG8_LDB(B1, 1, 1); PG8_STAGE(PG8_SB(1, 0), b3, voffB);
            PG8_BAR; PG8_WAIT_L(0); PG8_MMA(0, 1, At, B1); PG8_BAR;
            PG8_LDA(At, 1, 1); PG8_STAGE(PG8_SA(1, 0), a3, voffA);
            PG8_BAR; PG8_WAIT_L(0); PG8_MMA(1, 0, At, B0); PG8_BAR; PG8_SCHED;
            PG8_STAGE(PG8_SB(1, 1), b3 + hstep, voffB);
            PG8_WAIT_V(6); PG8_BAR; PG8_MMA(1, 1, At, B1); PG8_BAR;
        }
        PG8_STAMP();
        if constexpr (!Epi::AFTER_DRAIN) { E(acc, cur, wr, wc, fr, fq); S.done(cur); }
        PG8_STAMP();
        if (!has_next) break;
#pragma unroll
        for (int a = 0; a < 2; ++a)
#pragma unroll
            for (int b = 0; b < 2; ++b)
#pragma unroll
                for (int m = 0; m < 4; ++m)
#pragma unroll
                    for (int n = 0; n < 2; ++n) acc[a][b][m][n] = (f32x4){0.f, 0.f, 0.f, 0.f};
        cur = nxt; cA = nA; cB = nB; ++ui;
    }
    PG8_WAIT_V(0);
    if (wr == 0) PG8_BAR;
    PG8_BAR;
    if constexpr (Epi::AFTER_DRAIN) { E.fused(acc, cur, wr, wc, fr, fq, lds, wid, lane); S.done(cur); }
    PG8_STAMP();
    if (STAMP && wid == 0) { stamps[lane] = lane < nts ? (((unsigned long long)(unsigned)ts_hi << 32) | (unsigned)ts_lo) : 0ull;
        if (lane == 62) stamps[62] = rt_entry; if (lane == 63) stamps[63] = (unsigned long long)wall_clock64(); }
#undef PG8_STAMP
#undef PG8_SA
#undef PG8_SB
#undef PG8_STAGE
#undef PG8_LDA
#undef PG8_LDB
#undef PG8_MMA
#undef PG8_WAIT_V
#undef PG8_WAIT_L
#undef PG8_BAR
#undef PG8_SCHED
}
}

#define LAS __attribute__((address_space(3)))
typedef unsigned short bf16_t;
typedef pg8::bf16x8 bf16x8;
typedef pg8::f32x4 f32x4;
typedef pg8::u32x4 u32x4;
typedef unsigned u32x2 __attribute__((ext_vector_type(2)));

constexpr int DM = 1024, NB = 16, SEQ = 2048, DEPTH = 4, CTXL = 256, DFF = 4096;
constexpr int ZW = 10752;
constexpr int INW = 10528;
constexpr int ZA_Q = 0, ZA_K = 512, ZA_V = 640, ZB_Q = 768, ZB_K = 1280, ZB_V = 1792, ZC_Q = 2304, ZC_FF = 2816, ZC_FB = 3328, ZC_I = 3840, ZC_G = 4352,
              ZD_Q = 4864, ZD_K = 5120, ZD_V = 5376, ZD_GK = 5888, ZD_G = 6016, ZMERGE = 6656;
constexpr int VTS = 2304;
constexpr int LDS_BYTES = 131072 + 1024;
constexpr float EPS = 1e-6f;

struct Params {
    const float *x, *c, *ctx, *c_ctx, *w_mod, *b_mod, *norm_gains, *w_in, *a_sink, *b_rel_bias, *c_lb, *c_norm, *d_gate_up, *d_gate_bias, *d_norm, *w_branch, *w_out, *w_ff1, *w_ff2;
    float* out;
    unsigned char* ws;
    unsigned long long o_mod, o_lb, o_rope, o_xc, o_win, o_wb, o_wo, o_w1, o_w2, o_h, o_z, o_y4, o_ob, o_vta, o_vtb;
    int GB, NGRP, MG, pad0;
};
typedef const Params __attribute__((address_space(4)))* PPtr;

__device__ __forceinline__ float bf2f(unsigned v) { return __uint_as_float(v << 16); }
__device__ __forceinline__ bf16_t f2bf(float f) { unsigned u = __float_as_uint(f); u += 0x7FFFu + ((u >> 16) & 1u); return (bf16_t)(u >> 16); }
typedef __bf16 bf16v2_t __attribute__((ext_vector_type(2)));
typedef float f32v2_t __attribute__((ext_vector_type(2)));
__device__ __forceinline__ unsigned pk2(float lo, float hi) { const f32v2_t v = {lo, hi}; const bf16v2_t b = __builtin_convertvector(v, bf16v2_t); return __builtin_bit_cast(unsigned, b); }
__device__ __forceinline__ float wave_sum(float v) {
#pragma unroll
    for (int o = 1; o < 64; o <<= 1) v += __shfl_xor(v, o);
    return v;
}
__device__ __forceinline__ float lo16(unsigned w) { return __uint_as_float(w << 16); }
__device__ __forceinline__ float hi16(unsigned w) { return __uint_as_float(w & 0xffff0000u); }
__device__ __forceinline__ float sigm(float x) { return 1.0f / (1.0f + __expf(-x)); }

__device__ __forceinline__ int src_col(int n) {
    if (n < 640) {
        const int p = n & 63, base = n - p, pp = p >> 1, wh = p & 1;
        const int dim = (pp < 16) ? (wh ? 16 + pp : pp) : (wh ? 48 + (pp - 16) : 32 + (pp - 16));
        return base + dim;
    }
    if (n < 5920) return n;
    if (n < 6016) return -1;
    if (n < 6528) return n - 96;
    if (n < 6656) return -1;
    return 6432 + (n - 6656);
}

__device__ __forceinline__ void conv_tile(const float* src, int Nsrc, int k0, int n0, bool inmap, bf16_t* dst, int Kd, LAS float* t) {
    const int tid = ltid(), nl = tid & 63, ks = tid >> 6;
    const int sc = inmap ? src_col(n0 + nl) : (n0 + nl);
#pragma unroll
    for (int i = 0; i < 8; ++i) { const int kk = ks + 8 * i; t[nl * 65 + kk] = (sc >= 0) ? src[(size_t)(k0 + kk) * Nsrc + sc] : 0.f; }
    __syncthreads();
    const int kl = (tid & 31) * 2, ns = tid >> 5;
#pragma unroll
    for (int i = 0; i < 4; ++i) { const int n = ns + 16 * i; *(unsigned*)(dst + (size_t)(n0 + n) * Kd + k0 + kl) = pk2(t[n * 65 + kl], t[n * 65 + kl + 1]); }
    __syncthreads();
}
__device__ __forceinline__ void convert_weights(PPtr p, int l, LAS unsigned char* lds) {
    LAS float* t = (LAS float*)lds;
    bf16_t* WinT = (bf16_t*)(p->ws + p->o_win); bf16_t* WbT = (bf16_t*)(p->ws + p->o_wb); bf16_t* WoT = (bf16_t*)(p->ws + p->o_wo);
    bf16_t* W1T = (bf16_t*)(p->ws + p->o_w1); bf16_t* W2T = (bf16_t*)(p->ws + p->o_w2);
    constexpr int T_IN = 16 * 168, T_BR = 4 * 8 * 16, T_O = 16 * 16, T_1 = 16 * 64, T_2 = 64 * 16, T_ALL = T_IN + T_BR + T_O + T_1 + T_2;
    for (int it = blockIdx.x; it < T_ALL; it += gridDim.x) {
        int r = it;
        if (r < T_IN) { const int kb = r / 168, nb = r % 168; conv_tile(p->w_in + (size_t)l * 1024 * INW, INW, kb * 64, nb * 64, true, WinT, 1024, t); continue; } r -= T_IN;
        if (r < T_BR) { const int j = r / 128, q = r % 128, kb = q / 16, nb = q % 16; conv_tile(p->w_branch + (size_t)(l * 4 + j) * 512 * 1024, 1024, kb * 64, nb * 64, false, WbT + (size_t)j * 1024 * 512, 512, t); continue; } r -= T_BR;
        if (r < T_O) { const int kb = r / 16, nb = r % 16; conv_tile(p->w_out + (size_t)l * 1024 * 1024, 1024, kb * 64, nb * 64, false, WoT, 1024, t); continue; } r -= T_O;
        if (r < T_1) { const int kb = r / 64, nb = r % 64; conv_tile(p->w_ff1 + (size_t)l * 1024 * 4096, 4096, kb * 64, nb * 64, false, W1T, 1024, t); continue; } r -= T_1;
        { const int kb = r / 16, nb = r % 16; conv_tile(p->w_ff2 + (size_t)l * 4096 * 1024, 1024, kb * 64, nb * 64, false, W2T, 4096, t); }
    }
}

__device__ __forceinline__ void prologue(PPtr p, LAS unsigned char* lds) {
    const int tid = ltid();
    if (blockIdx.x == 0 && tid < 64) atomicExch((unsigned*)p->ws + tid, 0u);
    float* modb = (float*)(p->ws + p->o_mod);
    LAS float* sl = (LAS float*)lds;
    LAS float* red = sl + 17 * 1024;
    bool loaded = false;
    for (int task = blockIdx.x; task < 192; task += gridDim.x) {
        if (!loaded) {
            for (int i = tid; i < 17 * 1024; i += 512) { const int b = i >> 10, k = i & 1023; const float v = (b < 16) ? p->c[b * 1024 + k] : p->c_ctx[k]; sl[i] = v * sigm(v); }
            loaded = true;
        }
        __syncthreads();
        const int l = task / 48, nc = task % 48, nn = tid & 127, n = nc * 128 + nn, kq = tid >> 7;
        float acc[17];
#pragma unroll
        for (int b = 0; b < 17; ++b) acc[b] = 0.f;
        const float* w = p->w_mod + ((size_t)l * 1024 + kq * 256) * 6144 + n;
#pragma unroll 4
        for (int k = 0; k < 256; ++k) {
            const float wv = w[(size_t)k * 6144];
#pragma unroll
            for (int b = 0; b < 17; ++b) acc[b] += sl[b * 1024 + kq * 256 + k] * wv;
        }
#pragma unroll
        for (int b = 0; b < 17; ++b) red[(kq * 17 + b) * 128 + nn] = acc[b];
        __syncthreads();
        if (kq == 0) {
            const float bm = p->b_mod[l * 6144 + n];
#pragma unroll
            for (int b = 0; b < 17; ++b) modb[((size_t)l * 17 + b) * 6144 + n] = red[b * 128 + nn] + red[(17 + b) * 128 + nn] + red[(34 + b) * 128 + nn] + red[(51 + b) * 128 + nn] + bm;
        }
        __syncthreads();
    }
    if (blockIdx.x == gridDim.x - 1) {
        float* lb = (float*)(p->ws + p->o_lb);
        {
            const int ch = tid;
            float v[4], mx = -1e30f;
#pragma unroll
            for (int l = 0; l < 4; ++l) { v[l] = p->c_lb[l * 512 + ch]; mx = fmaxf(mx, v[l]); }
            float s = 0.f;
#pragma unroll
            for (int l = 0; l < 4; ++l) { v[l] = __expf(v[l] - mx); s += v[l]; }
            const float inv = 1.0f / s, s0 = v[0] * inv; float cum = 0.f;
#pragma unroll
            for (int l = 0; l < 4; ++l) { cum += v[l] * inv; lb[l * 512 + ch] = cum - s0; }
        }
        float* rt = (float*)(p->ws + p->o_rope);
        for (int i = tid; i < 1024; i += 512) {
            const int n = i >> 4, f = i & 15;
            const float inv = __expf(-((float)(2 * f) / 32.0f) * 9.210340371976184f);
            const float a = (float)n * inv;
            const float kf = rintf(a * 0.15915494309189535f);
            const float rr = fmaf(-kf, 6.2831854820251465f, a) + kf * 1.7484556e-7f;
            rt[i] = __cosf(rr); rt[1024 + i] = __sinf(rr);
        }
    }
    __syncthreads();
    convert_weights(p, 0, lds);
}

__device__ __forceinline__ void rowpass(PPtr p, int l, int g, int mode, int nrows) {
    const int lane = ltid() & 63, gw = blockIdx.x * 8 + (ltid() >> 6), NGW = gridDim.x * 8;
    const int LATR = p->GB * 2048;
    const float* ng = p->norm_gains + (size_t)l * 4 * 1024;
    const float* modb = (const float*)(p->ws + p->o_mod) + (size_t)l * 17 * 6144;
    bf16_t* hb = (bf16_t*)(p->ws + p->o_h);
    const float* yf = (const float*)(p->ws + p->o_z);
    float* xcb = (float*)(p->ws + p->o_xc);
    for (int row = gw; row < nrows; row += NGW) {
        const bool lat = row < LATR;
        int b; size_t xrow;
        if (lat) { b = g * p->GB + (row >> 11); xrow = (size_t)b * 2048 + (row & 2047); }
        else { const int r2 = row - LATR; b = g * p->GB + (r2 >> 8); xrow = (size_t)b * 256 + (r2 & 255); }
        const bool first = (l == 0 && mode <= 2);
        const float* xs = (lat ? (first ? p->x : (const float*)p->out) : (first ? p->ctx : (const float*)xcb)) + xrow * 1024;
        float* xd = (lat ? p->out : xcb) + xrow * 1024;
        const float* m = modb + (size_t)(lat ? b : 16) * 6144;
        f32x4 xv[4];
#pragma unroll
        for (int j = 0; j < 4; ++j) xv[j] = *(const f32x4*)(xs + lane * 4 + 256 * j);
        if (mode >= 2) {
            f32x4 yv[4]; float ss = 0.f;
#pragma unroll
            for (int j = 0; j < 4; ++j) { yv[j] = *(const f32x4*)(yf + (size_t)row * 1024 + lane * 4 + 256 * j); ss += yv[j].x * yv[j].x + yv[j].y * yv[j].y + yv[j].z * yv[j].z + yv[j].w * yv[j].w; }
            ss = wave_sum(ss);
            const float rs = rsqrtf(ss * (1.0f / 1024.0f) + EPS);
            const float* gate = m + (mode == 2 ? 2048 : 5120); const float* gn = ng + (mode == 2 ? 1024 : 3072);
#pragma unroll
            for (int j = 0; j < 4; ++j) {
                const int c = lane * 4 + 256 * j;
                const f32x4 gv = *(const f32x4*)(gate + c), nv = *(const f32x4*)(gn + c);
                xv[j] = xv[j] + gv * (yv[j] * rs * nv);
                *(f32x4*)(xd + c) = xv[j];
            }
        }
        if (mode <= 2) {
            float ss = 0.f;
#pragma unroll
            for (int j = 0; j < 4; ++j) ss += xv[j].x * xv[j].x + xv[j].y * xv[j].y + xv[j].z * xv[j].z + xv[j].w * xv[j].w;
            ss = wave_sum(ss);
            const float rs = rsqrtf(ss * (1.0f / 1024.0f) + EPS);
            const float* sh = m + (mode == 1 ? 0 : 3072); const float* sc = m + (mode == 1 ? 1024 : 4096); const float* gn = ng + (mode == 1 ? 0 : 2048);
#pragma unroll
            for (int j = 0; j < 4; ++j) {
                const int c = lane * 4 + 256 * j;
                const f32x4 shv = *(const f32x4*)(sh + c), scv = *(const f32x4*)(sc + c), nv = *(const f32x4*)(gn + c);
                const f32x4 hv = (xv[j] * rs * nv) * (scv + 1.0f) + shv;
                u32x2 o; o.x = pk2(hv.x, hv.y); o.y = pk2(hv.z, hv.w);
                *(u32x2*)(hb + (size_t)row * 1024 + c) = o;
            }
        }
    }
}

struct EpiInproj {
    static constexpr bool PERM = true, AFTER_DRAIN = false;
    bf16_t* Z; bf16_t* vta; bf16_t* vtb; const float* rope; int GB;
    __device__ __forceinline__ void operator()(const f32x4 (&acc)[2][2][4][2], const pg8::Unit& u, int wr, int wc, int fr, int fq) const {
        const int row0 = u.pm * 256 + wr * 64 + fr, LATR = GB * 2048;
#pragma unroll
        for (int bj = 0; bj < 2; ++bj) {
            const int seg = u.pn * 2 + bj, c0 = u.pn * 256 + bj * 128 + wc * 32 + 8 * fq;
            const int type = (seg <= 4) ? 1 : (seg == 5 ? 2 : ((seg >= 14 && seg <= 17) ? 3 : 0));
#pragma unroll
            for (int ai = 0; ai < 2; ++ai)
#pragma unroll
                for (int m = 0; m < 4; ++m) {
                    const int row = row0 + ai * 128 + m * 16;
                    f32x4 v0 = acc[ai][bj][m][0], v1 = acc[ai][bj][m][1];
                    if (type <= 1) {
                        if (type == 1 && row < LATR) {
                            const int t = row & 2047, pp0 = (c0 & 63) >> 1;
                            const int n = (pp0 < 16) ? (t >> 6) : (t & 63);
                            const float* cs = rope + n * 16 + (pp0 & 15);
                            const f32x4 cv = *(const f32x4*)cs, sv = *(const f32x4*)(cs + 1024);
                            f32x4 r0, r1;
                            r0.x = v0.x * cv.x - v0.y * sv.x; r0.y = v0.y * cv.x + v0.x * sv.x;
                            r0.z = v0.z * cv.y - v0.w * sv.y; r0.w = v0.w * cv.y + v0.z * sv.y;
                            r1.x = v1.x * cv.z - v1.y * sv.z; r1.y = v1.y * cv.z + v1.x * sv.z;
                            r1.z = v1.z * cv.w - v1.w * sv.w; r1.w = v1.w * cv.w + v1.z * sv.w;
                            v0 = r0; v1 = r1;
                        }
                        u32x4 w; w.x = pk2(v0.x, v0.y); w.y = pk2(v0.z, v0.w); w.z = pk2(v1.x, v1.y); w.w = pk2(v1.z, v1.w);
                        *(u32x4*)(Z + (size_t)row * ZW + c0) = w;
                    } else {
                        int bl, tok;
                        if (row < LATR) { bl = row >> 11; tok = row & 2047; } else { const int r2 = row - LATR; bl = r2 >> 8; tok = 2048 + (r2 & 255); }
                        const int cc = c0 - (type == 2 ? ZA_V : ZB_V), head = cc >> 6, dim0 = cc & 63, H = (type == 2) ? 2 : 8;
                        bf16_t* base = (type == 2 ? vta : vtb) + ((size_t)(bl * H + head) * 64 + dim0) * VTS + tok;
                        base[0 * VTS] = f2bf(v0.x); base[1 * VTS] = f2bf(v0.y); base[2 * VTS] = f2bf(v0.z); base[3 * VTS] = f2bf(v0.w);
                        base[4 * VTS] = f2bf(v1.x); base[5 * VTS] = f2bf(v1.y); base[6 * VTS] = f2bf(v1.z); base[7 * VTS] = f2bf(v1.w);
                    }
                }
        }
    }
};
struct EpiBranch {
    static constexpr bool PERM = true, AFTER_DRAIN = false;
    const bf16_t* Z; bf16_t* macc; int nMfull;
    __device__ __forceinline__ void operator()(const f32x4 (&acc)[2][2][4][2], const pg8::Unit& u, int wr, int wc, int fr, int fq) const {
        const int j = u.pm / nMfull, pm = u.pm - j * nMfull, pn = u.pn & 3;
        const int row0 = pm * 256 + wr * 64 + fr, col0 = pn * 256 + wc * 32 + 8 * fq;
#pragma unroll
        for (int ai = 0; ai < 2; ++ai)
#pragma unroll
            for (int m = 0; m < 4; ++m) {
                const int row = row0 + ai * 128 + m * 16;
#pragma unroll
                for (int bj = 0; bj < 2; ++bj) {
                    const int col = col0 + bj * 128;
                    const u32x4 gw = *(const u32x4*)(Z + (size_t)row * ZW + ZMERGE + j * 1024 + col);
                    const f32x4 v0 = acc[ai][bj][m][0], v1 = acc[ai][bj][m][1];
                    float t0 = v0.x * sigm(lo16(gw.x)), t1 = v0.y * sigm(hi16(gw.x)), t2 = v0.z * sigm(lo16(gw.y)), t3 = v0.w * sigm(hi16(gw.y));
                    float t4 = v1.x * sigm(lo16(gw.z)), t5 = v1.y * sigm(hi16(gw.z)), t6 = v1.z * sigm(lo16(gw.w)), t7 = v1.w * sigm(hi16(gw.w));
                    bf16_t* dst = macc + (size_t)row * 1024 + col;
                    if (j > 0) {
                        const u32x4 pv = *(const u32x4*)dst;
                        t0 += lo16(pv.x); t1 += hi16(pv.x); t2 += lo16(pv.y); t3 += hi16(pv.y); t4 += lo16(pv.z); t5 += hi16(pv.z); t6 += lo16(pv.w); t7 += hi16(pv.w);
                    }
                    u32x4 w; w.x = pk2(t0, t1); w.y = pk2(t2, t3); w.z = pk2(t4, t5); w.w = pk2(t6, t7);
                    *(u32x4*)dst = w;
                }
            }
    }
};
struct BranchOrder {
    int nM, nMfull, G, c;
    __device__ __forceinline__ bool next(int i, pg8::Unit& u) const {
        const int j = i & 3; const long T = (long)(i >> 2) * G + c;
        if (T >= (long)nM * 4) return false;
        u.pm = j * nMfull + (int)(T >> 2); u.pn = j * 4 + (int)(T & 3); return true;
    }
    __device__ __forceinline__ void a_ready(const pg8::Unit&) const {}
    __device__ __forceinline__ void done(const pg8::Unit&) const {}
};
struct EpiRelu2 {
    static constexpr bool PERM = true, AFTER_DRAIN = false;
    bf16_t* O; int ldc;
    __device__ __forceinline__ void operator()(const f32x4 (&acc)[2][2][4][2], const pg8::Unit& u, int wr, int wc, int fr, int fq) const {
        const int row0 = u.pm * 256 + wr * 64 + fr, col0 = u.pn * 256 + wc * 32 + 8 * fq;
#pragma unroll
        for (int ai = 0; ai < 2; ++ai)
#pragma unroll
            for (int m = 0; m < 4; ++m) {
                bf16_t* rowp = O + (size_t)(row0 + ai * 128 + m * 16) * ldc + col0;
#pragma unroll
                for (int bj = 0; bj < 2; ++bj) {
                    f32x4 v0 = acc[ai][bj][m][0], v1 = acc[ai][bj][m][1];
#pragma unroll
                    for (int e = 0; e < 4; ++e) { const float a = fmaxf(v0[e], 0.f), b = fmaxf(v1[e], 0.f); v0[e] = a * a; v1[e] = b * b; }
                    u32x4 w; w.x = pk2(v0.x, v0.y); w.y = pk2(v0.z, v0.w); w.z = pk2(v1.x, v1.y); w.w = pk2(v1.z, v1.w);
                    *(u32x4*)(rowp + bj * 128) = w;
                }
            }
    }
};

#define MFMA16(a, b, c) __builtin_amdgcn_mfma_f32_16x16x32_bf16((a), (b), (c), 0, 0, 0)
__device__ __forceinline__ void attn_wave(PPtr p, int l, int kind, int idx, int lane, const LAS float* biasL) {
    const int fr = lane & 15, fq = lane >> 4;
    const int LATR = p->GB * 2048, MG = p->MG;
    const bf16_t* Z = (const bf16_t*)(p->ws + p->o_z);
    const bool isA = (kind == 1 || kind == 2);
    int bl, hk, qrow0, r = 0, q0 = 0;
    if (kind == 0) { bl = idx >> 8; hk = (idx >> 5) & 7; r = idx & 31; qrow0 = bl * 2048 + r * 64; }
    else if (kind == 1) { bl = idx >> 8; hk = (idx >> 7) & 1; q0 = (idx & 127) * 16; qrow0 = bl * 2048 + q0; }
    else if (kind == 2) { bl = idx >> 5; hk = (idx >> 4) & 1; qrow0 = LATR + bl * 256 + (idx & 15) * 16; }
    else { bl = idx >> 5; hk = (idx >> 2) & 7; qrow0 = LATR + bl * 256 + (idx & 3) * 64; }
    const int qrstep = isA ? 0 : 16, qcstep = isA ? 64 : 0;
    const int qcol0 = isA ? (ZA_Q + hk * 4 * 64) : (ZB_Q + hk * 64);
    const int kcol = isA ? (ZA_K + hk * 64) : (ZB_K + hk * 64);
    const bf16_t* vt = isA ? ((const bf16_t*)(p->ws + p->o_vta) + (size_t)(bl * 2 + hk) * 64 * VTS) : ((const bf16_t*)(p->ws + p->o_vtb) + (size_t)(bl * 8 + hk) * 64 * VTS);
    bf16_t* yo = (bf16_t*)(p->ws + p->o_y4) + (isA ? (size_t)0 : (size_t)MG * 512);
    const int ocol0 = isA ? hk * 4 * 64 : hk * 64;
    const int krow_ctx0 = LATR + bl * 256, krow_lat0 = bl * 2048;
    const float scale = 0.125f;

    bf16x8 Q[4][2];
#pragma unroll
    for (int s = 0; s < 4; ++s)
#pragma unroll
        for (int ks = 0; ks < 2; ++ks) Q[s][ks] = *(const bf16x8*)(Z + (size_t)(qrow0 + s * qrstep + fr) * ZW + qcol0 + s * qcstep + ks * 32 + fq * 8);
    f32x4 O[4][4]; float mrun[4], lrun[4];
#pragma unroll
    for (int s = 0; s < 4; ++s) { mrun[s] = -1e30f; lrun[s] = 0.f;
#pragma unroll
        for (int dt = 0; dt < 4; ++dt) O[s][dt] = (f32x4){0.f, 0.f, 0.f, 0.f}; }

    auto do_block = [&](int krow, int vtoff, int mode, int a0, int a1) {
        bf16x8 Kf[2][2];
#pragma unroll
        for (int kt = 0; kt < 2; ++kt)
#pragma unroll
            for (int ks = 0; ks < 2; ++ks) Kf[kt][ks] = *(const bf16x8*)(Z + (size_t)(krow + kt * 16 + fr) * ZW + kcol + ks * 32 + fq * 8);
        bf16x8 Vf[4];
#pragma unroll
        for (int dt = 0; dt < 4; ++dt) {
            const bf16_t* vp = vt + (size_t)(dt * 16 + fr) * VTS + vtoff + fq * 4;
            const u32x2 lo = *(const u32x2*)vp, hi = *(const u32x2*)(vp + 16);
            u32x4 w; w.x = lo.x; w.y = lo.y; w.z = hi.x; w.w = hi.y;
            Vf[dt] = __builtin_bit_cast(bf16x8, w);
        }
#pragma unroll
        for (int s = 0; s < 4; ++s) {
            const bool active = (mode != 2) || !((s == 0 && a1 == 1) || (s == 3 && a1 == 0));
            if (active) {
                f32x4 S0 = (f32x4){0.f, 0.f, 0.f, 0.f}, S1 = (f32x4){0.f, 0.f, 0.f, 0.f};
                S0 = MFMA16(Kf[0][0], Q[s][0], S0); S0 = MFMA16(Kf[0][1], Q[s][1], S0);
                S1 = MFMA16(Kf[1][0], Q[s][0], S1); S1 = MFMA16(Kf[1][1], Q[s][1], S1);
                float sc[8];
#pragma unroll
                for (int j = 0; j < 4; ++j) { sc[j] = S0[j] * scale; sc[4 + j] = S1[j] * scale; }
                if (mode == 1) {
                    const int qpos = q0 + fr;
#pragma unroll
                    for (int e = 0; e < 8; ++e) { const int kpos = a0 + (e >> 2) * 16 + fq * 4 + (e & 3); const int d = kpos - qpos; if (d > 128 || d < -128) sc[e] = -1e30f; }
                } else if (mode == 2) {
                    const int qc = 16 * s + fr; const int cs = min(max(qc - 8, 0), 48);
                    const LAS float* bp = biasL + hk * 465 + a0 * 31;
#pragma unroll
                    for (int e = 0; e < 8; ++e) {
                        const int kc = a1 * 32 + (e >> 2) * 16 + fq * 4 + (e & 3);
                        const int dc = min(max(kc - qc + 15, 0), 30);
                        const float bv = bp[dc];
                        sc[e] = (kc >= cs && kc < cs + 16) ? (sc[e] + bv) : -1e30f;
                    }
                }
                float ml = fmaxf(fmaxf(fmaxf(sc[0], sc[1]), fmaxf(sc[2], sc[3])), fmaxf(fmaxf(sc[4], sc[5]), fmaxf(sc[6], sc[7])));
                ml = fmaxf(ml, __shfl_xor(ml, 16)); ml = fmaxf(ml, __shfl_xor(ml, 32));
                const float mn = fmaxf(mrun[s], ml), alpha = __expf(mrun[s] - mn);
                mrun[s] = mn;
                float pv[8], ls = 0.f;
#pragma unroll
                for (int e = 0; e < 8; ++e) { pv[e] = __expf(sc[e] - mn); ls += pv[e]; }
                ls += __shfl_xor(ls, 16); ls += __shfl_xor(ls, 32);
                lrun[s] = lrun[s] * alpha + ls;
                u32x4 pw; pw.x = pk2(pv[0], pv[1]); pw.y = pk2(pv[2], pv[3]); pw.z = pk2(pv[4], pv[5]); pw.w = pk2(pv[6], pv[7]);
                const bf16x8 P = __builtin_bit_cast(bf16x8, pw);
#pragma unroll
                for (int dt = 0; dt < 4; ++dt) { O[s][dt] = O[s][dt] * alpha; O[s][dt] = MFMA16(Vf[dt], P, O[s][dt]); }
            }
            __builtin_amdgcn_sched_barrier(0);
        }
    };
    int nloc = 0, lo = 0, r0 = 0;
    if (kind == 1) { lo = max(0, q0 - 128) & ~31; const int hi = min(2048, (q0 + 16 + 128 + 31) & ~31); nloc = (hi - lo) >> 5; }
    else if (kind == 0) { r0 = min(max(r - 4, 0), 24); nloc = 16; }
#pragma unroll 1
    for (int i = 0; i < 8 + nloc; ++i) {
        int krow, vtoff, mode, a0, a1;
        if (i < 8) { krow = krow_ctx0 + 32 * i; vtoff = 2048 + 32 * i; mode = 0; a0 = 0; a1 = 0; }
        else if (kind == 1) { const int kb = lo + 32 * (i - 8); krow = krow_lat0 + kb; vtoff = kb; mode = 1; a0 = kb; a1 = 0; }
        else { const int jj = i - 8, kr = r0 + (jj >> 1), hb = jj & 1; krow = krow_lat0 + kr * 64 + hb * 32; vtoff = kr * 64 + hb * 32; mode = 2; a0 = kr - r + 7; a1 = hb; }
        do_block(krow, vtoff, mode, a0, a1);
    }
#pragma unroll
    for (int s = 0; s < 4; ++s) {
        float fac;
        if (isA) { const float sk = p->a_sink[l * 8 + hk * 4 + s]; const float M = fmaxf(mrun[s], sk); const float e1 = __expf(mrun[s] - M); fac = e1 / (lrun[s] * e1 + __expf(sk - M)); }
        else fac = 1.0f / lrun[s];
        bf16_t* op = yo + (size_t)(qrow0 + s * qrstep + fr) * 512 + ocol0 + s * qcstep + fq * 4;
#pragma unroll
        for (int dt = 0; dt < 4; ++dt) { const f32x4 o = O[s][dt] * fac; u32x2 w; w.x = pk2(o.x, o.y); w.y = pk2(o.z, o.w); *(u32x2*)(op + dt * 16) = w; }
    }
}

template <int DK, bool ISC>
__device__ __forceinline__ void scan_task(PPtr p, int l, int bl, int h, int dir, LAS unsigned char* lds) {
    constexpr int KPW = DK / 8, NTG = 64 / KPW, TPG = 32 / NTG, QS = (DK + 8) * 2, NKT = DK / 16;
    const int tid = ltid(), w = tid >> 6, lane = tid & 63, fr = lane & 15, fq = lane >> 4;
    const int kl = lane % KPW, tg = lane / KPW, kch = w * KPW + kl;
    const int vcol = tid & 127, vg = tid >> 7;
    LAS unsigned char* qt = lds; LAS unsigned char* kt_ = qt + 32 * QS; LAS unsigned char* khT = kt_ + 32 * QS; LAS unsigned char* vT = khT + DK * 80;
    LAS unsigned char* att = vT + 128 * 80; LAS float* dvec = (LAS float*)(att + 32 * 80); LAS float* evec = dvec + DK;
    const bf16_t* Z = (const bf16_t*)(p->ws + p->o_z);
    const int LATR = p->GB * 2048, MG = p->MG;
    const int qc = ISC ? (ZC_Q + h * 128 + kch) : (ZD_Q + h * 64 + kch);
    const int kc = ISC ? ((dir ? ZC_FB : ZC_FF) + h * 128 + kch) : (ZD_K + h * 64 + kch);
    const int vc = (ISC ? ZC_I : ZD_V) + h * 128 + vcol;
    const int gcol = ZD_GK + dir * 16;
    float lbv = 0.f, oml = 1.f, up[16], gb = 0.f;
#pragma unroll
    for (int r = 0; r < 16; ++r) up[r] = 0.f;
    if (ISC) { lbv = ((const float*)(p->ws + p->o_lb))[l * 512 + h * 128 + kch]; oml = 1.0f - lbv; }
    else {
#pragma unroll
        for (int r = 0; r < 16; ++r) up[r] = p->d_gate_up[((size_t)(l * 2 + dir) * 16 + r) * 256 + h * 64 + kch];
        gb = p->d_gate_bias[(l * 2 + dir) * 256 + h * 64 + kch];
    }
    bf16_t* odst = (dir == 0) ? ((bf16_t*)(p->ws + p->o_y4) + (size_t)(ISC ? 2 : 3) * MG * 512) : ((bf16_t*)(p->ws + p->o_ob) + (size_t)(ISC ? 0 : 1) * MG * 512);
    f32x4 S[NKT];
#pragma unroll
    for (int i = 0; i < NKT; ++i) S[i] = (f32x4){0.f, 0.f, 0.f, 0.f};
    auto rowof = [&](int cc, int i) -> int {
        const bool isctx = cc < 8; const int L = isctx ? 256 : 2048, base = isctx ? (LATR + bl * 256) : (bl * 2048), c = isctx ? cc : cc - 8;
        const int pos = c * 32 + i; return base + (dir ? (L - 1 - pos) : pos);
    };
    bf16_t rq[TPG], rk[TPG], rv[8]; u32x4 rz[TPG][2];
    auto load_raw = [&](int cc) {
#pragma unroll
        for (int e = 0; e < TPG; ++e) {
            const bf16_t* zr = Z + (size_t)rowof(cc, tg * TPG + e) * ZW;
            rq[e] = zr[qc]; rk[e] = zr[kc];
            if (!ISC) { rz[e][0] = *(const u32x4*)(zr + gcol); rz[e][1] = *(const u32x4*)(zr + gcol + 8); }
        }
#pragma unroll
        for (int e = 0; e < 8; ++e) rv[e] = Z[(size_t)rowof(cc, vg * 8 + e) * ZW + vc];
    };
    load_raw(0);
    for (int cc = 0; cc < 72; ++cc) {
        __syncthreads();
        {
            float gq[TPG], gk[TPG], cum[TPG]; float run = 0.f;
#pragma unroll
            for (int e = 0; e < TPG; ++e) {
                const float zq = bf2f(rq[e]), zk = bf2f(rk[e]); float g, key, q;
                if (ISC) { const float sg = sigm(zk); g = __logf(lbv + oml * sg); key = oml * (1.0f - sg); q = zq * sigm(zq); }
                else {
                    float a = gb;
                    const u32x4 z0 = rz[e][0], z1 = rz[e][1];
                    a += lo16(z0.x) * up[0] + hi16(z0.x) * up[1] + lo16(z0.y) * up[2] + hi16(z0.y) * up[3] + lo16(z0.z) * up[4] + hi16(z0.z) * up[5] + lo16(z0.w) * up[6] + hi16(z0.w) * up[7];
                    a += lo16(z1.x) * up[8] + hi16(z1.x) * up[9] + lo16(z1.y) * up[10] + hi16(z1.y) * up[11] + lo16(z1.z) * up[12] + hi16(z1.z) * up[13] + lo16(z1.w) * up[14] + hi16(z1.w) * up[15];
                    g = (fminf(a, 0.f) - __logf(1.0f + __expf(-fabsf(a)))) * (1.0f / 16.0f); key = zk; q = zq * 0.125f;
                }
                run += g; cum[e] = run; gq[e] = q; gk[e] = key;
            }
            float pre = 0.f, total = 0.f, cref = 0.f;
#pragma unroll
            for (int t = 0; t < NTG; ++t) { const float tt = __shfl(run, kl + KPW * t); if (t < tg) pre += tt; if (t < NTG / 2) cref += tt; total += tt; }
            float khv[TPG];
#pragma unroll
            for (int e = 0; e < TPG; ++e) {
                const float c = cum[e] + pre; const int i = tg * TPG + e;
                *(LAS bf16_t*)(qt + i * QS + kch * 2) = f2bf(gq[e] * __expf(c - cref));
                *(LAS bf16_t*)(kt_ + i * QS + kch * 2) = f2bf(gk[e] * __expf(cref - c));
                khv[e] = gk[e] * __expf(total - c);
            }
            if constexpr (TPG == 8) { u32x4 o; o.x = pk2(khv[0], khv[1]); o.y = pk2(khv[2], khv[3]); o.z = pk2(khv[4], khv[5]); o.w = pk2(khv[6], khv[7]); *(LAS u32x4*)(khT + kch * 80 + tg * 16) = o; }
            else { u32x2 o; o.x = pk2(khv[0], khv[1]); o.y = pk2(khv[2], khv[3]); *(LAS u32x2*)(khT + kch * 80 + tg * 8) = o; }
            if (tg == 0) { dvec[kch] = __expf(total); evec[kch] = __expf(cref); }
            u32x4 vo; vo.x = (unsigned)rv[0] | ((unsigned)rv[1] << 16); vo.y = (unsigned)rv[2] | ((unsigned)rv[3] << 16); vo.z = (unsigned)rv[4] | ((unsigned)rv[5] << 16); vo.w = (unsigned)rv[6] | ((unsigned)rv[7] << 16);
            *(LAS u32x4*)(vT + vcol * 80 + vg * 16) = vo;
        }
        if (cc + 1 < 72) load_raw(cc + 1);
        __syncthreads();
        if (w < 3) {
            const int tt = (w == 0) ? 0 : 1, st = (w == 2) ? 1 : 0;
            f32x4 a = (f32x4){0.f, 0.f, 0.f, 0.f};
#pragma unroll
            for (int ks = 0; ks < DK / 32; ++ks) {
                const bf16x8 A = *(const LAS bf16x8*)(qt + (tt * 16 + fr) * QS + (ks * 32 + fq * 8) * 2);
                const bf16x8 B = *(const LAS bf16x8*)(kt_ + (st * 16 + fr) * QS + (ks * 32 + fq * 8) * 2);
                a = MFMA16(A, B, a);
            }
#pragma unroll
            for (int j = 0; j < 4; ++j) { const int t = tt * 16 + fq * 4 + j, s = st * 16 + fr; *(LAS bf16_t*)(att + t * 80 + s * 2) = f2bf(s <= t ? a[j] : 0.f); }
        } else if (w == 3) {
#pragma unroll
            for (int j = 0; j < 4; ++j) { const int t = fq * 4 + j, s = 16 + fr; *(LAS bf16_t*)(att + t * 80 + s * 2) = (bf16_t)0; }
        }
        __syncthreads();
        {
            const int vs = w * 16;
            const bf16x8 Bv = *(const LAS bf16x8*)(vT + (vs + fr) * 80 + fq * 16);
            bf16x8 Sb[NKT / 2];
#pragma unroll
            for (int kp = 0; kp < NKT / 2; ++kp) {
                const f32x4 e0 = *(const LAS f32x4*)(evec + (2 * kp) * 16 + fq * 4), e1 = *(const LAS f32x4*)(evec + (2 * kp + 1) * 16 + fq * 4);
                const f32x4 s0 = S[2 * kp] * e0, s1 = S[2 * kp + 1] * e1;
                u32x4 sw; sw.x = pk2(s0.x, s0.y); sw.y = pk2(s0.z, s0.w); sw.z = pk2(s1.x, s1.y); sw.w = pk2(s1.z, s1.w);
                Sb[kp] = __builtin_bit_cast(bf16x8, sw);
            }
#pragma unroll
            for (int tt = 0; tt < 2; ++tt) {
                f32x4 o = (f32x4){0.f, 0.f, 0.f, 0.f};
#pragma unroll
                for (int kp = 0; kp < NKT / 2; ++kp) {
                    const u32x2 lo = *(const LAS u32x2*)(qt + (tt * 16 + fr) * QS + ((2 * kp) * 16 + fq * 4) * 2);
                    const u32x2 hi = *(const LAS u32x2*)(qt + (tt * 16 + fr) * QS + ((2 * kp + 1) * 16 + fq * 4) * 2);
                    u32x4 aw; aw.x = lo.x; aw.y = lo.y; aw.z = hi.x; aw.w = hi.y;
                    o = MFMA16(__builtin_bit_cast(bf16x8, aw), Sb[kp], o);
                }
                const bf16x8 A2 = *(const LAS bf16x8*)(att + (tt * 16 + fr) * 80 + fq * 16);
                o = MFMA16(A2, Bv, o);
#pragma unroll
                for (int j = 0; j < 4; ++j) { const int row = rowof(cc, tt * 16 + fq * 4 + j); odst[(size_t)row * 512 + h * 128 + vs + fr] = f2bf(o[j]); }
            }
#pragma unroll
            for (int k2 = 0; k2 < NKT; ++k2) {
                const f32x4 d = *(const LAS f32x4*)(dvec + k2 * 16 + fq * 4);
                S[k2] = S[k2] * d;
                const bf16x8 A3 = *(const LAS bf16x8*)(khT + (k2 * 16 + fr) * 80 + fq * 16);
                S[k2] = MFMA16(A3, Bv, S[k2]);
            }
        }
    }
    __syncthreads();
}

__device__ __forceinline__ void mixer(PPtr p, int l, int g, LAS unsigned char* lds) {
    const int tid = ltid(), w = tid >> 6, lane = tid & 63;
    LAS float* biasL = (LAS float*)(lds + 49152);
    for (int i = tid; i < 8 * 465; i += 512) biasL[i] = p->b_rel_bias[(size_t)l * 8 * 465 + i];
    __syncthreads();
    const int GB = p->GB, NSC = GB * 8, NS = GB * 16;
    for (int st = blockIdx.x; st < NS; st += gridDim.x) {
        if (st < NSC) { scan_task<128, true>(p, l, st >> 3, (st >> 1) & 3, st & 1, lds); }
        else { const int s2 = st - NSC; scan_task<64, false>(p, l, s2 >> 3, (s2 >> 1) & 3, s2 & 1, lds); }
    }
    unsigned* ctr = (unsigned*)p->ws + (l * 16 + g);
    const int NB0 = GB * 32, NB1 = GB * 32, NB2 = (l < DEPTH - 1) ? GB * 4 : 0, NB3 = NB2, NBT = NB0 + NB1 + NB2 + NB3;
    LAS int* tw = (LAS int*)(lds + 131072);
    for (;;) {
        if (tid == 0) *tw = (int)atomicAdd(ctr, 1u);
        __syncthreads();
        const int bt = *tw;
        __syncthreads();
        if (bt >= NBT) break;
        int kind, idx;
        if (bt < NB0) { kind = 0; idx = bt * 8 + w; }
        else if (bt < NB0 + NB1) { kind = 1; idx = (bt - NB0) * 8 + w; }
        else if (bt < NB0 + NB1 + NB2) { kind = 2; idx = (bt - NB0 - NB1) * 8 + w; }
        else { kind = 3; idx = (bt - NB0 - NB1 - NB2) * 8 + w; }
        attn_wave(p, l, kind, idx, lane, biasL);
    }
}

__device__ __forceinline__ void postpass(PPtr p, int l, int nrows) {
    const int lane = ltid() & 63, gw = blockIdx.x * 8 + (ltid() >> 6), NGW = gridDim.x * 8, MG = p->MG;
    const bf16_t* Z = (const bf16_t*)(p->ws + p->o_z);
    for (int it = gw; it < nrows * 2; it += NGW) {
        const int row = it >> 1, br = it & 1;
        bf16_t* yf = (bf16_t*)(p->ws + p->o_y4) + (size_t)(2 + br) * MG * 512 + (size_t)row * 512 + lane * 8;
        const bf16_t* yb = (const bf16_t*)(p->ws + p->o_ob) + (size_t)br * MG * 512 + (size_t)row * 512 + lane * 8;
        const u32x4 a = *(const u32x4*)yf, b = *(const u32x4*)yb;
        const u32x4 gt = *(const u32x4*)(Z + (size_t)row * ZW + (br ? ZD_G : ZC_G) + lane * 8);
        const float* gain = (br ? p->d_norm : p->c_norm) + l * 128 + (lane & 15) * 8;
        float o[8], gv[8];
        o[0] = lo16(a.x) + lo16(b.x); o[1] = hi16(a.x) + hi16(b.x); o[2] = lo16(a.y) + lo16(b.y); o[3] = hi16(a.y) + hi16(b.y);
        o[4] = lo16(a.z) + lo16(b.z); o[5] = hi16(a.z) + hi16(b.z); o[6] = lo16(a.w) + lo16(b.w); o[7] = hi16(a.w) + hi16(b.w);
        gv[0] = lo16(gt.x); gv[1] = hi16(gt.x); gv[2] = lo16(gt.y); gv[3] = hi16(gt.y); gv[4] = lo16(gt.z); gv[5] = hi16(gt.z); gv[6] = lo16(gt.w); gv[7] = hi16(gt.w);
        float ss = 0.f;
#pragma unroll
        for (int e = 0; e < 8; ++e) ss += o[e] * o[e];
        ss += __shfl_xor(ss, 1); ss += __shfl_xor(ss, 2); ss += __shfl_xor(ss, 4); ss += __shfl_xor(ss, 8);
        const float rs = rsqrtf(ss * (1.0f / 128.0f) + EPS);
        const f32x4 g0 = *(const f32x4*)gain, g1 = *(const f32x4*)(gain + 4);
        float y[8];
#pragma unroll
        for (int e = 0; e < 8; ++e) { const float gn = (e < 4) ? g0[e & 3] : g1[e & 3]; y[e] = o[e] * rs * gn * (gv[e] * sigm(gv[e])); }
        u32x4 wv; wv.x = pk2(y[0], y[1]); wv.y = pk2(y[2], y[3]); wv.z = pk2(y[4], y[5]); wv.w = pk2(y[6], y[7]);
        *(u32x4*)yf = wv;
    }
}

#define NOINL __device__ __forceinline__
NOINL void ph_prologue(PPtr pc, LAS unsigned char* lds) { PPtr p = pc; asm volatile("" : "+s"(p)); prologue(p, lds); }
NOINL void ph_rowpass(PPtr pc, int l, int g, int mode, int nrows, int conv_l, LAS unsigned char* lds) { PPtr p = pc; asm volatile("" : "+s"(p)); rowpass(p, l, g, mode, nrows); if (conv_l >= 0) convert_weights(p, conv_l, lds); }
NOINL void ph_inproj(PPtr pc, LAS unsigned char* lds) {
    PPtr p = pc; asm volatile("" : "+s"(p)); const int G = (int)gridDim.x, c = (int)blockIdx.x;
    pg8::Gemm gm{(const bf16_t*)(p->ws + p->o_h), (const bf16_t*)(p->ws + p->o_win), p->MG, ZW, 1024}; pg8::StaticOrder S; S.init(p->MG, ZW, G, c);
    EpiInproj E{(bf16_t*)(p->ws + p->o_z), (bf16_t*)(p->ws + p->o_vta), (bf16_t*)(p->ws + p->o_vtb), (const float*)(p->ws + p->o_rope), p->GB};
    pg8::gemm_phase<EpiInproj, pg8::StaticOrder>(lds, gm, S, E, nullptr);
}
NOINL void ph_mixer(PPtr pc, int l, int g, LAS unsigned char* lds) { PPtr p = pc; asm volatile("" : "+s"(p)); mixer(p, l, g, lds); }
NOINL void ph_post(PPtr pc, int l, int nrows) { PPtr p = pc; asm volatile("" : "+s"(p)); postpass(p, l, nrows); }
NOINL void ph_branch(PPtr pc, int Mr, LAS unsigned char* lds) {
    PPtr p = pc; asm volatile("" : "+s"(p)); const int G = (int)gridDim.x, c = (int)blockIdx.x;
    pg8::Gemm gm{(const bf16_t*)(p->ws + p->o_y4), (const bf16_t*)(p->ws + p->o_wb), Mr, 1024, 512}; BranchOrder S{Mr / 256, p->MG / 256, G, c};
    EpiBranch E{(const bf16_t*)(p->ws + p->o_z), (bf16_t*)(p->ws + p->o_h), p->MG / 256};
    pg8::gemm_phase<EpiBranch, BranchOrder>(lds, gm, S, E, nullptr);
}
NOINL void ph_gemm_f32(PPtr pc, int which, int Mr, LAS unsigned char* lds) {
    PPtr p = pc; asm volatile("" : "+s"(p)); const int G = (int)gridDim.x, c = (int)blockIdx.x;
    const bf16_t* A = which ? (const bf16_t*)(p->ws + p->o_z + (size_t)p->MG * 1024 * 4) : (const bf16_t*)(p->ws + p->o_h);
    const bf16_t* Bt = which ? (const bf16_t*)(p->ws + p->o_w2) : (const bf16_t*)(p->ws + p->o_wo);
    pg8::Gemm gm{A, Bt, Mr, 1024, which ? 4096 : 1024}; pg8::StaticOrder S; S.init(Mr, 1024, G, c);
    pg8::EpiF32 E{(float*)(p->ws + p->o_z), 1024, nullptr};
    pg8::gemm_phase<pg8::EpiF32, pg8::StaticOrder>(lds, gm, S, E, nullptr);
}
NOINL void ph_ffn1(PPtr pc, int Mr, LAS unsigned char* lds) {
    PPtr p = pc; asm volatile("" : "+s"(p)); const int G = (int)gridDim.x, c = (int)blockIdx.x;
    pg8::Gemm gm{(const bf16_t*)(p->ws + p->o_h), (const bf16_t*)(p->ws + p->o_w1), Mr, 4096, 1024}; pg8::StaticOrder S; S.init(Mr, 4096, G, c);
    EpiRelu2 E{(bf16_t*)(p->ws + p->o_z + (size_t)p->MG * 1024 * 4), 4096};
    pg8::gemm_phase<EpiRelu2, pg8::StaticOrder>(lds, gm, S, E, nullptr);
}

__global__ void __launch_bounds__(512) hybrid_fwd(Params pk) {
    extern __shared__ __attribute__((aligned(16))) unsigned char smem[];
    LAS unsigned char* lds = (LAS unsigned char*)smem;
    cg::grid_group grid = cg::this_grid();
    PPtr pc = (PPtr)__builtin_amdgcn_kernarg_segment_ptr();
    const int GB = pc->GB, MG = pc->MG, NGRP = pc->NGRP, LATR = GB * 2048;
    ph_prologue(pc, lds);
    grid.sync();
    for (int l = 0; l < DEPTH; ++l) {
        const int Mr = (l < DEPTH - 1) ? MG : LATR;
        for (int g = 0; g < NGRP; ++g) {
            ph_rowpass(pc, l, g, 1, MG, -1, lds);
            grid.sync();
            ph_inproj(pc, lds);
            grid.sync();
            ph_mixer(pc, l, g, lds);
            grid.sync();
            ph_post(pc, l, Mr);
            grid.sync();
            ph_branch(pc, Mr, lds);
            grid.sync();
            ph_gemm_f32(pc, 0, Mr, lds);
            grid.sync();
            ph_rowpass(pc, l, g, 2, Mr, -1, lds);
            grid.sync();
            ph_ffn1(pc, Mr, lds);
            grid.sync();
            ph_gemm_f32(pc, 1, Mr, lds);
            grid.sync();
            ph_rowpass(pc, l, g, 3, Mr, (g == NGRP - 1 && l + 1 < DEPTH) ? l + 1 : -1, lds);
            grid.sync();
        }
    }
}

extern "C" void kernel_launch(void* const* d_in, const int* in_sizes, int n_in, void* d_out, int out_size, void* d_ws, size_t ws_size, hipStream_t stream) {
    static int grid_blocks = 0;
    if (grid_blocks == 0) {
        int dev = 0, cus = 0, per_cu = 0;
        hipGetDevice(&dev);
        hipDeviceGetAttribute(&cus, hipDeviceAttributeMultiprocessorCount, dev);
        if (hipFuncSetAttribute((const void*)hybrid_fwd, hipFuncAttributeMaxDynamicSharedMemorySize, LDS_BYTES) != hipSuccess) fprintf(stderr, "hipFuncSetAttribute failed\n");
        if (hipOccupancyMaxActiveBlocksPerMultiprocessor(&per_cu, (const void*)hybrid_fwd, 512, LDS_BYTES) != hipSuccess || per_cu < 1) { fprintf(stderr, "occupancy query: %d\n", per_cu); per_cu = 1; }
        (void)hipGetLastError();
        grid_blocks = cus * 1;
        if (grid_blocks <= 0) grid_blocks = 256;
    }
    Params p{};
    const float* const* in = (const float* const*)d_in;
    p.x = in[0]; p.c = in[1]; p.ctx = in[2]; p.c_ctx = in[3]; p.w_mod = in[4]; p.b_mod = in[5]; p.norm_gains = in[6]; p.w_in = in[7]; p.a_sink = in[8]; p.b_rel_bias = in[9];
    p.c_lb = in[10]; p.c_norm = in[11]; p.d_gate_up = in[12]; p.d_gate_bias = in[13]; p.d_norm = in[14]; p.w_branch = in[15]; p.w_out = in[16]; p.w_ff1 = in[17]; p.w_ff2 = in[18];
    p.out = (float*)d_out; p.ws = (unsigned char*)d_ws;
    auto al = [](unsigned long long v) { return (v + 255ull) & ~255ull; };
    unsigned long long off = 1024;
    p.o_mod = off; off = al(off + 4ull * 17 * 6144 * 4);
    p.o_lb = off; off = al(off + 4ull * 512 * 4);
    p.o_rope = off; off = al(off + 2048ull * 4);
    p.o_xc = off; off = al(off + 4096ull * 1024 * 4);
    p.o_win = off; off = al(off + (unsigned long long)ZW * 1024 * 2);
    p.o_wb = off; off = al(off + 4096ull * 512 * 2);
    p.o_wo = off; off = al(off + 1024ull * 1024 * 2);
    p.o_w1 = off; off = al(off + 4096ull * 1024 * 2);
    p.o_w2 = off; off = al(off + 1024ull * 4096 * 2);
    const unsigned long long fixed = off;
    int GB = 16;
    for (; GB > 1; GB >>= 1) {
        const unsigned long long MGt = (unsigned long long)GB * 2304;
        const unsigned long long need = fixed + MGt * (2048ull + (unsigned long long)ZW * 2 + 4096ull + 2048ull) + (unsigned long long)GB * 10 * 64 * VTS * 2 + 8 * 256;
        if (need <= (unsigned long long)ws_size) break;
    }
    p.GB = GB; p.NGRP = 16 / GB; p.MG = GB * 2304;
    const unsigned long long MGu = (unsigned long long)p.MG;
    p.o_h = off; off = al(off + MGu * 1024 * 2);
    p.o_z = off; off = al(off + MGu * ZW * 2);
    p.o_y4 = off; off = al(off + MGu * 2048 * 2);
    p.o_ob = off; off = al(off + MGu * 1024 * 2);
    p.o_vta = off; off = al(off + (unsigned long long)GB * 2 * 64 * VTS * 2);
    p.o_vtb = off; off = al(off + (unsigned long long)GB * 8 * 64 * VTS * 2);
    hipMemsetAsync(d_ws, 0, 1024, stream);
    void* args[] = {&p};
    hipError_t e = hipLaunchCooperativeKernel((const void*)hybrid_fwd, dim3(grid_blocks), dim3(512), args, LDS_BYTES, stream);
    if (e != hipSuccess) fprintf(stderr, "cooperative launch failed: %s (grid %d)\n", hipGetErrorString(e), grid_blocks);
}
```

```cpp
#include <hip/hip_runtime.h>
#include <hip/hip_cooperative_groups.h>
#include <cstdio>
namespace cg = cooperative_groups;
__device__ __forceinline__ int ltid() { int t = (int)threadIdx.x; asm volatile("" : "+v"(t)); return t; }
#define LAS __attribute__((address_space(3)))
namespace pg8 {
#define PG8_LAS __attribute__((address_space(3)))
typedef unsigned short bf16_t;
typedef short bf16x8 __attribute__((ext_vector_type(8)));
typedef float f32x4 __attribute__((ext_vector_type(4)));
typedef unsigned u32x4 __attribute__((ext_vector_type(4)));
constexpr int BM = 256, BK = 64, HALF = 128, HTB = HALF * BK * 2  , STAGE_BYTES = 8 * HTB, NXCD = 8, WGM = 8;

__host__ __device__ __forceinline__ int lds_byte(int r, int c) { const int st = (r >> 4) * 2 + (c >> 5), rr = r & 15, cc = c & 31, ob = rr * 64 + cc * 2; return st * 1024 + (ob ^ (((ob >> 9) & 1) << 5)); }
__host__ __device__ __forceinline__ void stage_rc(int b, int& R, int& C) { const int st = b / 1024, sb = b % 1024, swz = sb ^ (((sb >> 9) & 1) << 5); R = (st >> 1) * 16 + swz / 64; C = (st & 1) * 32 + (swz % 64) / 2; }
__host__ __device__ __forceinline__ int perm32(int rho) { const int n = rho >> 4, i = rho & 15; return 8 * (i >> 2) + 4 * n + (i & 3); }

struct Unit { int pm, pn; };
struct Gemm { const bf16_t* A; const bf16_t* Bt; int M, N, K; };

struct StaticOrder {
    int nM, nN, nwg, G, c;
    __host__ __device__ void init(int M, int N, int G_, int c_) { nM = M / BM; nN = N / BM; nwg = nM * nN; G = G_; c = c_; }
    __host__ __device__ bool next(int i, Unit& u) const {
        const long L = (long)i * G + c; if (L >= nwg) return false;
        int wgid = (int)L; { const int q = nwg / NXCD, r = nwg % NXCD, xcd = wgid % NXCD, off = wgid / NXCD; wgid = (xcd < r ? xcd * (q + 1) : r * (q + 1) + (xcd - r) * q) + off; }
        const int nig = WGM * nN, gid = wgid / nig, fm = gid * WGM, gsz = (nM - fm) < WGM ? (nM - fm) : WGM;
        u.pm = fm + ((wgid % nig) % gsz); u.pn = (wgid % nig) / gsz; return true;
    }
    __device__ __forceinline__ void a_ready(const Unit&) const {}
    __device__ __forceinline__ void done(const Unit&) const {}
};
__device__ __forceinline__ unsigned cvt_pk_bf16(float lo, float hi) { unsigned r; asm volatile("v_cvt_pk_bf16_f32 %0, %1, %2" : "=v"(r) : "v"(lo), "v"(hi)); return r; }
struct EpiF32 {
    static constexpr bool PERM = false, AFTER_DRAIN = false;
    float* C; int ldc; const float* bias;
    __device__ __forceinline__ void operator()(const f32x4 (&acc)[2][2][4][2], const Unit& u, int wr, int wc, int fr, int fq) const {
        const int row0 = u.pm * BM + wr * 64 + fr, col0 = u.pn * BM + wc * 32 + 4 * fq;
        f32x4 bv[2][2];
#pragma unroll
        for (int bj = 0; bj < 2; ++bj)
#pragma unroll
            for (int n = 0; n < 2; ++n) bv[bj][n] = bias ? *(const f32x4*)(bias + col0 + bj * HALF + n * 16) : (f32x4){0.f, 0.f, 0.f, 0.f};
#pragma unroll
        for (int ai = 0; ai < 2; ++ai)
#pragma unroll
            for (int m = 0; m < 4; ++m) { float* rowp = C + (size_t)(row0 + ai * HALF + m * 16) * ldc + col0;
#pragma unroll
                for (int bj = 0; bj < 2; ++bj)
#pragma unroll
                    for (int n = 0; n < 2; ++n) *(f32x4*)(rowp + bj * HALF + n * 16) = acc[ai][bj][m][n] + bv[bj][n]; }
    }
};
template <class Epi, class Sched, bool STAMP = false>
__device__ __forceinline__ void gemm_phase(PG8_LAS unsigned char* lds, const Gemm g, const Sched& S, const Epi& E, unsigned long long* stamps) {
    const int tid = ltid(), wid = __builtin_amdgcn_readfirstlane(tid >> 6), lane = tid & 63, wr = wid >> 2, wc = wid & 3, fr = lane & 15, fq = lane >> 4;
    const int K = g.K, nt = K / BK;
    int ts_lo = 0, ts_hi = 0, nts = 0; const unsigned long long rt_entry = STAMP ? (unsigned long long)wall_clock64() : 0ull;
#define PG8_STAMP() do { if (STAMP && wid == 0 && nts < 64) { const unsigned long long _c = (unsigned long long)clock64(); \
        ts_lo = (lane == nts) ? (int)(unsigned)_c : ts_lo; ts_hi = (lane == nts) ? (int)(unsigned)(_c >> 32) : ts_hi; ++nts; } } while (0)
    PG8_STAMP();
    unsigned voffA[2], voffB[2];
#pragma unroll
    for (int i = 0; i < 2; ++i) { int R, C; stage_rc(tid * 16 + i * 8192, R, C); const int Rb = Epi::PERM ? ((R & ~31) + perm32(R & 31)) : R;
        voffA[i] = (unsigned)(R * K + C) * 2u; voffB[i] = (unsigned)(Rb * K + C) * 2u; }
    const size_t kstep = (size_t)(BK * 2);
    const size_t hstep = (size_t)HALF * K * 2;
    const size_t tstep = 2 * hstep;
    const unsigned ldsw = (unsigned)wid * 1024u;
    const int aoff = lds_byte(wr * 64 + fr, fq * 8), boff = lds_byte(wc * 32 + fr, fq * 8);
#define PG8_SA(b, h) (((b) * 2 + (h)) * HTB)
#define PG8_SB(b, h) ((4 + (b) * 2 + (h)) * HTB)
#define PG8_STAGE(bufoff, gbase, voff) do { _Pragma("unroll") for (int _i = 0; _i < 2; ++_i) \
        __builtin_amdgcn_global_load_lds((const unsigned*)((const char*)(gbase) + (voff)[_i]), (PG8_LAS unsigned*)(lds + (bufoff) + ldsw + _i * 8192), 16, 0, 0); } while (0)
#define PG8_LDA(dst, b, h) do { _Pragma("unroll") for (int m = 0; m < 4; ++m) _Pragma("unroll") for (int k = 0; k < 2; ++k) dst[m][k] = *(const PG8_LAS bf16x8*)(lds + PG8_SA(b, h) + aoff + m * 2048 + k * 1024); } while (0)
#define PG8_LDB(dst, b, h) do { _Pragma("unroll") for (int n = 0; n < 2; ++n) _Pragma("unroll") for (int k = 0; k < 2; ++k) dst[n][k] = *(const PG8_LAS bf16x8*)(lds + PG8_SB(b, h) + boff + n * 2048 + k * 1024); } while (0)
#define PG8_MMA(ai, bj, At, Bt) do { __builtin_amdgcn_s_setprio(1); _Pragma("unroll") for (int m = 0; m < 4; ++m) _Pragma("unroll") for (int n = 0; n < 2; ++n) _Pragma("unroll") for (int k = 0; k < 2; ++k) \
        acc[ai][bj][m][n] = __builtin_amdgcn_mfma_f32_16x16x32_bf16(Bt[n][k], At[m][k], acc[ai][bj][m][n], 0, 0, 0); __builtin_amdgcn_s_setprio(0); } while (0)
#define PG8_WAIT_V(n) asm volatile("s_waitcnt vmcnt(" #n ")" ::: "memory")
#define PG8_WAIT_L(n) asm volatile("s_waitcnt lgkmcnt(" #n ")" ::: "memory")
#define PG8_BAR __builtin_amdgcn_s_barrier()
#define PG8_SCHED __builtin_amdgcn_sched_barrier(0)
    Unit cur, nxt; int ui = 0;
    if (!S.next(0, cur)) return;
    f32x4 acc[2][2][4][2];
#pragma unroll
    for (int a = 0; a < 2; ++a)
#pragma unroll
        for (int b = 0; b < 2; ++b)
#pragma unroll
            for (int m = 0; m < 4; ++m)
#pragma unroll
                for (int n = 0; n < 2; ++n) acc[a][b][m][n] = (f32x4){0.f, 0.f, 0.f, 0.f};
    bf16x8 At[4][2], B0[2][2], B1[2][2];
    const char* cA = (const char*)g.A + (size_t)cur.pm * tstep; const char* cB = (const char*)g.Bt + (size_t)cur.pn * tstep;
    S.a_ready(cur);
    PG8_STAGE(PG8_SB(0, 0), cB, voffB); PG8_STAGE(PG8_SA(0, 0), cA, voffA); PG8_STAGE(PG8_SB(0, 1), cB + hstep, voffB); PG8_STAGE(PG8_SA(0, 1), cA + hstep, voffA);
    if (wr == 1) PG8_BAR;
    PG8_WAIT_V(4); PG8_BAR;
    PG8_STAGE(PG8_SB(1, 0), cB + kstep, voffB); PG8_STAGE(PG8_SA(1, 0), cA + kstep, voffA); PG8_STAGE(PG8_SB(1, 1), cB + hstep + kstep, voffB);
    PG8_WAIT_V(6); PG8_BAR;
    PG8_STAMP();
    for (;;) {
        const bool has_next = S.next(ui + 1, nxt);
        const char* nA = has_next ? (const char*)g.A + (size_t)nxt.pm * tstep : cA; const char* nB = has_next ? (const char*)g.Bt + (size_t)nxt.pn * tstep : cB;
        for (int t = 0; t < nt; t += 2) {
            const bool last = (t == nt - 2);
            const char* a1 = cA + (size_t)(t + 1) * kstep;
            const char* a2 = last ? nA : cA + (size_t)(t + 2) * kstep; const char* b2 = last ? nB : cB + (size_t)(t + 2) * kstep;
            const char* a3 = a2 + kstep; const char* b3 = b2 + kstep;
            if (last && has_next) S.a_ready(nxt);
            PG8_LDB(B0, 0, 0); PG8_SCHED; PG8_LDA(At, 0, 0); PG8_STAGE(PG8_SA(1, 1), a1 + hstep, voffA);
            PG8_WAIT_L(8); PG8_BAR; PG8_WAIT_L(0); PG8_MMA(0, 0, At, B0); PG8_BAR; PG8_SCHED;
            PG8_LDB(B1, 0, 1); PG8_STAGE(PG8_SB(0, 0), b2, voffB);
            PG8_BAR; PG8_WAIT_L(0); PG8_MMA(0, 1, At, B1); PG8_BAR;
            PG8_LDA(At, 0, 1); PG8_STAGE(PG8_SA(0, 0), a2, voffA);
            PG8_BAR; PG8_WAIT_L(0); PG8_MMA(1, 0, At, B0); PG8_BAR; PG8_SCHED;
            PG8_STAGE(PG8_SB(0, 1), b2 + hstep, voffB);
            PG8_WAIT_V(6); PG8_BAR; PG8_MMA(1, 1, At, B1); PG8_BAR;
            PG8_LDB(B0, 1, 0); PG8_SCHED; PG8_LDA(At, 1, 0); PG8_STAGE(PG8_SA(0, 1), a2 + hstep, voffA);
            PG8_WAIT_L(8); PG8_BAR; PG8_WAIT_L(0); PG8_MMA(0, 0, At, B0); PG8_BAR; PG8_SCHED;
            PG8_LDB(B1, 1, 1); PG8_STAGE(PG8_SB(1, 0), b3, voffB);
            PG8_BAR; PG8_WAIT_L(0); PG8_MMA(0, 1, At, B1); PG8_BAR;
            PG8_LDA(At, 1, 1); PG8_STAGE(PG8_SA(1, 0), a3, voffA);
            PG8_BAR; PG8_WAIT_L(0); PG8_MMA(1, 0, At, B0); PG8_BAR; PG8_SCHED;
            PG8_STAGE(PG8_SB(1, 1), b3 + hstep, voffB);
            PG8_WAIT_V(6); PG8_BAR; PG8_MMA(1, 1, At, B1); PG8_BAR;
        }
        PG8_STAMP();
        if constexpr (!Epi::AFTER_DRAIN) { E(acc, cur, wr, wc, fr, fq); S.done(cur); }
        PG8_STAMP();
        if (!has_next) break;
#pragma unroll
        for (int a = 0; a < 2; ++a)
#pragma unroll
            for (int b = 0; b < 2; ++b)
#pragma unroll
                for (int m = 0; m < 4; ++m)
#pragma unroll
                    for (int n = 0; n < 2; ++n) acc[a][b][m][n] = (f32x4){0.f, 0.f, 0.f, 0.f};
        cur = nxt; cA = nA; cB = nB; ++ui;
    }
    PG8_WAIT_V(0);
    if (wr == 0) PG8_BAR;
    PG8_BAR;
    if constexpr (Epi::AFTER_DRAIN) { E.fused(acc, cur, wr, wc, fr, fq, lds, wid, lane); S.done(cur); }
    PG8_STAMP();
    if (STAMP && wid == 0) { stamps[lane] = lane < nts ? (((unsigned long long)(unsigned)ts_hi << 32) | (unsigned)ts_lo) : 0ull;
        if (lane == 62) stamps[62] = rt_entry; if (lane == 63) stamps[63] = (unsigned long long)wall_clock64(); }
#undef PG8_STAMP
#undef PG8_SA
#undef PG8_SB
#undef PG8_STAGE
#undef PG8_LDA
#undef PG8_LDB
#undef PG8_MMA
#undef PG8_WAIT_V
#undef PG8_WAIT_L
#undef PG8_BAR
#undef PG8_SCHED
}
}
#define XB_TMO      128
#define XB_XCNT(j)  (256  + 64 * (j))
#define XB_XSUB(j)  (1280 + 64 * (j))
#define XB_XGEN(j)  (2304 + 64 * (j))
#define XB_TOP      3328
#define XB_TOPGEN   3392
#define XCD_BAR_WORDS 3456
#define XB_SPIN_CAP (1u << 18)

__device__ __forceinline__ unsigned xb_ld(unsigned* p)              { return __hip_atomic_load(p, __ATOMIC_RELAXED, __HIP_MEMORY_SCOPE_AGENT); }
__device__ __forceinline__ unsigned xb_add(unsigned* p, unsigned v) { return __hip_atomic_fetch_add(p, v, __ATOMIC_RELAXED, __HIP_MEMORY_SCOPE_AGENT); }
__device__ __forceinline__ unsigned xb_xcc_id() { return (unsigned)__builtin_amdgcn_s_getreg((3 << 11) | 20) & 0xFu; }
#define XB_SPIN(cond, bar) do { unsigned _sp = 0; while (cond) { __builtin_amdgcn_s_sleep(1); \
    if ((++_sp & 255u) == 0u) { if (xb_ld(&(bar)[XB_TMO])) break; if (_sp > XB_SPIN_CAP) { atomicAdd(&(bar)[XB_TMO], 1u); break; } } } } while (0)

struct XcdBarrier {
    unsigned* bar; unsigned x;
    volatile LAS unsigned* st;
};

__device__ __forceinline__ XcdBarrier xcd_barrier_post(unsigned* bar, volatile LAS unsigned* st) {
    XcdBarrier b; b.bar = bar; b.x = xb_xcc_id(); b.st = st;
    if (threadIdx.x == 0) (void)xb_add(&bar[XB_XCNT(b.x)], 1u);
    return b;
}
__device__ __forceinline__ void xcd_barrier_complete(unsigned* bar, unsigned x, unsigned& nloc, unsigned& nx) {
    const unsigned G = gridDim.x * gridDim.y * gridDim.z;
    unsigned sum, cnt, mine, sp = 0u;
    for (;;) {
        sum = 0u; cnt = 0u; mine = 0u;
#pragma unroll
        for (unsigned j = 0; j < 16; ++j) { const unsigned c = xb_ld(&bar[XB_XCNT(j)]); sum += c; cnt += (c > 0u) ? 1u : 0u; mine = (j == x) ? c : mine; }
        if (sum == G) break;
        __builtin_amdgcn_s_sleep(1);
        if ((++sp & 255u) == 0u) { if (xb_ld(&bar[XB_TMO])) break; if (sp > XB_SPIN_CAP) { atomicAdd(&bar[XB_TMO], 1u); break; } }
    }
    nloc = mine > 0u ? mine : 1u; nx = cnt > 0u ? cnt : 1u;
}

__device__ __forceinline__ void xcd_barrier(const XcdBarrier& b) {
    asm volatile("s_waitcnt vmcnt(0)" ::: "memory");
    __syncthreads();
    if (threadIdx.x == 0) {
        unsigned* bar = b.bar;
        __builtin_amdgcn_s_waitcnt(0);
        unsigned nloc = b.st[0], nx = b.st[1];
        if (nloc == 0u) { xcd_barrier_complete(bar, b.x, nloc, nx); b.st[0] = nloc; b.st[1] = nx; }
        const unsigned old = xb_add(&bar[XB_XSUB(b.x)], 1u);
        const unsigned gen = old / nloc;
        if (old + 1u == (gen + 1u) * nloc) {
            __builtin_amdgcn_fence(__ATOMIC_RELEASE, "agent");
            asm volatile("s_waitcnt vmcnt(0)" ::: "memory");
            const unsigned og = xb_add(&bar[XB_TOP], 1u);
            const unsigned tg = og / nx;
            if (og + 1u == (tg + 1u) * nx) xb_add(&bar[XB_TOPGEN], 1u);
            else XB_SPIN(xb_ld(&bar[XB_TOPGEN]) == tg, bar);
            __builtin_amdgcn_fence(__ATOMIC_ACQUIRE, "agent");
            xb_add(&bar[XB_XGEN(b.x)], 1u);
            asm volatile("s_waitcnt vmcnt(0)" ::: "memory");
        } else {
            XB_SPIN(xb_ld(&bar[XB_XGEN(b.x)]) == gen, bar);
            __builtin_amdgcn_fence(__ATOMIC_ACQUIRE, "agent");
            asm volatile("s_waitcnt vmcnt(0)" ::: "memory");
        }
    }
    __syncthreads();
}

typedef unsigned short bf16_t;
typedef pg8::bf16x8 bf16x8;
typedef pg8::f32x4 f32x4;
typedef pg8::u32x4 u32x4;
typedef unsigned u32x2 __attribute__((ext_vector_type(2)));

constexpr int DM = 1024, NB = 16, SEQ = 2048, DEPTH = 4, CTXL = 256, DFF = 4096;
constexpr int ZW = 10752;
constexpr int INW = 10528;
constexpr int ZA_Q = 0, ZA_K = 512, ZA_V = 640, ZB_Q = 768, ZB_K = 1280, ZB_V = 1792, ZC_Q = 2304, ZC_FF = 2816, ZC_FB = 3328, ZC_I = 3840, ZC_G = 4352,
              ZD_Q = 4864, ZD_K = 5120, ZD_V = 5376, ZD_GK = 5888, ZD_G = 6016, ZMERGE = 6656;
constexpr int VTS = 2304;
constexpr int LDS_BYTES = 131072 + 1024;
constexpr float EPS = 1e-6f;

struct Params {
    const float *x, *c, *ctx, *c_ctx, *w_mod, *b_mod, *norm_gains, *w_in, *a_sink, *b_rel_bias, *c_lb, *c_norm, *d_gate_up, *d_gate_bias, *d_norm, *w_branch, *w_out, *w_ff1, *w_ff2;
    float* out;
    unsigned char* ws;
    unsigned long long o_mod, o_lb, o_rope, o_xc, o_win, o_wb, o_wo, o_w1, o_w2, o_h, o_z, o_y4, o_ob, o_vta, o_vtb;
    int GB, NGRP, MG, pad0;
};
typedef const Params __attribute__((address_space(4)))* PPtr;

__device__ __forceinline__ float bf2f(unsigned v) { return __uint_as_float(v << 16); }
__device__ __forceinline__ bf16_t f2bf(float f) { unsigned u = __float_as_uint(f); u += 0x7FFFu + ((u >> 16) & 1u); return (bf16_t)(u >> 16); }
typedef __bf16 bf16v2_t __attribute__((ext_vector_type(2)));
typedef float f32v2_t __attribute__((ext_vector_type(2)));
__device__ __forceinline__ unsigned pk2(float lo, float hi) { const f32v2_t v = {lo, hi}; const bf16v2_t b = __builtin_convertvector(v, bf16v2_t); return __builtin_bit_cast(unsigned, b); }
__device__ __forceinline__ float wave_sum(float v) {
#pragma unroll
    for (int o = 1; o < 64; o <<= 1) v += __shfl_xor(v, o);
    return v;
}
__device__ __forceinline__ float lo16(unsigned w) { return __uint_as_float(w << 16); }
__device__ __forceinline__ float hi16(unsigned w) { return __uint_as_float(w & 0xffff0000u); }
__device__ __forceinline__ float sigm(float x) { return 1.0f / (1.0f + __expf(-x)); }

__device__ __forceinline__ int src_col(int n) {
    if (n < 640) {
        const int p = n & 63, base = n - p, pp = p >> 1, wh = p & 1;
        const int dim = (pp < 16) ? (wh ? 16 + pp : pp) : (wh ? 48 + (pp - 16) : 32 + (pp - 16));
        return base + dim;
    }
    if (n < 5920) return n;
    if (n < 6016) return -1;
    if (n < 6528) return n - 96;
    if (n < 6656) return -1;
    return 6432 + (n - 6656);
}

__device__ __forceinline__ void conv_tile(const float* src, int Nsrc, int k0, int n0, bool inmap, bf16_t* dst, int Kd, LAS float* t) {
    const int tid = ltid(), nl = tid & 63, ks = tid >> 6;
    const int sc = inmap ? src_col(n0 + nl) : (n0 + nl);
#pragma unroll
    for (int i = 0; i < 8; ++i) { const int kk = ks + 8 * i; t[nl * 65 + kk] = (sc >= 0) ? src[(size_t)(k0 + kk) * Nsrc + sc] : 0.f; }
    __syncthreads();
    const int kl = (tid & 31) * 2, ns = tid >> 5;
#pragma unroll
    for (int i = 0; i < 4; ++i) { const int n = ns + 16 * i; *(unsigned*)(dst + (size_t)(n0 + n) * Kd + k0 + kl) = pk2(t[n * 65 + kl], t[n * 65 + kl + 1]); }
    __syncthreads();
}
__device__ __forceinline__ void convert_weights(PPtr p, int l, LAS unsigned char* lds) {
    LAS float* t = (LAS float*)lds;
    bf16_t* WinT = (bf16_t*)(p->ws + p->o_win); bf16_t* WbT = (bf16_t*)(p->ws + p->o_wb); bf16_t* WoT = (bf16_t*)(p->ws + p->o_wo);
    bf16_t* W1T = (bf16_t*)(p->ws + p->o_w1); bf16_t* W2T = (bf16_t*)(p->ws + p->o_w2);
    constexpr int T_IN = 16 * 168, T_BR = 4 * 8 * 16, T_O = 16 * 16, T_1 = 16 * 64, T_2 = 64 * 16, T_ALL = T_IN + T_BR + T_O + T_1 + T_2;
    for (int it = blockIdx.x; it < T_ALL; it += gridDim.x) {
        int r = it;
        if (r < T_IN) { const int kb = r / 168, nb = r % 168; conv_tile(p->w_in + (size_t)l * 1024 * INW, INW, kb * 64, nb * 64, true, WinT, 1024, t); continue; } r -= T_IN;
        if (r < T_BR) { const int j = r / 128, q = r % 128, kb = q / 16, nb = q % 16; conv_tile(p->w_branch + (size_t)(l * 4 + j) * 512 * 1024, 1024, kb * 64, nb * 64, false, WbT + (size_t)j * 1024 * 512, 512, t); continue; } r -= T_BR;
        if (r < T_O) { const int kb = r / 16, nb = r % 16; conv_tile(p->w_out + (size_t)l * 1024 * 1024, 1024, kb * 64, nb * 64, false, WoT, 1024, t); continue; } r -= T_O;
        if (r < T_1) { const int kb = r / 64, nb = r % 64; conv_tile(p->w_ff1 + (size_t)l * 1024 * 4096, 4096, kb * 64, nb * 64, false, W1T, 1024, t); continue; } r -= T_1;
        { const int kb = r / 16, nb = r % 16; conv_tile(p->w_ff2 + (size_t)l * 4096 * 1024, 1024, kb * 64, nb * 64, false, W2T, 4096, t); }
    }
}

__device__ __forceinline__ void prologue(PPtr p, LAS unsigned char* lds) {
    const int tid = ltid();
    if (blockIdx.x == 0) {
        if (tid < 64) atomicExch((unsigned*)p->ws + tid, 0u);
        for (int i = tid; i < XCD_BAR_WORDS; i += 512) __hip_atomic_store((unsigned*)(p->ws + 4096) + i, 0u, __ATOMIC_RELAXED, __HIP_MEMORY_SCOPE_AGENT);
    }
    if (tid < 4) *((LAS unsigned*)(lds + 131072 + 64) + tid) = 0u;
    float* modb = (float*)(p->ws + p->o_mod);
    LAS float* sl = (LAS float*)lds;
    LAS float* red = sl + 17 * 1024;
    bool loaded = false;
    for (int task = blockIdx.x; task < 192; task += gridDim.x) {
        if (!loaded) {
            for (int i = tid; i < 17 * 1024; i += 512) { const int b = i >> 10, k = i & 1023; const float v = (b < 16) ? p->c[b * 1024 + k] : p->c_ctx[k]; sl[i] = v * sigm(v); }
            loaded = true;
        }
        __syncthreads();
        const int l = task / 48, nc = task % 48, nn = tid & 127, n = nc * 128 + nn, kq = tid >> 7;
        float acc[17];
#pragma unroll
        for (int b = 0; b < 17; ++b) acc[b] = 0.f;
        const float* w = p->w_mod + ((size_t)l * 1024 + kq * 256) * 6144 + n;
#pragma unroll 4
        for (int k = 0; k < 256; ++k) {
            const float wv = w[(size_t)k * 6144];
#pragma unroll
            for (int b = 0; b < 17; ++b) acc[b] += sl[b * 1024 + kq * 256 + k] * wv;
        }
#pragma unroll
        for (int b = 0; b < 17; ++b) red[(kq * 17 + b) * 128 + nn] = acc[b];
        __syncthreads();
        if (kq == 0) {
            const float bm = p->b_mod[l * 6144 + n];
#pragma unroll
            for (int b = 0; b < 17; ++b) modb[((size_t)l * 17 + b) * 6144 + n] = red[b * 128 + nn] + red[(17 + b) * 128 + nn] + red[(34 + b) * 128 + nn] + red[(51 + b) * 128 + nn] + bm;
        }
        __syncthreads();
    }
    if (blockIdx.x == gridDim.x - 1) {
        float* lb = (float*)(p->ws + p->o_lb);
        {
            const int ch = tid;
            float v[4], mx = -1e30f;
#pragma unroll
            for (int l = 0; l < 4; ++l) { v[l] = p->c_lb[l * 512 + ch]; mx = fmaxf(mx, v[l]); }
            float s = 0.f;
#pragma unroll
            for (int l = 0; l < 4; ++l) { v[l] = __expf(v[l] - mx); s += v[l]; }
            const float inv = 1.0f / s, s0 = v[0] * inv; float cum = 0.f;
#pragma unroll
            for (int l = 0; l < 4; ++l) { cum += v[l] * inv; lb[l * 512 + ch] = cum - s0; }
        }
        float* rt = (float*)(p->ws + p->o_rope);
        for (int i = tid; i < 1024; i += 512) {
            const int n = i >> 4, f = i & 15;
            const float inv = __expf(-((float)(2 * f) / 32.0f) * 9.210340371976184f);
            const float a = (float)n * inv;
            const float kf = rintf(a * 0.15915494309189535f);
            const float rr = fmaf(-kf, 6.2831854820251465f, a) + kf * 1.7484556e-7f;
            rt[i] = __cosf(rr); rt[1024 + i] = __sinf(rr);
        }
    }
    __syncthreads();
    convert_weights(p, 0, lds);
}

__device__ __forceinline__ void rowpass(PPtr p, int l, int g, int mode, int nrows) {
    const int lane = ltid() & 63, gw = blockIdx.x * 8 + (ltid() >> 6), NGW = gridDim.x * 8;
    const int LATR = p->GB * 2048;
    const float* ng = p->norm_gains + (size_t)l * 4 * 1024;
    const float* modb = (const float*)(p->ws + p->o_mod) + (size_t)l * 17 * 6144;
    bf16_t* hb = (bf16_t*)(p->ws + p->o_h);
    const float* yf = (const float*)(p->ws + p->o_z);
    float* xcb = (float*)(p->ws + p->o_xc);
    for (int row = gw; row < nrows; row += NGW) {
        const bool lat = row < LATR;
        int b; size_t xrow;
        if (lat) { b = g * p->GB + (row >> 11); xrow = (size_t)b * 2048 + (row & 2047); }
        else { const int r2 = row - LATR; b = g * p->GB + (r2 >> 8); xrow = (size_t)b * 256 + (r2 & 255); }
        const bool first = (l == 0 && mode <= 2);
        const float* xs = (lat ? (first ? p->x : (const float*)p->out) : (first ? p->ctx : (const float*)xcb)) + xrow * 1024;
        float* xd = (lat ? p->out : xcb) + xrow * 1024;
        const float* m = modb + (size_t)(lat ? b : 16) * 6144;
        f32x4 xv[4];
#pragma unroll
        for (int j = 0; j < 4; ++j) xv[j] = *(const f32x4*)(xs + lane * 4 + 256 * j);
        if (mode >= 2) {
            f32x4 yv[4]; float ss = 0.f;
#pragma unroll
            for (int j = 0; j < 4; ++j) { yv[j] = *(const f32x4*)(yf + (size_t)row * 1024 + lane * 4 + 256 * j); ss += yv[j].x * yv[j].x + yv[j].y * yv[j].y + yv[j].z * yv[j].z + yv[j].w * yv[j].w; }
            ss = wave_sum(ss);
            const float rs = rsqrtf(ss * (1.0f / 1024.0f) + EPS);
            const float* gate = m + (mode == 2 ? 2048 : 5120); const float* gn = ng + (mode == 2 ? 1024 : 3072);
#pragma unroll
            for (int j = 0; j < 4; ++j) {
                const int c = lane * 4 + 256 * j;
                const f32x4 gv = *(const f32x4*)(gate + c), nv = *(const f32x4*)(gn + c);
                xv[j] = xv[j] + gv * (yv[j] * rs * nv);
                *(f32x4*)(xd + c) = xv[j];
            }
        }
        if (mode <= 2) {
            float ss = 0.f;
#pragma unroll
            for (int j = 0; j < 4; ++j) ss += xv[j].x * xv[j].x + xv[j].y * xv[j].y + xv[j].z * xv[j].z + xv[j].w * xv[j].w;
            ss = wave_sum(ss);
            const float rs = rsqrtf(ss * (1.0f / 1024.0f) + EPS);
            const float* sh = m + (mode == 1 ? 0 : 3072); const float* sc = m + (mode == 1 ? 1024 : 4096); const float* gn = ng + (mode == 1 ? 0 : 2048);
#pragma unroll
            for (int j = 0; j < 4; ++j) {
                const int c = lane * 4 + 256 * j;
                const f32x4 shv = *(const f32x4*)(sh + c), scv = *(const f32x4*)(sc + c), nv = *(const f32x4*)(gn + c);
                const f32x4 hv = (xv[j] * rs * nv) * (scv + 1.0f) + shv;
                u32x2 o; o.x = pk2(hv.x, hv.y); o.y = pk2(hv.z, hv.w);
                *(u32x2*)(hb + (size_t)row * 1024 + c) = o;
            }
        }
    }
}

struct EpiInproj {
    static constexpr bool PERM = true, AFTER_DRAIN = false;
    bf16_t* Z; bf16_t* vta; bf16_t* vtb; const float* rope; int GB;
    __device__ __forceinline__ void operator()(const f32x4 (&acc)[2][2][4][2], const pg8::Unit& u, int wr, int wc, int fr, int fq) const {
        const int row0 = u.pm * 256 + wr * 64 + fr, LATR = GB * 2048;
#pragma unroll
        for (int bj = 0; bj < 2; ++bj) {
            const int seg = u.pn * 2 + bj, c0 = u.pn * 256 + bj * 128 + wc * 32 + 8 * fq;
            const int type = (seg <= 4) ? 1 : (seg == 5 ? 2 : ((seg >= 14 && seg <= 17) ? 3 : 0));
#pragma unroll
            for (int ai = 0; ai < 2; ++ai)
#pragma unroll
                for (int m = 0; m < 4; ++m) {
                    const int row = row0 + ai * 128 + m * 16;
                    f32x4 v0 = acc[ai][bj][m][0], v1 = acc[ai][bj][m][1];
                    if (type <= 1) {
                        if (type == 1 && row < LATR) {
                            const int t = row & 2047, pp0 = (c0 & 63) >> 1;
                            const int n = (pp0 < 16) ? (t >> 6) : (t & 63);
                            const float* cs = rope + n * 16 + (pp0 & 15);
                            const f32x4 cv = *(const f32x4*)cs, sv = *(const f32x4*)(cs + 1024);
                            f32x4 r0, r1;
                            r0.x = v0.x * cv.x - v0.y * sv.x; r0.y = v0.y * cv.x + v0.x * sv.x;
                            r0.z = v0.z * cv.y - v0.w * sv.y; r0.w = v0.w * cv.y + v0.z * sv.y;
                            r1.x = v1.x * cv.z - v1.y * sv.z; r1.y = v1.y * cv.z + v1.x * sv.z;
                            r1.z = v1.z * cv.w - v1.w * sv.w; r1.w = v1.w * cv.w + v1.z * sv.w;
                            v0 = r0; v1 = r1;
                        }
                        u32x4 w; w.x = pk2(v0.x, v0.y); w.y = pk2(v0.z, v0.w); w.z = pk2(v1.x, v1.y); w.w = pk2(v1.z, v1.w);
                        *(u32x4*)(Z + (size_t)row * ZW + c0) = w;
                    } else {
                        int bl, tok;
                        if (row < LATR) { bl = row >> 11; tok = row & 2047; } else { const int r2 = row - LATR; bl = r2 >> 8; tok = 2048 + (r2 & 255); }
                        const int cc = c0 - (type == 2 ? ZA_V : ZB_V), head = cc >> 6, dim0 = cc & 63, H = (type == 2) ? 2 : 8;
                        bf16_t* base = (type == 2 ? vta : vtb) + ((size_t)(bl * H + head) * 64 + dim0) * VTS + tok;
                        base[0 * VTS] = f2bf(v0.x); base[1 * VTS] = f2bf(v0.y); base[2 * VTS] = f2bf(v0.z); base[3 * VTS] = f2bf(v0.w);
                        base[4 * VTS] = f2bf(v1.x); base[5 * VTS] = f2bf(v1.y); base[6 * VTS] = f2bf(v1.z); base[7 * VTS] = f2bf(v1.w);
                    }
                }
        }
    }
};
struct EpiBranch {
    static constexpr bool PERM = true, AFTER_DRAIN = false;
    const bf16_t* Z; bf16_t* macc; int nMfull;
    __device__ __forceinline__ void operator()(const f32x4 (&acc)[2][2][4][2], const pg8::Unit& u, int wr, int wc, int fr, int fq) const {
        const int j = u.pm / nMfull, pm = u.pm - j * nMfull, pn = u.pn & 3;
        const int row0 = pm * 256 + wr * 64 + fr, col0 = pn * 256 + wc * 32 + 8 * fq;
#pragma unroll
        for (int ai = 0; ai < 2; ++ai)
#pragma unroll
            for (int m = 0; m < 4; ++m) {
                const int row = row0 + ai * 128 + m * 16;
#pragma unroll
                for (int bj = 0; bj < 2; ++bj) {
                    const int col = col0 + bj * 128;
                    const u32x4 gw = *(const u32x4*)(Z + (size_t)row * ZW + ZMERGE + j * 1024 + col);
                    const f32x4 v0 = acc[ai][bj][m][0], v1 = acc[ai][bj][m][1];
                    float t0 = v0.x * sigm(lo16(gw.x)), t1 = v0.y * sigm(hi16(gw.x)), t2 = v0.z * sigm(lo16(gw.y)), t3 = v0.w * sigm(hi16(gw.y));
                    float t4 = v1.x * sigm(lo16(gw.z)), t5 = v1.y * sigm(hi16(gw.z)), t6 = v1.z * sigm(lo16(gw.w)), t7 = v1.w * sigm(hi16(gw.w));
                    bf16_t* dst = macc + (size_t)row * 1024 + col;
                    if (j > 0) {
                        const u32x4 pv = *(const u32x4*)dst;
                        t0 += lo16(pv.x); t1 += hi16(pv.x); t2 += lo16(pv.y); t3 += hi16(pv.y); t4 += lo16(pv.z); t5 += hi16(pv.z); t6 += lo16(pv.w); t7 += hi16(pv.w);
                    }
                    u32x4 w; w.x = pk2(t0, t1); w.y = pk2(t2, t3); w.z = pk2(t4, t5); w.w = pk2(t6, t7);
                    *(u32x4*)dst = w;
                }
            }
    }
};
struct BranchOrder {
    int nM, nMfull, G, c;
    __device__ __forceinline__ bool next(int i, pg8::Unit& u) const {
        const int j = i & 3; const long T = (long)(i >> 2) * G + c;
        if (T >= (long)nM * 4) return false;
        u.pm = j * nMfull + (int)(T >> 2); u.pn = j * 4 + (int)(T & 3); return true;
    }
    __device__ __forceinline__ void a_ready(const pg8::Unit&) const {}
    __device__ __forceinline__ void done(const pg8::Unit&) const {}
};
struct EpiRelu2 {
    static constexpr bool PERM = true, AFTER_DRAIN = false;
    bf16_t* O; int ldc;
    __device__ __forceinline__ void operator()(const f32x4 (&acc)[2][2][4][2], const pg8::Unit& u, int wr, int wc, int fr, int fq) const {
        const int row0 = u.pm * 256 + wr * 64 + fr, col0 = u.pn * 256 + wc * 32 + 8 * fq;
#pragma unroll
        for (int ai = 0; ai < 2; ++ai)
#pragma unroll
            for (int m = 0; m < 4; ++m) {
                bf16_t* rowp = O + (size_t)(row0 + ai * 128 + m * 16) * ldc + col0;
#pragma unroll
                for (int bj = 0; bj < 2; ++bj) {
                    f32x4 v0 = acc[ai][bj][m][0], v1 = acc[ai][bj][m][1];
#pragma unroll
                    for (int e = 0; e < 4; ++e) { const float a = fmaxf(v0[e], 0.f), b = fmaxf(v1[e], 0.f); v0[e] = a * a; v1[e] = b * b; }
                    u32x4 w; w.x = pk2(v0.x, v0.y); w.y = pk2(v0.z, v0.w); w.z = pk2(v1.x, v1.y); w.w = pk2(v1.z, v1.w);
                    *(u32x4*)(rowp + bj * 128) = w;
                }
            }
    }
};

#define MFMA16(a, b, c) __builtin_amdgcn_mfma_f32_16x16x32_bf16((a), (b), (c), 0, 0, 0)
__device__ __forceinline__ void attn_wave(PPtr p, int l, int kind, int idx, int lane, const LAS float* biasL) {
    const int fr = lane & 15, fq = lane >> 4;
    const int LATR = p->GB * 2048, MG = p->MG;
    const bf16_t* Z = (const bf16_t*)(p->ws + p->o_z);
    const bool isA = (kind == 1 || kind == 2);
    int bl, hk, qrow0, r = 0, q0 = 0;
    if (kind == 0) { bl = idx >> 8; hk = (idx >> 5) & 7; r = idx & 31; qrow0 = bl * 2048 + r * 64; }
    else if (kind == 1) { bl = idx >> 8; hk = (idx >> 7) & 1; q0 = (idx & 127) * 16; qrow0 = bl * 2048 + q0; }
    else if (kind == 2) { bl = idx >> 5; hk = (idx >> 4) & 1; qrow0 = LATR + bl * 256 + (idx & 15) * 16; }
    else { bl = idx >> 5; hk = (idx >> 2) & 7; qrow0 = LATR + bl * 256 + (idx & 3) * 64; }
    const int qrstep = isA ? 0 : 16, qcstep = isA ? 64 : 0;
    const int qcol0 = isA ? (ZA_Q + hk * 4 * 64) : (ZB_Q + hk * 64);
    const int kcol = isA ? (ZA_K + hk * 64) : (ZB_K + hk * 64);
    const bf16_t* vt = isA ? ((const bf16_t*)(p->ws + p->o_vta) + (size_t)(bl * 2 + hk) * 64 * VTS) : ((const bf16_t*)(p->ws + p->o_vtb) + (size_t)(bl * 8 + hk) * 64 * VTS);
    bf16_t* yo = (bf16_t*)(p->ws + p->o_y4) + (isA ? (size_t)0 : (size_t)MG * 512);
    const int ocol0 = isA ? hk * 4 * 64 : hk * 64;
    const int krow_ctx0 = LATR + bl * 256, krow_lat0 = bl * 2048;
    const float scale = 0.125f;

    bf16x8 Q[4][2];
#pragma unroll
    for (int s = 0; s < 4; ++s)
#pragma unroll
        for (int ks = 0; ks < 2; ++ks) Q[s][ks] = *(const bf16x8*)(Z + (size_t)(qrow0 + s * qrstep + fr) * ZW + qcol0 + s * qcstep + ks * 32 + fq * 8);
    f32x4 O[4][4]; float mrun[4], lrun[4];
#pragma unroll
    for (int s = 0; s < 4; ++s) { mrun[s] = -1e30f; lrun[s] = 0.f;
#pragma unroll
        for (int dt = 0; dt < 4; ++dt) O[s][dt] = (f32x4){0.f, 0.f, 0.f, 0.f}; }

    auto do_block = [&](int krow, int vtoff, int mode, int a0, int a1) {
        bf16x8 Kf[2][2];
#pragma unroll
        for (int kt = 0; kt < 2; ++kt)
#pragma unroll
            for (int ks = 0; ks < 2; ++ks) Kf[kt][ks] = *(const bf16x8*)(Z + (size_t)(krow + kt * 16 + fr) * ZW + kcol + ks * 32 + fq * 8);
        bf16x8 Vf[4];
#pragma unroll
        for (int dt = 0; dt < 4; ++dt) {
            const bf16_t* vp = vt + (size_t)(dt * 16 + fr) * VTS + vtoff + fq * 4;
            const u32x2 lo = *(const u32x2*)vp, hi = *(const u32x2*)(vp + 16);
            u32x4 w; w.x = lo.x; w.y = lo.y; w.z = hi.x; w.w = hi.y;
            Vf[dt] = __builtin_bit_cast(bf16x8, w);
        }
#pragma unroll
        for (int s = 0; s < 4; ++s) {
            const bool active = (mode != 2) || !((s == 0 && a1 == 1) || (s == 3 && a1 == 0));
            if (active) {
                f32x4 S0 = (f32x4){0.f, 0.f, 0.f, 0.f}, S1 = (f32x4){0.f, 0.f, 0.f, 0.f};
                S0 = MFMA16(Kf[0][0], Q[s][0], S0); S0 = MFMA16(Kf[0][1], Q[s][1], S0);
                S1 = MFMA16(Kf[1][0], Q[s][0], S1); S1 = MFMA16(Kf[1][1], Q[s][1], S1);
                float sc[8];
#pragma unroll
                for (int j = 0; j < 4; ++j) { sc[j] = S0[j] * scale; sc[4 + j] = S1[j] * scale; }
                if (mode == 1) {
                    const int qpos = q0 + fr;
#pragma unroll
                    for (int e = 0; e < 8; ++e) { const int kpos = a0 + (e >> 2) * 16 + fq * 4 + (e & 3); const int d = kpos - qpos; if (d > 128 || d < -128) sc[e] = -1e30f; }
                } else if (mode == 2) {
                    const int qc = 16 * s + fr; const int cs = min(max(qc - 8, 0), 48);
                    const LAS float* bp = biasL + hk * 465 + a0 * 31;
#pragma unroll
                    for (int e = 0; e < 8; ++e) {
                        const int kc = a1 * 32 + (e >> 2) * 16 + fq * 4 + (e & 3);
                        const int dc = min(max(kc - qc + 15, 0), 30);
                        const float bv = bp[dc];
                        sc[e] = (kc >= cs && kc < cs + 16) ? (sc[e] + bv) : -1e30f;
                    }
                }
                float ml = fmaxf(fmaxf(fmaxf(sc[0], sc[1]), fmaxf(sc[2], sc[3])), fmaxf(fmaxf(sc[4], sc[5]), fmaxf(sc[6], sc[7])));
                ml = fmaxf(ml, __shfl_xor(ml, 16)); ml = fmaxf(ml, __shfl_xor(ml, 32));
                const float mn = fmaxf(mrun[s], ml), alpha = __expf(mrun[s] - mn);
                mrun[s] = mn;
                float pv[8], ls = 0.f;
#pragma unroll
                for (int e = 0; e < 8; ++e) { pv[e] = __expf(sc[e] - mn); ls += pv[e]; }
                ls += __shfl_xor(ls, 16); ls += __shfl_xor(ls, 32);
                lrun[s] = lrun[s] * alpha + ls;
                u32x4 pw; pw.x = pk2(pv[0], pv[1]); pw.y = pk2(pv[2], pv[3]); pw.z = pk2(pv[4], pv[5]); pw.w = pk2(pv[6], pv[7]);
                const bf16x8 P = __builtin_bit_cast(bf16x8, pw);
#pragma unroll
                for (int dt = 0; dt < 4; ++dt) { O[s][dt] = O[s][dt] * alpha; O[s][dt] = MFMA16(Vf[dt], P, O[s][dt]); }
            }
            __builtin_amdgcn_sched_barrier(0);
        }
    };
    int nloc = 0, lo = 0, r0 = 0;
    if (kind == 1) { lo = max(0, q0 - 128) & ~31; const int hi = min(2048, (q0 + 16 + 128 + 31) & ~31); nloc = (hi - lo) >> 5; }
    else if (kind == 0) { r0 = min(max(r - 4, 0), 24); nloc = 16; }
#pragma unroll 1
    for (int i = 0; i < 8 + nloc; ++i) {
        int krow, vtoff, mode, a0, a1;
        if (i < 8) { krow = krow_ctx0 + 32 * i; vtoff = 2048 + 32 * i; mode = 0; a0 = 0; a1 = 0; }
        else if (kind == 1) { const int kb = lo + 32 * (i - 8); krow = krow_lat0 + kb; vtoff = kb; mode = 1; a0 = kb; a1 = 0; }
        else { const int jj = i - 8, kr = r0 + (jj >> 1), hb = jj & 1; krow = krow_lat0 + kr * 64 + hb * 32; vtoff = kr * 64 + hb * 32; mode = 2; a0 = kr - r + 7; a1 = hb; }
        do_block(krow, vtoff, mode, a0, a1);
    }
#pragma unroll
    for (int s = 0; s < 4; ++s) {
        float fac;
        if (isA) { const float sk = p->a_sink[l * 8 + hk * 4 + s]; const float M = fmaxf(mrun[s], sk); const float e1 = __expf(mrun[s] - M); fac = e1 / (lrun[s] * e1 + __expf(sk - M)); }
        else fac = 1.0f / lrun[s];
        bf16_t* op = yo + (size_t)(qrow0 + s * qrstep + fr) * 512 + ocol0 + s * qcstep + fq * 4;
#pragma unroll
        for (int dt = 0; dt < 4; ++dt) { const f32x4 o = O[s][dt] * fac; u32x2 w; w.x = pk2(o.x, o.y); w.y = pk2(o.z, o.w); *(u32x2*)(op + dt * 16) = w; }
    }
}

template <int DK, bool ISC>
__device__ __forceinline__ void scan_task(PPtr p, int l, int bl, int h, int dir, LAS unsigned char* lds) {
    constexpr int KPW = DK / 8, NTG = 64 / KPW, TPG = 32 / NTG, QS = (DK + 8) * 2, NKT = DK / 16;
    const int tid = ltid(), w = tid >> 6, lane = tid & 63, fr = lane & 15, fq = lane >> 4;
    const int kl = lane % KPW, tg = lane / KPW, kch = w * KPW + kl;
    const int vcol = tid & 127, vg = tid >> 7;
    LAS unsigned char* qt = lds; LAS unsigned char* kt_ = qt + 32 * QS; LAS unsigned char* khT = kt_ + 32 * QS; LAS unsigned char* vT = khT + DK * 80;
    LAS unsigned char* att = vT + 128 * 80; LAS float* dvec = (LAS float*)(att + 32 * 80); LAS float* evec = dvec + DK;
    const bf16_t* Z = (const bf16_t*)(p->ws + p->o_z);
    const int LATR = p->GB * 2048, MG = p->MG;
    const int qc = ISC ? (ZC_Q + h * 128 + kch) : (ZD_Q + h * 64 + kch);
    const int kc = ISC ? ((dir ? ZC_FB : ZC_FF) + h * 128 + kch) : (ZD_K + h * 64 + kch);
    const int vc = (ISC ? ZC_I : ZD_V) + h * 128 + vcol;
    const int gcol = ZD_GK + dir * 16;
    float lbv = 0.f, oml = 1.f, up[16], gb = 0.f;
#pragma unroll
    for (int r = 0; r < 16; ++r) up[r] = 0.f;
    if (ISC) { lbv = ((const float*)(p->ws + p->o_lb))[l * 512 + h * 128 + kch]; oml = 1.0f - lbv; }
    else {
#pragma unroll
        for (int r = 0; r < 16; ++r) up[r] = p->d_gate_up[((size_t)(l * 2 + dir) * 16 + r) * 256 + h * 64 + kch];
        gb = p->d_gate_bias[(l * 2 + dir) * 256 + h * 64 + kch];
    }
    bf16_t* odst = (dir == 0) ? ((bf16_t*)(p->ws + p->o_y4) + (size_t)(ISC ? 2 : 3) * MG * 512) : ((bf16_t*)(p->ws + p->o_ob) + (size_t)(ISC ? 0 : 1) * MG * 512);
    f32x4 S[NKT];
#pragma unroll
    for (int i = 0; i < NKT; ++i) S[i] = (f32x4){0.f, 0.f, 0.f, 0.f};
    auto rowof = [&](int cc, int i) -> int {
        const bool isctx = cc < 8; const int L = isctx ? 256 : 2048, base = isctx ? (LATR + bl * 256) : (bl * 2048), c = isctx ? cc : cc - 8;
        const int pos = c * 32 + i; return base + (dir ? (L - 1 - pos) : pos);
    };
    bf16_t rq[TPG], rk[TPG], rv[8]; u32x4 rz[TPG][2];
    auto load_raw = [&](int cc) {
#pragma unroll
        for (int e = 0; e < TPG; ++e) {
            const bf16_t* zr = Z + (size_t)rowof(cc, tg * TPG + e) * ZW;
            rq[e] = zr[qc]; rk[e] = zr[kc];
            if (!ISC) { rz[e][0] = *(const u32x4*)(zr + gcol); rz[e][1] = *(const u32x4*)(zr + gcol + 8); }
        }
#pragma unroll
        for (int e = 0; e < 8; ++e) rv[e] = Z[(size_t)rowof(cc, vg * 8 + e) * ZW + vc];
    };
    load_raw(0);
    for (int cc = 0; cc < 72; ++cc) {
        __syncthreads();
        {
            float gq[TPG], gk[TPG], cum[TPG]; float run = 0.f;
#pragma unroll
            for (int e = 0; e < TPG; ++e) {
                const float zq = bf2f(rq[e]), zk = bf2f(rk[e]); float g, key, q;
                if (ISC) { const float sg = sigm(zk); g = __logf(lbv + oml * sg); key = oml * (1.0f - sg); q = zq * sigm(zq); }
                else {
                    float a = gb;
                    const u32x4 z0 = rz[e][0], z1 = rz[e][1];
                    a += lo16(z0.x) * up[0] + hi16(z0.x) * up[1] + lo16(z0.y) * up[2] + hi16(z0.y) * up[3] + lo16(z0.z) * up[4] + hi16(z0.z) * up[5] + lo16(z0.w) * up[6] + hi16(z0.w) * up[7];
                    a += lo16(z1.x) * up[8] + hi16(z1.x) * up[9] + lo16(z1.y) * up[10] + hi16(z1.y) * up[11] + lo16(z1.z) * up[12] + hi16(z1.z) * up[13] + lo16(z1.w) * up[14] + hi16(z1.w) * up[15];
                    g = (fminf(a, 0.f) - __logf(1.0f + __expf(-fabsf(a)))) * (1.0f / 16.0f); key = zk; q = zq * 0.125f;
                }
                run += g; cum[e] = run; gq[e] = q; gk[e] = key;
            }
            float pre = 0.f, total = 0.f, cref = 0.f;
#pragma unroll
            for (int t = 0; t < NTG; ++t) { const float tt = __shfl(run, kl + KPW * t); if (t < tg) pre += tt; if (t < NTG / 2) cref += tt; total += tt; }
            float khv[TPG];
#pragma unroll
            for (int e = 0; e < TPG; ++e) {
                const float c = cum[e] + pre; const int i = tg * TPG + e;
                *(LAS bf16_t*)(qt + i * QS + kch * 2) = f2bf(gq[e] * __expf(c - cref));
                *(LAS bf16_t*)(kt_ + i * QS + kch * 2) = f2bf(gk[e] * __expf(cref - c));
                khv[e] = gk[e] * __expf(total - c);
            }
            if constexpr (TPG == 8) { u32x4 o; o.x = pk2(khv[0], khv[1]); o.y = pk2(khv[2], khv[3]); o.z = pk2(khv[4], khv[5]); o.w = pk2(khv[6], khv[7]); *(LAS u32x4*)(khT + kch * 80 + tg * 16) = o; }
            else { u32x2 o; o.x = pk2(khv[0], khv[1]); o.y = pk2(khv[2], khv[3]); *(LAS u32x2*)(khT + kch * 80 + tg * 8) = o; }
            if (tg == 0) { dvec[kch] = __expf(total); evec[kch] = __expf(cref); }
            u32x4 vo; vo.x = (unsigned)rv[0] | ((unsigned)rv[1] << 16); vo.y = (unsigned)rv[2] | ((unsigned)rv[3] << 16); vo.z = (unsigned)rv[4] | ((unsigned)rv[5] << 16); vo.w = (unsigned)rv[6] | ((unsigned)rv[7] << 16);
            *(LAS u32x4*)(vT + vcol * 80 + vg * 16) = vo;
        }
        if (cc + 1 < 72) load_raw(cc + 1);
        __syncthreads();
        if (w < 3) {
            const int tt = (w == 0) ? 0 : 1, st = (w == 2) ? 1 : 0;
            f32x4 a = (f32x4){0.f, 0.f, 0.f, 0.f};
#pragma unroll
            for (int ks = 0; ks < DK / 32; ++ks) {
                const bf16x8 A = *(const LAS bf16x8*)(qt + (tt * 16 + fr) * QS + (ks * 32 + fq * 8) * 2);
                const bf16x8 B = *(const LAS bf16x8*)(kt_ + (st * 16 + fr) * QS + (ks * 32 + fq * 8) * 2);
                a = MFMA16(A, B, a);
            }
#pragma unroll
            for (int j = 0; j < 4; ++j) { const int t = tt * 16 + fq * 4 + j, s = st * 16 + fr; *(LAS bf16_t*)(att + t * 80 + s * 2) = f2bf(s <= t ? a[j] : 0.f); }
        } else if (w == 3) {
#pragma unroll
            for (int j = 0; j < 4; ++j) { const int t = fq * 4 + j, s = 16 + fr; *(LAS bf16_t*)(att + t * 80 + s * 2) = (bf16_t)0; }
        }
        __syncthreads();
        {
            const int vs = w * 16;
            const bf16x8 Bv = *(const LAS bf16x8*)(vT + (vs + fr) * 80 + fq * 16);
            bf16x8 Sb[NKT / 2];
#pragma unroll
            for (int kp = 0; kp < NKT / 2; ++kp) {
                const f32x4 e0 = *(const LAS f32x4*)(evec + (2 * kp) * 16 + fq * 4), e1 = *(const LAS f32x4*)(evec + (2 * kp + 1) * 16 + fq * 4);
                const f32x4 s0 = S[2 * kp] * e0, s1 = S[2 * kp + 1] * e1;
                u32x4 sw; sw.x = pk2(s0.x, s0.y); sw.y = pk2(s0.z, s0.w); sw.z = pk2(s1.x, s1.y); sw.w = pk2(s1.z, s1.w);
                Sb[kp] = __builtin_bit_cast(bf16x8, sw);
            }
#pragma unroll
            for (int tt = 0; tt < 2; ++tt) {
                f32x4 o = (f32x4){0.f, 0.f, 0.f, 0.f};
#pragma unroll
                for (int kp = 0; kp < NKT / 2; ++kp) {
                    const u32x2 lo = *(const LAS u32x2*)(qt + (tt * 16 + fr) * QS + ((2 * kp) * 16 + fq * 4) * 2);
                    const u32x2 hi = *(const LAS u32x2*)(qt + (tt * 16 + fr) * QS + ((2 * kp + 1) * 16 + fq * 4) * 2);
                    u32x4 aw; aw.x = lo.x; aw.y = lo.y; aw.z = hi.x; aw.w = hi.y;
                    o = MFMA16(__builtin_bit_cast(bf16x8, aw), Sb[kp], o);
                }
                const bf16x8 A2 = *(const LAS bf16x8*)(att + (tt * 16 + fr) * 80 + fq * 16);
                o = MFMA16(A2, Bv, o);
#pragma unroll
                for (int j = 0; j < 4; ++j) { const int row = rowof(cc, tt * 16 + fq * 4 + j); odst[(size_t)row * 512 + h * 128 + vs + fr] = f2bf(o[j]); }
            }
#pragma unroll
            for (int k2 = 0; k2 < NKT; ++k2) {
                const f32x4 d = *(const LAS f32x4*)(dvec + k2 * 16 + fq * 4);
                S[k2] = S[k2] * d;
                const bf16x8 A3 = *(const LAS bf16x8*)(khT + (k2 * 16 + fr) * 80 + fq * 16);
                S[k2] = MFMA16(A3, Bv, S[k2]);
            }
        }
    }
    __syncthreads();
}

__device__ __forceinline__ void mixer(PPtr p, int l, int g, LAS unsigned char* lds) {
    const int tid = ltid(), w = tid >> 6, lane = tid & 63;
    LAS float* biasL = (LAS float*)(lds + 49152);
    for (int i = tid; i < 8 * 465; i += 512) biasL[i] = p->b_rel_bias[(size_t)l * 8 * 465 + i];
    __syncthreads();
    const int GB = p->GB, NSC = GB * 8, NS = GB * 16;
    for (int st = blockIdx.x; st < NS; st += gridDim.x) {
        if (st < NSC) { scan_task<128, true>(p, l, st >> 3, (st >> 1) & 3, st & 1, lds); }
        else { const int s2 = st - NSC; scan_task<64, false>(p, l, s2 >> 3, (s2 >> 1) & 3, s2 & 1, lds); }
    }
    unsigned* ctr = (unsigned*)p->ws + (l * 16 + g);
    const int NB0 = GB * 32, NB1 = GB * 32, NB2 = (l < DEPTH - 1) ? GB * 4 : 0, NB3 = NB2, NBT = NB0 + NB1 + NB2 + NB3;
    LAS int* tw = (LAS int*)(lds + 131072);
    for (;;) {
        if (tid == 0) *tw = (int)atomicAdd(ctr, 1u);
        __syncthreads();
        const int bt = *tw;
        __syncthreads();
        if (bt >= NBT) break;
        int kind, idx;
        if (bt < NB0) { kind = 0; idx = bt * 8 + w; }
        else if (bt < NB0 + NB1) { kind = 1; idx = (bt - NB0) * 8 + w; }
        else if (bt < NB0 + NB1 + NB2) { kind = 2; idx = (bt - NB0 - NB1) * 8 + w; }
        else { kind = 3; idx = (bt - NB0 - NB1 - NB2) * 8 + w; }
        attn_wave(p, l, kind, idx, lane, biasL);
    }
}

__device__ __forceinline__ void postpass(PPtr p, int l, int nrows) {
    const int lane = ltid() & 63, gw = blockIdx.x * 8 + (ltid() >> 6), NGW = gridDim.x * 8, MG = p->MG;
    const bf16_t* Z = (const bf16_t*)(p->ws + p->o_z);
    for (int it = gw; it < nrows * 2; it += NGW) {
        const int row = it >> 1, br = it & 1;
        bf16_t* yf = (bf16_t*)(p->ws + p->o_y4) + (size_t)(2 + br) * MG * 512 + (size_t)row * 512 + lane * 8;
        const bf16_t* yb = (const bf16_t*)(p->ws + p->o_ob) + (size_t)br * MG * 512 + (size_t)row * 512 + lane * 8;
        const u32x4 a = *(const u32x4*)yf, b = *(const u32x4*)yb;
        const u32x4 gt = *(const u32x4*)(Z + (size_t)row * ZW + (br ? ZD_G : ZC_G) + lane * 8);
        const float* gain = (br ? p->d_norm : p->c_norm) + l * 128 + (lane & 15) * 8;
        float o[8], gv[8];
        o[0] = lo16(a.x) + lo16(b.x); o[1] = hi16(a.x) + hi16(b.x); o[2] = lo16(a.y) + lo16(b.y); o[3] = hi16(a.y) + hi16(b.y);
        o[4] = lo16(a.z) + lo16(b.z); o[5] = hi16(a.z) + hi16(b.z); o[6] = lo16(a.w) + lo16(b.w); o[7] = hi16(a.w) + hi16(b.w);
        gv[0] = lo16(gt.x); gv[1] = hi16(gt.x); gv[2] = lo16(gt.y); gv[3] = hi16(gt.y); gv[4] = lo16(gt.z); gv[5] = hi16(gt.z); gv[6] = lo16(gt.w); gv[7] = hi16(gt.w);
        float ss = 0.f;
#pragma unroll
        for (int e = 0; e < 8; ++e) ss += o[e] * o[e];
        ss += __shfl_xor(ss, 1); ss += __shfl_xor(ss, 2); ss += __shfl_xor(ss, 4); ss += __shfl_xor(ss, 8);
        const float rs = rsqrtf(ss * (1.0f / 128.0f) + EPS);
        const f32x4 g0 = *(const f32x4*)gain, g1 = *(const f32x4*)(gain + 4);
        float y[8];
#pragma unroll
        for (int e = 0; e < 8; ++e) { const float gn = (e < 4) ? g0[e & 3] : g1[e & 3]; y[e] = o[e] * rs * gn * (gv[e] * sigm(gv[e])); }
        u32x4 wv; wv.x = pk2(y[0], y[1]); wv.y = pk2(y[2], y[3]); wv.z = pk2(y[4], y[5]); wv.w = pk2(y[6], y[7]);
        *(u32x4*)yf = wv;
    }
}

#define NOINL __device__ __forceinline__
NOINL void ph_prologue(PPtr pc, LAS unsigned char* lds) { PPtr p = pc; asm volatile("" : "+s"(p)); prologue(p, lds); }
NOINL void ph_rowpass(PPtr pc, int l, int g, int mode, int nrows, int conv_l, LAS unsigned char* lds) { PPtr p = pc; asm volatile("" : "+s"(p)); rowpass(p, l, g, mode, nrows); if (conv_l >= 0) convert_weights(p, conv_l, lds); }
NOINL void ph_inproj(PPtr pc, LAS unsigned char* lds) {
    PPtr p = pc; asm volatile("" : "+s"(p)); const int G = (int)gridDim.x, c = (int)blockIdx.x;
    pg8::Gemm gm{(const bf16_t*)(p->ws + p->o_h), (const bf16_t*)(p->ws + p->o_win), p->MG, ZW, 1024}; pg8::StaticOrder S; S.init(p->MG, ZW, G, c);
    EpiInproj E{(bf16_t*)(p->ws + p->o_z), (bf16_t*)(p->ws + p->o_vta), (bf16_t*)(p->ws + p->o_vtb), (const float*)(p->ws + p->o_rope), p->GB};
    pg8::gemm_phase<EpiInproj, pg8::StaticOrder>(lds, gm, S, E, nullptr);
}
NOINL void ph_mixer(PPtr pc, int l, int g, LAS unsigned char* lds) { PPtr p = pc; asm volatile("" : "+s"(p)); mixer(p, l, g, lds); }
NOINL void ph_post(PPtr pc, int l, int nrows) { PPtr p = pc; asm volatile("" : "+s"(p)); postpass(p, l, nrows); }
NOINL void ph_branch(PPtr pc, int Mr, LAS unsigned char* lds) {
    PPtr p = pc; asm volatile("" : "+s"(p)); const int G = (int)gridDim.x, c = (int)blockIdx.x;
    pg8::Gemm gm{(const bf16_t*)(p->ws + p->o_y4), (const bf16_t*)(p->ws + p->o_wb), Mr, 1024, 512}; BranchOrder S{Mr / 256, p->MG / 256, G, c};
    EpiBranch E{(const bf16_t*)(p->ws + p->o_z), (bf16_t*)(p->ws + p->o_h), p->MG / 256};
    pg8::gemm_phase<EpiBranch, BranchOrder>(lds, gm, S, E, nullptr);
}
NOINL void ph_gemm_f32(PPtr pc, int which, int Mr, LAS unsigned char* lds) {
    PPtr p = pc; asm volatile("" : "+s"(p)); const int G = (int)gridDim.x, c = (int)blockIdx.x;
    const bf16_t* A = which ? (const bf16_t*)(p->ws + p->o_z + (size_t)p->MG * 1024 * 4) : (const bf16_t*)(p->ws + p->o_h);
    const bf16_t* Bt = which ? (const bf16_t*)(p->ws + p->o_w2) : (const bf16_t*)(p->ws + p->o_wo);
    pg8::Gemm gm{A, Bt, Mr, 1024, which ? 4096 : 1024}; pg8::StaticOrder S; S.init(Mr, 1024, G, c);
    pg8::EpiF32 E{(float*)(p->ws + p->o_z), 1024, nullptr};
    pg8::gemm_phase<pg8::EpiF32, pg8::StaticOrder>(lds, gm, S, E, nullptr);
}
NOINL void ph_ffn1(PPtr pc, int Mr, LAS unsigned char* lds) {
    PPtr p = pc; asm volatile("" : "+s"(p)); const int G = (int)gridDim.x, c = (int)blockIdx.x;
    pg8::Gemm gm{(const bf16_t*)(p->ws + p->o_h), (const bf16_t*)(p->ws + p->o_w1), Mr, 4096, 1024}; pg8::StaticOrder S; S.init(Mr, 4096, G, c);
    EpiRelu2 E{(bf16_t*)(p->ws + p->o_z + (size_t)p->MG * 1024 * 4), 4096};
    pg8::gemm_phase<EpiRelu2, pg8::StaticOrder>(lds, gm, S, E, nullptr);
}

#define XB_SETUP() volatile LAS unsigned* xb_st = (volatile LAS unsigned*)(lds + 131072 + 64); unsigned* xb_bar = (unsigned*)(pc->ws + 4096); { XcdBarrier xb0 = xcd_barrier_post(xb_bar, xb_st); (void)xb0; }
#define GSYNC() { XcdBarrier xb_; xb_.bar = (unsigned*)(pc->ws + 4096); xb_.x = xb_xcc_id(); xb_.st = (volatile LAS unsigned*)(lds + 131072 + 64); xcd_barrier(xb_); }
#ifdef PROBE_MASK
__global__ void __launch_bounds__(512) hybrid_fwd(Params pk) {
    extern __shared__ __attribute__((aligned(16))) unsigned char smem[];
    LAS unsigned char* lds = (LAS unsigned char*)smem;
    cg::grid_group grid = cg::this_grid();
    PPtr pc = (PPtr)__builtin_amdgcn_kernarg_segment_ptr();
    const int GB = pc->GB, MG = pc->MG, NGRP = pc->NGRP, LATR = GB * 2048;
    unsigned long long tacc = 0, t0_ = __builtin_amdgcn_s_memrealtime();
#define PT(kind) { const unsigned long long t1_ = __builtin_amdgcn_s_memrealtime(); if ((PROBE_MASK >> (kind)) & 1) tacc += t1_ - t0_; t0_ = t1_; }
    ph_prologue(pc, lds);
    grid.sync();
    XB_SETUP(); PT(0)
    for (int l = 0; l < DEPTH; ++l) {
        const int Mr = (l < DEPTH - 1) ? MG : LATR;
        for (int g = 0; g < NGRP; ++g) {
            ph_rowpass(pc, l, g, 1, MG, -1, lds);
            GSYNC(); PT(1)
            ph_inproj(pc, lds);
            GSYNC(); PT(2)
            ph_mixer(pc, l, g, lds);
            GSYNC(); PT(3)
            ph_post(pc, l, Mr);
            GSYNC(); PT(4)
            ph_branch(pc, Mr, lds);
            GSYNC(); PT(5)
            ph_gemm_f32(pc, 0, Mr, lds);
            GSYNC(); PT(6)
            ph_rowpass(pc, l, g, 2, Mr, -1, lds);
            GSYNC(); PT(7)
            ph_ffn1(pc, Mr, lds);
            GSYNC(); PT(8)
            ph_gemm_f32(pc, 1, Mr, lds);
            GSYNC(); PT(9)
            ph_rowpass(pc, l, g, 3, Mr, (g == NGRP - 1 && l + 1 < DEPTH) ? l + 1 : -1, lds);
            GSYNC(); PT(10)
        }
    }
    if (blockIdx.x == 0) { const unsigned M = (unsigned)(tacc / 100ull); float* o = pc->out; for (unsigned i2 = threadIdx.x; i2 < M; i2 += 512) o[i2] += 0.125f; }
}

#else
__global__ void __launch_bounds__(512) hybrid_fwd(Params pk) {
    extern __shared__ __attribute__((aligned(16))) unsigned char smem[];
    LAS unsigned char* lds = (LAS unsigned char*)smem;
    cg::grid_group grid = cg::this_grid();
    PPtr pc = (PPtr)__builtin_amdgcn_kernarg_segment_ptr();
    const int GB = pc->GB, MG = pc->MG, NGRP = pc->NGRP, LATR = GB * 2048;
    ph_prologue(pc, lds);
    grid.sync();
    XB_SETUP();
    for (int l = 0; l < DEPTH; ++l) {
        const int Mr = (l < DEPTH - 1) ? MG : LATR;
        for (int g = 0; g < NGRP; ++g) {
            ph_rowpass(pc, l, g, 1, MG, -1, lds);
            GSYNC();
            ph_inproj(pc, lds);
            GSYNC();
            ph_mixer(pc, l, g, lds);
            GSYNC();
            ph_post(pc, l, Mr);
            GSYNC();
            ph_branch(pc, Mr, lds);
            GSYNC();
            ph_gemm_f32(pc, 0, Mr, lds);
            GSYNC();
            ph_rowpass(pc, l, g, 2, Mr, -1, lds);
            GSYNC();
            ph_ffn1(pc, Mr, lds);
            GSYNC();
            ph_gemm_f32(pc, 1, Mr, lds);
            GSYNC();
            ph_rowpass(pc, l, g, 3, Mr, (g == NGRP - 1 && l + 1 < DEPTH) ? l + 1 : -1, lds);
            GSYNC();
        }
    }
}

#endif
extern "C" void kernel_launch(void* const* d_in, const int* in_sizes, int n_in, void* d_out, int out_size, void* d_ws, size_t ws_size, hipStream_t stream) {
    static int grid_blocks = 0;
    if (grid_blocks == 0) {
        int dev = 0, cus = 0, per_cu = 0;
        hipGetDevice(&dev);
        hipDeviceGetAttribute(&cus, hipDeviceAttributeMultiprocessorCount, dev);
        if (hipFuncSetAttribute((const void*)hybrid_fwd, hipFuncAttributeMaxDynamicSharedMemorySize, LDS_BYTES) != hipSuccess) fprintf(stderr, "hipFuncSetAttribute failed\n");
        if (hipOccupancyMaxActiveBlocksPerMultiprocessor(&per_cu, (const void*)hybrid_fwd, 512, LDS_BYTES) != hipSuccess || per_cu < 1) { fprintf(stderr, "occupancy query: %d\n", per_cu); per_cu = 1; }
        (void)hipGetLastError();
        grid_blocks = cus * 1;
        if (grid_blocks <= 0) grid_blocks = 256;
    }
    Params p{};
    const float* const* in = (const float* const*)d_in;
    p.x = in[0]; p.c = in[1]; p.ctx = in[2]; p.c_ctx = in[3]; p.w_mod = in[4]; p.b_mod = in[5]; p.norm_gains = in[6]; p.w_in = in[7]; p.a_sink = in[8]; p.b_rel_bias = in[9];
    p.c_lb = in[10]; p.c_norm = in[11]; p.d_gate_up = in[12]; p.d_gate_bias = in[13]; p.d_norm = in[14]; p.w_branch = in[15]; p.w_out = in[16]; p.w_ff1 = in[17]; p.w_ff2 = in[18];
    p.out = (float*)d_out; p.ws = (unsigned char*)d_ws;
    auto al = [](unsigned long long v) { return (v + 255ull) & ~255ull; };
    unsigned long long off = 32768;
    p.o_mod = off; off = al(off + 4ull * 17 * 6144 * 4);
    p.o_lb = off; off = al(off + 4ull * 512 * 4);
    p.o_rope = off; off = al(off + 2048ull * 4);
    p.o_xc = off; off = al(off + 4096ull * 1024 * 4);
    p.o_win = off; off = al(off + (unsigned long long)ZW * 1024 * 2);
    p.o_wb = off; off = al(off + 4096ull * 512 * 2);
    p.o_wo = off; off = al(off + 1024ull * 1024 * 2);
    p.o_w1 = off; off = al(off + 4096ull * 1024 * 2);
    p.o_w2 = off; off = al(off + 1024ull * 4096 * 2);
    const unsigned long long fixed = off;
    int GB = 16;
    for (; GB > 1; GB >>= 1) {
        const unsigned long long MGt = (unsigned long long)GB * 2304;
        const unsigned long long need = fixed + MGt * (2048ull + (unsigned long long)ZW * 2 + 4096ull + 2048ull) + (unsigned long long)GB * 10 * 64 * VTS * 2 + 8 * 256;
        if (need <= (unsigned long long)ws_size) break;
    }
    p.GB = GB; p.NGRP = 16 / GB; p.MG = GB * 2304;
    const unsigned long long MGu = (unsigned long long)p.MG;
    p.o_h = off; off = al(off + MGu * 1024 * 2);
    p.o_z = off; off = al(off + MGu * ZW * 2);
    p.o_y4 = off; off = al(off + MGu * 2048 * 2);
    p.o_ob = off; off = al(off + MGu * 1024 * 2);
    p.o_vta = off; off = al(off + (unsigned long long)GB * 2 * 64 * VTS * 2);
    p.o_vtb = off; off = al(off + (unsigned long long)GB * 8 * 64 * VTS * 2);
    hipMemsetAsync(d_ws, 0, 32768, stream);
    void* args[] = {&p};
    hipError_t e = hipLaunchCooperativeKernel((const void*)hybrid_fwd, dim3(grid_blocks), dim3(512), args, LDS_BYTES, stream);
    if (e != hipSuccess) fprintf(stderr, "cooperative launch failed: %s (grid %d)\n", hipGetErrorString(e), grid_blocks);
}
```

```cpp
#include <hip/hip_runtime.h>
#include <hip/hip_cooperative_groups.h>
#include <cstdio>
namespace cg = cooperative_groups;
__device__ __forceinline__ int ltid() { int t = (int)threadIdx.x; asm volatile("" : "+v"(t)); return t; }
#define LAS __attribute__((address_space(3)))
namespace pg8 {
#define PG8_LAS __attribute__((address_space(3)))
typedef unsigned short bf16_t;
typedef short bf16x8 __attribute__((ext_vector_type(8)));
typedef float f32x4 __attribute__((ext_vector_type(4)));
typedef unsigned u32x4 __attribute__((ext_vector_type(4)));
constexpr int BM = 256, BK = 64, HALF = 128, HTB = HALF * BK * 2  , STAGE_BYTES = 8 * HTB, NXCD = 8, WGM = 8;

__host__ __device__ __forceinline__ int lds_byte(int r, int c) { const int st = (r >> 4) * 2 + (c >> 5), rr = r & 15, cc = c & 31, ob = rr * 64 + cc * 2; return st * 1024 + (ob ^ (((ob >> 9) & 1) << 5)); }
__host__ __device__ __forceinline__ void stage_rc(int b, int& R, int& C) { const int st = b / 1024, sb = b % 1024, swz = sb ^ (((sb >> 9) & 1) << 5); R = (st >> 1) * 16 + swz / 64; C = (st & 1) * 32 + (swz % 64) / 2; }
__host__ __device__ __forceinline__ int perm32(int rho) { const int n = rho >> 4, i = rho & 15; return 8 * (i >> 2) + 4 * n + (i & 3); }

struct Unit { int pm, pn; };
struct Gemm { const bf16_t* A; const bf16_t* Bt; int M, N, K; };

struct StaticOrder {
    int nM, nN, nwg, G, c;
    __host__ __device__ void init(int M, int N, int G_, int c_) { nM = M / BM; nN = N / BM; nwg = nM * nN; G = G_; c = c_; }
    __host__ __device__ bool next(int i, Unit& u) const {
        const long L = (long)i * G + c; if (L >= nwg) return false;
        int wgid = (int)L; { const int q = nwg / NXCD, r = nwg % NXCD, xcd = wgid % NXCD, off = wgid / NXCD; wgid = (xcd < r ? xcd * (q + 1) : r * (q + 1) + (xcd - r) * q) + off; }
        const int nig = WGM * nN, gid = wgid / nig, fm = gid * WGM, gsz = (nM - fm) < WGM ? (nM - fm) : WGM;
        u.pm = fm + ((wgid % nig) % gsz); u.pn = (wgid % nig) / gsz; return true;
    }
    __device__ __forceinline__ void a_ready(const Unit&) const {}
    __device__ __forceinline__ void done(const Unit&) const {}
};
__device__ __forceinline__ unsigned cvt_pk_bf16(float lo, float hi) { unsigned r; asm volatile("v_cvt_pk_bf16_f32 %0, %1, %2" : "=v"(r) : "v"(lo), "v"(hi)); return r; }
struct EpiF32 {
    static constexpr bool PERM = false, AFTER_DRAIN = false;
    float* C; int ldc; const float* bias;
    __device__ __forceinline__ void operator()(const f32x4 (&acc)[2][2][4][2], const Unit& u, int wr, int wc, int fr, int fq) const {
        const int row0 = u.pm * BM + wr * 64 + fr, col0 = u.pn * BM + wc * 32 + 4 * fq;
        f32x4 bv[2][2];
#pragma unroll
        for (int bj = 0; bj < 2; ++bj)
#pragma unroll
            for (int n = 0; n < 2; ++n) bv[bj][n] = bias ? *(const f32x4*)(bias + col0 + bj * HALF + n * 16) : (f32x4){0.f, 0.f, 0.f, 0.f};
#pragma unroll
        for (int ai = 0; ai < 2; ++ai)
#pragma unroll
            for (int m = 0; m < 4; ++m) { float* rowp = C + (size_t)(row0 + ai * HALF + m * 16) * ldc + col0;
#pragma unroll
                for (int bj = 0; bj < 2; ++bj)
#pragma unroll
                    for (int n = 0; n < 2; ++n) *(f32x4*)(rowp + bj * HALF + n * 16) = acc[ai][bj][m][n] + bv[bj][n]; }
    }
};
template <class Epi, class Sched, bool STAMP = false>
__device__ __forceinline__ void gemm_phase(PG8_LAS unsigned char* lds, const Gemm g, const Sched& S, const Epi& E, unsigned long long* stamps) {
    const int tid = ltid(), wid = __builtin_amdgcn_readfirstlane(tid >> 6), lane = tid & 63, wr = wid >> 2, wc = wid & 3, fr = lane & 15, fq = lane >> 4;
    const int K = g.K, nt = K / BK;
    int ts_lo = 0, ts_hi = 0, nts = 0; const unsigned long long rt_entry = STAMP ? (unsigned long long)wall_clock64() : 0ull;
#define PG8_STAMP() do { if (STAMP && wid == 0 && nts < 64) { const unsigned long long _c = (unsigned long long)clock64(); \
        ts_lo = (lane == nts) ? (int)(unsigned)_c : ts_lo; ts_hi = (lane == nts) ? (int)(unsigned)(_c >> 32) : ts_hi; ++nts; } } while (0)
    PG8_STAMP();
    unsigned voffA[2], voffB[2];
#pragma unroll
    for (int i = 0; i < 2; ++i) { int R, C; stage_rc(tid * 16 + i * 8192, R, C); const int Rb = Epi::PERM ? ((R & ~31) + perm32(R & 31)) : R;
        voffA[i] = (unsigned)(R * K + C) * 2u; voffB[i] = (unsigned)(Rb * K + C) * 2u; }
    const size_t kstep = (size_t)(BK * 2);
    const size_t hstep = (size_t)HALF * K * 2;
    const size_t tstep = 2 * hstep;
    const unsigned ldsw = (unsigned)wid * 1024u;
    const int aoff = lds_byte(wr * 64 + fr, fq * 8), boff = lds_byte(wc * 32 + fr, fq * 8);
#define PG8_SA(b, h) (((b) * 2 + (h)) * HTB)
#define PG8_SB(b, h) ((4 + (b) * 2 + (h)) * HTB)
#define PG8_STAGE(bufoff, gbase, voff) do { _Pragma("unroll") for (int _i = 0; _i < 2; ++_i) \
        __builtin_amdgcn_global_load_lds((const unsigned*)((const char*)(gbase) + (voff)[_i]), (PG8_LAS unsigned*)(lds + (bufoff) + ldsw + _i * 8192), 16, 0, 0); } while (0)
#define PG8_LDA(dst, b, h) do { _Pragma("unroll") for (int m = 0; m < 4; ++m) _Pragma("unroll") for (int k = 0; k < 2; ++k) dst[m][k] = *(const PG8_LAS bf16x8*)(lds + PG8_SA(b, h) + aoff + m * 2048 + k * 1024); } while (0)
#define PG8_LDB(dst, b, h) do { _Pragma("unroll") for (int n = 0; n < 2; ++n) _Pragma("unroll") for (int k = 0; k < 2; ++k) dst[n][k] = *(const PG8_LAS bf16x8*)(lds + PG8_SB(b, h) + boff + n * 2048 + k * 1024); } while (0)
#define PG8_MMA(ai, bj, At, Bt) do { __builtin_amdgcn_s_setprio(1); _Pragma("unroll") for (int m = 0; m < 4; ++m) _Pragma("unroll") for (int n = 0; n < 2; ++n) _Pragma("unroll") for (int k = 0; k < 2; ++k) \
        acc[ai][bj][m][n] = __builtin_amdgcn_mfma_f32_16x16x32_bf16(Bt[n][k], At[m][k], acc[ai][bj][m][n], 0, 0, 0); __builtin_amdgcn_s_setprio(0); } while (0)
#define PG8_WAIT_V(n) asm volatile("s_waitcnt vmcnt(" #n ")" ::: "memory")
#define PG8_WAIT_L(n) asm volatile("s_waitcnt lgkmcnt(" #n ")" ::: "memory")
#define PG8_BAR __builtin_amdgcn_s_barrier()
#define PG8_SCHED __builtin_amdgcn_sched_barrier(0)
    Unit cur, nxt; int ui = 0;
    if (!S.next(0, cur)) return;
    f32x4 acc[2][2][4][2];
#pragma unroll
    for (int a = 0; a < 2; ++a)
#pragma unroll
        for (int b = 0; b < 2; ++b)
#pragma unroll
            for (int m = 0; m < 4; ++m)
#pragma unroll
                for (int n = 0; n < 2; ++n) acc[a][b][m][n] = (f32x4){0.f, 0.f, 0.f, 0.f};
    bf16x8 At[4][2], B0[2][2], B1[2][2];
    const char* cA = (const char*)g.A + (size_t)cur.pm * tstep; const char* cB = (const char*)g.Bt + (size_t)cur.pn * tstep;
    S.a_ready(cur);
    PG8_STAGE(PG8_SB(0, 0), cB, voffB); PG8_STAGE(PG8_SA(0, 0), cA, voffA); PG8_STAGE(PG8_SB(0, 1), cB + hstep, voffB); PG8_STAGE(PG8_SA(0, 1), cA + hstep, voffA);
    if (wr == 1) PG8_BAR;
    PG8_WAIT_V(4); PG8_BAR;
    PG8_STAGE(PG8_SB(1, 0), cB + kstep, voffB); PG8_STAGE(PG8_SA(1, 0), cA + kstep, voffA); PG8_STAGE(PG8_SB(1, 1), cB + hstep + kstep, voffB);
    PG8_WAIT_V(6); PG8_BAR;
    PG8_STAMP();
    for (;;) {
        const bool has_next = S.next(ui + 1, nxt);
        const char* nA = has_next ? (const char*)g.A + (size_t)nxt.pm * tstep : cA; const char* nB = has_next ? (const char*)g.Bt + (size_t)nxt.pn * tstep : cB;
        for (int t = 0; t < nt; t += 2) {
            const bool last = (t == nt - 2);
            const char* a1 = cA + (size_t)(t + 1) * kstep;
            const char* a2 = last ? nA : cA + (size_t)(t + 2) * kstep; const char* b2 = last ? nB : cB + (size_t)(t + 2) * kstep;
            const char* a3 = a2 + kstep; const char* b3 = b2 + kstep;
            if (last && has_next) S.a_ready(nxt);
            PG8_LDB(B0, 0, 0); PG8_SCHED; PG8_LDA(At, 0, 0); PG8_STAGE(PG8_SA(1, 1), a1 + hstep, voffA);
            PG8_WAIT_L(8); PG8_BAR; PG8_WAIT_L(0); PG8_MMA(0, 0, At, B0); PG8_BAR; PG8_SCHED;
            PG8_LDB(B1, 0, 1); PG8_STAGE(PG8_SB(0, 0), b2, voffB);
            PG8_BAR; PG8_WAIT_L(0); PG8_MMA(0, 1, At, B1); PG8_BAR;
            PG8_LDA(At, 0, 1); PG8_STAGE(PG8_SA(0, 0), a2, voffA);
            PG8_BAR; PG8_WAIT_L(0); PG8_MMA(1, 0, At, B0); PG8_BAR; PG8_SCHED;
            PG8_STAGE(PG8_SB(0, 1), b2 + hstep, voffB);
            PG8_WAIT_V(6); PG8_BAR; PG8_MMA(1, 1, At, B1); PG8_BAR;
            PG8_LDB(B0, 1, 0); PG8_SCHED; PG8_LDA(At, 1, 0); PG8_STAGE(PG8_SA(0, 1), a2 + hstep, voffA);
            PG8_WAIT_L(8); PG8_BAR; PG8_WAIT_L(0); PG8_MMA(0, 0, At, B0); PG8_BAR; PG8_SCHED;
            PG8_LDB(B1, 1, 1); PG8_STAGE(PG8_SB(1, 0), b3, voffB);
            PG8_BAR; PG8_WAIT_L(0); PG8_MMA(0, 1, At, B1); PG8_BAR;
            PG8_LDA(At, 1, 1); PG8_STAGE(PG8_SA(1, 0), a3, voffA);
            PG8_BAR; PG8_WAIT_L(0); PG8_MMA(1, 0, At, B0); PG8_BAR; PG8_SCHED;
            PG8_STAGE(PG8_SB(1, 1), b3 + hstep, voffB);
            PG8_WAIT_V(6); PG8_BAR; PG8_MMA(1, 1, At, B1); PG8_BAR;
        }
        PG8_STAMP();
        if constexpr (!Epi::AFTER_DRAIN) { E(acc, cur, wr, wc, fr, fq); S.done(cur); }
        PG8_STAMP();
        if (!has_next) break;
#pragma unroll
        for (int a = 0; a < 2; ++a)
#pragma unroll
            for (int b = 0; b < 2; ++b)
#pragma unroll
                for (int m = 0; m < 4; ++m)
#pragma unroll
                    for (int n = 0; n < 2; ++n) acc[a][b][m][n] = (f32x4){0.f, 0.f, 0.f, 0.f};
        cur = nxt; cA = nA; cB = nB; ++ui;
    }
    PG8_WAIT_V(0);
    if (wr == 0) PG8_BAR;
    PG8_BAR;
    if constexpr (Epi::AFTER_DRAIN) { E.fused(acc, cur, wr, wc, fr, fq, lds, wid, lane); S.done(cur); }
    PG8_STAMP();
    if (STAMP && wid == 0) { stamps[lane] = lane < nts ? (((unsigned long long)(unsigned)ts_hi << 32) | (unsigned)ts_lo) : 0ull;
        if (lane == 62) stamps[62] = rt_entry; if (lane == 63) stamps[63] = (unsigned long long)wall_clock64(); }
#undef PG8_STAMP
#undef PG8_SA
#undef PG8_SB
#undef PG8_STAGE
#undef PG8_LDA
#undef PG8_LDB
#undef PG8_MMA
#undef PG8_WAIT_V
#undef PG8_WAIT_L
#undef PG8_BAR
#undef PG8_SCHED
}
}
#define XB_TMO      128
#define XB_XCNT(j)  (256  + 64 * (j))
#define XB_XSUB(j)  (1280 + 64 * (j))
#define XB_XGEN(j)  (2304 + 64 * (j))
#define XB_TOP      3328
#define XB_TOPGEN   3392
#define XCD_BAR_WORDS 3456
#define XB_SPIN_CAP (1u << 18)

__device__ __forceinline__ unsigned xb_ld(unsigned* p)              { return __hip_atomic_load(p, __ATOMIC_RELAXED, __HIP_MEMORY_SCOPE_AGENT); }
__device__ __forceinline__ unsigned xb_add(unsigned* p, unsigned v) { return __hip_atomic_fetch_add(p, v, __ATOMIC_RELAXED, __HIP_MEMORY_SCOPE_AGENT); }
__device__ __forceinline__ unsigned xb_xcc_id() { return (unsigned)__builtin_amdgcn_s_getreg((3 << 11) | 20) & 0xFu; }
#define XB_SPIN(cond, bar) do { unsigned _sp = 0; while (cond) { __builtin_amdgcn_s_sleep(1); \
    if ((++_sp & 255u) == 0u) { if (xb_ld(&(bar)[XB_TMO])) break; if (_sp > XB_SPIN_CAP) { atomicAdd(&(bar)[XB_TMO], 1u); break; } } } } while (0)

struct XcdBarrier {
    unsigned* bar; unsigned x;
    volatile LAS unsigned* st;
};

__device__ __forceinline__ XcdBarrier xcd_barrier_post(unsigned* bar, volatile LAS unsigned* st) {
    XcdBarrier b; b.bar = bar; b.x = xb_xcc_id(); b.st = st;
    if (threadIdx.x == 0) (void)xb_add(&bar[XB_XCNT(b.x)], 1u);
    return b;
}
__device__ __forceinline__ void xcd_barrier_complete(unsigned* bar, unsigned x, unsigned& nloc, unsigned& nx) {
    const unsigned G = gridDim.x * gridDim.y * gridDim.z;
    unsigned sum, cnt, mine, sp = 0u;
    for (;;) {
        sum = 0u; cnt = 0u; mine = 0u;
#pragma unroll
        for (unsigned j = 0; j < 16; ++j) { const unsigned c = xb_ld(&bar[XB_XCNT(j)]); sum += c; cnt += (c > 0u) ? 1u : 0u; mine = (j == x) ? c : mine; }
        if (sum == G) break;
        __builtin_amdgcn_s_sleep(1);
        if ((++sp & 255u) == 0u) { if (xb_ld(&bar[XB_TMO])) break; if (sp > XB_SPIN_CAP) { atomicAdd(&bar[XB_TMO], 1u); break; } }
    }
    nloc = mine > 0u ? mine : 1u; nx = cnt > 0u ? cnt : 1u;
}

__device__ __forceinline__ void xcd_barrier(const XcdBarrier& b) {
    asm volatile("s_waitcnt vmcnt(0)" ::: "memory");
    __syncthreads();
    if (threadIdx.x == 0) {
        unsigned* bar = b.bar;
        __builtin_amdgcn_s_waitcnt(0);
        unsigned nloc = b.st[0], nx = b.st[1];
        if (nloc == 0u) { xcd_barrier_complete(bar, b.x, nloc, nx); b.st[0] = nloc; b.st[1] = nx; }
        const unsigned old = xb_add(&bar[XB_XSUB(b.x)], 1u);
        const unsigned gen = old / nloc;
        if (old + 1u == (gen + 1u) * nloc) {
            __builtin_amdgcn_fence(__ATOMIC_RELEASE, "agent");
            asm volatile("s_waitcnt vmcnt(0)" ::: "memory");
            const unsigned og = xb_add(&bar[XB_TOP], 1u);
            const unsigned tg = og / nx;
            if (og + 1u == (tg + 1u) * nx) xb_add(&bar[XB_TOPGEN], 1u);
            else XB_SPIN(xb_ld(&bar[XB_TOPGEN]) == tg, bar);
            __builtin_amdgcn_fence(__ATOMIC_ACQUIRE, "agent");
            xb_add(&bar[XB_XGEN(b.x)], 1u);
            asm volatile("s_waitcnt vmcnt(0)" ::: "memory");
        } else {
            XB_SPIN(xb_ld(&bar[XB_XGEN(b.x)]) == gen, bar);
            __builtin_amdgcn_fence(__ATOMIC_ACQUIRE, "agent");
            asm volatile("s_waitcnt vmcnt(0)" ::: "memory");
        }
    }
    __syncthreads();
}

typedef unsigned short bf16_t;
typedef pg8::bf16x8 bf16x8;
typedef pg8::f32x4 f32x4;
typedef pg8::u32x4 u32x4;
typedef unsigned u32x2 __attribute__((ext_vector_type(2)));

constexpr int DM = 1024, NB = 16, SEQ = 2048, DEPTH = 4, CTXL = 256, DFF = 4096;
constexpr int ZW = 10752;
constexpr int INW = 10528;
constexpr int ZA_Q = 0, ZA_K = 512, ZA_V = 640, ZB_Q = 768, ZB_K = 1280, ZB_V = 1792, ZC_Q = 2304, ZC_FF = 2816, ZC_FB = 3328, ZC_I = 3840, ZC_G = 4352,
              ZD_Q = 4864, ZD_K = 5120, ZD_V = 5376, ZD_GK = 5888, ZD_G = 6016, ZMERGE = 6656;
constexpr int VTS = 2304;
constexpr int LDS_BYTES = 144 * 1024;
constexpr int CTRL_OFF = LDS_BYTES - 256;
constexpr float EPS = 1e-6f;
constexpr float LOG2E = 1.4426950408889634f;
constexpr float QSCALE2 = 0.125f * LOG2E;

struct Params {
    const float *x, *c, *ctx, *c_ctx, *w_mod, *b_mod, *norm_gains, *w_in, *a_sink, *b_rel_bias, *c_lb, *c_norm, *d_gate_up, *d_gate_bias, *d_norm, *w_branch, *w_out, *w_ff1, *w_ff2;
    float* out;
    unsigned char* ws;
    unsigned long long o_mod, o_lb, o_rope, o_xc, o_win, o_wb, o_wo, o_w1, o_w2, o_h, o_z, o_y4, o_ob, o_vta, o_vtb;
    int GB, NGRP, MG, pad0;
};
typedef const Params __attribute__((address_space(4)))* PPtr;

__device__ __forceinline__ float bf2f(unsigned v) { return __uint_as_float(v << 16); }
__device__ __forceinline__ bf16_t f2bf(float f) { unsigned u = __float_as_uint(f); u += 0x7FFFu + ((u >> 16) & 1u); return (bf16_t)(u >> 16); }
typedef __bf16 bf16v2_t __attribute__((ext_vector_type(2)));
typedef float f32v2_t __attribute__((ext_vector_type(2)));
__device__ __forceinline__ unsigned pk2(float lo, float hi) { const f32v2_t v = {lo, hi}; const bf16v2_t b = __builtin_convertvector(v, bf16v2_t); return __builtin_bit_cast(unsigned, b); }
__device__ __forceinline__ float wave_sum(float v) {
#pragma unroll
    for (int o = 1; o < 64; o <<= 1) v += __shfl_xor(v, o);
    return v;
}
__device__ __forceinline__ float lo16(unsigned w) { return __uint_as_float(w << 16); }
__device__ __forceinline__ float hi16(unsigned w) { return __uint_as_float(w & 0xffff0000u); }
__device__ __forceinline__ float sigm(float x) { return 1.0f / (1.0f + __expf(-x)); }
__device__ __forceinline__ bf16_t f2bf1(float x) { return (bf16_t)pk2(x, 0.f); }

__device__ __forceinline__ int src_col(int n) {
    if (n < 640) {
        const int p = n & 63, base = n - p, pp = p >> 1, wh = p & 1;
        const int dim = (pp < 16) ? (wh ? 16 + pp : pp) : (wh ? 48 + (pp - 16) : 32 + (pp - 16));
        return base + dim;
    }
    if (n < 5920) return n;
    if (n < 6016) return -1;
    if (n < 6528) return n - 96;
    if (n < 6656) return -1;
    return 6432 + (n - 6656);
}

__device__ __forceinline__ void conv_tile(const float* src, int Nsrc, int k0, int n0, bool inmap, bf16_t* dst, int Kd, LAS float* t) {
    const int tid = ltid(), nl = tid & 63, ks = tid >> 6;
    const int sc = inmap ? src_col(n0 + nl) : (n0 + nl);
#pragma unroll
    for (int i = 0; i < 8; ++i) { const int kk = ks + 8 * i; t[nl * 65 + kk] = (sc >= 0) ? src[(size_t)(k0 + kk) * Nsrc + sc] : 0.f; }
    __syncthreads();
    const int kl = (tid & 31) * 2, ns = tid >> 5;
#pragma unroll
    for (int i = 0; i < 4; ++i) { const int n = ns + 16 * i; *(unsigned*)(dst + (size_t)(n0 + n) * Kd + k0 + kl) = pk2(t[n * 65 + kl], t[n * 65 + kl + 1]); }
    __syncthreads();
}
__device__ __forceinline__ void convert_weights(PPtr p, int l, LAS unsigned char* lds) {
    LAS float* t = (LAS float*)lds;
    bf16_t* WinT = (bf16_t*)(p->ws + p->o_win); bf16_t* WbT = (bf16_t*)(p->ws + p->o_wb); bf16_t* WoT = (bf16_t*)(p->ws + p->o_wo);
    bf16_t* W1T = (bf16_t*)(p->ws + p->o_w1); bf16_t* W2T = (bf16_t*)(p->ws + p->o_w2);
    constexpr int T_IN = 16 * 168, T_BR = 4 * 8 * 16, T_O = 16 * 16, T_1 = 16 * 64, T_2 = 64 * 16, T_ALL = T_IN + T_BR + T_O + T_1 + T_2;
    for (int it = blockIdx.x; it < T_ALL; it += gridDim.x) {
        int r = it;
        if (r < T_IN) { const int kb = r / 168, nb = r % 168; conv_tile(p->w_in + (size_t)l * 1024 * INW, INW, kb * 64, nb * 64, true, WinT, 1024, t); continue; } r -= T_IN;
        if (r < T_BR) { const int j = r / 128, q = r % 128, kb = q / 16, nb = q % 16; conv_tile(p->w_branch + (size_t)(l * 4 + j) * 512 * 1024, 1024, kb * 64, nb * 64, false, WbT + (size_t)j * 1024 * 512, 512, t); continue; } r -= T_BR;
        if (r < T_O) { const int kb = r / 16, nb = r % 16; conv_tile(p->w_out + (size_t)l * 1024 * 1024, 1024, kb * 64, nb * 64, false, WoT, 1024, t); continue; } r -= T_O;
        if (r < T_1) { const int kb = r / 64, nb = r % 64; conv_tile(p->w_ff1 + (size_t)l * 1024 * 4096, 4096, kb * 64, nb * 64, false, W1T, 1024, t); continue; } r -= T_1;
        { const int kb = r / 16, nb = r % 16; conv_tile(p->w_ff2 + (size_t)l * 4096 * 1024, 1024, kb * 64, nb * 64, false, W2T, 4096, t); }
    }
}

__device__ __forceinline__ void prologue(PPtr p, LAS unsigned char* lds) {
    const int tid = ltid();
    if (blockIdx.x == 0) {
        if (tid < 64) atomicExch((unsigned*)p->ws + tid, 0u);
        for (int i = tid; i < XCD_BAR_WORDS; i += 512) __hip_atomic_store((unsigned*)(p->ws + 4096) + i, 0u, __ATOMIC_RELAXED, __HIP_MEMORY_SCOPE_AGENT);
    }
    if (tid < 4) *((LAS unsigned*)(lds + CTRL_OFF + 64) + tid) = 0u;
    float* modb = (float*)(p->ws + p->o_mod);
    LAS float* sl = (LAS float*)lds;
    LAS float* red = sl + 17 * 1024;
    bool loaded = false;
    for (int task = blockIdx.x; task < 192; task += gridDim.x) {
        if (!loaded) {
            for (int i = tid; i < 17 * 1024; i += 512) { const int b = i >> 10, k = i & 1023; const float v = (b < 16) ? p->c[b * 1024 + k] : p->c_ctx[k]; sl[i] = v * sigm(v); }
            loaded = true;
        }
        __syncthreads();
        const int l = task / 48, nc = task % 48, nn = tid & 127, n = nc * 128 + nn, kq = tid >> 7;
        float acc[17];
#pragma unroll
        for (int b = 0; b < 17; ++b) acc[b] = 0.f;
        const float* w = p->w_mod + ((size_t)l * 1024 + kq * 256) * 6144 + n;
#pragma unroll 4
        for (int k = 0; k < 256; ++k) {
            const float wv = w[(size_t)k * 6144];
#pragma unroll
            for (int b = 0; b < 17; ++b) acc[b] += sl[b * 1024 + kq * 256 + k] * wv;
        }
#pragma unroll
        for (int b = 0; b < 17; ++b) red[(kq * 17 + b) * 128 + nn] = acc[b];
        __syncthreads();
        if (kq == 0) {
            const float bm = p->b_mod[l * 6144 + n];
#pragma unroll
            for (int b = 0; b < 17; ++b) modb[((size_t)l * 17 + b) * 6144 + n] = red[b * 128 + nn] + red[(17 + b) * 128 + nn] + red[(34 + b) * 128 + nn] + red[(51 + b) * 128 + nn] + bm;
        }
        __syncthreads();
    }
    if (blockIdx.x == gridDim.x - 1) {
        float* lb = (float*)(p->ws + p->o_lb);
        {
            const int ch = tid;
            float v[4], mx = -1e30f;
#pragma unroll
            for (int l = 0; l < 4; ++l) { v[l] = p->c_lb[l * 512 + ch]; mx = fmaxf(mx, v[l]); }
            float s = 0.f;
#pragma unroll
            for (int l = 0; l < 4; ++l) { v[l] = __expf(v[l] - mx); s += v[l]; }
            const float inv = 1.0f / s, s0 = v[0] * inv; float cum = 0.f;
#pragma unroll
            for (int l = 0; l < 4; ++l) { cum += v[l] * inv; lb[l * 512 + ch] = cum - s0; }
        }
        float* rt = (float*)(p->ws + p->o_rope);
        for (int i = tid; i < 1024; i += 512) {
            const int n = i >> 4, f = i & 15;
            const float inv = __expf(-((float)(2 * f) / 32.0f) * 9.210340371976184f);
            const float a = (float)n * inv;
            const float kf = rintf(a * 0.15915494309189535f);
            const float rr = fmaf(-kf, 6.2831854820251465f, a) + kf * 1.7484556e-7f;
            rt[i] = __cosf(rr); rt[1024 + i] = __sinf(rr);
        }
    }
    __syncthreads();
    convert_weights(p, 0, lds);
}

__device__ __forceinline__ void rowpass(PPtr p, int l, int g, int mode, int nrows) {
    const int lane = ltid() & 63, gw = blockIdx.x * 8 + (ltid() >> 6), NGW = gridDim.x * 8;
    const int LATR = p->GB * 2048, GB = p->GB;
    const float* ng = p->norm_gains + (size_t)l * 4 * 1024;
    const float* modb = (const float*)(p->ws + p->o_mod) + (size_t)l * 17 * 6144;
    bf16_t* hb = (bf16_t*)(p->ws + p->o_h);
    const float* yf = (const float*)(p->ws + p->o_z);
    float* xcb = (float*)(p->ws + p->o_xc);
    const bool first = (l == 0 && mode <= 2);
    const float* xlat = first ? p->x : (const float*)p->out;
    const float* xctx = first ? p->ctx : (const float*)xcb;
    auto xsrc = [&](int row) -> const float* {
        if (row < LATR) return xlat + ((size_t)(g * GB + (row >> 11)) * 2048 + (row & 2047)) * 1024;
        const int r2 = row - LATR; return xctx + ((size_t)(g * GB + (r2 >> 8)) * 256 + (r2 & 255)) * 1024;
    };
    f32x4 xv[4], yv[4];
    int row = gw;
    if (row < nrows) {
        const float* xs = xsrc(row);
#pragma unroll
        for (int j = 0; j < 4; ++j) { xv[j] = *(const f32x4*)(xs + lane * 4 + 256 * j); if (mode >= 2) yv[j] = *(const f32x4*)(yf + (size_t)row * 1024 + lane * 4 + 256 * j); }
    }
    while (row < nrows) {
        const int nrow = row + NGW;
        f32x4 xn[4], yn[4];
        if (nrow < nrows) {
            const float* xs = xsrc(nrow);
#pragma unroll
            for (int j = 0; j < 4; ++j) { xn[j] = *(const f32x4*)(xs + lane * 4 + 256 * j); if (mode >= 2) yn[j] = *(const f32x4*)(yf + (size_t)nrow * 1024 + lane * 4 + 256 * j); }
        }
        const bool lat = row < LATR;
        int b; size_t xrow;
        if (lat) { b = g * GB + (row >> 11); xrow = (size_t)b * 2048 + (row & 2047); }
        else { const int r2 = row - LATR; b = g * GB + (r2 >> 8); xrow = (size_t)b * 256 + (r2 & 255); }
        float* xd = (lat ? p->out : xcb) + xrow * 1024;
        const float* m = modb + (size_t)(lat ? b : 16) * 6144;
        if (mode >= 2) {
            float ss = 0.f;
#pragma unroll
            for (int j = 0; j < 4; ++j) ss += yv[j].x * yv[j].x + yv[j].y * yv[j].y + yv[j].z * yv[j].z + yv[j].w * yv[j].w;
            ss = wave_sum(ss);
            const float rs = rsqrtf(ss * (1.0f / 1024.0f) + EPS);
            const float* gate = m + (mode == 2 ? 2048 : 5120); const float* gn = ng + (mode == 2 ? 1024 : 3072);
#pragma unroll
            for (int j = 0; j < 4; ++j) {
                const int c = lane * 4 + 256 * j;
                const f32x4 gv = *(const f32x4*)(gate + c), nv = *(const f32x4*)(gn + c);
                xv[j] = xv[j] + gv * (yv[j] * rs * nv);
                *(f32x4*)(xd + c) = xv[j];
            }
        }
        if (mode <= 2) {
            float ss = 0.f;
#pragma unroll
            for (int j = 0; j < 4; ++j) ss += xv[j].x * xv[j].x + xv[j].y * xv[j].y + xv[j].z * xv[j].z + xv[j].w * xv[j].w;
            ss = wave_sum(ss);
            const float rs = rsqrtf(ss * (1.0f / 1024.0f) + EPS);
            const float* sh = m + (mode == 1 ? 0 : 3072); const float* sc = m + (mode == 1 ? 1024 : 4096); const float* gn = ng + (mode == 1 ? 0 : 2048);
#pragma unroll
            for (int j = 0; j < 4; ++j) {
                const int c = lane * 4 + 256 * j;
                const f32x4 shv = *(const f32x4*)(sh + c), scv = *(const f32x4*)(sc + c), nv = *(const f32x4*)(gn + c);
                const f32x4 hv = (xv[j] * rs * nv) * (scv + 1.0f) + shv;
                u32x2 o; o.x = pk2(hv.x, hv.y); o.y = pk2(hv.z, hv.w);
                *(u32x2*)(hb + (size_t)row * 1024 + c) = o;
            }
        }
#pragma unroll
        for (int j = 0; j < 4; ++j) { xv[j] = xn[j]; yv[j] = yn[j]; }
        row = nrow;
    }
}

struct EpiInproj {
    static constexpr bool PERM = true, AFTER_DRAIN = false;
    bf16_t* Z; bf16_t* vta; bf16_t* vtb; const float* rope; int GB;
    __device__ __forceinline__ void operator()(const f32x4 (&acc)[2][2][4][2], const pg8::Unit& u, int wr, int wc, int fr, int fq) const {
        const int row0 = u.pm * 256 + wr * 64 + fr, LATR = GB * 2048;
#pragma unroll
        for (int bj = 0; bj < 2; ++bj) {
            const int seg = u.pn * 2 + bj, c0 = u.pn * 256 + bj * 128 + wc * 32 + 8 * fq;
            const int type = (seg <= 4) ? 1 : (seg == 5 ? 2 : ((seg >= 14 && seg <= 17) ? 3 : 0));
            const int xf = (seg <= 3 || (seg >= 6 && seg <= 9)) ? 1 : ((seg >= 18 && seg <= 21) ? 2 : ((seg >= 22 && seg <= 29) ? 3 : ((seg == 38 || seg == 39) ? 4 : 0)));
#pragma unroll
            for (int ai = 0; ai < 2; ++ai)
#pragma unroll
                for (int m = 0; m < 4; ++m) {
                    const int row = row0 + ai * 128 + m * 16;
                    f32x4 v0 = acc[ai][bj][m][0], v1 = acc[ai][bj][m][1];
                    if (type <= 1) {
                        if (type == 1 && row < LATR) {
                            const int t = row & 2047, pp0 = (c0 & 63) >> 1;
                            const int n = (pp0 < 16) ? (t >> 6) : (t & 63);
                            const float* cs = rope + n * 16 + (pp0 & 15);
                            const f32x4 cv = *(const f32x4*)cs, sv = *(const f32x4*)(cs + 1024);
                            f32x4 r0, r1;
                            r0.x = v0.x * cv.x - v0.y * sv.x; r0.y = v0.y * cv.x + v0.x * sv.x;
                            r0.z = v0.z * cv.y - v0.w * sv.y; r0.w = v0.w * cv.y + v0.z * sv.y;
                            r1.x = v1.x * cv.z - v1.y * sv.z; r1.y = v1.y * cv.z + v1.x * sv.z;
                            r1.z = v1.z * cv.w - v1.w * sv.w; r1.w = v1.w * cv.w + v1.z * sv.w;
                            v0 = r0; v1 = r1;
                        }
                        if (xf == 1) { v0 = v0 * QSCALE2; v1 = v1 * QSCALE2; }
                        else if (xf == 4) { v0 = v0 * 0.125f; v1 = v1 * 0.125f; }
                        else if (xf == 2) {
#pragma unroll
                            for (int e = 0; e < 4; ++e) { v0[e] = v0[e] * sigm(v0[e]); v1[e] = v1[e] * sigm(v1[e]); }
                        } else if (xf == 3) {
#pragma unroll
                            for (int e = 0; e < 4; ++e) { v0[e] = sigm(v0[e]); v1[e] = sigm(v1[e]); }
                        }
                        u32x4 w; w.x = pk2(v0.x, v0.y); w.y = pk2(v0.z, v0.w); w.z = pk2(v1.x, v1.y); w.w = pk2(v1.z, v1.w);
                        *(u32x4*)(Z + (size_t)row * ZW + c0) = w;
                    } else {
                        int bl, tok;
                        if (row < LATR) { bl = row >> 11; tok = row & 2047; } else { const int r2 = row - LATR; bl = r2 >> 8; tok = 2048 + (r2 & 255); }
                        const int cc = c0 - (type == 2 ? ZA_V : ZB_V), head = cc >> 6, dim0 = cc & 63, H = (type == 2) ? 2 : 8;
                        bf16_t* base = (type == 2 ? vta : vtb) + ((size_t)(bl * H + head) * 64 + dim0) * VTS + tok;
                        base[0 * VTS] = f2bf(v0.x); base[1 * VTS] = f2bf(v0.y); base[2 * VTS] = f2bf(v0.z); base[3 * VTS] = f2bf(v0.w);
                        base[4 * VTS] = f2bf(v1.x); base[5 * VTS] = f2bf(v1.y); base[6 * VTS] = f2bf(v1.z); base[7 * VTS] = f2bf(v1.w);
                    }
                }
        }
    }
};
struct EpiBranch {
    static constexpr bool PERM = true, AFTER_DRAIN = false;
    const bf16_t* Z; bf16_t* macc; int nMfull;
    __device__ __forceinline__ void operator()(const f32x4 (&acc)[2][2][4][2], const pg8::Unit& u, int wr, int wc, int fr, int fq) const {
        const int j = u.pm / nMfull, pm = u.pm - j * nMfull, pn = u.pn & 3;
        const int row0 = pm * 256 + wr * 64 + fr, col0 = pn * 256 + wc * 32 + 8 * fq;
        const bf16_t* gbase = Z + (size_t)row0 * ZW + ZMERGE + j * 1024 + col0;
        bf16_t* mbase = macc + (size_t)row0 * 1024 + col0;
#pragma unroll
        for (int ai = 0; ai < 2; ++ai) {
            u32x4 gw[4][2], pv[4][2];
#pragma unroll
            for (int m = 0; m < 4; ++m)
#pragma unroll
                for (int bj = 0; bj < 2; ++bj) {
                    const size_t ro = (size_t)(ai * 128 + m * 16);
                    gw[m][bj] = *(const u32x4*)(gbase + ro * ZW + bj * 128);
                    pv[m][bj] = (j > 0) ? *(const u32x4*)(mbase + ro * 1024 + bj * 128) : (u32x4){0u, 0u, 0u, 0u};
                }
#pragma unroll
            for (int m = 0; m < 4; ++m)
#pragma unroll
                for (int bj = 0; bj < 2; ++bj) {
                    const u32x4 g = gw[m][bj], q = pv[m][bj];
                    const f32x4 v0 = acc[ai][bj][m][0], v1 = acc[ai][bj][m][1];
                    const float t0 = v0.x * sigm(lo16(g.x)) + lo16(q.x), t1 = v0.y * sigm(hi16(g.x)) + hi16(q.x), t2 = v0.z * sigm(lo16(g.y)) + lo16(q.y), t3 = v0.w * sigm(hi16(g.y)) + hi16(q.y);
                    const float t4 = v1.x * sigm(lo16(g.z)) + lo16(q.z), t5 = v1.y * sigm(hi16(g.z)) + hi16(q.z), t6 = v1.z * sigm(lo16(g.w)) + lo16(q.w), t7 = v1.w * sigm(hi16(g.w)) + hi16(q.w);
                    u32x4 w; w.x = pk2(t0, t1); w.y = pk2(t2, t3); w.z = pk2(t4, t5); w.w = pk2(t6, t7);
                    *(u32x4*)(mbase + (size_t)(ai * 128 + m * 16) * 1024 + bj * 128) = w;
                }
        }
    }
};
struct BranchOrder {
    int nM, nMfull, G, c;
    __device__ __forceinline__ bool next(int i, pg8::Unit& u) const {
        const int j = i & 3; const int v = (c & 7) * (G >> 3) + (c >> 3);
        const long T = (long)(i >> 2) * G + v;
        if (T >= (long)nM * 4) return false;
        u.pm = j * nMfull + (int)(T >> 2); u.pn = j * 4 + (int)(T & 3); return true;
    }
    __device__ __forceinline__ void a_ready(const pg8::Unit&) const {}
    __device__ __forceinline__ void done(const pg8::Unit&) const {}
};
struct EpiRelu2 {
    static constexpr bool PERM = true, AFTER_DRAIN = false;
    bf16_t* O; int ldc;
    __device__ __forceinline__ void operator()(const f32x4 (&acc)[2][2][4][2], const pg8::Unit& u, int wr, int wc, int fr, int fq) const {
        const int row0 = u.pm * 256 + wr * 64 + fr, col0 = u.pn * 256 + wc * 32 + 8 * fq;
#pragma unroll
        for (int ai = 0; ai < 2; ++ai)
#pragma unroll
            for (int m = 0; m < 4; ++m) {
                bf16_t* rowp = O + (size_t)(row0 + ai * 128 + m * 16) * ldc + col0;
#pragma unroll
                for (int bj = 0; bj < 2; ++bj) {
                    f32x4 v0 = acc[ai][bj][m][0], v1 = acc[ai][bj][m][1];
#pragma unroll
                    for (int e = 0; e < 4; ++e) { const float a = fmaxf(v0[e], 0.f), b = fmaxf(v1[e], 0.f); v0[e] = a * a; v1[e] = b * b; }
                    u32x4 w; w.x = pk2(v0.x, v0.y); w.y = pk2(v0.z, v0.w); w.z = pk2(v1.x, v1.y); w.w = pk2(v1.z, v1.w);
                    *(u32x4*)(rowp + bj * 128) = w;
                }
            }
    }
};

#define MFMA16(a, b, c) __builtin_amdgcn_mfma_f32_16x16x32_bf16((a), (b), (c), 0, 0, 0)
__device__ __forceinline__ void attn_wave(PPtr p, int l, int kind, int idx, int lane, const LAS float* biasL) {
    const int fr = lane & 15, fq = lane >> 4;
    const int LATR = p->GB * 2048, MG = p->MG;
    const bf16_t* Z = (const bf16_t*)(p->ws + p->o_z);
    const bool isA = (kind == 1 || kind == 2);
    int bl, hk, qrow0, r = 0, q0 = 0;
    if (kind == 0) { bl = idx >> 8; hk = (idx >> 5) & 7; r = idx & 31; qrow0 = bl * 2048 + r * 64; }
    else if (kind == 1) { bl = idx >> 8; hk = (idx >> 7) & 1; q0 = (idx & 127) * 16; qrow0 = bl * 2048 + q0; }
    else if (kind == 2) { bl = idx >> 5; hk = (idx >> 4) & 1; qrow0 = LATR + bl * 256 + (idx & 15) * 16; }
    else { bl = idx >> 5; hk = (idx >> 2) & 7; qrow0 = LATR + bl * 256 + (idx & 3) * 64; }
    const int qrstep = isA ? 0 : 16, qcstep = isA ? 64 : 0;
    const int qcol0 = isA ? (ZA_Q + hk * 4 * 64) : (ZB_Q + hk * 64);
    const int kcol = isA ? (ZA_K + hk * 64) : (ZB_K + hk * 64);
    const bf16_t* vt = isA ? ((const bf16_t*)(p->ws + p->o_vta) + (size_t)(bl * 2 + hk) * 64 * VTS) : ((const bf16_t*)(p->ws + p->o_vtb) + (size_t)(bl * 8 + hk) * 64 * VTS);
    bf16_t* yo = (bf16_t*)(p->ws + p->o_y4) + (isA ? (size_t)0 : (size_t)MG * 512);
    const int ocol0 = isA ? hk * 4 * 64 : hk * 64;
    const int krow_ctx0 = LATR + bl * 256, krow_lat0 = bl * 2048;

    bf16x8 Q[4][2];
#pragma unroll
    for (int s = 0; s < 4; ++s)
#pragma unroll
        for (int ks = 0; ks < 2; ++ks) Q[s][ks] = *(const bf16x8*)(Z + (size_t)(qrow0 + s * qrstep + fr) * ZW + qcol0 + s * qcstep + ks * 32 + fq * 8);
    f32x4 O[4][4]; float mrun[4], lrun[4];
#pragma unroll
    for (int s = 0; s < 4; ++s) { mrun[s] = -1e30f; lrun[s] = 0.f;
#pragma unroll
        for (int dt = 0; dt < 4; ++dt) O[s][dt] = (f32x4){0.f, 0.f, 0.f, 0.f}; }

    auto do_block = [&](int krow, int vtoff, int mode, int a0, int a1) {
        bf16x8 Kf[2][2];
#pragma unroll
        for (int kt = 0; kt < 2; ++kt)
#pragma unroll
            for (int ks = 0; ks < 2; ++ks) Kf[kt][ks] = *(const bf16x8*)(Z + (size_t)(krow + kt * 16 + fr) * ZW + kcol + ks * 32 + fq * 8);
        bf16x8 Vf[4];
#pragma unroll
        for (int dt = 0; dt < 4; ++dt) {
            const bf16_t* vp = vt + (size_t)(dt * 16 + fr) * VTS + vtoff + fq * 4;
            const u32x2 lo = *(const u32x2*)vp, hi = *(const u32x2*)(vp + 16);
            u32x4 w; w.x = lo.x; w.y = lo.y; w.z = hi.x; w.w = hi.y;
            Vf[dt] = __builtin_bit_cast(bf16x8, w);
        }
#pragma unroll
        for (int s = 0; s < 4; ++s) {
            const bool active = (mode != 2) || !((s == 0 && a1 == 1) || (s == 3 && a1 == 0));
            if (active) {
                f32x4 S0 = (f32x4){0.f, 0.f, 0.f, 0.f}, S1 = (f32x4){0.f, 0.f, 0.f, 0.f};
                S0 = MFMA16(Kf[0][0], Q[s][0], S0); S0 = MFMA16(Kf[0][1], Q[s][1], S0);
                S1 = MFMA16(Kf[1][0], Q[s][0], S1); S1 = MFMA16(Kf[1][1], Q[s][1], S1);
                float sc[8];
#pragma unroll
                for (int j = 0; j < 4; ++j) { sc[j] = S0[j]; sc[4 + j] = S1[j]; }
                if (mode == 1) {
                    const int qpos = q0 + fr;
#pragma unroll
                    for (int e = 0; e < 8; ++e) { const int kpos = a0 + (e >> 2) * 16 + fq * 4 + (e & 3); const int d = kpos - qpos; if (d > 128 || d < -128) sc[e] = -1e30f; }
                } else if (mode == 2) {
                    const int qc = 16 * s + fr; const int cs = min(max(qc - 8, 0), 48);
                    const LAS float* bp = biasL + hk * 465 + a0 * 31;
#pragma unroll
                    for (int e = 0; e < 8; ++e) {
                        const int kc = a1 * 32 + (e >> 2) * 16 + fq * 4 + (e & 3);
                        const int dc = min(max(kc - qc + 15, 0), 30);
                        const float bv = bp[dc];
                        sc[e] = (kc >= cs && kc < cs + 16) ? (sc[e] + bv) : -1e30f;
                    }
                }
                float ml = fmaxf(fmaxf(fmaxf(sc[0], sc[1]), fmaxf(sc[2], sc[3])), fmaxf(fmaxf(sc[4], sc[5]), fmaxf(sc[6], sc[7])));
                ml = fmaxf(ml, __shfl_xor(ml, 16)); ml = fmaxf(ml, __shfl_xor(ml, 32));
                const float mold = mrun[s], mn = fmaxf(mold, ml), alpha = __builtin_amdgcn_exp2f(mold - mn);
                mrun[s] = mn;
                float pv[8], ls = 0.f;
#pragma unroll
                for (int e = 0; e < 8; ++e) { pv[e] = __builtin_amdgcn_exp2f(sc[e] - mn); ls += pv[e]; }
                ls += __shfl_xor(ls, 16); ls += __shfl_xor(ls, 32);
                lrun[s] = lrun[s] * alpha + ls;
                u32x4 pw; pw.x = pk2(pv[0], pv[1]); pw.y = pk2(pv[2], pv[3]); pw.z = pk2(pv[4], pv[5]); pw.w = pk2(pv[6], pv[7]);
                const bf16x8 P = __builtin_bit_cast(bf16x8, pw);
                if (__builtin_amdgcn_ballot_w64(mn > mold) != 0ull) {
#pragma unroll
                    for (int dt = 0; dt < 4; ++dt) O[s][dt] = O[s][dt] * alpha;
                }
#pragma unroll
                for (int dt = 0; dt < 4; ++dt) O[s][dt] = MFMA16(Vf[dt], P, O[s][dt]);
            }
            __builtin_amdgcn_sched_barrier(0);
        }
    };
    int nloc = 0, lo = 0, r0 = 0;
    if (kind == 1) { lo = max(0, q0 - 128) & ~31; const int hi = min(2048, (q0 + 16 + 128 + 31) & ~31); nloc = (hi - lo) >> 5; }
    else if (kind == 0) { r0 = min(max(r - 4, 0), 24); nloc = 16; }
#pragma unroll 1
    for (int i = 0; i < 8 + nloc; ++i) {
        int krow, vtoff, mode, a0, a1;
        if (i < 8) { krow = krow_ctx0 + 32 * i; vtoff = 2048 + 32 * i; mode = 0; a0 = 0; a1 = 0; }
        else if (kind == 1) { const int kb = lo + 32 * (i - 8); krow = krow_lat0 + kb; vtoff = kb; mode = 1; a0 = kb; a1 = 0; }
        else { const int jj = i - 8, kr = r0 + (jj >> 1), hb = jj & 1; krow = krow_lat0 + kr * 64 + hb * 32; vtoff = kr * 64 + hb * 32; mode = 2; a0 = kr - r + 7; a1 = hb; }
        do_block(krow, vtoff, mode, a0, a1);
    }
#pragma unroll
    for (int s = 0; s < 4; ++s) {
        float fac;
        if (isA) { const float sk = p->a_sink[l * 8 + hk * 4 + s] * LOG2E; const float M = fmaxf(mrun[s], sk); const float e1 = __builtin_amdgcn_exp2f(mrun[s] - M); fac = e1 / (lrun[s] * e1 + __builtin_amdgcn_exp2f(sk - M)); }
        else fac = 1.0f / lrun[s];
        bf16_t* op = yo + (size_t)(qrow0 + s * qrstep + fr) * 512 + ocol0 + s * qcstep + fq * 4;
#pragma unroll
        for (int dt = 0; dt < 4; ++dt) { const f32x4 o = O[s][dt] * fac; u32x2 w; w.x = pk2(o.x, o.y); w.y = pk2(o.z, o.w); *(u32x2*)(op + dt * 16) = w; }
    }
}

constexpr int SCAN_BUF = 41472;
constexpr int BIAS_OFF = 3 * SCAN_BUF;
template <int DK, bool ISC>
__device__ __forceinline__ void scan_task(PPtr p, int l, int bl, int h, int dir, LAS unsigned char* lds) {
    constexpr int KPW = DK / 8, NTG = 64 / KPW, TPG = 32 / NTG, QS = (DK + 8) * 2, NKT = DK / 16;
    const int tid = ltid(), w = tid >> 6, lane = tid & 63, fr = lane & 15, fq = lane >> 4;
    const int kl = lane % KPW, tg = lane / KPW, kch = w * KPW + kl;
    const int vcol = tid & 127, vg = tid >> 7;
    LAS unsigned char* qt = lds; LAS unsigned char* kt_ = qt + 32 * QS; LAS unsigned char* khT = kt_ + 32 * QS; LAS unsigned char* vT = khT + DK * 80;
    LAS unsigned char* att = vT + 128 * 80; LAS float* dvec = (LAS float*)(att + 32 * 80); LAS float* evec = dvec + DK;
    const bf16_t* Z = (const bf16_t*)(p->ws + p->o_z);
    const int LATR = p->GB * 2048, MG = p->MG;
    const int qc = ISC ? (ZC_Q + h * 128 + kch) : (ZD_Q + h * 64 + kch);
    const int kc = ISC ? ((dir ? ZC_FB : ZC_FF) + h * 128 + kch) : (ZD_K + h * 64 + kch);
    const int vc = (ISC ? ZC_I : ZD_V) + h * 128 + vcol;
    const int gcol = ZD_GK + dir * 16;
    float lbv = 0.f, oml = 1.f, up[16], gb = 0.f;
#pragma unroll
    for (int r = 0; r < 16; ++r) up[r] = 0.f;
    if (ISC) { lbv = ((const float*)(p->ws + p->o_lb))[l * 512 + h * 128 + kch]; oml = 1.0f - lbv; }
    else {
#pragma unroll
        for (int r = 0; r < 16; ++r) up[r] = p->d_gate_up[((size_t)(l * 2 + dir) * 16 + r) * 256 + h * 64 + kch];
        gb = p->d_gate_bias[(l * 2 + dir) * 256 + h * 64 + kch];
    }
    bf16_t* odst = (dir == 0) ? ((bf16_t*)(p->ws + p->o_y4) + (size_t)(ISC ? 2 : 3) * MG * 512) : ((bf16_t*)(p->ws + p->o_ob) + (size_t)(ISC ? 0 : 1) * MG * 512);
    f32x4 S[NKT];
#pragma unroll
    for (int i = 0; i < NKT; ++i) S[i] = (f32x4){0.f, 0.f, 0.f, 0.f};
    auto rowof = [&](int cc, int i) -> int {
        const bool isctx = cc < 8; const int L = isctx ? 256 : 2048, base = isctx ? (LATR + bl * 256) : (bl * 2048), c = isctx ? cc : cc - 8;
        const int pos = c * 32 + i; return base + (dir ? (L - 1 - pos) : pos);
    };
    bf16_t rq[TPG], rk[TPG], rv[8]; u32x4 rz[TPG][2];
    auto load_raw = [&](int cc) {
#pragma unroll
        for (int e = 0; e < TPG; ++e) {
            const bf16_t* zr = Z + (size_t)rowof(cc, tg * TPG + e) * ZW;
            rq[e] = zr[qc]; rk[e] = zr[kc];
            if (!ISC) { rz[e][0] = *(const u32x4*)(zr + gcol); rz[e][1] = *(const u32x4*)(zr + gcol + 8); }
        }
#pragma unroll
        for (int e = 0; e < 8; ++e) rv[e] = Z[(size_t)rowof(cc, vg * 8 + e) * ZW + vc];
    };
    load_raw(0);
    for (int cc = 0; cc < 72; ++cc) {
        __syncthreads();
        {
            float gq[TPG], gk[TPG], cum[TPG]; float run = 0.f;
#pragma unroll
            for (int e = 0; e < TPG; ++e) {
                const float zq = bf2f(rq[e]), zk = bf2f(rk[e]); float g, key, q;
                if (ISC) { const float sg = zk; g = __logf(lbv + oml * sg); key = oml * (1.0f - sg); q = zq; }
                else {
                    float a = gb;
                    const u32x4 z0 = rz[e][0], z1 = rz[e][1];
                    a += lo16(z0.x) * up[0] + hi16(z0.x) * up[1] + lo16(z0.y) * up[2] + hi16(z0.y) * up[3] + lo16(z0.z) * up[4] + hi16(z0.z) * up[5] + lo16(z0.w) * up[6] + hi16(z0.w) * up[7];
                    a += lo16(z1.x) * up[8] + hi16(z1.x) * up[9] + lo16(z1.y) * up[10] + hi16(z1.y) * up[11] + lo16(z1.z) * up[12] + hi16(z1.z) * up[13] + lo16(z1.w) * up[14] + hi16(z1.w) * up[15];
                    g = (fminf(a, 0.f) - __logf(1.0f + __expf(-fabsf(a)))) * (1.0f / 16.0f); key = zk; q = zq;
                }
                run += g; cum[e] = run; gq[e] = q; gk[e] = key;
            }
            float pre = 0.f, total = 0.f, cref = 0.f;
#pragma unroll
            for (int t = 0; t < NTG; ++t) { const float tt = __shfl(run, kl + KPW * t); if (t < tg) pre += tt; if (t < NTG / 2) cref += tt; total += tt; }
            float khv[TPG]; const float etc = __expf(total - cref);
#pragma unroll
            for (int e = 0; e < TPG; ++e) {
                const float c = cum[e] + pre; const int i = tg * TPG + e;
                const float E = __expf(c - cref), kE = gk[e] * __builtin_amdgcn_rcpf(E);
                *(LAS bf16_t*)(qt + i * QS + kch * 2) = f2bf1(gq[e] * E);
                *(LAS bf16_t*)(kt_ + i * QS + kch * 2) = f2bf1(kE);
                khv[e] = kE * etc;
            }
            if constexpr (TPG == 8) { u32x4 o; o.x = pk2(khv[0], khv[1]); o.y = pk2(khv[2], khv[3]); o.z = pk2(khv[4], khv[5]); o.w = pk2(khv[6], khv[7]); *(LAS u32x4*)(khT + kch * 80 + tg * 16) = o; }
            else { u32x2 o; o.x = pk2(khv[0], khv[1]); o.y = pk2(khv[2], khv[3]); *(LAS u32x2*)(khT + kch * 80 + tg * 8) = o; }
            if (tg == 0) { dvec[kch] = __expf(total); evec[kch] = __expf(cref); }
            u32x4 vo; vo.x = (unsigned)rv[0] | ((unsigned)rv[1] << 16); vo.y = (unsigned)rv[2] | ((unsigned)rv[3] << 16); vo.z = (unsigned)rv[4] | ((unsigned)rv[5] << 16); vo.w = (unsigned)rv[6] | ((unsigned)rv[7] << 16);
            *(LAS u32x4*)(vT + vcol * 80 + vg * 16) = vo;
        }
        if (cc + 1 < 72) load_raw(cc + 1);
        __syncthreads();
        if (w < 3) {
            const int tt = (w == 0) ? 0 : 1, st = (w == 2) ? 1 : 0;
            f32x4 a = (f32x4){0.f, 0.f, 0.f, 0.f};
#pragma unroll
            for (int ks = 0; ks < DK / 32; ++ks) {
                const bf16x8 A = *(const LAS bf16x8*)(qt + (tt * 16 + fr) * QS + (ks * 32 + fq * 8) * 2);
                const bf16x8 B = *(const LAS bf16x8*)(kt_ + (st * 16 + fr) * QS + (ks * 32 + fq * 8) * 2);
                a = MFMA16(A, B, a);
            }
#pragma unroll
            for (int j = 0; j < 4; ++j) { const int t = tt * 16 + fq * 4 + j, s = st * 16 + fr; *(LAS bf16_t*)(att + t * 80 + s * 2) = f2bf1(s <= t ? a[j] : 0.f); }
        } else if (w == 3) {
#pragma unroll
            for (int j = 0; j < 4; ++j) { const int t = fq * 4 + j, s = 16 + fr; *(LAS bf16_t*)(att + t * 80 + s * 2) = (bf16_t)0; }
        }
        __syncthreads();
        {
            const int vs = w * 16;
            const bf16x8 Bv = *(const LAS bf16x8*)(vT + (vs + fr) * 80 + fq * 16);
            bf16x8 Sb[NKT / 2];
#pragma unroll
            for (int kp = 0; kp < NKT / 2; ++kp) {
                const f32x4 e0 = *(const LAS f32x4*)(evec + (2 * kp) * 16 + fq * 4), e1 = *(const LAS f32x4*)(evec + (2 * kp + 1) * 16 + fq * 4);
                const f32x4 s0 = S[2 * kp] * e0, s1 = S[2 * kp + 1] * e1;
                u32x4 sw; sw.x = pk2(s0.x, s0.y); sw.y = pk2(s0.z, s0.w); sw.z = pk2(s1.x, s1.y); sw.w = pk2(s1.z, s1.w);
                Sb[kp] = __builtin_bit_cast(bf16x8, sw);
            }
#pragma unroll
            for (int tt = 0; tt < 2; ++tt) {
                f32x4 o = (f32x4){0.f, 0.f, 0.f, 0.f};
#pragma unroll
                for (int kp = 0; kp < NKT / 2; ++kp) {
                    const u32x2 lo = *(const LAS u32x2*)(qt + (tt * 16 + fr) * QS + ((2 * kp) * 16 + fq * 4) * 2);
                    const u32x2 hi = *(const LAS u32x2*)(qt + (tt * 16 + fr) * QS + ((2 * kp + 1) * 16 + fq * 4) * 2);
                    u32x4 aw; aw.x = lo.x; aw.y = lo.y; aw.z = hi.x; aw.w = hi.y;
                    o = MFMA16(__builtin_bit_cast(bf16x8, aw), Sb[kp], o);
                }
                const bf16x8 A2 = *(const LAS bf16x8*)(att + (tt * 16 + fr) * 80 + fq * 16);
                o = MFMA16(A2, Bv, o);
#pragma unroll
                for (int j = 0; j < 4; ++j) { const int row = rowof(cc, tt * 16 + fq * 4 + j); odst[(size_t)row * 512 + h * 128 + vs + fr] = f2bf1(o[j]); }
            }
#pragma unroll
            for (int k2 = 0; k2 < NKT; ++k2) {
                const f32x4 d = *(const LAS f32x4*)(dvec + k2 * 16 + fq * 4);
                S[k2] = S[k2] * d;
                const bf16x8 A3 = *(const LAS bf16x8*)(khT + (k2 * 16 + fr) * 80 + fq * 16);
                S[k2] = MFMA16(A3, Bv, S[k2]);
            }
        }
    }
    __syncthreads();
}

__device__ __forceinline__ void mixer(PPtr p, int l, int g, LAS unsigned char* lds, unsigned long long* tscan = nullptr) {
    const int tid = ltid(), w = tid >> 6, lane = tid & 63;
    LAS float* biasL = (LAS float*)(lds + BIAS_OFF);
    for (int i = tid; i < 8 * 465; i += 512) biasL[i] = p->b_rel_bias[(size_t)l * 8 * 465 + i] * LOG2E;
    __syncthreads();
    const int GB = p->GB, NSC = GB * 8, NS = GB * 16;
    const unsigned long long ts0 = tscan ? __builtin_amdgcn_s_memrealtime() : 0ull;
    for (int st = blockIdx.x; st < NS; st += gridDim.x) {
        if (st < NSC) { scan_task<128, true>(p, l, st >> 3, (st >> 1) & 3, st & 1, lds); }
        else { const int s2 = st - NSC; scan_task<64, false>(p, l, s2 >> 3, (s2 >> 1) & 3, s2 & 1, lds); }
    }
    if (tscan) *tscan += __builtin_amdgcn_s_memrealtime() - ts0;
    unsigned* ctr = (unsigned*)p->ws + (l * 16 + g);
    const int NB0 = GB * 32, NB1 = GB * 32, NB2 = (l < DEPTH - 1) ? GB * 4 : 0, NB3 = NB2, NBT = NB0 + NB1 + NB2 + NB3;
    LAS int* tw = (LAS int*)(lds + CTRL_OFF);
    for (;;) {
        if (tid == 0) *tw = (int)atomicAdd(ctr, 1u);
        __syncthreads();
        const int bt = *tw;
        __syncthreads();
        if (bt >= NBT) break;
        int kind, idx;
        if (bt < NB0) { kind = 0; idx = bt * 8 + w; }
        else if (bt < NB0 + NB1) { kind = 1; idx = (bt - NB0) * 8 + w; }
        else if (bt < NB0 + NB1 + NB2) { kind = 2; idx = (bt - NB0 - NB1) * 8 + w; }
        else { kind = 3; idx = (bt - NB0 - NB1 - NB2) * 8 + w; }
        attn_wave(p, l, kind, idx, lane, biasL);
    }
}

__device__ __forceinline__ void postpass(PPtr p, int l, int nrows) {
    const int lane = ltid() & 63, gw = blockIdx.x * 8 + (ltid() >> 6), NGW = gridDim.x * 8, MG = p->MG;
    const bf16_t* Z = (const bf16_t*)(p->ws + p->o_z);
    for (int it = gw; it < nrows * 2; it += NGW) {
        const int row = it >> 1, br = it & 1;
        bf16_t* yf = (bf16_t*)(p->ws + p->o_y4) + (size_t)(2 + br) * MG * 512 + (size_t)row * 512 + lane * 8;
        const bf16_t* yb = (const bf16_t*)(p->ws + p->o_ob) + (size_t)br * MG * 512 + (size_t)row * 512 + lane * 8;
        const u32x4 a = *(const u32x4*)yf, b = *(const u32x4*)yb;
        const u32x4 gt = *(const u32x4*)(Z + (size_t)row * ZW + (br ? ZD_G : ZC_G) + lane * 8);
        const float* gain = (br ? p->d_norm : p->c_norm) + l * 128 + (lane & 15) * 8;
        float o[8], gv[8];
        o[0] = lo16(a.x) + lo16(b.x); o[1] = hi16(a.x) + hi16(b.x); o[2] = lo16(a.y) + lo16(b.y); o[3] = hi16(a.y) + hi16(b.y);
        o[4] = lo16(a.z) + lo16(b.z); o[5] = hi16(a.z) + hi16(b.z); o[6] = lo16(a.w) + lo16(b.w); o[7] = hi16(a.w) + hi16(b.w);
        gv[0] = lo16(gt.x); gv[1] = hi16(gt.x); gv[2] = lo16(gt.y); gv[3] = hi16(gt.y); gv[4] = lo16(gt.z); gv[5] = hi16(gt.z); gv[6] = lo16(gt.w); gv[7] = hi16(gt.w);
        float ss = 0.f;
#pragma unroll
        for (int e = 0; e < 8; ++e) ss += o[e] * o[e];
        ss += __shfl_xor(ss, 1); ss += __shfl_xor(ss, 2); ss += __shfl_xor(ss, 4); ss += __shfl_xor(ss, 8);
        const float rs = rsqrtf(ss * (1.0f / 128.0f) + EPS);
        const f32x4 g0 = *(const f32x4*)gain, g1 = *(const f32x4*)(gain + 4);
        float y[8];
#pragma unroll
        for (int e = 0; e < 8; ++e) { const float gn = (e < 4) ? g0[e & 3] : g1[e & 3]; y[e] = o[e] * rs * gn * (gv[e] * sigm(gv[e])); }
        u32x4 wv; wv.x = pk2(y[0], y[1]); wv.y = pk2(y[2], y[3]); wv.z = pk2(y[4], y[5]); wv.w = pk2(y[6], y[7]);
        *(u32x4*)yf = wv;
    }
}

#define NOINL __device__ __forceinline__
NOINL void ph_prologue(PPtr pc, LAS unsigned char* lds) { PPtr p = pc; asm volatile("" : "+s"(p)); prologue(p, lds); }
NOINL void ph_rowpass(PPtr pc, int l, int g, int mode, int nrows, int conv_l, LAS unsigned char* lds) { PPtr p = pc; asm volatile("" : "+s"(p)); rowpass(p, l, g, mode, nrows); if (conv_l >= 0) convert_weights(p, conv_l, lds); }
NOINL void ph_inproj(PPtr pc, LAS unsigned char* lds) {
    PPtr p = pc; asm volatile("" : "+s"(p)); const int G = (int)gridDim.x, c = (int)blockIdx.x;
    pg8::Gemm gm{(const bf16_t*)(p->ws + p->o_h), (const bf16_t*)(p->ws + p->o_win), p->MG, ZW, 1024}; pg8::StaticOrder S; S.init(p->MG, ZW, G, c);
    EpiInproj E{(bf16_t*)(p->ws + p->o_z), (bf16_t*)(p->ws + p->o_vta), (bf16_t*)(p->ws + p->o_vtb), (const float*)(p->ws + p->o_rope), p->GB};
    pg8::gemm_phase<EpiInproj, pg8::StaticOrder>(lds, gm, S, E, nullptr);
}
NOINL void ph_mixer(PPtr pc, int l, int g, LAS unsigned char* lds, unsigned long long* tscan = nullptr) { PPtr p = pc; asm volatile("" : "+s"(p)); mixer(p, l, g, lds, tscan); }
NOINL void ph_post(PPtr pc, int l, int nrows) { PPtr p = pc; asm volatile("" : "+s"(p)); postpass(p, l, nrows); }
NOINL void ph_branch(PPtr pc, int Mr, LAS unsigned char* lds) {
    PPtr p = pc; asm volatile("" : "+s"(p)); const int G = (int)gridDim.x, c = (int)blockIdx.x;
    pg8::Gemm gm{(const bf16_t*)(p->ws + p->o_y4), (const bf16_t*)(p->ws + p->o_wb), Mr, 1024, 512}; BranchOrder S{Mr / 256, p->MG / 256, G, c};
    EpiBranch E{(const bf16_t*)(p->ws + p->o_z), (bf16_t*)(p->ws + p->o_h), p->MG / 256};
    pg8::gemm_phase<EpiBranch, BranchOrder>(lds, gm, S, E, nullptr);
}
NOINL void ph_gemm_f32(PPtr pc, int which, int Mr, LAS unsigned char* lds) {
    PPtr p = pc; asm volatile("" : "+s"(p)); const int G = (int)gridDim.x, c = (int)blockIdx.x;
    const bf16_t* A = which ? (const bf16_t*)(p->ws + p->o_z + (size_t)p->MG * 1024 * 4) : (const bf16_t*)(p->ws + p->o_h);
    const bf16_t* Bt = which ? (const bf16_t*)(p->ws + p->o_w2) : (const bf16_t*)(p->ws + p->o_wo);
    pg8::Gemm gm{A, Bt, Mr, 1024, which ? 4096 : 1024}; pg8::StaticOrder S; S.init(Mr, 1024, G, c);
    pg8::EpiF32 E{(float*)(p->ws + p->o_z), 1024, nullptr};
    pg8::gemm_phase<pg8::EpiF32, pg8::StaticOrder>(lds, gm, S, E, nullptr);
}
NOINL void ph_ffn1(PPtr pc, int Mr, LAS unsigned char* lds) {
    PPtr p = pc; asm volatile("" : "+s"(p)); const int G = (int)gridDim.x, c = (int)blockIdx.x;
    pg8::Gemm gm{(const bf16_t*)(p->ws + p->o_h), (const bf16_t*)(p->ws + p->o_w1), Mr, 4096, 1024}; pg8::StaticOrder S; S.init(Mr, 4096, G, c);
    EpiRelu2 E{(bf16_t*)(p->ws + p->o_z + (size_t)p->MG * 1024 * 4), 4096};
    pg8::gemm_phase<EpiRelu2, pg8::StaticOrder>(lds, gm, S, E, nullptr);
}

#define XB_SETUP() volatile LAS unsigned* xb_st = (volatile LAS unsigned*)(lds + CTRL_OFF + 64); unsigned* xb_bar = (unsigned*)(pc->ws + 4096); { XcdBarrier xb0 = xcd_barrier_post(xb_bar, xb_st); (void)xb0; }
#define GSYNC() { XcdBarrier xb_; xb_.bar = (unsigned*)(pc->ws + 4096); xb_.x = xb_xcc_id(); xb_.st = (volatile LAS unsigned*)(lds + CTRL_OFF + 64); xcd_barrier(xb_); }
#ifdef PROBE_MASK
__global__ void __launch_bounds__(512) hybrid_fwd(Params pk) {
    extern __shared__ __attribute__((aligned(16))) unsigned char smem[];
    LAS unsigned char* lds = (LAS unsigned char*)smem;
    cg::grid_group grid = cg::this_grid();
    PPtr pc = (PPtr)__builtin_amdgcn_kernarg_segment_ptr();
    const int GB = pc->GB, MG = pc->MG, NGRP = pc->NGRP, LATR = GB * 2048;
    unsigned long long tacc = 0, t0_ = __builtin_amdgcn_s_memrealtime();
#define PT(kind) { const unsigned long long t1_ = __builtin_amdgcn_s_memrealtime(); if ((PROBE_MASK >> (kind)) & 1) tacc += t1_ - t0_; t0_ = t1_; }
    ph_prologue(pc, lds);
    grid.sync();
    XB_SETUP(); PT(0)
    for (int l = 0; l < DEPTH; ++l) {
        const int Mr = (l < DEPTH - 1) ? MG : LATR;
        for (int g = 0; g < NGRP; ++g) {
            ph_rowpass(pc, l, g, 1, MG, -1, lds);
            GSYNC(); PT(1)
            ph_inproj(pc, lds);
            GSYNC(); PT(2)
            { unsigned long long tsc = 0; ph_mixer(pc, l, g, lds, &tsc); if ((PROBE_MASK >> 11) & 1) tacc += tsc; }
            GSYNC(); PT(3)
            ph_post(pc, l, Mr);
            GSYNC(); PT(4)
            ph_branch(pc, Mr, lds);
            GSYNC(); PT(5)
            ph_gemm_f32(pc, 0, Mr, lds);
            GSYNC(); PT(6)
            ph_rowpass(pc, l, g, 2, Mr, -1, lds);
            GSYNC(); PT(7)
            ph_ffn1(pc, Mr, lds);
            GSYNC(); PT(8)
            ph_gemm_f32(pc, 1, Mr, lds);
            GSYNC(); PT(9)
            ph_rowpass(pc, l, g, 3, Mr, (g == NGRP - 1 && l + 1 < DEPTH) ? l + 1 : -1, lds);
            GSYNC(); PT(10)
        }
    }
    if (blockIdx.x == 0) { const unsigned M = (unsigned)(tacc / 100ull); float* o = pc->out; for (unsigned i2 = threadIdx.x; i2 < M; i2 += 512) o[i2] += 0.125f; }
}

#else
__global__ void __launch_bounds__(512) hybrid_fwd(Params pk) {
    extern __shared__ __attribute__((aligned(16))) unsigned char smem[];
    LAS unsigned char* lds = (LAS unsigned char*)smem;
    cg::grid_group grid = cg::this_grid();
    PPtr pc = (PPtr)__builtin_amdgcn_kernarg_segment_ptr();
    const int GB = pc->GB, MG = pc->MG, NGRP = pc->NGRP, LATR = GB * 2048;
    ph_prologue(pc, lds);
    grid.sync();
    XB_SETUP();
    for (int l = 0; l < DEPTH; ++l) {
        const int Mr = (l < DEPTH - 1) ? MG : LATR;
        for (int g = 0; g < NGRP; ++g) {
            ph_rowpass(pc, l, g, 1, MG, -1, lds);
            GSYNC();
            ph_inproj(pc, lds);
            GSYNC();
            ph_mixer(pc, l, g, lds);
            GSYNC();
            ph_post(pc, l, Mr);
            GSYNC();
            ph_branch(pc, Mr, lds);
            GSYNC();
            ph_gemm_f32(pc, 0, Mr, lds);
            GSYNC();
            ph_rowpass(pc, l, g, 2, Mr, -1, lds);
            GSYNC();
            ph_ffn1(pc, Mr, lds);
            GSYNC();
            ph_gemm_f32(pc, 1, Mr, lds);
            GSYNC();
            ph_rowpass(pc, l, g, 3, Mr, (g == NGRP - 1 && l + 1 < DEPTH) ? l + 1 : -1, lds);
            GSYNC();
        }
    }
}

#endif
extern "C" void kernel_launch(void* const* d_in, const int* in_sizes, int n_in, void* d_out, int out_size, void* d_ws, size_t ws_size, hipStream_t stream) {
    static int grid_blocks = 0;
    if (grid_blocks == 0) {
        int dev = 0, cus = 0, per_cu = 0;
        hipGetDevice(&dev);
        hipDeviceGetAttribute(&cus, hipDeviceAttributeMultiprocessorCount, dev);
        if (hipFuncSetAttribute((const void*)hybrid_fwd, hipFuncAttributeMaxDynamicSharedMemorySize, LDS_BYTES) != hipSuccess) fprintf(stderr, "hipFuncSetAttribute failed\n");
        if (hipOccupancyMaxActiveBlocksPerMultiprocessor(&per_cu, (const void*)hybrid_fwd, 512, LDS_BYTES) != hipSuccess || per_cu < 1) { fprintf(stderr, "occupancy query: %d\n", per_cu); per_cu = 1; }
        (void)hipGetLastError();
        grid_blocks = cus * 1;
        if (grid_blocks <= 0) grid_blocks = 256;
    }
    Params p{};
    const float* const* in = (const float* const*)d_in;
    p.x = in[0]; p.c = in[1]; p.ctx = in[2]; p.c_ctx = in[3]; p.w_mod = in[4]; p.b_mod = in[5]; p.norm_gains = in[6]; p.w_in = in[7]; p.a_sink = in[8]; p.b_rel_bias = in[9];
    p.c_lb = in[10]; p.c_norm = in[11]; p.d_gate_up = in[12]; p.d_gate_bias = in[13]; p.d_norm = in[14]; p.w_branch = in[15]; p.w_out = in[16]; p.w_ff1 = in[17]; p.w_ff2 = in[18];
    p.out = (float*)d_out; p.ws = (unsigned char*)d_ws;
    auto al = [](unsigned long long v) { return (v + 255ull) & ~255ull; };
    unsigned long long off = 32768;
    p.o_mod = off; off = al(off + 4ull * 17 * 6144 * 4);
    p.o_lb = off; off = al(off + 4ull * 512 * 4);
    p.o_rope = off; off = al(off + 2048ull * 4);
    p.o_xc = off; off = al(off + 4096ull * 1024 * 4);
    p.o_win = off; off = al(off + (unsigned long long)ZW * 1024 * 2);
    p.o_wb = off; off = al(off + 4096ull * 512 * 2);
    p.o_wo = off; off = al(off + 1024ull * 1024 * 2);
    p.o_w1 = off; off = al(off + 4096ull * 1024 * 2);
    p.o_w2 = off; off = al(off + 1024ull * 4096 * 2);
    const unsigned long long fixed = off;
    int GB = 16;
    for (; GB > 1; GB >>= 1) {
        const unsigned long long MGt = (unsigned long long)GB * 2304;
        const unsigned long long need = fixed + MGt * (2048ull + (unsigned long long)ZW * 2 + 4096ull + 2048ull) + (unsigned long long)GB * 10 * 64 * VTS * 2 + 8 * 256;
        if (need <= (unsigned long long)ws_size) break;
    }
    p.GB = GB; p.NGRP = 16 / GB; p.MG = GB * 2304;
    const unsigned long long MGu = (unsigned long long)p.MG;
    p.o_h = off; off = al(off + MGu * 1024 * 2);
    p.o_z = off; off = al(off + MGu * ZW * 2);
    p.o_y4 = off; off = al(off + MGu * 2048 * 2);
    p.o_ob = off; off = al(off + MGu * 1024 * 2);
    p.o_vta = off; off = al(off + (unsigned long long)GB * 2 * 64 * VTS * 2);
    p.o_vtb = off; off = al(off + (unsigned long long)GB * 8 * 64 * VTS * 2);
    hipMemsetAsync(d_ws, 0, 32768, stream);
    void* args[] = {&p};
    hipError_t e = hipLaunchCooperativeKernel((const void*)hybrid_fwd, dim3(grid_blocks), dim3(512), args, LDS_BYTES, stream);
    if (e != hipSuccess) fprintf(stderr, "cooperative launch failed: %s (grid %d)\n", hipGetErrorString(e), grid_blocks);
}
```

```cpp
#include <hip/hip_runtime.h>
#include <hip/hip_cooperative_groups.h>
#include <cstdio>
namespace cg = cooperative_groups;
__device__ __forceinline__ int ltid() { int t = (int)threadIdx.x; asm volatile("" : "+v"(t)); return t; }
#define LAS __attribute__((address_space(3)))
namespace pg8 {
#define PG8_LAS __attribute__((address_space(3)))
typedef unsigned short bf16_t;
typedef short bf16x8 __attribute__((ext_vector_type(8)));
typedef float f32x4 __attribute__((ext_vector_type(4)));
typedef unsigned u32x4 __attribute__((ext_vector_type(4)));
constexpr int BM = 256, BK = 64, HALF = 128, HTB = HALF * BK * 2  , STAGE_BYTES = 8 * HTB, NXCD = 8, WGM = 8;

__host__ __device__ __forceinline__ int lds_byte(int r, int c) { const int st = (r >> 4) * 2 + (c >> 5), rr = r & 15, cc = c & 31, ob = rr * 64 + cc * 2; return st * 1024 + (ob ^ (((ob >> 9) & 1) << 5)); }
__host__ __device__ __forceinline__ void stage_rc(int b, int& R, int& C) { const int st = b / 1024, sb = b % 1024, swz = sb ^ (((sb >> 9) & 1) << 5); R = (st >> 1) * 16 + swz / 64; C = (st & 1) * 32 + (swz % 64) / 2; }
__host__ __device__ __forceinline__ int perm32(int rho) { const int n = rho >> 4, i = rho & 15; return 8 * (i >> 2) + 4 * n + (i & 3); }

struct Unit { int pm, pn, ko; };
struct Gemm { const bf16_t* A; const bf16_t* Bt; int M, N, K, Kl; };

struct StaticOrder {
    int nM, nN, nwg, G, c;
    __host__ __device__ void init(int M, int N, int G_, int c_) { nM = M / BM; nN = N / BM; nwg = nM * nN; G = G_; c = c_; }
    __host__ __device__ bool next(int i, Unit& u) const {
        const long L = (long)i * G + c; if (L >= nwg) return false;
        int wgid = (int)L; { const int q = nwg / NXCD, r = nwg % NXCD, xcd = wgid % NXCD, off = wgid / NXCD; wgid = (xcd < r ? xcd * (q + 1) : r * (q + 1) + (xcd - r) * q) + off; }
        const int nig = WGM * nN, gid = wgid / nig, fm = gid * WGM, gsz = (nM - fm) < WGM ? (nM - fm) : WGM;
        u.pm = fm + ((wgid % nig) % gsz); u.pn = (wgid % nig) / gsz; u.ko = 0; return true;
    }
    __device__ __forceinline__ void a_ready(const Unit&) const {}
    __device__ __forceinline__ void done(const Unit&) const {}
};
__device__ __forceinline__ unsigned cvt_pk_bf16(float lo, float hi) { unsigned r; asm volatile("v_cvt_pk_bf16_f32 %0, %1, %2" : "=v"(r) : "v"(lo), "v"(hi)); return r; }
struct EpiF32 {
    static constexpr bool PERM = false, AFTER_DRAIN = false;
    float* C; int ldc; const float* bias;
    __device__ __forceinline__ void operator()(const f32x4 (&acc)[2][2][4][2], const Unit& u, int wr, int wc, int fr, int fq) const {
        const int row0 = u.pm * BM + wr * 64 + fr, col0 = u.pn * BM + wc * 32 + 4 * fq;
        f32x4 bv[2][2];
#pragma unroll
        for (int bj = 0; bj < 2; ++bj)
#pragma unroll
            for (int n = 0; n < 2; ++n) bv[bj][n] = bias ? *(const f32x4*)(bias + col0 + bj * HALF + n * 16) : (f32x4){0.f, 0.f, 0.f, 0.f};
#pragma unroll
        for (int ai = 0; ai < 2; ++ai)
#pragma unroll
            for (int m = 0; m < 4; ++m) { float* rowp = C + (size_t)(row0 + ai * HALF + m * 16) * ldc + col0;
#pragma unroll
                for (int bj = 0; bj < 2; ++bj)
#pragma unroll
                    for (int n = 0; n < 2; ++n) *(f32x4*)(rowp + bj * HALF + n * 16) = acc[ai][bj][m][n] + bv[bj][n]; }
    }
};
template <class Epi, class Sched, bool STAMP = false>
__device__ __forceinline__ void gemm_phase(PG8_LAS unsigned char* lds, const Gemm g, const Sched& S, const Epi& E, unsigned long long* stamps) {
    const int tid = ltid(), wid = __builtin_amdgcn_readfirstlane(tid >> 6), lane = tid & 63, wr = wid >> 2, wc = wid & 3, fr = lane & 15, fq = lane >> 4;
    const int K = g.K, nt = g.Kl / BK;
    int ts_lo = 0, ts_hi = 0, nts = 0; const unsigned long long rt_entry = STAMP ? (unsigned long long)wall_clock64() : 0ull;
#define PG8_STAMP() do { if (STAMP && wid == 0 && nts < 64) { const unsigned long long _c = (unsigned long long)clock64(); \
        ts_lo = (lane == nts) ? (int)(unsigned)_c : ts_lo; ts_hi = (lane == nts) ? (int)(unsigned)(_c >> 32) : ts_hi; ++nts; } } while (0)
    PG8_STAMP();
    unsigned voffA[2], voffB[2];
#pragma unroll
    for (int i = 0; i < 2; ++i) { int R, C; stage_rc(tid * 16 + i * 8192, R, C); const int Rb = Epi::PERM ? ((R & ~31) + perm32(R & 31)) : R;
        voffA[i] = (unsigned)(R * K + C) * 2u; voffB[i] = (unsigned)(Rb * K + C) * 2u; }
    const size_t kstep = (size_t)(BK * 2);
    const size_t hstep = (size_t)HALF * K * 2;
    const size_t tstep = 2 * hstep;
    const unsigned ldsw = (unsigned)wid * 1024u;
    const int aoff = lds_byte(wr * 64 + fr, fq * 8), boff = lds_byte(wc * 32 + fr, fq * 8);
#define PG8_SA(b, h) (((b) * 2 + (h)) * HTB)
#define PG8_SB(b, h) ((4 + (b) * 2 + (h)) * HTB)
#define PG8_STAGE(bufoff, gbase, voff) do { _Pragma("unroll") for (int _i = 0; _i < 2; ++_i) \
        __builtin_amdgcn_global_load_lds((const unsigned*)((const char*)(gbase) + (voff)[_i]), (PG8_LAS unsigned*)(lds + (bufoff) + ldsw + _i * 8192), 16, 0, 0); } while (0)
#define PG8_LDA(dst, b, h) do { _Pragma("unroll") for (int m = 0; m < 4; ++m) _Pragma("unroll") for (int k = 0; k < 2; ++k) dst[m][k] = *(const PG8_LAS bf16x8*)(lds + PG8_SA(b, h) + aoff + m * 2048 + k * 1024); } while (0)
#define PG8_LDB(dst, b, h) do { _Pragma("unroll") for (int n = 0; n < 2; ++n) _Pragma("unroll") for (int k = 0; k < 2; ++k) dst[n][k] = *(const PG8_LAS bf16x8*)(lds + PG8_SB(b, h) + boff + n * 2048 + k * 1024); } while (0)
#define PG8_MMA(ai, bj, At, Bt) do { __builtin_amdgcn_s_setprio(1); _Pragma("unroll") for (int m = 0; m < 4; ++m) _Pragma("unroll") for (int n = 0; n < 2; ++n) _Pragma("unroll") for (int k = 0; k < 2; ++k) \
        acc[ai][bj][m][n] = __builtin_amdgcn_mfma_f32_16x16x32_bf16(Bt[n][k], At[m][k], acc[ai][bj][m][n], 0, 0, 0); __builtin_amdgcn_s_setprio(0); } while (0)
#define PG8_WAIT_V(n) asm volatile("s_waitcnt vmcnt(" #n ")" ::: "memory")
#define PG8_WAIT_L(n) asm volatile("s_waitcnt lgkmcnt(" #n ")" ::: "memory")
#define PG8_BAR __builtin_amdgcn_s_barrier()
#define PG8_SCHED __builtin_amdgcn_sched_barrier(0)
    Unit cur, nxt; int ui = 0;
    if (!S.next(0, cur)) return;
    f32x4 acc[2][2][4][2];
#pragma unroll
    for (int a = 0; a < 2; ++a)
#pragma unroll
        for (int b = 0; b < 2; ++b)
#pragma unroll
            for (int m = 0; m < 4; ++m)
#pragma unroll
                for (int n = 0; n < 2; ++n) acc[a][b][m][n] = (f32x4){0.f, 0.f, 0.f, 0.f};
    bf16x8 At[4][2], B0[2][2], B1[2][2];
    const char* cA = (const char*)g.A + (size_t)cur.pm * tstep + (size_t)cur.ko * 2; const char* cB = (const char*)g.Bt + (size_t)cur.pn * tstep + (size_t)cur.ko * 2;
    S.a_ready(cur);
    PG8_STAGE(PG8_SB(0, 0), cB, voffB); PG8_STAGE(PG8_SA(0, 0), cA, voffA); PG8_STAGE(PG8_SB(0, 1), cB + hstep, voffB); PG8_STAGE(PG8_SA(0, 1), cA + hstep, voffA);
    if (wr == 1) PG8_BAR;
    PG8_WAIT_V(4); PG8_BAR;
    PG8_STAGE(PG8_SB(1, 0), cB + kstep, voffB); PG8_STAGE(PG8_SA(1, 0), cA + kstep, voffA); PG8_STAGE(PG8_SB(1, 1), cB + hstep + kstep, voffB);
    PG8_WAIT_V(6); PG8_BAR;
    PG8_STAMP();
    for (;;) {
        const bool has_next = S.next(ui + 1, nxt);
        const char* nA = has_next ? (const char*)g.A + (size_t)nxt.pm * tstep + (size_t)nxt.ko * 2 : cA; const char* nB = has_next ? (const char*)g.Bt + (size_t)nxt.pn * tstep + (size_t)nxt.ko * 2 : cB;
        for (int t = 0; t < nt; t += 2) {
            const bool last = (t == nt - 2);
            const char* a1 = cA + (size_t)(t + 1) * kstep;
            const char* a2 = last ? nA : cA + (size_t)(t + 2) * kstep; const char* b2 = last ? nB : cB + (size_t)(t + 2) * kstep;
            const char* a3 = a2 + kstep; const char* b3 = b2 + kstep;
            if (last && has_next) S.a_ready(nxt);
            PG8_LDB(B0, 0, 0); PG8_SCHED; PG8_LDA(At, 0, 0); PG8_STAGE(PG8_SA(1, 1), a1 + hstep, voffA);
            PG8_WAIT_L(8); PG8_BAR; PG8_WAIT_L(0); PG8_MMA(0, 0, At, B0); PG8_BAR; PG8_SCHED;
            PG8_LDB(B1, 0, 1); PG8_STAGE(PG8_SB(0, 0), b2, voffB);
            PG8_BAR; PG8_WAIT_L(0); PG8_MMA(0, 1, At, B1); PG8_BAR;
            PG8_LDA(At, 0, 1); PG8_STAGE(PG8_SA(0, 0), a2, voffA);
            PG8_BAR; PG8_WAIT_L(0); PG8_MMA(1, 0, At, B0); PG8_BAR; PG8_SCHED;
            PG8_STAGE(PG8_SB(0, 1), b2 + hstep, voffB);
            PG8_WAIT_V(6); PG8_BAR; PG8_MMA(1, 1, At, B1); PG8_BAR;
            PG8_LDB(B0, 1, 0); PG8_SCHED; PG8_LDA(At, 1, 0); PG8_STAGE(PG8_SA(0, 1), a2 + hstep, voffA);
            PG8_WAIT_L(8); PG8_BAR; PG8_WAIT_L(0); PG8_MMA(0, 0, At, B0); PG8_BAR; PG8_SCHED;
            PG8_LDB(B1, 1, 1); PG8_STAGE(PG8_SB(1, 0), b3, voffB);
            PG8_BAR; PG8_WAIT_L(0); PG8_MMA(0, 1, At, B1); PG8_BAR;
            PG8_LDA(At, 1, 1); PG8_STAGE(PG8_SA(1, 0), a3, voffA);
            PG8_BAR; PG8_WAIT_L(0); PG8_MMA(1, 0, At, B0); PG8_BAR; PG8_SCHED;
            PG8_STAGE(PG8_SB(1, 1), b3 + hstep, voffB);
            PG8_WAIT_V(6); PG8_BAR; PG8_MMA(1, 1, At, B1); PG8_BAR;
        }
        PG8_STAMP();
        if constexpr (!Epi::AFTER_DRAIN) { E(acc, cur, wr, wc, fr, fq); S.done(cur); }
        PG8_STAMP();
        if (!has_next) break;
#pragma unroll
        for (int a = 0; a < 2; ++a)
#pragma unroll
            for (int b = 0; b < 2; ++b)
#pragma unroll
                for (int m = 0; m < 4; ++m)
#pragma unroll
                    for (int n = 0; n < 2; ++n) acc[a][b][m][n] = (f32x4){0.f, 0.f, 0.f, 0.f};
        cur = nxt; cA = nA; cB = nB; ++ui;
    }
    PG8_WAIT_V(0);
    if (wr == 0) PG8_BAR;
    PG8_BAR;
    if constexpr (Epi::AFTER_DRAIN) { E.fused(acc, cur, wr, wc, fr, fq, lds, wid, lane); S.done(cur); }
    PG8_STAMP();
    if (STAMP && wid == 0) { stamps[lane] = lane < nts ? (((unsigned long long)(unsigned)ts_hi << 32) | (unsigned)ts_lo) : 0ull;
        if (lane == 62) stamps[62] = rt_entry; if (lane == 63) stamps[63] = (unsigned long long)wall_clock64(); }
#undef PG8_STAMP
#undef PG8_SA
#undef PG8_SB
#undef PG8_STAGE
#undef PG8_LDA
#undef PG8_LDB
#undef PG8_MMA
#undef PG8_WAIT_V
#undef PG8_WAIT_L
#undef PG8_BAR
#undef PG8_SCHED
}
}
#define XB_TMO      128
#define XB_XCNT(j)  (256  + 64 * (j))
#define XB_XSUB(j)  (1280 + 64 * (j))
#define XB_XGEN(j)  (2304 + 64 * (j))
#define XB_TOP      3328
#define XB_TOPGEN   3392
#define XCD_BAR_WORDS 3456
#define XB_SPIN_CAP (1u << 18)

__device__ __forceinline__ unsigned xb_ld(unsigned* p)              { return __hip_atomic_load(p, __ATOMIC_RELAXED, __HIP_MEMORY_SCOPE_AGENT); }
__device__ __forceinline__ unsigned xb_add(unsigned* p, unsigned v) { return __hip_atomic_fetch_add(p, v, __ATOMIC_RELAXED, __HIP_MEMORY_SCOPE_AGENT); }
__device__ __forceinline__ unsigned xb_xcc_id() { return (unsigned)__builtin_amdgcn_s_getreg((3 << 11) | 20) & 0xFu; }
#define XB_SPIN(cond, bar) do { unsigned _sp = 0; while (cond) { __builtin_amdgcn_s_sleep(1); \
    if ((++_sp & 255u) == 0u) { if (xb_ld(&(bar)[XB_TMO])) break; if (_sp > XB_SPIN_CAP) { atomicAdd(&(bar)[XB_TMO], 1u); break; } } } } while (0)

struct XcdBarrier {
    unsigned* bar; unsigned x;
    volatile LAS unsigned* st;
};

__device__ __forceinline__ XcdBarrier xcd_barrier_post(unsigned* bar, volatile LAS unsigned* st) {
    XcdBarrier b; b.bar = bar; b.x = xb_xcc_id(); b.st = st;
    if (threadIdx.x == 0) (void)xb_add(&bar[XB_XCNT(b.x)], 1u);
    return b;
}
__device__ __forceinline__ void xcd_barrier_complete(unsigned* bar, unsigned x, unsigned& nloc, unsigned& nx) {
    const unsigned G = gridDim.x * gridDim.y * gridDim.z;
    unsigned sum, cnt, mine, sp = 0u;
    for (;;) {
        sum = 0u; cnt = 0u; mine = 0u;
#pragma unroll
        for (unsigned j = 0; j < 16; ++j) { const unsigned c = xb_ld(&bar[XB_XCNT(j)]); sum += c; cnt += (c > 0u) ? 1u : 0u; mine = (j == x) ? c : mine; }
        if (sum == G) break;
        __builtin_amdgcn_s_sleep(1);
        if ((++sp & 255u) == 0u) { if (xb_ld(&bar[XB_TMO])) break; if (sp > XB_SPIN_CAP) { atomicAdd(&bar[XB_TMO], 1u); break; } }
    }
    nloc = mine > 0u ? mine : 1u; nx = cnt > 0u ? cnt : 1u;
}

__device__ __forceinline__ void xcd_barrier(const XcdBarrier& b) {
    asm volatile("s_waitcnt vmcnt(0)" ::: "memory");
    __syncthreads();
    if (threadIdx.x == 0) {
        unsigned* bar = b.bar;
        __builtin_amdgcn_s_waitcnt(0);
        unsigned nloc = b.st[0], nx = b.st[1];
        if (nloc == 0u) { xcd_barrier_complete(bar, b.x, nloc, nx); b.st[0] = nloc; b.st[1] = nx; }
        const unsigned old = xb_add(&bar[XB_XSUB(b.x)], 1u);
        const unsigned gen = old / nloc;
        if (old + 1u == (gen + 1u) * nloc) {
            __builtin_amdgcn_fence(__ATOMIC_RELEASE, "agent");
            asm volatile("s_waitcnt vmcnt(0)" ::: "memory");
            const unsigned og = xb_add(&bar[XB_TOP], 1u);
            const unsigned tg = og / nx;
            if (og + 1u == (tg + 1u) * nx) xb_add(&bar[XB_TOPGEN], 1u);
            else XB_SPIN(xb_ld(&bar[XB_TOPGEN]) == tg, bar);
            __builtin_amdgcn_fence(__ATOMIC_ACQUIRE, "agent");
            xb_add(&bar[XB_XGEN(b.x)], 1u);
            asm volatile("s_waitcnt vmcnt(0)" ::: "memory");
        } else {
            XB_SPIN(xb_ld(&bar[XB_XGEN(b.x)]) == gen, bar);
            __builtin_amdgcn_fence(__ATOMIC_ACQUIRE, "agent");
            asm volatile("s_waitcnt vmcnt(0)" ::: "memory");
        }
    }
    __syncthreads();
}

typedef unsigned short bf16_t;
typedef pg8::bf16x8 bf16x8;
typedef pg8::f32x4 f32x4;
typedef pg8::u32x4 u32x4;
typedef unsigned u32x2 __attribute__((ext_vector_type(2)));

constexpr int DM = 1024, NB = 16, SEQ = 2048, DEPTH = 4, CTXL = 256, DFF = 4096;
constexpr int ZW = 10752;
constexpr int INW = 10528;
constexpr int ZA_Q = 0, ZA_K = 512, ZA_V = 640, ZB_Q = 768, ZB_K = 1280, ZB_V = 1792, ZC_Q = 2304, ZC_FF = 2816, ZC_FB = 3328, ZC_I = 3840, ZC_G = 4352,
              ZD_Q = 4864, ZD_K = 5120, ZD_V = 5376, ZD_GK = 5888, ZD_G = 6016, ZMERGE = 6656;
constexpr int VTS = 2304;
constexpr int LDS_BYTES = 144 * 1024;
constexpr int CTRL_OFF = LDS_BYTES - 256;
constexpr float EPS = 1e-6f;
constexpr float LOG2E = 1.4426950408889634f;
constexpr float QSCALE2 = 0.125f * LOG2E;

struct Params {
    const float *x, *c, *ctx, *c_ctx, *w_mod, *b_mod, *norm_gains, *w_in, *a_sink, *b_rel_bias, *c_lb, *c_norm, *d_gate_up, *d_gate_bias, *d_norm, *w_branch, *w_out, *w_ff1, *w_ff2;
    float* out;
    unsigned char* ws;
    unsigned long long o_mod, o_lb, o_rope, o_xc, o_win, o_wb, o_wo, o_w1, o_w2, o_h, o_z, o_y4, o_ob, o_vta, o_vtb, o_wo4;
    int GB, NGRP, MG, pad0;
};
typedef const Params __attribute__((address_space(4)))* PPtr;

__device__ __forceinline__ float bf2f(unsigned v) { return __uint_as_float(v << 16); }
__device__ __forceinline__ bf16_t f2bf(float f) { unsigned u = __float_as_uint(f); u += 0x7FFFu + ((u >> 16) & 1u); return (bf16_t)(u >> 16); }
typedef __bf16 bf16v2_t __attribute__((ext_vector_type(2)));
typedef float f32v2_t __attribute__((ext_vector_type(2)));
__device__ __forceinline__ unsigned pk2(float lo, float hi) { const f32v2_t v = {lo, hi}; const bf16v2_t b = __builtin_convertvector(v, bf16v2_t); return __builtin_bit_cast(unsigned, b); }
template <int CTRL> __device__ __forceinline__ float dpp(float x) { return __builtin_bit_cast(float, __builtin_amdgcn_mov_dpp(__builtin_bit_cast(int, x), CTRL, 0xf, 0xf, true)); }
constexpr int XOR1 = 0xB1, XOR2 = 0x4E, XOR7 = 0x141, XOR8 = 0x128;
__device__ __forceinline__ float xrow16_max(float x) {
    auto s = __builtin_amdgcn_permlane16_swap(__float_as_uint(x), __float_as_uint(x), false, false);
    x = fmaxf(__uint_as_float(s[0]), __uint_as_float(s[1]));
    auto t = __builtin_amdgcn_permlane32_swap(__float_as_uint(x), __float_as_uint(x), false, false);
    return fmaxf(__uint_as_float(t[0]), __uint_as_float(t[1]));
}
__device__ __forceinline__ float xrow16_sum(float x) {
    auto s = __builtin_amdgcn_permlane16_swap(__float_as_uint(x), __float_as_uint(x), false, false);
    x = __uint_as_float(s[0]) + __uint_as_float(s[1]);
    auto t = __builtin_amdgcn_permlane32_swap(__float_as_uint(x), __float_as_uint(x), false, false);
    return __uint_as_float(t[0]) + __uint_as_float(t[1]);
}
__device__ __forceinline__ float row16_sum(float v) {
    v += dpp<XOR1>(v); v += dpp<XOR2>(v); v += dpp<XOR7>(v); v += dpp<XOR8>(v);
    return v;
}
__device__ __forceinline__ float wave_sum(float v) { return xrow16_sum(row16_sum(v)); }
__device__ __forceinline__ float lo16(unsigned w) { return __uint_as_float(w << 16); }
__device__ __forceinline__ float hi16(unsigned w) { return __uint_as_float(w & 0xffff0000u); }
__device__ __forceinline__ float sigm(float x) { return 1.0f / (1.0f + __expf(-x)); }
__device__ __forceinline__ bf16_t f2bf1(float x) { return (bf16_t)pk2(x, 0.f); }

__device__ __forceinline__ int src_col(int n) {
    if (n < 640) {
        const int p = n & 63, base = n - p, pp = p >> 1, wh = p & 1;
        const int dim = (pp < 16) ? (wh ? 16 + pp : pp) : (wh ? 48 + (pp - 16) : 32 + (pp - 16));
        return base + dim;
    }
    if (n < 5920) return n;
    if (n < 6016) return -1;
    if (n < 6528) return n - 96;
    if (n < 6656) return -1;
    return 6432 + (n - 6656);
}

__device__ __forceinline__ void conv_tile(const float* src, int Nsrc, int k0, int n0, bool inmap, bf16_t* dst, int Kd, LAS float* t) {
    const int tid = ltid(), nl = tid & 63, ks = tid >> 6;
    const int sc = inmap ? src_col(n0 + nl) : (n0 + nl);
#pragma unroll
    for (int i = 0; i < 8; ++i) { const int kk = ks + 8 * i; t[nl * 65 + kk] = (sc >= 0) ? src[(size_t)(k0 + kk) * Nsrc + sc] : 0.f; }
    __syncthreads();
    const int kl = (tid & 31) * 2, ns = tid >> 5;
#pragma unroll
    for (int i = 0; i < 4; ++i) { const int n = ns + 16 * i; *(unsigned*)(dst + (size_t)(n0 + n) * Kd + k0 + kl) = pk2(t[n * 65 + kl], t[n * 65 + kl + 1]); }
    __syncthreads();
}
__device__ __forceinline__ void convert_weights(PPtr p, int l, LAS unsigned char* lds) {
    LAS float* t = (LAS float*)lds;
    bf16_t* WinT = (bf16_t*)(p->ws + p->o_win); bf16_t* WbT = (bf16_t*)(p->ws + p->o_wb); bf16_t* WoT = (bf16_t*)(p->ws + p->o_wo);
    bf16_t* W1T = (bf16_t*)(p->ws + p->o_w1); bf16_t* W2T = (bf16_t*)(p->ws + p->o_w2);
    constexpr int T_IN = 16 * 168, T_BR = 4 * 8 * 16, T_O = 16 * 16, T_1 = 16 * 64, T_2 = 64 * 16, T_ALL = T_IN + T_BR + T_O + T_1 + T_2;
    for (int it = blockIdx.x; it < T_ALL; it += gridDim.x) {
        int r = it;
        if (r < T_IN) { const int kb = r / 168, nb = r % 168; conv_tile(p->w_in + (size_t)l * 1024 * INW, INW, kb * 64, nb * 64, true, WinT, 1024, t); continue; } r -= T_IN;
        if (r < T_BR) { const int j = r / 128, q = r % 128, kb = q / 16, nb = q % 16; conv_tile(p->w_branch + (size_t)(l * 4 + j) * 512 * 1024, 1024, kb * 64, nb * 64, false, WbT + (size_t)j * 1024 * 512, 512, t); continue; } r -= T_BR;
        if (r < T_O) { const int kb = r / 16, nb = r % 16; conv_tile(p->w_out + (size_t)l * 1024 * 1024, 1024, kb * 64, nb * 64, false, WoT, 1024, t);
#pragma unroll 1
            for (int cpy = 0; cpy < 4; ++cpy) conv_tile(p->w_out + (size_t)l * 1024 * 1024, 1024, kb * 64, nb * 64, false, (bf16_t*)(p->ws + p->o_wo4) + cpy * 1024, 4096, t);
            continue; } r -= T_O;
        if (r < T_1) { const int kb = r / 64, nb = r % 64; conv_tile(p->w_ff1 + (size_t)l * 1024 * 4096, 4096, kb * 64, nb * 64, false, W1T, 1024, t); continue; } r -= T_1;
        { const int kb = r / 16, nb = r % 16; conv_tile(p->w_ff2 + (size_t)l * 4096 * 1024, 1024, kb * 64, nb * 64, false, W2T, 4096, t); }
    }
}

__device__ __forceinline__ void prologue(PPtr p, LAS unsigned char* lds) {
    const int tid = ltid();
    if (blockIdx.x == 0) {
        if (tid < 64) atomicExch((unsigned*)p->ws + tid, 0u);
        for (int i = tid; i < XCD_BAR_WORDS; i += 512) __hip_atomic_store((unsigned*)(p->ws + 4096) + i, 0u, __ATOMIC_RELAXED, __HIP_MEMORY_SCOPE_AGENT);
    }
    if (tid < 4) *((LAS unsigned*)(lds + CTRL_OFF + 64) + tid) = 0u;
    float* modb = (float*)(p->ws + p->o_mod);
    LAS float* sl = (LAS float*)lds;
    LAS float* red = sl + 17 * 1024;
    bool loaded = false;
    for (int task = blockIdx.x; task < 192; task += gridDim.x) {
        if (!loaded) {
            for (int i = tid; i < 17 * 1024; i += 512) { const int b = i >> 10, k = i & 1023; const float v = (b < 16) ? p->c[b * 1024 + k] : p->c_ctx[k]; sl[i] = v * sigm(v); }
            loaded = true;
        }
        __syncthreads();
        const int l = task / 48, nc = task % 48, nn = tid & 127, n = nc * 128 + nn, kq = tid >> 7;
        float acc[17];
#pragma unroll
        for (int b = 0; b < 17; ++b) acc[b] = 0.f;
        const float* w = p->w_mod + ((size_t)l * 1024 + kq * 256) * 6144 + n;
#pragma unroll 4
        for (int k = 0; k < 256; ++k) {
            const float wv = w[(size_t)k * 6144];
#pragma unroll
            for (int b = 0; b < 17; ++b) acc[b] += sl[b * 1024 + kq * 256 + k] * wv;
        }
#pragma unroll
        for (int b = 0; b < 17; ++b) red[(kq * 17 + b) * 128 + nn] = acc[b];
        __syncthreads();
        if (kq == 0) {
            const float bm = p->b_mod[l * 6144 + n];
#pragma unroll
            for (int b = 0; b < 17; ++b) modb[((size_t)l * 17 + b) * 6144 + n] = red[b * 128 + nn] + red[(17 + b) * 128 + nn] + red[(34 + b) * 128 + nn] + red[(51 + b) * 128 + nn] + bm;
        }
        __syncthreads();
    }
    if (blockIdx.x == gridDim.x - 1) {
        float* lb = (float*)(p->ws + p->o_lb);
        {
            const int ch = tid;
            float v[4], mx = -1e30f;
#pragma unroll
            for (int l = 0; l < 4; ++l) { v[l] = p->c_lb[l * 512 + ch]; mx = fmaxf(mx, v[l]); }
            float s = 0.f;
#pragma unroll
            for (int l = 0; l < 4; ++l) { v[l] = __expf(v[l] - mx); s += v[l]; }
            const float inv = 1.0f / s, s0 = v[0] * inv; float cum = 0.f;
#pragma unroll
            for (int l = 0; l < 4; ++l) { cum += v[l] * inv; lb[l * 512 + ch] = cum - s0; }
        }
        float* rt = (float*)(p->ws + p->o_rope);
        for (int i = tid; i < 1024; i += 512) {
            const int n = i >> 4, f = i & 15;
            const float inv = __expf(-((float)(2 * f) / 32.0f) * 9.210340371976184f);
            const float a = (float)n * inv;
            const float kf = rintf(a * 0.15915494309189535f);
            const float rr = fmaf(-kf, 6.2831854820251465f, a) + kf * 1.7484556e-7f;
            rt[i] = __cosf(rr); rt[1024 + i] = __sinf(rr);
        }
    }
    __syncthreads();
    convert_weights(p, 0, lds);
}

__device__ __forceinline__ void rowpass(PPtr p, int l, int g, int mode, int nrows) {
    const int lane = ltid() & 63, gw = blockIdx.x * 8 + (ltid() >> 6), NGW = gridDim.x * 8;
    const int LATR = p->GB * 2048, GB = p->GB;
    const float* ng = p->norm_gains + (size_t)l * 4 * 1024;
    const float* modb = (const float*)(p->ws + p->o_mod) + (size_t)l * 17 * 6144;
    bf16_t* hb = (bf16_t*)(p->ws + p->o_h);
    const float* yf = (const float*)(p->ws + p->o_z);
    float* xcb = (float*)(p->ws + p->o_xc);
    const bool first = (l == 0 && mode <= 2);
    const float* xlat = first ? p->x : (const float*)p->out;
    const float* xctx = first ? p->ctx : (const float*)xcb;
    auto xsrc = [&](int row) -> const float* {
        if (row < LATR) return xlat + ((size_t)(g * GB + (row >> 11)) * 2048 + (row & 2047)) * 1024;
        const int r2 = row - LATR; return xctx + ((size_t)(g * GB + (r2 >> 8)) * 256 + (r2 & 255)) * 1024;
    };
    const float* slab = (const float*)(p->ws + p->o_z + (size_t)p->MG * 12288);
    const size_t slab_stride = (size_t)(p->MG - LATR) * 1024;
    auto yload = [&](int row, f32x4 (&yv)[4]) {
        if (row < LATR) {
#pragma unroll
            for (int j = 0; j < 4; ++j) yv[j] = *(const f32x4*)(yf + (size_t)row * 1024 + lane * 4 + 256 * j);
        } else {
            const float* s0 = slab + (size_t)(row - LATR) * 1024 + lane * 4;
#pragma unroll
            for (int j = 0; j < 4; ++j) yv[j] = *(const f32x4*)(s0 + 256 * j);
#pragma unroll
            for (int ks = 1; ks < 8; ++ks)
#pragma unroll
                for (int j = 0; j < 4; ++j) yv[j] = yv[j] + *(const f32x4*)(s0 + ks * slab_stride + 256 * j);
        }
    };
    f32x4 xv[4], yv[4];
    int row = gw;
    if (row < nrows) {
        const float* xs = xsrc(row);
#pragma unroll
        for (int j = 0; j < 4; ++j) xv[j] = *(const f32x4*)(xs + lane * 4 + 256 * j);
        if (mode >= 2) yload(row, yv);
    }
    while (row < nrows) {
        const int nrow = row + NGW;
        f32x4 xn[4], yn[4];
        if (nrow < nrows) {
            const float* xs = xsrc(nrow);
#pragma unroll
            for (int j = 0; j < 4; ++j) xn[j] = *(const f32x4*)(xs + lane * 4 + 256 * j);
            if (mode >= 2) yload(nrow, yn);
        }
        const bool lat = row < LATR;
        int b; size_t xrow;
        if (lat) { b = g * GB + (row >> 11); xrow = (size_t)b * 2048 + (row & 2047); }
        else { const int r2 = row - LATR; b = g * GB + (r2 >> 8); xrow = (size_t)b * 256 + (r2 & 255); }
        float* xd = (lat ? p->out : xcb) + xrow * 1024;
        const float* m = modb + (size_t)(lat ? b : 16) * 6144;
        if (mode >= 2) {
            float ss = 0.f;
#pragma unroll
            for (int j = 0; j < 4; ++j) ss += yv[j].x * yv[j].x + yv[j].y * yv[j].y + yv[j].z * yv[j].z + yv[j].w * yv[j].w;
            ss = wave_sum(ss);
            const float rs = rsqrtf(ss * (1.0f / 1024.0f) + EPS);
            const float* gate = m + (mode == 2 ? 2048 : 5120); const float* gn = ng + (mode == 2 ? 1024 : 3072);
#pragma unroll
            for (int j = 0; j < 4; ++j) {
                const int c = lane * 4 + 256 * j;
                const f32x4 gv = *(const f32x4*)(gate + c), nv = *(const f32x4*)(gn + c);
                xv[j] = xv[j] + gv * (yv[j] * rs * nv);
                *(f32x4*)(xd + c) = xv[j];
            }
        }
        if (mode <= 2) {
            float ss = 0.f;
#pragma unroll
            for (int j = 0; j < 4; ++j) ss += xv[j].x * xv[j].x + xv[j].y * xv[j].y + xv[j].z * xv[j].z + xv[j].w * xv[j].w;
            ss = wave_sum(ss);
            const float rs = rsqrtf(ss * (1.0f / 1024.0f) + EPS);
            const float* sh = m + (mode == 1 ? 0 : 3072); const float* sc = m + (mode == 1 ? 1024 : 4096); const float* gn = ng + (mode == 1 ? 0 : 2048);
#pragma unroll
            for (int j = 0; j < 4; ++j) {
                const int c = lane * 4 + 256 * j;
                const f32x4 shv = *(const f32x4*)(sh + c), scv = *(const f32x4*)(sc + c), nv = *(const f32x4*)(gn + c);
                const f32x4 hv = (xv[j] * rs * nv) * (scv + 1.0f) + shv;
                u32x2 o; o.x = pk2(hv.x, hv.y); o.y = pk2(hv.z, hv.w);
                *(u32x2*)(hb + (size_t)row * 1024 + c) = o;
            }
        }
#pragma unroll
        for (int j = 0; j < 4; ++j) { xv[j] = xn[j]; yv[j] = yn[j]; }
        row = nrow;
    }
}

struct EpiInproj {
    static constexpr bool PERM = true, AFTER_DRAIN = false;
    bf16_t* Z; bf16_t* vta; bf16_t* vtb; const float* rope; int GB;
    __device__ __forceinline__ void operator()(const f32x4 (&acc)[2][2][4][2], const pg8::Unit& u, int wr, int wc, int fr, int fq) const {
        const int row0 = u.pm * 256 + wr * 64 + fr, LATR = GB * 2048;
#pragma unroll
        for (int bj = 0; bj < 2; ++bj) {
            const int seg = u.pn * 2 + bj, c0 = u.pn * 256 + bj * 128 + wc * 32 + 8 * fq;
            const int type = (seg <= 4) ? 1 : (seg == 5 ? 2 : ((seg >= 14 && seg <= 17) ? 3 : 0));
            const int xf = (seg <= 3 || (seg >= 6 && seg <= 9)) ? 1 : ((seg >= 18 && seg <= 21) ? 2 : ((seg >= 22 && seg <= 29) ? 3 : ((seg == 38 || seg == 39) ? 4 : 0)));
#pragma unroll
            for (int ai = 0; ai < 2; ++ai)
#pragma unroll
                for (int m = 0; m < 4; ++m) {
                    const int row = row0 + ai * 128 + m * 16;
                    f32x4 v0 = acc[ai][bj][m][0], v1 = acc[ai][bj][m][1];
                    if (type <= 1) {
                        if (type == 1 && row < LATR) {
                            const int t = row & 2047, pp0 = (c0 & 63) >> 1;
                            const int n = (pp0 < 16) ? (t >> 6) : (t & 63);
                            const float* cs = rope + n * 16 + (pp0 & 15);
                            const f32x4 cv = *(const f32x4*)cs, sv = *(const f32x4*)(cs + 1024);
                            f32x4 r0, r1;
                            r0.x = v0.x * cv.x - v0.y * sv.x; r0.y = v0.y * cv.x + v0.x * sv.x;
                            r0.z = v0.z * cv.y - v0.w * sv.y; r0.w = v0.w * cv.y + v0.z * sv.y;
                            r1.x = v1.x * cv.z - v1.y * sv.z; r1.y = v1.y * cv.z + v1.x * sv.z;
                            r1.z = v1.z * cv.w - v1.w * sv.w; r1.w = v1.w * cv.w + v1.z * sv.w;
                            v0 = r0; v1 = r1;
                        }
                        if (xf == 1) { v0 = v0 * QSCALE2; v1 = v1 * QSCALE2; }
                        else if (xf == 4) { v0 = v0 * 0.125f; v1 = v1 * 0.125f; }
                        else if (xf == 2) {
#pragma unroll
                            for (int e = 0; e < 4; ++e) { v0[e] = v0[e] * sigm(v0[e]); v1[e] = v1[e] * sigm(v1[e]); }
                        } else if (xf == 3) {
#pragma unroll
                            for (int e = 0; e < 4; ++e) { v0[e] = sigm(v0[e]); v1[e] = sigm(v1[e]); }
                        }
                        u32x4 w; w.x = pk2(v0.x, v0.y); w.y = pk2(v0.z, v0.w); w.z = pk2(v1.x, v1.y); w.w = pk2(v1.z, v1.w);
                        *(u32x4*)(Z + (size_t)row * ZW + c0) = w;
                    } else {
                        int bl, tok;
                        if (row < LATR) { bl = row >> 11; tok = row & 2047; } else { const int r2 = row - LATR; bl = r2 >> 8; tok = 2048 + (r2 & 255); }
                        const int cc = c0 - (type == 2 ? ZA_V : ZB_V), head = cc >> 6, dim0 = cc & 63, H = (type == 2) ? 2 : 8;
                        bf16_t* base = (type == 2 ? vta : vtb) + ((size_t)(bl * H + head) * 64 + dim0) * VTS + tok;
                        base[0 * VTS] = f2bf(v0.x); base[1 * VTS] = f2bf(v0.y); base[2 * VTS] = f2bf(v0.z); base[3 * VTS] = f2bf(v0.w);
                        base[4 * VTS] = f2bf(v1.x); base[5 * VTS] = f2bf(v1.y); base[6 * VTS] = f2bf(v1.z); base[7 * VTS] = f2bf(v1.w);
                    }
                }
        }
    }
};
struct EpiBranch {
    static constexpr bool PERM = true, AFTER_DRAIN = false;
    const bf16_t* Z; bf16_t* macc; int nMfull;
    __device__ __forceinline__ void operator()(const f32x4 (&acc)[2][2][4][2], const pg8::Unit& u, int wr, int wc, int fr, int fq) const {
        const int j = u.pm / nMfull, pm = u.pm - j * nMfull, pn = u.pn & 3;
        const int row0 = pm * 256 + wr * 64 + fr, col0 = pn * 256 + wc * 32 + 8 * fq;
        const bf16_t* gbase = Z + (size_t)row0 * ZW + ZMERGE + j * 1024 + col0;
        bf16_t* mbase = macc + (size_t)row0 * 1024 + col0;
#pragma unroll
        for (int ai = 0; ai < 2; ++ai) {
            u32x4 gw[4][2], pv[4][2];
#pragma unroll
            for (int m = 0; m < 4; ++m)
#pragma unroll
                for (int bj = 0; bj < 2; ++bj) {
                    const size_t ro = (size_t)(ai * 128 + m * 16);
                    gw[m][bj] = *(const u32x4*)(gbase + ro * ZW + bj * 128);
                    pv[m][bj] = (j > 0) ? *(const u32x4*)(mbase + ro * 1024 + bj * 128) : (u32x4){0u, 0u, 0u, 0u};
                }
#pragma unroll
            for (int m = 0; m < 4; ++m)
#pragma unroll
                for (int bj = 0; bj < 2; ++bj) {
                    const u32x4 g = gw[m][bj], q = pv[m][bj];
                    const f32x4 v0 = acc[ai][bj][m][0], v1 = acc[ai][bj][m][1];
                    const float t0 = v0.x * sigm(lo16(g.x)) + lo16(q.x), t1 = v0.y * sigm(hi16(g.x)) + hi16(q.x), t2 = v0.z * sigm(lo16(g.y)) + lo16(q.y), t3 = v0.w * sigm(hi16(g.y)) + hi16(q.y);
                    const float t4 = v1.x * sigm(lo16(g.z)) + lo16(q.z), t5 = v1.y * sigm(hi16(g.z)) + hi16(q.z), t6 = v1.z * sigm(lo16(g.w)) + lo16(q.w), t7 = v1.w * sigm(hi16(g.w)) + hi16(q.w);
                    u32x4 w; w.x = pk2(t0, t1); w.y = pk2(t2, t3); w.z = pk2(t4, t5); w.w = pk2(t6, t7);
                    *(u32x4*)(mbase + (size_t)(ai * 128 + m * 16) * 1024 + bj * 128) = w;
                }
        }
    }
};
struct BranchOrder {
    int nM, nMfull, G, c;
    __device__ __forceinline__ bool next(int i, pg8::Unit& u) const {
        const int j = i & 3; const int v = (c & 7) * (G >> 3) + (c >> 3);
        const long T = (long)(i >> 2) * G + v;
        if (T >= (long)nM * 4) return false;
        u.pm = j * nMfull + (int)(T >> 2); u.pn = j * 4 + (int)(T & 3); u.ko = 0; return true;
    }
    __device__ __forceinline__ void a_ready(const pg8::Unit&) const {}
    __device__ __forceinline__ void done(const pg8::Unit&) const {}
};
struct EpiRelu2 {
    static constexpr bool PERM = true, AFTER_DRAIN = false;
    bf16_t* O; int ldc;
    __device__ __forceinline__ void operator()(const f32x4 (&acc)[2][2][4][2], const pg8::Unit& u, int wr, int wc, int fr, int fq) const {
        const int row0 = u.pm * 256 + wr * 64 + fr, col0 = u.pn * 256 + wc * 32 + 8 * fq;
#pragma unroll
        for (int ai = 0; ai < 2; ++ai)
#pragma unroll
            for (int m = 0; m < 4; ++m) {
                bf16_t* rowp = O + (size_t)(row0 + ai * 128 + m * 16) * ldc + col0;
#pragma unroll
                for (int bj = 0; bj < 2; ++bj) {
                    f32x4 v0 = acc[ai][bj][m][0], v1 = acc[ai][bj][m][1];
#pragma unroll
                    for (int e = 0; e < 4; ++e) { const float a = fmaxf(v0[e], 0.f), b = fmaxf(v1[e], 0.f); v0[e] = a * a; v1[e] = b * b; }
                    u32x4 w; w.x = pk2(v0.x, v0.y); w.y = pk2(v0.z, v0.w); w.z = pk2(v1.x, v1.y); w.w = pk2(v1.z, v1.w);
                    *(u32x4*)(rowp + bj * 128) = w;
                }
            }
    }
};

struct CtxBranchOrder {
    int nMfull, pm0, nT, G, c;
    __device__ __forceinline__ bool next(int i, pg8::Unit& u) const {
        const long L = (long)i * G + c; if (L >= (long)nT * 4) return false;
        const int j = (int)(L & 3), t = (int)(L >> 2);
        u.pm = j * nMfull + pm0 + (t >> 2); u.pn = j * 4 + (t & 3); u.ko = 0; return true;
    }
    __device__ __forceinline__ void a_ready(const pg8::Unit&) const {}
    __device__ __forceinline__ void done(const pg8::Unit&) const {}
};
struct EpiBranchCtx {
    static constexpr bool PERM = true, AFTER_DRAIN = false;
    const bf16_t* Z; bf16_t* P; int nMfull, pm0;
    __device__ __forceinline__ void operator()(const f32x4 (&acc)[2][2][4][2], const pg8::Unit& u, int wr, int wc, int fr, int fq) const {
        const int j = u.pm / nMfull, pm = u.pm - j * nMfull, pn = u.pn & 3;
        const int row0 = pm * 256 + wr * 64 + fr, col0 = pn * 256 + wc * 32 + 8 * fq;
        const bf16_t* gbase = Z + (size_t)row0 * ZW + ZMERGE + j * 1024 + col0;
        bf16_t* pbase = P + (size_t)(row0 - pm0 * 256) * 4096 + j * 1024 + col0;
#pragma unroll
        for (int ai = 0; ai < 2; ++ai) {
            u32x4 gw[4][2];
#pragma unroll
            for (int m = 0; m < 4; ++m)
#pragma unroll
                for (int bj = 0; bj < 2; ++bj) gw[m][bj] = *(const u32x4*)(gbase + (size_t)(ai * 128 + m * 16) * ZW + bj * 128);
#pragma unroll
            for (int m = 0; m < 4; ++m)
#pragma unroll
                for (int bj = 0; bj < 2; ++bj) {
                    const u32x4 g = gw[m][bj];
                    const f32x4 v0 = acc[ai][bj][m][0], v1 = acc[ai][bj][m][1];
                    u32x4 w; w.x = pk2(v0.x * sigm(lo16(g.x)), v0.y * sigm(hi16(g.x))); w.y = pk2(v0.z * sigm(lo16(g.y)), v0.w * sigm(hi16(g.y)));
                    w.z = pk2(v1.x * sigm(lo16(g.z)), v1.y * sigm(hi16(g.z))); w.w = pk2(v1.z * sigm(lo16(g.w)), v1.w * sigm(hi16(g.w)));
                    *(u32x4*)(pbase + (size_t)(ai * 128 + m * 16) * 4096 + bj * 128) = w;
                }
        }
    }
};
struct SplitOrder {
    int pm0, nT, SPLIT, Kl, G, c;
    __device__ __forceinline__ bool next(int i, pg8::Unit& u) const {
        const long L = (long)i * G + c; if (L >= (long)nT * 4 * SPLIT) return false;
        const int ks = (int)(L % SPLIT), t = (int)(L / SPLIT);
        u.pm = pm0 + (t >> 2); u.pn = t & 3; u.ko = ks * Kl; return true;
    }
    __device__ __forceinline__ void a_ready(const pg8::Unit&) const {}
    __device__ __forceinline__ void done(const pg8::Unit&) const {}
};
struct EpiSlab {
    static constexpr bool PERM = false, AFTER_DRAIN = false;
    float* S; int pm0, nrows, Kl;
    __device__ __forceinline__ void operator()(const f32x4 (&acc)[2][2][4][2], const pg8::Unit& u, int wr, int wc, int fr, int fq) const {
        const int ks = u.ko / Kl;
        const int row0 = (u.pm - pm0) * 256 + wr * 64 + fr, col0 = u.pn * 256 + wc * 32 + 4 * fq;
        float* base = S + (size_t)ks * nrows * 1024;
#pragma unroll
        for (int ai = 0; ai < 2; ++ai)
#pragma unroll
            for (int m = 0; m < 4; ++m) { float* rowp = base + (size_t)(row0 + ai * 128 + m * 16) * 1024 + col0;
#pragma unroll
                for (int bj = 0; bj < 2; ++bj)
#pragma unroll
                    for (int n = 0; n < 2; ++n) *(f32x4*)(rowp + bj * 128 + n * 16) = acc[ai][bj][m][n]; }
    }
};

#define MFMA16(a, b, c) __builtin_amdgcn_mfma_f32_16x16x32_bf16((a), (b), (c), 0, 0, 0)
__device__ __forceinline__ void attn_wave(PPtr p, int l, int kind, int idx, int lane, const LAS float* biasL) {
    const int fr = lane & 15, fq = lane >> 4;
    const int LATR = p->GB * 2048, MG = p->MG;
    const bf16_t* Z = (const bf16_t*)(p->ws + p->o_z);
    const bool isA = (kind == 1 || kind == 2);
    int bl, hk, qrow0, r = 0, q0 = 0;
    if (kind == 0) { bl = idx >> 8; hk = (idx >> 5) & 7; r = idx & 31; qrow0 = bl * 2048 + r * 64; }
    else if (kind == 1) { bl = idx >> 8; hk = (idx >> 7) & 1; q0 = (idx & 127) * 16; qrow0 = bl * 2048 + q0; }
    else if (kind == 2) { bl = idx >> 5; hk = (idx >> 4) & 1; qrow0 = LATR + bl * 256 + (idx & 15) * 16; }
    else { bl = idx >> 5; hk = (idx >> 2) & 7; qrow0 = LATR + bl * 256 + (idx & 3) * 64; }
    const int qrstep = isA ? 0 : 16, qcstep = isA ? 64 : 0;
    const int qcol0 = isA ? (ZA_Q + hk * 4 * 64) : (ZB_Q + hk * 64);
    const int kcol = isA ? (ZA_K + hk * 64) : (ZB_K + hk * 64);
    const bf16_t* vt = isA ? ((const bf16_t*)(p->ws + p->o_vta) + (size_t)(bl * 2 + hk) * 64 * VTS) : ((const bf16_t*)(p->ws + p->o_vtb) + (size_t)(bl * 8 + hk) * 64 * VTS);
    bf16_t* yo = (bf16_t*)(p->ws + p->o_y4) + (isA ? (size_t)0 : (size_t)MG * 512);
    const int ocol0 = isA ? hk * 4 * 64 : hk * 64;
    const int krow_ctx0 = LATR + bl * 256, krow_lat0 = bl * 2048;

    bf16x8 Q[4][2];
#pragma unroll
    for (int s = 0; s < 4; ++s)
#pragma unroll
        for (int ks = 0; ks < 2; ++ks) Q[s][ks] = *(const bf16x8*)(Z + (size_t)(qrow0 + s * qrstep + fr) * ZW + qcol0 + s * qcstep + ks * 32 + fq * 8);
    f32x4 O[4][4]; float mrun[4], lrun[4];
#pragma unroll
    for (int s = 0; s < 4; ++s) { mrun[s] = -1e30f; lrun[s] = 0.f;
#pragma unroll
        for (int dt = 0; dt < 4; ++dt) O[s][dt] = (f32x4){0.f, 0.f, 0.f, 0.f}; }

    auto do_block = [&](int krow, int vtoff, int mode, int a0, int a1) {
        bf16x8 Kf[2][2];
#pragma unroll
        for (int kt = 0; kt < 2; ++kt)
#pragma unroll
            for (int ks = 0; ks < 2; ++ks) Kf[kt][ks] = *(const bf16x8*)(Z + (size_t)(krow + kt * 16 + fr) * ZW + kcol + ks * 32 + fq * 8);
        bf16x8 Vf[4];
#pragma unroll
        for (int dt = 0; dt < 4; ++dt) {
            const bf16_t* vp = vt + (size_t)(dt * 16 + fr) * VTS + vtoff + fq * 4;
            const u32x2 lo = *(const u32x2*)vp, hi = *(const u32x2*)(vp + 16);
            u32x4 w; w.x = lo.x; w.y = lo.y; w.z = hi.x; w.w = hi.y;
            Vf[dt] = __builtin_bit_cast(bf16x8, w);
        }
#pragma unroll
        for (int s = 0; s < 4; ++s) {
            const bool active = (mode != 2) || !((s == 0 && a1 == 1) || (s == 3 && a1 == 0));
            if (active) {
                f32x4 S0 = (f32x4){0.f, 0.f, 0.f, 0.f}, S1 = (f32x4){0.f, 0.f, 0.f, 0.f};
                S0 = MFMA16(Kf[0][0], Q[s][0], S0); S0 = MFMA16(Kf[0][1], Q[s][1], S0);
                S1 = MFMA16(Kf[1][0], Q[s][0], S1); S1 = MFMA16(Kf[1][1], Q[s][1], S1);
                float sc[8];
#pragma unroll
                for (int j = 0; j < 4; ++j) { sc[j] = S0[j]; sc[4 + j] = S1[j]; }
                if (mode == 1) {
                    const int qpos = q0 + fr;
#pragma unroll
                    for (int e = 0; e < 8; ++e) { const int kpos = a0 + (e >> 2) * 16 + fq * 4 + (e & 3); const int d = kpos - qpos; if (d > 128 || d < -128) sc[e] = -1e30f; }
                } else if (mode == 2) {
                    const int qc = 16 * s + fr; const int cs = min(max(qc - 8, 0), 48);
                    const LAS float* bp = biasL + hk * 465 + a0 * 31;
#pragma unroll
                    for (int e = 0; e < 8; ++e) {
                        const int kc = a1 * 32 + (e >> 2) * 16 + fq * 4 + (e & 3);
                        const int dc = min(max(kc - qc + 15, 0), 30);
                        const float bv = bp[dc];
                        sc[e] = (kc >= cs && kc < cs + 16) ? (sc[e] + bv) : -1e30f;
                    }
                }
                float ml = fmaxf(fmaxf(fmaxf(sc[0], sc[1]), fmaxf(sc[2], sc[3])), fmaxf(fmaxf(sc[4], sc[5]), fmaxf(sc[6], sc[7])));
                ml = xrow16_max(ml);
                const float mold = mrun[s], mn = fmaxf(mold, ml), alpha = __builtin_amdgcn_exp2f(mold - mn);
                mrun[s] = mn;
                float pv[8], ls = 0.f;
#pragma unroll
                for (int e = 0; e < 8; ++e) { pv[e] = __builtin_amdgcn_exp2f(sc[e] - mn); ls += pv[e]; }
                ls = xrow16_sum(ls);
                lrun[s] = lrun[s] * alpha + ls;
                u32x4 pw; pw.x = pk2(pv[0], pv[1]); pw.y = pk2(pv[2], pv[3]); pw.z = pk2(pv[4], pv[5]); pw.w = pk2(pv[6], pv[7]);
                const bf16x8 P = __builtin_bit_cast(bf16x8, pw);
                if (__builtin_amdgcn_ballot_w64(mn > mold) != 0ull) {
#pragma unroll
                    for (int dt = 0; dt < 4; ++dt) O[s][dt] = O[s][dt] * alpha;
                }
#pragma unroll
                for (int dt = 0; dt < 4; ++dt) O[s][dt] = MFMA16(Vf[dt], P, O[s][dt]);
            }
            __builtin_amdgcn_sched_barrier(0);
        }
    };
    int nloc = 0, lo = 0, r0 = 0;
    if (kind == 1) { lo = max(0, q0 - 128) & ~31; const int hi = min(2048, (q0 + 16 + 128 + 31) & ~31); nloc = (hi - lo) >> 5; }
    else if (kind == 0) { r0 = min(max(r - 4, 0), 24); nloc = 16; }
#pragma unroll 1
    for (int i = 0; i < 8 + nloc; ++i) {
        int krow, vtoff, mode, a0, a1;
        if (i < 8) { krow = krow_ctx0 + 32 * i; vtoff = 2048 + 32 * i; mode = 0; a0 = 0; a1 = 0; }
        else if (kind == 1) { const int kb = lo + 32 * (i - 8); krow = krow_lat0 + kb; vtoff = kb; mode = 1; a0 = kb; a1 = 0; }
        else { const int jj = i - 8, kr = r0 + (jj >> 1), hb = jj & 1; krow = krow_lat0 + kr * 64 + hb * 32; vtoff = kr * 64 + hb * 32; mode = 2; a0 = kr - r + 7; a1 = hb; }
        do_block(krow, vtoff, mode, a0, a1);
    }
#pragma unroll
    for (int s = 0; s < 4; ++s) {
        float fac;
        if (isA) { const float sk = p->a_sink[l * 8 + hk * 4 + s] * LOG2E; const float M = fmaxf(mrun[s], sk); const float e1 = __builtin_amdgcn_exp2f(mrun[s] - M); fac = e1 / (lrun[s] * e1 + __builtin_amdgcn_exp2f(sk - M)); }
        else fac = 1.0f / lrun[s];
        bf16_t* op = yo + (size_t)(qrow0 + s * qrstep + fr) * 512 + ocol0 + s * qcstep + fq * 4;
#pragma unroll
        for (int dt = 0; dt < 4; ++dt) { const f32x4 o = O[s][dt] * fac; u32x2 w; w.x = pk2(o.x, o.y); w.y = pk2(o.z, o.w); *(u32x2*)(op + dt * 16) = w; }
    }
}

constexpr int SCAN_BUF = 41472;
constexpr int BIAS_OFF = 3 * SCAN_BUF;
template <int DK, bool ISC>
__device__ __forceinline__ void scan_task(PPtr p, int l, int bl, int h, int dir, LAS unsigned char* lds) {
    constexpr int KPW = DK / 8, NTG = 64 / KPW, TPG = 32 / NTG, QS = (DK + 8) * 2, NKT = DK / 16;
    const int tid = ltid(), w = tid >> 6, lane = tid & 63, fr = lane & 15, fq = lane >> 4;
    const int kl = lane % KPW, tg = lane / KPW, kch = w * KPW + kl;
    const int vcol = tid & 127, vg = tid >> 7;
    LAS unsigned char* qt = lds; LAS unsigned char* kt_ = qt + 32 * QS; LAS unsigned char* khT = kt_ + 32 * QS; LAS unsigned char* vT = khT + DK * 80;
    LAS unsigned char* att = vT + 128 * 80; LAS float* dvec = (LAS float*)(att + 32 * 80); LAS float* evec = dvec + DK;
    const bf16_t* Z = (const bf16_t*)(p->ws + p->o_z);
    const int LATR = p->GB * 2048, MG = p->MG;
    const int qc = ISC ? (ZC_Q + h * 128 + kch) : (ZD_Q + h * 64 + kch);
    const int kc = ISC ? ((dir ? ZC_FB : ZC_FF) + h * 128 + kch) : (ZD_K + h * 64 + kch);
    const int vc = (ISC ? ZC_I : ZD_V) + h * 128 + vcol;
    const int gcol = ZD_GK + dir * 16;
    float lbv = 0.f, oml = 1.f, up[16], gb = 0.f;
#pragma unroll
    for (int r = 0; r < 16; ++r) up[r] = 0.f;
    if (ISC) { lbv = ((const float*)(p->ws + p->o_lb))[l * 512 + h * 128 + kch]; oml = 1.0f - lbv; }
    else {
#pragma unroll
        for (int r = 0; r < 16; ++r) up[r] = p->d_gate_up[((size_t)(l * 2 + dir) * 16 + r) * 256 + h * 64 + kch];
        gb = p->d_gate_bias[(l * 2 + dir) * 256 + h * 64 + kch];
    }
    bf16_t* odst = (dir == 0) ? ((bf16_t*)(p->ws + p->o_y4) + (size_t)(ISC ? 2 : 3) * MG * 512) : ((bf16_t*)(p->ws + p->o_ob) + (size_t)(ISC ? 0 : 1) * MG * 512);
    f32x4 S[NKT];
#pragma unroll
    for (int i = 0; i < NKT; ++i) S[i] = (f32x4){0.f, 0.f, 0.f, 0.f};
    auto rowof = [&](int cc, int i) -> int {
        const bool isctx = cc < 8; const int L = isctx ? 256 : 2048, base = isctx ? (LATR + bl * 256) : (bl * 2048), c = isctx ? cc : cc - 8;
        const int pos = c * 32 + i; return base + (dir ? (L - 1 - pos) : pos);
    };
    bf16_t rq[TPG], rk[TPG], rv[8]; u32x4 rz[TPG][2];
    auto load_raw = [&](int cc) {
#pragma unroll
        for (int e = 0; e < TPG; ++e) {
            const bf16_t* zr = Z + (size_t)rowof(cc, tg * TPG + e) * ZW;
            rq[e] = zr[qc]; rk[e] = zr[kc];
            if (!ISC) { rz[e][0] = *(const u32x4*)(zr + gcol); rz[e][1] = *(const u32x4*)(zr + gcol + 8); }
        }
#pragma unroll
        for (int e = 0; e < 8; ++e) rv[e] = Z[(size_t)rowof(cc, vg * 8 + e) * ZW + vc];
    };
    load_raw(0);
    for (int cc = 0; cc < 72; ++cc) {
        __syncthreads();
        {
            float gq[TPG], gk[TPG], cum[TPG]; float run = 0.f;
#pragma unroll
            for (int e = 0; e < TPG; ++e) {
                const float zq = bf2f(rq[e]), zk = bf2f(rk[e]); float g, key, q;
                if (ISC) { const float sg = zk; g = __logf(lbv + oml * sg); key = oml * (1.0f - sg); q = zq; }
                else {
                    float a = gb;
                    const u32x4 z0 = rz[e][0], z1 = rz[e][1];
                    a += lo16(z0.x) * up[0] + hi16(z0.x) * up[1] + lo16(z0.y) * up[2] + hi16(z0.y) * up[3] + lo16(z0.z) * up[4] + hi16(z0.z) * up[5] + lo16(z0.w) * up[6] + hi16(z0.w) * up[7];
                    a += lo16(z1.x) * up[8] + hi16(z1.x) * up[9] + lo16(z1.y) * up[10] + hi16(z1.y) * up[11] + lo16(z1.z) * up[12] + hi16(z1.z) * up[13] + lo16(z1.w) * up[14] + hi16(z1.w) * up[15];
                    g = (fminf(a, 0.f) - __logf(1.0f + __expf(-fabsf(a)))) * (1.0f / 16.0f); key = zk; q = zq;
                }
                run += g; cum[e] = run; gq[e] = q; gk[e] = key;
            }
            float pre = 0.f, total = 0.f, cref = 0.f;
#pragma unroll
            for (int t = 0; t < NTG; ++t) { const float tt = __shfl(run, kl + KPW * t); if (t < tg) pre += tt; if (t < NTG / 2) cref += tt; total += tt; }
            float khv[TPG]; const float etc = __expf(total - cref);
#pragma unroll
            for (int e = 0; e < TPG; ++e) {
                const float c = cum[e] + pre; const int i = tg * TPG + e;
                const float E = __expf(c - cref), kE = gk[e] * __builtin_amdgcn_rcpf(E);
                *(LAS bf16_t*)(qt + i * QS + kch * 2) = f2bf1(gq[e] * E);
                *(LAS bf16_t*)(kt_ + i * QS + kch * 2) = f2bf1(kE);
                khv[e] = kE * etc;
            }
            if constexpr (TPG == 8) { u32x4 o; o.x = pk2(khv[0], khv[1]); o.y = pk2(khv[2], khv[3]); o.z = pk2(khv[4], khv[5]); o.w = pk2(khv[6], khv[7]); *(LAS u32x4*)(khT + kch * 80 + tg * 16) = o; }
            else { u32x2 o; o.x = pk2(khv[0], khv[1]); o.y = pk2(khv[2], khv[3]); *(LAS u32x2*)(khT + kch * 80 + tg * 8) = o; }
            if (tg == 0) { dvec[kch] = __expf(total); evec[kch] = __expf(cref); }
            u32x4 vo; vo.x = (unsigned)rv[0] | ((unsigned)rv[1] << 16); vo.y = (unsigned)rv[2] | ((unsigned)rv[3] << 16); vo.z = (unsigned)rv[4] | ((unsigned)rv[5] << 16); vo.w = (unsigned)rv[6] | ((unsigned)rv[7] << 16);
            *(LAS u32x4*)(vT + vcol * 80 + vg * 16) = vo;
        }
        if (cc + 1 < 72) load_raw(cc + 1);
        __syncthreads();
        if (w < 3) {
            const int tt = (w == 0) ? 0 : 1, st = (w == 2) ? 1 : 0;
            f32x4 a = (f32x4){0.f, 0.f, 0.f, 0.f};
#pragma unroll
            for (int ks = 0; ks < DK / 32; ++ks) {
                const bf16x8 A = *(const LAS bf16x8*)(qt + (tt * 16 + fr) * QS + (ks * 32 + fq * 8) * 2);
                const bf16x8 B = *(const LAS bf16x8*)(kt_ + (st * 16 + fr) * QS + (ks * 32 + fq * 8) * 2);
                a = MFMA16(A, B, a);
            }
#pragma unroll
            for (int j = 0; j < 4; ++j) { const int t = tt * 16 + fq * 4 + j, s = st * 16 + fr; *(LAS bf16_t*)(att + t * 80 + s * 2) = f2bf1(s <= t ? a[j] : 0.f); }
        } else if (w == 3) {
#pragma unroll
            for (int j = 0; j < 4; ++j) { const int t = fq * 4 + j, s = 16 + fr; *(LAS bf16_t*)(att + t * 80 + s * 2) = (bf16_t)0; }
        }
        __syncthreads();
        {
            const int vs = w * 16;
            const bf16x8 Bv = *(const LAS bf16x8*)(vT + (vs + fr) * 80 + fq * 16);
            bf16x8 Sb[NKT / 2];
#pragma unroll
            for (int kp = 0; kp < NKT / 2; ++kp) {
                const f32x4 e0 = *(const LAS f32x4*)(evec + (2 * kp) * 16 + fq * 4), e1 = *(const LAS f32x4*)(evec + (2 * kp + 1) * 16 + fq * 4);
                const f32x4 s0 = S[2 * kp] * e0, s1 = S[2 * kp + 1] * e1;
                u32x4 sw; sw.x = pk2(s0.x, s0.y); sw.y = pk2(s0.z, s0.w); sw.z = pk2(s1.x, s1.y); sw.w = pk2(s1.z, s1.w);
                Sb[kp] = __builtin_bit_cast(bf16x8, sw);
            }
#pragma unroll
            for (int tt = 0; tt < 2; ++tt) {
                f32x4 o = (f32x4){0.f, 0.f, 0.f, 0.f};
#pragma unroll
                for (int kp = 0; kp < NKT / 2; ++kp) {
                    const u32x2 lo = *(const LAS u32x2*)(qt + (tt * 16 + fr) * QS + ((2 * kp) * 16 + fq * 4) * 2);
                    const u32x2 hi = *(const LAS u32x2*)(qt + (tt * 16 + fr) * QS + ((2 * kp + 1) * 16 + fq * 4) * 2);
                    u32x4 aw; aw.x = lo.x; aw.y = lo.y; aw.z = hi.x; aw.w = hi.y;
                    o = MFMA16(__builtin_bit_cast(bf16x8, aw), Sb[kp], o);
                }
                const bf16x8 A2 = *(const LAS bf16x8*)(att + (tt * 16 + fr) * 80 + fq * 16);
                o = MFMA16(A2, Bv, o);
#pragma unroll
                for (int j = 0; j < 4; ++j) { const int row = rowof(cc, tt * 16 + fq * 4 + j); odst[(size_t)row * 512 + h * 128 + vs + fr] = f2bf1(o[j]); }
            }
#pragma unroll
            for (int k2 = 0; k2 < NKT; ++k2) {
                const f32x4 d = *(const LAS f32x4*)(dvec + k2 * 16 + fq * 4);
                S[k2] = S[k2] * d;
                const bf16x8 A3 = *(const LAS bf16x8*)(khT + (k2 * 16 + fr) * 80 + fq * 16);
                S[k2] = MFMA16(A3, Bv, S[k2]);
            }
        }
    }
    __syncthreads();
}

__device__ __forceinline__ void mixer(PPtr p, int l, int g, LAS unsigned char* lds, unsigned long long* tscan = nullptr) {
    const int tid = ltid(), w = tid >> 6, lane = tid & 63;
    LAS float* biasL = (LAS float*)(lds + BIAS_OFF);
    for (int i = tid; i < 8 * 465; i += 512) biasL[i] = p->b_rel_bias[(size_t)l * 8 * 465 + i] * LOG2E;
    __syncthreads();
    const int GB = p->GB, NSC = GB * 8, NS = GB * 16;
    const unsigned long long ts0 = tscan ? __builtin_amdgcn_s_memrealtime() : 0ull;
    for (int st = blockIdx.x; st < NS; st += gridDim.x) {
        if (st < NSC) { scan_task<128, true>(p, l, st >> 3, (st >> 1) & 3, st & 1, lds); }
        else { const int s2 = st - NSC; scan_task<64, false>(p, l, s2 >> 3, (s2 >> 1) & 3, s2 & 1, lds); }
    }
    if (tscan) *tscan += __builtin_amdgcn_s_memrealtime() - ts0;
    unsigned* ctr = (unsigned*)p->ws + (l * 16 + g);
    const int NB0 = GB * 32, NB1 = GB * 32, NB2 = (l < DEPTH - 1) ? GB * 4 : 0, NB3 = NB2, NBT = NB0 + NB1 + NB2 + NB3;
    LAS int* tw = (LAS int*)(lds + CTRL_OFF);
    for (;;) {
        if (tid == 0) *tw = (int)atomicAdd(ctr, 1u);
        __syncthreads();
        const int bt = *tw;
        __syncthreads();
        if (bt >= NBT) break;
        int kind, idx;
        if (bt < NB0) { kind = 0; idx = bt * 8 + w; }
        else if (bt < NB0 + NB1) { kind = 1; idx = (bt - NB0) * 8 + w; }
        else if (bt < NB0 + NB1 + NB2) { kind = 2; idx = (bt - NB0 - NB1) * 8 + w; }
        else { kind = 3; idx = (bt - NB0 - NB1 - NB2) * 8 + w; }
        attn_wave(p, l, kind, idx, lane, biasL);
    }
}

__device__ __forceinline__ void postpass(PPtr p, int l, int nrows) {
    const int lane = ltid() & 63, gw = blockIdx.x * 8 + (ltid() >> 6), NGW = gridDim.x * 8, MG = p->MG;
    const bf16_t* Z = (const bf16_t*)(p->ws + p->o_z);
    for (int it = gw; it < nrows * 2; it += NGW) {
        const int row = it >> 1, br = it & 1;
        bf16_t* yf = (bf16_t*)(p->ws + p->o_y4) + (size_t)(2 + br) * MG * 512 + (size_t)row * 512 + lane * 8;
        const bf16_t* yb = (const bf16_t*)(p->ws + p->o_ob) + (size_t)br * MG * 512 + (size_t)row * 512 + lane * 8;
        const u32x4 a = *(const u32x4*)yf, b = *(const u32x4*)yb;
        const u32x4 gt = *(const u32x4*)(Z + (size_t)row * ZW + (br ? ZD_G : ZC_G) + lane * 8);
        const float* gain = (br ? p->d_norm : p->c_norm) + l * 128 + (lane & 15) * 8;
        float o[8], gv[8];
        o[0] = lo16(a.x) + lo16(b.x); o[1] = hi16(a.x) + hi16(b.x); o[2] = lo16(a.y) + lo16(b.y); o[3] = hi16(a.y) + hi16(b.y);
        o[4] = lo16(a.z) + lo16(b.z); o[5] = hi16(a.z) + hi16(b.z); o[6] = lo16(a.w) + lo16(b.w); o[7] = hi16(a.w) + hi16(b.w);
        gv[0] = lo16(gt.x); gv[1] = hi16(gt.x); gv[2] = lo16(gt.y); gv[3] = hi16(gt.y); gv[4] = lo16(gt.z); gv[5] = hi16(gt.z); gv[6] = lo16(gt.w); gv[7] = hi16(gt.w);
        float ss = 0.f;
#pragma unroll
        for (int e = 0; e < 8; ++e) ss += o[e] * o[e];
        ss = row16_sum(ss);
        const float rs = rsqrtf(ss * (1.0f / 128.0f) + EPS);
        const f32x4 g0 = *(const f32x4*)gain, g1 = *(const f32x4*)(gain + 4);
        float y[8];
#pragma unroll
        for (int e = 0; e < 8; ++e) { const float gn = (e < 4) ? g0[e & 3] : g1[e & 3]; y[e] = o[e] * rs * gn * (gv[e] * sigm(gv[e])); }
        u32x4 wv; wv.x = pk2(y[0], y[1]); wv.y = pk2(y[2], y[3]); wv.z = pk2(y[4], y[5]); wv.w = pk2(y[6], y[7]);
        *(u32x4*)yf = wv;
    }
}

#define NOINL __device__ __forceinline__
NOINL void ph_prologue(PPtr pc, LAS unsigned char* lds) { PPtr p = pc; asm volatile("" : "+s"(p)); prologue(p, lds); }
NOINL void ph_rowpass(PPtr pc, int l, int g, int mode, int nrows, int conv_l, LAS unsigned char* lds) { PPtr p = pc; asm volatile("" : "+s"(p)); rowpass(p, l, g, mode, nrows); if (conv_l >= 0) convert_weights(p, conv_l, lds); }
NOINL void ph_inproj(PPtr pc, LAS unsigned char* lds) {
    PPtr p = pc; asm volatile("" : "+s"(p)); const int G = (int)gridDim.x, c = (int)blockIdx.x;
    pg8::Gemm gm{(const bf16_t*)(p->ws + p->o_h), (const bf16_t*)(p->ws + p->o_win), p->MG, ZW, 1024, 1024}; pg8::StaticOrder S; S.init(p->MG, ZW, G, c);
    EpiInproj E{(bf16_t*)(p->ws + p->o_z), (bf16_t*)(p->ws + p->o_vta), (bf16_t*)(p->ws + p->o_vtb), (const float*)(p->ws + p->o_rope), p->GB};
    pg8::gemm_phase<EpiInproj, pg8::StaticOrder>(lds, gm, S, E, nullptr);
}
NOINL void ph_mixer(PPtr pc, int l, int g, LAS unsigned char* lds, unsigned long long* tscan = nullptr) { PPtr p = pc; asm volatile("" : "+s"(p)); mixer(p, l, g, lds, tscan); }
NOINL void ph_post(PPtr pc, int l, int nrows) { PPtr p = pc; asm volatile("" : "+s"(p)); postpass(p, l, nrows); }
NOINL void ph_branch(PPtr pc, int Mr, LAS unsigned char* lds) {
    PPtr p = pc; asm volatile("" : "+s"(p)); const int G = (int)gridDim.x, c = (int)blockIdx.x;
    const int LATR = p->GB * 2048, nMfull = p->MG / 256;
    pg8::Gemm gm{(const bf16_t*)(p->ws + p->o_y4), (const bf16_t*)(p->ws + p->o_wb), Mr, 1024, 512, 512};
    { BranchOrder S{LATR / 256, nMfull, G, c};
      EpiBranch E{(const bf16_t*)(p->ws + p->o_z), (bf16_t*)(p->ws + p->o_h), nMfull};
      pg8::gemm_phase<EpiBranch, BranchOrder>(lds, gm, S, E, nullptr); }
    if (Mr > LATR) {
        CtxBranchOrder S{nMfull, LATR / 256, (Mr - LATR) / 256 * 4, G, c};
        EpiBranchCtx E{(const bf16_t*)(p->ws + p->o_z), (bf16_t*)(p->ws + p->o_ob), nMfull, LATR / 256};
        pg8::gemm_phase<EpiBranchCtx, CtxBranchOrder>(lds, gm, S, E, nullptr);
    }
}
NOINL void ph_gemm_f32(PPtr pc, int which, int Mr, LAS unsigned char* lds) {
    PPtr p = pc; asm volatile("" : "+s"(p)); const int G = (int)gridDim.x, c = (int)blockIdx.x;
    const int LATR = p->GB * 2048;
    const bf16_t* hid = (const bf16_t*)(p->ws + p->o_z + (size_t)p->MG * 1024 * 4);
    { const bf16_t* A = which ? hid : (const bf16_t*)(p->ws + p->o_h);
      const bf16_t* Bt = which ? (const bf16_t*)(p->ws + p->o_w2) : (const bf16_t*)(p->ws + p->o_wo);
      const int K = which ? 4096 : 1024;
      pg8::Gemm gm{A, Bt, LATR, 1024, K, K}; pg8::StaticOrder S; S.init(LATR, 1024, G, c);
      pg8::EpiF32 E{(float*)(p->ws + p->o_z), 1024, nullptr};
      pg8::gemm_phase<pg8::EpiF32, pg8::StaticOrder>(lds, gm, S, E, nullptr); }
    if (Mr > LATR) {
        const bf16_t* A = which ? hid : ((const bf16_t*)(p->ws + p->o_ob) - (size_t)LATR * 4096);
        const bf16_t* Bt = which ? (const bf16_t*)(p->ws + p->o_w2) : (const bf16_t*)(p->ws + p->o_wo4);
        pg8::Gemm gm{A, Bt, Mr, 1024, 4096, 512};
        SplitOrder S{LATR / 256, (Mr - LATR) / 256, 8, 512, G, c};
        EpiSlab E{(float*)(p->ws + p->o_z + (size_t)p->MG * 12288), LATR / 256, Mr - LATR, 512};
        pg8::gemm_phase<EpiSlab, SplitOrder>(lds, gm, S, E, nullptr);
    }
}
NOINL void ph_ffn1(PPtr pc, int Mr, LAS unsigned char* lds) {
    PPtr p = pc; asm volatile("" : "+s"(p)); const int G = (int)gridDim.x, c = (int)blockIdx.x;
    pg8::Gemm gm{(const bf16_t*)(p->ws + p->o_h), (const bf16_t*)(p->ws + p->o_w1), Mr, 4096, 1024, 1024}; pg8::StaticOrder S; S.init(Mr, 4096, G, c);
    EpiRelu2 E{(bf16_t*)(p->ws + p->o_z + (size_t)p->MG * 1024 * 4), 4096};
    pg8::gemm_phase<EpiRelu2, pg8::StaticOrder>(lds, gm, S, E, nullptr);
}

#define XB_SETUP() volatile LAS unsigned* xb_st = (volatile LAS unsigned*)(lds + CTRL_OFF + 64); unsigned* xb_bar = (unsigned*)(pc->ws + 4096); { XcdBarrier xb0 = xcd_barrier_post(xb_bar, xb_st); (void)xb0; }
#define GSYNC() { XcdBarrier xb_; xb_.bar = (unsigned*)(pc->ws + 4096); xb_.x = xb_xcc_id(); xb_.st = (volatile LAS unsigned*)(lds + CTRL_OFF + 64); xcd_barrier(xb_); }
#ifdef PROBE_MASK
__global__ void __launch_bounds__(512) hybrid_fwd(Params pk) {
    extern __shared__ __attribute__((aligned(16))) unsigned char smem[];
    LAS unsigned char* lds = (LAS unsigned char*)smem;
    cg::grid_group grid = cg::this_grid();
    PPtr pc = (PPtr)__builtin_amdgcn_kernarg_segment_ptr();
    const int GB = pc->GB, MG = pc->MG, NGRP = pc->NGRP, LATR = GB * 2048;
    unsigned long long tacc = 0, t0_ = __builtin_amdgcn_s_memrealtime();
#define PT(kind) { const unsigned long long t1_ = __builtin_amdgcn_s_memrealtime(); if ((PROBE_MASK >> (kind)) & 1) tacc += t1_ - t0_; t0_ = t1_; }
    ph_prologue(pc, lds);
    grid.sync();
    XB_SETUP(); PT(0)
    for (int l = 0; l < DEPTH; ++l) {
        const int Mr = (l < DEPTH - 1) ? MG : LATR;
        for (int g = 0; g < NGRP; ++g) {
            ph_rowpass(pc, l, g, 1, MG, -1, lds);
            GSYNC(); PT(1)
            ph_inproj(pc, lds);
            GSYNC(); PT(2)
            { unsigned long long tsc = 0; ph_mixer(pc, l, g, lds, &tsc); if ((PROBE_MASK >> 11) & 1) tacc += tsc; }
            GSYNC(); PT(3)
            ph_post(pc, l, Mr);
            GSYNC(); PT(4)
            ph_branch(pc, Mr, lds);
            GSYNC(); PT(5)
            ph_gemm_f32(pc, 0, Mr, lds);
            GSYNC(); PT(6)
            ph_rowpass(pc, l, g, 2, Mr, -1, lds);
            GSYNC(); PT(7)
            ph_ffn1(pc, Mr, lds);
            GSYNC(); PT(8)
            ph_gemm_f32(pc, 1, Mr, lds);
            GSYNC(); PT(9)
            ph_rowpass(pc, l, g, 3, Mr, (g == NGRP - 1 && l + 1 < DEPTH) ? l + 1 : -1, lds);
            GSYNC(); PT(10)
        }
    }
    if (blockIdx.x == 0) { const unsigned M = (unsigned)(tacc / 100ull); float* o = pc->out; for (unsigned i2 = threadIdx.x; i2 < M; i2 += 512) o[i2] += 0.125f; }
}

#else
__global__ void __launch_bounds__(512) hybrid_fwd(Params pk) {
    extern __shared__ __attribute__((aligned(16))) unsigned char smem[];
    LAS unsigned char* lds = (LAS unsigned char*)smem;
    cg::grid_group grid = cg::this_grid();
    PPtr pc = (PPtr)__builtin_amdgcn_kernarg_segment_ptr();
    const int GB = pc->GB, MG = pc->MG, NGRP = pc->NGRP, LATR = GB * 2048;
    ph_prologue(pc, lds);
    grid.sync();
    XB_SETUP();
    for (int l = 0; l < DEPTH; ++l) {
        const int Mr = (l < DEPTH - 1) ? MG : LATR;
        for (int g = 0; g < NGRP; ++g) {
            ph_rowpass(pc, l, g, 1, MG, -1, lds);
            GSYNC();
            ph_inproj(pc, lds);
            GSYNC();
            ph_mixer(pc, l, g, lds);
            GSYNC();
            ph_post(pc, l, Mr);
            GSYNC();
            ph_branch(pc, Mr, lds);
            GSYNC();
            ph_gemm_f32(pc, 0, Mr, lds);
            GSYNC();
            ph_rowpass(pc, l, g, 2, Mr, -1, lds);
            GSYNC();
            ph_ffn1(pc, Mr, lds);
            GSYNC();
            ph_gemm_f32(pc, 1, Mr, lds);
            GSYNC();
            ph_rowpass(pc, l, g, 3, Mr, (g == NGRP - 1 && l + 1 < DEPTH) ? l + 1 : -1, lds);
            GSYNC();
        }
    }
}

#endif
extern "C" void kernel_launch(void* const* d_in, const int* in_sizes, int n_in, void* d_out, int out_size, void* d_ws, size_t ws_size, hipStream_t stream) {
    static int grid_blocks = 0;
    if (grid_blocks == 0) {
        int dev = 0, cus = 0, per_cu = 0;
        hipGetDevice(&dev);
        hipDeviceGetAttribute(&cus, hipDeviceAttributeMultiprocessorCount, dev);
        if (hipFuncSetAttribute((const void*)hybrid_fwd, hipFuncAttributeMaxDynamicSharedMemorySize, LDS_BYTES) != hipSuccess) fprintf(stderr, "hipFuncSetAttribute failed\n");
        if (hipOccupancyMaxActiveBlocksPerMultiprocessor(&per_cu, (const void*)hybrid_fwd, 512, LDS_BYTES) != hipSuccess || per_cu < 1) { fprintf(stderr, "occupancy query: %d\n", per_cu); per_cu = 1; }
        (void)hipGetLastError();
        grid_blocks = cus * 1;
        if (grid_blocks <= 0) grid_blocks = 256;
    }
    Params p{};
    const float* const* in = (const float* const*)d_in;
    p.x = in[0]; p.c = in[1]; p.ctx = in[2]; p.c_ctx = in[3]; p.w_mod = in[4]; p.b_mod = in[5]; p.norm_gains = in[6]; p.w_in = in[7]; p.a_sink = in[8]; p.b_rel_bias = in[9];
    p.c_lb = in[10]; p.c_norm = in[11]; p.d_gate_up = in[12]; p.d_gate_bias = in[13]; p.d_norm = in[14]; p.w_branch = in[15]; p.w_out = in[16]; p.w_ff1 = in[17]; p.w_ff2 = in[18];
    p.out = (float*)d_out; p.ws = (unsigned char*)d_ws;
    auto al = [](unsigned long long v) { return (v + 255ull) & ~255ull; };
    unsigned long long off = 32768;
    p.o_mod = off; off = al(off + 4ull * 17 * 6144 * 4);
    p.o_lb = off; off = al(off + 4ull * 512 * 4);
    p.o_rope = off; off = al(off + 2048ull * 4);
    p.o_xc = off; off = al(off + 4096ull * 1024 * 4);
    p.o_win = off; off = al(off + (unsigned long long)ZW * 1024 * 2);
    p.o_wb = off; off = al(off + 4096ull * 512 * 2);
    p.o_wo = off; off = al(off + 1024ull * 1024 * 2);
    p.o_w1 = off; off = al(off + 4096ull * 1024 * 2);
    p.o_w2 = off; off = al(off + 1024ull * 4096 * 2);
    p.o_wo4 = off; off = al(off + 1024ull * 4096 * 2);
    const unsigned long long fixed = off;
    int GB = 16;
    for (; GB > 1; GB >>= 1) {
        const unsigned long long MGt = (unsigned long long)GB * 2304;
        const unsigned long long need = fixed + MGt * (2048ull + (unsigned long long)ZW * 2 + 4096ull + 2048ull) + (unsigned long long)GB * 10 * 64 * VTS * 2 + 8 * 256;
        if (need <= (unsigned long long)ws_size) break;
    }
    p.GB = GB; p.NGRP = 16 / GB; p.MG = GB * 2304;
    const unsigned long long MGu = (unsigned long long)p.MG;
    p.o_h = off; off = al(off + MGu * 1024 * 2);
    p.o_z = off; off = al(off + MGu * ZW * 2);
    p.o_y4 = off; off = al(off + MGu * 2048 * 2);
    p.o_ob = off; off = al(off + MGu * 1024 * 2);
    p.o_vta = off; off = al(off + (unsigned long long)GB * 2 * 64 * VTS * 2);
    p.o_vtb = off; off = al(off + (unsigned long long)GB * 8 * 64 * VTS * 2);
    hipMemsetAsync(d_ws, 0, 32768, stream);
    void* args[] = {&p};
    hipError_t e = hipLaunchCooperativeKernel((const void*)hybrid_fwd, dim3(grid_blocks), dim3(512), args, LDS_BYTES, stream);
    if (e != hipSuccess) fprintf(stderr, "cooperative launch failed: %s (grid %d)\n", hipGetErrorString(e), grid_blocks);
}
```

```cpp
#include <hip/hip_runtime.h>
#include <hip/hip_cooperative_groups.h>
#include <cstdio>
namespace cg = cooperative_groups;
__device__ __forceinline__ int ltid() { int t = (int)threadIdx.x; asm volatile("" : "+v"(t)); return t; }
#define LAS __attribute__((address_space(3)))
namespace pg8 {
#define PG8_LAS __attribute__((address_space(3)))
typedef unsigned short bf16_t;
typedef short bf16x8 __attribute__((ext_vector_type(8)));
typedef float f32x4 __attribute__((ext_vector_type(4)));
typedef unsigned u32x4 __attribute__((ext_vector_type(4)));
constexpr int BM = 256, BK = 64, HALF = 128, HTB = HALF * BK * 2  , STAGE_BYTES = 8 * HTB, NXCD = 8, WGM = 8;

__host__ __device__ __forceinline__ int lds_byte(int r, int c) { const int st = (r >> 4) * 2 + (c >> 5), rr = r & 15, cc = c & 31, ob = rr * 64 + cc * 2; return st * 1024 + (ob ^ (((ob >> 9) & 1) << 5)); }
__host__ __device__ __forceinline__ void stage_rc(int b, int& R, int& C) { const int st = b / 1024, sb = b % 1024, swz = sb ^ (((sb >> 9) & 1) << 5); R = (st >> 1) * 16 + swz / 64; C = (st & 1) * 32 + (swz % 64) / 2; }
__host__ __device__ __forceinline__ int perm32(int rho) { const int n = rho >> 4, i = rho & 15; return 8 * (i >> 2) + 4 * n + (i & 3); }

struct Unit { int pm, pn, ko; };
struct Gemm { const bf16_t* A; const bf16_t* Bt; int M, N, K, Kl; };

struct StaticOrder {
    int nM, nN, nwg, G, c;
    __host__ __device__ void init(int M, int N, int G_, int c_) { nM = M / BM; nN = N / BM; nwg = nM * nN; G = G_; c = c_; }
    __host__ __device__ bool next(int i, Unit& u) const {
        const long L = (long)i * G + c; if (L >= nwg) return false;
        int wgid = (int)L; { const int q = nwg / NXCD, r = nwg % NXCD, xcd = wgid % NXCD, off = wgid / NXCD; wgid = (xcd < r ? xcd * (q + 1) : r * (q + 1) + (xcd - r) * q) + off; }
        const int nig = WGM * nN, gid = wgid / nig, fm = gid * WGM, gsz = (nM - fm) < WGM ? (nM - fm) : WGM;
        u.pm = fm + ((wgid % nig) % gsz); u.pn = (wgid % nig) / gsz; u.ko = 0; return true;
    }
    __device__ __forceinline__ void a_ready(const Unit&) const {}
    __device__ __forceinline__ void done(const Unit&) const {}
};
__device__ __forceinline__ unsigned cvt_pk_bf16(float lo, float hi) { unsigned r; asm volatile("v_cvt_pk_bf16_f32 %0, %1, %2" : "=v"(r) : "v"(lo), "v"(hi)); return r; }
struct EpiF32 {
    static constexpr bool PERM = false, AFTER_DRAIN = false;
    float* C; int ldc; const float* bias;
    __device__ __forceinline__ void operator()(const f32x4 (&acc)[2][2][4][2], const Unit& u, int wr, int wc, int fr, int fq) const {
        const int row0 = u.pm * BM + wr * 64 + fr, col0 = u.pn * BM + wc * 32 + 4 * fq;
        f32x4 bv[2][2];
#pragma unroll
        for (int bj = 0; bj < 2; ++bj)
#pragma unroll
            for (int n = 0; n < 2; ++n) bv[bj][n] = bias ? *(const f32x4*)(bias + col0 + bj * HALF + n * 16) : (f32x4){0.f, 0.f, 0.f, 0.f};
#pragma unroll
        for (int ai = 0; ai < 2; ++ai)
#pragma unroll
            for (int m = 0; m < 4; ++m) { float* rowp = C + (size_t)(row0 + ai * HALF + m * 16) * ldc + col0;
#pragma unroll
                for (int bj = 0; bj < 2; ++bj)
#pragma unroll
                    for (int n = 0; n < 2; ++n) *(f32x4*)(rowp + bj * HALF + n * 16) = acc[ai][bj][m][n] + bv[bj][n]; }
    }
};
template <class Epi, class Sched, bool STAMP = false>
__device__ __forceinline__ void gemm_phase(PG8_LAS unsigned char* lds, const Gemm g, const Sched& S, const Epi& E, unsigned long long* stamps) {
    const int tid = ltid(), wid = __builtin_amdgcn_readfirstlane(tid >> 6), lane = tid & 63, wr = wid >> 2, wc = wid & 3, fr = lane & 15, fq = lane >> 4;
    const int K = g.K, nt = g.Kl / BK;
    int ts_lo = 0, ts_hi = 0, nts = 0; const unsigned long long rt_entry = STAMP ? (unsigned long long)wall_clock64() : 0ull;
#define PG8_STAMP() do { if (STAMP && wid == 0 && nts < 64) { const unsigned long long _c = (unsigned long long)clock64(); \
        ts_lo = (lane == nts) ? (int)(unsigned)_c : ts_lo; ts_hi = (lane == nts) ? (int)(unsigned)(_c >> 32) : ts_hi; ++nts; } } while (0)
    PG8_STAMP();
    unsigned voffA[2], voffB[2];
#pragma unroll
    for (int i = 0; i < 2; ++i) { int R, C; stage_rc(tid * 16 + i * 8192, R, C); const int Rb = Epi::PERM ? ((R & ~31) + perm32(R & 31)) : R;
        voffA[i] = (unsigned)(R * K + C) * 2u; voffB[i] = (unsigned)(Rb * K + C) * 2u; }
    const size_t kstep = (size_t)(BK * 2);
    const size_t hstep = (size_t)HALF * K * 2;
    const size_t tstep = 2 * hstep;
    const unsigned ldsw = (unsigned)wid * 1024u;
    const int aoff = lds_byte(wr * 64 + fr, fq * 8), boff = lds_byte(wc * 32 + fr, fq * 8);
#define PG8_SA(b, h) (((b) * 2 + (h)) * HTB)
#define PG8_SB(b, h) ((4 + (b) * 2 + (h)) * HTB)
#define PG8_STAGE(bufoff, gbase, voff) do { _Pragma("unroll") for (int _i = 0; _i < 2; ++_i) \
        __builtin_amdgcn_global_load_lds((const unsigned*)((const char*)(gbase) + (voff)[_i]), (PG8_LAS unsigned*)(lds + (bufoff) + ldsw + _i * 8192), 16, 0, 0); } while (0)
#define PG8_LDA(dst, b, h) do { _Pragma("unroll") for (int m = 0; m < 4; ++m) _Pragma("unroll") for (int k = 0; k < 2; ++k) dst[m][k] = *(const PG8_LAS bf16x8*)(lds + PG8_SA(b, h) + aoff + m * 2048 + k * 1024); } while (0)
#define PG8_LDB(dst, b, h) do { _Pragma("unroll") for (int n = 0; n < 2; ++n) _Pragma("unroll") for (int k = 0; k < 2; ++k) dst[n][k] = *(const PG8_LAS bf16x8*)(lds + PG8_SB(b, h) + boff + n * 2048 + k * 1024); } while (0)
#define PG8_MMA(ai, bj, At, Bt) do { __builtin_amdgcn_s_setprio(1); _Pragma("unroll") for (int m = 0; m < 4; ++m) _Pragma("unroll") for (int n = 0; n < 2; ++n) _Pragma("unroll") for (int k = 0; k < 2; ++k) \
        acc[ai][bj][m][n] = __builtin_amdgcn_mfma_f32_16x16x32_bf16(Bt[n][k], At[m][k], acc[ai][bj][m][n], 0, 0, 0); __builtin_amdgcn_s_setprio(0); } while (0)
#define PG8_WAIT_V(n) asm volatile("s_waitcnt vmcnt(" #n ")" ::: "memory")
#define PG8_WAIT_L(n) asm volatile("s_waitcnt lgkmcnt(" #n ")" ::: "memory")
#define PG8_BAR __builtin_amdgcn_s_barrier()
#define PG8_SCHED __builtin_amdgcn_sched_barrier(0)
    Unit cur, nxt; int ui = 0;
    if (!S.next(0, cur)) return;
    f32x4 acc[2][2][4][2];
#pragma unroll
    for (int a = 0; a < 2; ++a)
#pragma unroll
        for (int b = 0; b < 2; ++b)
#pragma unroll
            for (int m = 0; m < 4; ++m)
#pragma unroll
                for (int n = 0; n < 2; ++n) acc[a][b][m][n] = (f32x4){0.f, 0.f, 0.f, 0.f};
    bf16x8 At[4][2], B0[2][2], B1[2][2];
    const char* cA = (const char*)g.A + (size_t)cur.pm * tstep + (size_t)cur.ko * 2; const char* cB = (const char*)g.Bt + (size_t)cur.pn * tstep + (size_t)cur.ko * 2;
    S.a_ready(cur);
    PG8_STAGE(PG8_SB(0, 0), cB, voffB); PG8_STAGE(PG8_SA(0, 0), cA, voffA); PG8_STAGE(PG8_SB(0, 1), cB + hstep, voffB); PG8_STAGE(PG8_SA(0, 1), cA + hstep, voffA);
    if (wr == 1) PG8_BAR;
    PG8_WAIT_V(4); PG8_BAR;
    PG8_STAGE(PG8_SB(1, 0), cB + kstep, voffB); PG8_STAGE(PG8_SA(1, 0), cA + kstep, voffA); PG8_STAGE(PG8_SB(1, 1), cB + hstep + kstep, voffB);
    PG8_WAIT_V(6); PG8_BAR;
    PG8_STAMP();
    for (;;) {
        const bool has_next = S.next(ui + 1, nxt);
        const char* nA = has_next ? (const char*)g.A + (size_t)nxt.pm * tstep + (size_t)nxt.ko * 2 : cA; const char* nB = has_next ? (const char*)g.Bt + (size_t)nxt.pn * tstep + (size_t)nxt.ko * 2 : cB;
        for (int t = 0; t < nt; t += 2) {
            const bool last = (t == nt - 2);
            const char* a1 = cA + (size_t)(t + 1) * kstep;
            const char* a2 = last ? nA : cA + (size_t)(t + 2) * kstep; const char* b2 = last ? nB : cB + (size_t)(t + 2) * kstep;
            const char* a3 = a2 + kstep; const char* b3 = b2 + kstep;
            if (last && has_next) S.a_ready(nxt);
            PG8_LDB(B0, 0, 0); PG8_SCHED; PG8_LDA(At, 0, 0); PG8_STAGE(PG8_SA(1, 1), a1 + hstep, voffA);
            PG8_WAIT_L(8); PG8_BAR; PG8_WAIT_L(0); PG8_MMA(0, 0, At, B0); PG8_BAR; PG8_SCHED;
            PG8_LDB(B1, 0, 1); PG8_STAGE(PG8_SB(0, 0), b2, voffB);
            PG8_BAR; PG8_WAIT_L(0); PG8_MMA(0, 1, At, B1); PG8_BAR;
            PG8_LDA(At, 0, 1); PG8_STAGE(PG8_SA(0, 0), a2, voffA);
            PG8_BAR; PG8_WAIT_L(0); PG8_MMA(1, 0, At, B0); PG8_BAR; PG8_SCHED;
            PG8_STAGE(PG8_SB(0, 1), b2 + hstep, voffB);
            PG8_WAIT_V(6); PG8_BAR; PG8_MMA(1, 1, At, B1); PG8_BAR;
            PG8_LDB(B0, 1, 0); PG8_SCHED; PG8_LDA(At, 1, 0); PG8_STAGE(PG8_SA(0, 1), a2 + hstep, voffA);
            PG8_WAIT_L(8); PG8_BAR; PG8_WAIT_L(0); PG8_MMA(0, 0, At, B0); PG8_BAR; PG8_SCHED;
            PG8_LDB(B1, 1, 1); PG8_STAGE(PG8_SB(1, 0), b3, voffB);
            PG8_BAR; PG8_WAIT_L(0); PG8_MMA(0, 1, At, B1); PG8_BAR;
            PG8_LDA(At, 1, 1); PG8_STAGE(PG8_SA(1, 0), a3, voffA);
            PG8_BAR; PG8_WAIT_L(0); PG8_MMA(1, 0, At, B0); PG8_BAR; PG8_SCHED;
            PG8_STAGE(PG8_SB(1, 1), b3 + hstep, voffB);
            PG8_WAIT_V(6); PG8_BAR; PG8_MMA(1, 1, At, B1); PG8_BAR;
        }
        PG8_STAMP();
        if constexpr (!Epi::AFTER_DRAIN) { E(acc, cur, wr, wc, fr, fq); S.done(cur); }
        PG8_STAMP();
        if (!has_next) break;
#pragma unroll
        for (int a = 0; a < 2; ++a)
#pragma unroll
            for (int b = 0; b < 2; ++b)
#pragma unroll
                for (int m = 0; m < 4; ++m)
#pragma unroll
                    for (int n = 0; n < 2; ++n) acc[a][b][m][n] = (f32x4){0.f, 0.f, 0.f, 0.f};
        cur = nxt; cA = nA; cB = nB; ++ui;
    }
    PG8_WAIT_V(0);
    if (wr == 0) PG8_BAR;
    PG8_BAR;
    if constexpr (Epi::AFTER_DRAIN) { E.fused(acc, cur, wr, wc, fr, fq, lds, wid, lane); S.done(cur); }
    PG8_STAMP();
    if (STAMP && wid == 0) { stamps[lane] = lane < nts ? (((unsigned long long)(unsigned)ts_hi << 32) | (unsigned)ts_lo) : 0ull;
        if (lane == 62) stamps[62] = rt_entry; if (lane == 63) stamps[63] = (unsigned long long)wall_clock64(); }
#undef PG8_STAMP
#undef PG8_SA
#undef PG8_SB
#undef PG8_STAGE
#undef PG8_LDA
#undef PG8_LDB
#undef PG8_MMA
#undef PG8_WAIT_V
#undef PG8_WAIT_L
#undef PG8_BAR
#undef PG8_SCHED
}
}
#define XB_TMO      128
#define XB_XCNT(j)  (256  + 64 * (j))
#define XB_XSUB(j)  (1280 + 64 * (j))
#define XB_XGEN(j)  (2304 + 64 * (j))
#define XB_TOP      3328
#define XB_TOPGEN   3392
#define XCD_BAR_WORDS 3456
#define XB_SPIN_CAP (1u << 18)

__device__ __forceinline__ unsigned xb_ld(unsigned* p)              { return __hip_atomic_load(p, __ATOMIC_RELAXED, __HIP_MEMORY_SCOPE_AGENT); }
__device__ __forceinline__ unsigned xb_add(unsigned* p, unsigned v) { return __hip_atomic_fetch_add(p, v, __ATOMIC_RELAXED, __HIP_MEMORY_SCOPE_AGENT); }
__device__ __forceinline__ unsigned xb_xcc_id() { return (unsigned)__builtin_amdgcn_s_getreg((3 << 11) | 20) & 0xFu; }
#define XB_SPIN(cond, bar) do { unsigned _sp = 0; while (cond) { __builtin_amdgcn_s_sleep(1); \
    if ((++_sp & 255u) == 0u) { if (xb_ld(&(bar)[XB_TMO])) break; if (_sp > XB_SPIN_CAP) { atomicAdd(&(bar)[XB_TMO], 1u); break; } } } } while (0)

struct XcdBarrier {
    unsigned* bar; unsigned x;
    volatile LAS unsigned* st;
};

__device__ __forceinline__ XcdBarrier xcd_barrier_post(unsigned* bar, volatile LAS unsigned* st) {
    XcdBarrier b; b.bar = bar; b.x = xb_xcc_id(); b.st = st;
    if (threadIdx.x == 0) (void)xb_add(&bar[XB_XCNT(b.x)], 1u);
    return b;
}
__device__ __forceinline__ void xcd_barrier_complete(unsigned* bar, unsigned x, unsigned& nloc, unsigned& nx) {
    const unsigned G = gridDim.x * gridDim.y * gridDim.z;
    unsigned sum, cnt, mine, sp = 0u;
    for (;;) {
        sum = 0u; cnt = 0u; mine = 0u;
#pragma unroll
        for (unsigned j = 0; j < 16; ++j) { const unsigned c = xb_ld(&bar[XB_XCNT(j)]); sum += c; cnt += (c > 0u) ? 1u : 0u; mine = (j == x) ? c : mine; }
        if (sum == G) break;
        __builtin_amdgcn_s_sleep(1);
        if ((++sp & 255u) == 0u) { if (xb_ld(&bar[XB_TMO])) break; if (sp > XB_SPIN_CAP) { atomicAdd(&bar[XB_TMO], 1u); break; } }
    }
    nloc = mine > 0u ? mine : 1u; nx = cnt > 0u ? cnt : 1u;
}

__device__ __forceinline__ void xcd_barrier(const XcdBarrier& b) {
    asm volatile("s_waitcnt vmcnt(0)" ::: "memory");
    __syncthreads();
    if (threadIdx.x == 0) {
        unsigned* bar = b.bar;
        __builtin_amdgcn_s_waitcnt(0);
        unsigned nloc = b.st[0], nx = b.st[1];
        if (nloc == 0u) { xcd_barrier_complete(bar, b.x, nloc, nx); b.st[0] = nloc; b.st[1] = nx; }
        const unsigned old = xb_add(&bar[XB_XSUB(b.x)], 1u);
        const unsigned gen = old / nloc;
        if (old + 1u == (gen + 1u) * nloc) {
            __builtin_amdgcn_fence(__ATOMIC_RELEASE, "agent");
            asm volatile("s_waitcnt vmcnt(0)" ::: "memory");
            const unsigned og = xb_add(&bar[XB_TOP], 1u);
            const unsigned tg = og / nx;
            if (og + 1u == (tg + 1u) * nx) xb_add(&bar[XB_TOPGEN], 1u);
            else XB_SPIN(xb_ld(&bar[XB_TOPGEN]) == tg, bar);
            __builtin_amdgcn_fence(__ATOMIC_ACQUIRE, "agent");
            xb_add(&bar[XB_XGEN(b.x)], 1u);
            asm volatile("s_waitcnt vmcnt(0)" ::: "memory");
        } else {
            XB_SPIN(xb_ld(&bar[XB_XGEN(b.x)]) == gen, bar);
            __builtin_amdgcn_fence(__ATOMIC_ACQUIRE, "agent");
            asm volatile("s_waitcnt vmcnt(0)" ::: "memory");
        }
    }
    __syncthreads();
}

typedef unsigned short bf16_t;
typedef pg8::bf16x8 bf16x8;
typedef pg8::f32x4 f32x4;
typedef pg8::u32x4 u32x4;
typedef unsigned u32x2 __attribute__((ext_vector_type(2)));

constexpr int DM = 1024, NB = 16, SEQ = 2048, DEPTH = 4, CTXL = 256, DFF = 4096;
constexpr int ZW = 10752;
constexpr int INW = 10528;
constexpr int ZA_Q = 0, ZA_K = 512, ZA_V = 640, ZB_Q = 768, ZB_K = 1280, ZB_V = 1792, ZC_Q = 2304, ZC_FF = 2816, ZC_FB = 3328, ZC_I = 3840, ZC_G = 4352,
              ZD_Q = 4864, ZD_K = 5120, ZD_V = 5376, ZD_GK = 5888, ZD_G = 6016, ZMERGE = 6656;
constexpr int VTS = 2304;
constexpr int LDS_BYTES = 144 * 1024;
constexpr int CTRL_OFF = LDS_BYTES - 256;
constexpr float EPS = 1e-6f;
constexpr float LOG2E = 1.4426950408889634f;
constexpr float QSCALE2 = 0.125f * LOG2E;

struct Params {
    const float *x, *c, *ctx, *c_ctx, *w_mod, *b_mod, *norm_gains, *w_in, *a_sink, *b_rel_bias, *c_lb, *c_norm, *d_gate_up, *d_gate_bias, *d_norm, *w_branch, *w_out, *w_ff1, *w_ff2;
    float* out;
    unsigned char* ws;
    unsigned long long o_mod, o_lb, o_rope, o_xc, o_win, o_wb, o_wo, o_w1, o_w2, o_h, o_z, o_y4, o_ob, o_vta, o_vtb, o_wo4;
    int GB, NGRP, MG, pad0;
};
typedef const Params __attribute__((address_space(4)))* PPtr;

__device__ __forceinline__ float bf2f(unsigned v) { return __uint_as_float(v << 16); }
__device__ __forceinline__ bf16_t f2bf(float f) { unsigned u = __float_as_uint(f); u += 0x7FFFu + ((u >> 16) & 1u); return (bf16_t)(u >> 16); }
typedef __bf16 bf16v2_t __attribute__((ext_vector_type(2)));
typedef float f32v2_t __attribute__((ext_vector_type(2)));
__device__ __forceinline__ unsigned pk2(float lo, float hi) { const f32v2_t v = {lo, hi}; const bf16v2_t b = __builtin_convertvector(v, bf16v2_t); return __builtin_bit_cast(unsigned, b); }
template <int CTRL> __device__ __forceinline__ float dpp(float x) { return __builtin_bit_cast(float, __builtin_amdgcn_mov_dpp(__builtin_bit_cast(int, x), CTRL, 0xf, 0xf, true)); }
constexpr int XOR1 = 0xB1, XOR2 = 0x4E, XOR7 = 0x141, XOR8 = 0x128;
__device__ __forceinline__ float xrow16_max(float x) {
    auto s = __builtin_amdgcn_permlane16_swap(__float_as_uint(x), __float_as_uint(x), false, false);
    x = fmaxf(__uint_as_float(s[0]), __uint_as_float(s[1]));
    auto t = __builtin_amdgcn_permlane32_swap(__float_as_uint(x), __float_as_uint(x), false, false);
    return fmaxf(__uint_as_float(t[0]), __uint_as_float(t[1]));
}
__device__ __forceinline__ float xrow16_sum(float x) {
    auto s = __builtin_amdgcn_permlane16_swap(__float_as_uint(x), __float_as_uint(x), false, false);
    x = __uint_as_float(s[0]) + __uint_as_float(s[1]);
    auto t = __builtin_amdgcn_permlane32_swap(__float_as_uint(x), __float_as_uint(x), false, false);
    return __uint_as_float(t[0]) + __uint_as_float(t[1]);
}
__device__ __forceinline__ float row16_sum(float v) {
    v += dpp<XOR1>(v); v += dpp<XOR2>(v); v += dpp<XOR7>(v); v += dpp<XOR8>(v);
    return v;
}
__device__ __forceinline__ float wave_sum(float v) { return xrow16_sum(row16_sum(v)); }
__device__ __forceinline__ float lo16(unsigned w) { return __uint_as_float(w << 16); }
__device__ __forceinline__ float hi16(unsigned w) { return __uint_as_float(w & 0xffff0000u); }
__device__ __forceinline__ float sigm(float x) { return __builtin_amdgcn_rcpf(1.0f + __builtin_amdgcn_exp2f(-LOG2E * x)); }
__device__ __forceinline__ bf16_t f2bf1(float x) { return (bf16_t)pk2(x, 0.f); }

__device__ __forceinline__ int src_col(int n) {
    if (n < 640) {
        const int p = n & 63, base = n - p, pp = p >> 1, wh = p & 1;
        const int dim = (pp < 16) ? (wh ? 16 + pp : pp) : (wh ? 48 + (pp - 16) : 32 + (pp - 16));
        return base + dim;
    }
    if (n < 5920) return n;
    if (n < 6016) return -1;
    if (n < 6528) return n - 96;
    if (n < 6656) return -1;
    return 6432 + (n - 6656);
}

__device__ __forceinline__ void conv_tile(const float* src, int Nsrc, int k0, int n0, bool inmap, bf16_t* dst, int Kd, LAS float* t) {
    const int tid = ltid(), nl = tid & 63, ks = tid >> 6;
    const int sc = inmap ? src_col(n0 + nl) : (n0 + nl);
#pragma unroll
    for (int i = 0; i < 8; ++i) { const int kk = ks + 8 * i; t[nl * 65 + kk] = (sc >= 0) ? src[(size_t)(k0 + kk) * Nsrc + sc] : 0.f; }
    __syncthreads();
    const int kl = (tid & 31) * 2, ns = tid >> 5;
#pragma unroll
    for (int i = 0; i < 4; ++i) { const int n = ns + 16 * i; *(unsigned*)(dst + (size_t)(n0 + n) * Kd + k0 + kl) = pk2(t[n * 65 + kl], t[n * 65 + kl + 1]); }
    __syncthreads();
}
__device__ __forceinline__ void convert_weights(PPtr p, int l, LAS unsigned char* lds) {
    LAS float* t = (LAS float*)lds;
    bf16_t* WinT = (bf16_t*)(p->ws + p->o_win); bf16_t* WbT = (bf16_t*)(p->ws + p->o_wb); bf16_t* WoT = (bf16_t*)(p->ws + p->o_wo);
    bf16_t* W1T = (bf16_t*)(p->ws + p->o_w1); bf16_t* W2T = (bf16_t*)(p->ws + p->o_w2);
    constexpr int T_IN = 16 * 168, T_BR = 4 * 8 * 16, T_O = 16 * 16, T_1 = 16 * 64, T_2 = 64 * 16, T_ALL = T_IN + T_BR + T_O + T_1 + T_2;
    for (int it = blockIdx.x; it < T_ALL; it += gridDim.x) {
        int r = it;
        if (r < T_IN) { const int kb = r / 168, nb = r % 168; conv_tile(p->w_in + (size_t)l * 1024 * INW, INW, kb * 64, nb * 64, true, WinT, 1024, t); continue; } r -= T_IN;
        if (r < T_BR) { const int j = r / 128, q = r % 128, kb = q / 16, nb = q % 16; conv_tile(p->w_branch + (size_t)(l * 4 + j) * 512 * 1024, 1024, kb * 64, nb * 64, false, WbT + (size_t)j * 1024 * 512, 512, t); continue; } r -= T_BR;
        if (r < T_O) { const int kb = r / 16, nb = r % 16; conv_tile(p->w_out + (size_t)l * 1024 * 1024, 1024, kb * 64, nb * 64, false, WoT, 1024, t);
#pragma unroll 1
            for (int cpy = 0; cpy < 4; ++cpy) conv_tile(p->w_out + (size_t)l * 1024 * 1024, 1024, kb * 64, nb * 64, false, (bf16_t*)(p->ws + p->o_wo4) + cpy * 1024, 4096, t);
            continue; } r -= T_O;
        if (r < T_1) { const int kb = r / 64, nb = r % 64; conv_tile(p->w_ff1 + (size_t)l * 1024 * 4096, 4096, kb * 64, nb * 64, false, W1T, 1024, t); continue; } r -= T_1;
        { const int kb = r / 16, nb = r % 16; conv_tile(p->w_ff2 + (size_t)l * 4096 * 1024, 1024, kb * 64, nb * 64, false, W2T, 4096, t); }
    }
}

__device__ __forceinline__ void prologue(PPtr p, LAS unsigned char* lds) {
    const int tid = ltid();
    if (blockIdx.x == 0) {
        if (tid < 64) atomicExch((unsigned*)p->ws + tid, 0u);
        for (int i = tid; i < XCD_BAR_WORDS; i += 512) __hip_atomic_store((unsigned*)(p->ws + 4096) + i, 0u, __ATOMIC_RELAXED, __HIP_MEMORY_SCOPE_AGENT);
    }
    if (tid < 4) *((LAS unsigned*)(lds + CTRL_OFF + 64) + tid) = 0u;
    float* modb = (float*)(p->ws + p->o_mod);
    LAS float* sl = (LAS float*)lds;
    LAS float* red = sl + 17 * 1024;
    bool loaded = false;
    for (int task = blockIdx.x; task < 192; task += gridDim.x) {
        if (!loaded) {
            for (int i = tid; i < 17 * 1024; i += 512) { const int b = i >> 10, k = i & 1023; const float v = (b < 16) ? p->c[b * 1024 + k] : p->c_ctx[k]; sl[i] = v * sigm(v); }
            loaded = true;
        }
        __syncthreads();
        const int l = task / 48, nc = task % 48, nn = tid & 127, n = nc * 128 + nn, kq = tid >> 7;
        float acc[17];
#pragma unroll
        for (int b = 0; b < 17; ++b) acc[b] = 0.f;
        const float* w = p->w_mod + ((size_t)l * 1024 + kq * 256) * 6144 + n;
#pragma unroll 4
        for (int k = 0; k < 256; ++k) {
            const float wv = w[(size_t)k * 6144];
#pragma unroll
            for (int b = 0; b < 17; ++b) acc[b] += sl[b * 1024 + kq * 256 + k] * wv;
        }
#pragma unroll
        for (int b = 0; b < 17; ++b) red[(kq * 17 + b) * 128 + nn] = acc[b];
        __syncthreads();
        if (kq == 0) {
            const float bm = p->b_mod[l * 6144 + n];
#pragma unroll
            for (int b = 0; b < 17; ++b) modb[((size_t)l * 17 + b) * 6144 + n] = red[b * 128 + nn] + red[(17 + b) * 128 + nn] + red[(34 + b) * 128 + nn] + red[(51 + b) * 128 + nn] + bm;
        }
        __syncthreads();
    }
    if (blockIdx.x == gridDim.x - 1) {
        float* lb = (float*)(p->ws + p->o_lb);
        {
            const int ch = tid;
            float v[4], mx = -1e30f;
#pragma unroll
            for (int l = 0; l < 4; ++l) { v[l] = p->c_lb[l * 512 + ch]; mx = fmaxf(mx, v[l]); }
            float s = 0.f;
#pragma unroll
            for (int l = 0; l < 4; ++l) { v[l] = __expf(v[l] - mx); s += v[l]; }
            const float inv = 1.0f / s, s0 = v[0] * inv; float cum = 0.f;
#pragma unroll
            for (int l = 0; l < 4; ++l) { cum += v[l] * inv; lb[l * 512 + ch] = cum - s0; }
        }
        float* rt = (float*)(p->ws + p->o_rope);
        for (int i = tid; i < 1024; i += 512) {
            const int n = i >> 4, f = i & 15;
            const float inv = __expf(-((float)(2 * f) / 32.0f) * 9.210340371976184f);
            const float a = (float)n * inv;
            const float kf = rintf(a * 0.15915494309189535f);
            const float rr = fmaf(-kf, 6.2831854820251465f, a) + kf * 1.7484556e-7f;
            rt[i] = __cosf(rr); rt[1024 + i] = __sinf(rr);
        }
    }
    __syncthreads();
    convert_weights(p, 0, lds);
}

__device__ __forceinline__ void rowpass(PPtr p, int l, int g, int mode, int nrows) {
    const int lane = ltid() & 63, gw = blockIdx.x * 8 + (ltid() >> 6), NGW = gridDim.x * 8;
    const int LATR = p->GB * 2048, GB = p->GB;
    const float* ng = p->norm_gains + (size_t)l * 4 * 1024;
    const float* modb = (const float*)(p->ws + p->o_mod) + (size_t)l * 17 * 6144;
    bf16_t* hb = (bf16_t*)(p->ws + p->o_h);
    const float* yf = (const float*)(p->ws + p->o_z);
    float* xcb = (float*)(p->ws + p->o_xc);
    const bool first = (l == 0 && mode <= 2);
    const float* xlat = first ? p->x : (const float*)p->out;
    const float* xctx = first ? p->ctx : (const float*)xcb;
    auto xsrc = [&](int row) -> const float* {
        if (row < LATR) return xlat + ((size_t)(g * GB + (row >> 11)) * 2048 + (row & 2047)) * 1024;
        const int r2 = row - LATR; return xctx + ((size_t)(g * GB + (r2 >> 8)) * 256 + (r2 & 255)) * 1024;
    };
    const float* slab = (const float*)(p->ws + p->o_z + (size_t)p->MG * 12288);
    const size_t slab_stride = (size_t)(p->MG - LATR) * 1024;
    auto yload = [&](int row, f32x4 (&yv)[4]) {
        if (row < LATR) {
#pragma unroll
            for (int j = 0; j < 4; ++j) yv[j] = *(const f32x4*)(yf + (size_t)row * 1024 + lane * 4 + 256 * j);
        } else {
            const float* s0 = slab + (size_t)(row - LATR) * 1024 + lane * 4;
#pragma unroll
            for (int j = 0; j < 4; ++j) yv[j] = *(const f32x4*)(s0 + 256 * j);
#pragma unroll
            for (int ks = 1; ks < 8; ++ks)
#pragma unroll
                for (int j = 0; j < 4; ++j) yv[j] = yv[j] + *(const f32x4*)(s0 + ks * slab_stride + 256 * j);
        }
    };
    f32x4 xv[4], yv[4];
    int row = gw;
    if (row < nrows) {
        const float* xs = xsrc(row);
#pragma unroll
        for (int j = 0; j < 4; ++j) xv[j] = *(const f32x4*)(xs + lane * 4 + 256 * j);
        if (mode >= 2) yload(row, yv);
    }
    while (row < nrows) {
        const int nrow = row + NGW;
        f32x4 xn[4], yn[4];
        if (nrow < nrows) {
            const float* xs = xsrc(nrow);
#pragma unroll
            for (int j = 0; j < 4; ++j) xn[j] = *(const f32x4*)(xs + lane * 4 + 256 * j);
            if (mode >= 2) yload(nrow, yn);
        }
        const bool lat = row < LATR;
        int b; size_t xrow;
        if (lat) { b = g * GB + (row >> 11); xrow = (size_t)b * 2048 + (row & 2047); }
        else { const int r2 = row - LATR; b = g * GB + (r2 >> 8); xrow = (size_t)b * 256 + (r2 & 255); }
        float* xd = (lat ? p->out : xcb) + xrow * 1024;
        const float* m = modb + (size_t)(lat ? b : 16) * 6144;
        if (mode >= 2) {
            float ss = 0.f;
#pragma unroll
            for (int j = 0; j < 4; ++j) ss += yv[j].x * yv[j].x + yv[j].y * yv[j].y + yv[j].z * yv[j].z + yv[j].w * yv[j].w;
            ss = wave_sum(ss);
            const float rs = rsqrtf(ss * (1.0f / 1024.0f) + EPS);
            const float* gate = m + (mode == 2 ? 2048 : 5120); const float* gn = ng + (mode == 2 ? 1024 : 3072);
#pragma unroll
            for (int j = 0; j < 4; ++j) {
                const int c = lane * 4 + 256 * j;
                const f32x4 gv = *(const f32x4*)(gate + c), nv = *(const f32x4*)(gn + c);
                xv[j] = xv[j] + gv * (yv[j] * rs * nv);
                *(f32x4*)(xd + c) = xv[j];
            }
        }
        if (mode <= 2) {
            float ss = 0.f;
#pragma unroll
            for (int j = 0; j < 4; ++j) ss += xv[j].x * xv[j].x + xv[j].y * xv[j].y + xv[j].z * xv[j].z + xv[j].w * xv[j].w;
            ss = wave_sum(ss);
            const float rs = rsqrtf(ss * (1.0f / 1024.0f) + EPS);
            const float* sh = m + (mode == 1 ? 0 : 3072); const float* sc = m + (mode == 1 ? 1024 : 4096); const float* gn = ng + (mode == 1 ? 0 : 2048);
#pragma unroll
            for (int j = 0; j < 4; ++j) {
                const int c = lane * 4 + 256 * j;
                const f32x4 shv = *(const f32x4*)(sh + c), scv = *(const f32x4*)(sc + c), nv = *(const f32x4*)(gn + c);
                const f32x4 hv = (xv[j] * rs * nv) * (scv + 1.0f) + shv;
                u32x2 o; o.x = pk2(hv.x, hv.y); o.y = pk2(hv.z, hv.w);
                *(u32x2*)(hb + (size_t)row * 1024 + c) = o;
            }
        }
#pragma unroll
        for (int j = 0; j < 4; ++j) { xv[j] = xn[j]; yv[j] = yn[j]; }
        row = nrow;
    }
}

struct EpiInproj {
    static constexpr bool PERM = true, AFTER_DRAIN = false;
    bf16_t* Z; bf16_t* vta; bf16_t* vtb; const float* rope; int GB;
    __device__ __forceinline__ void operator()(const f32x4 (&acc)[2][2][4][2], const pg8::Unit& u, int wr, int wc, int fr, int fq) const {
        const int row0 = u.pm * 256 + wr * 64 + fr, LATR = GB * 2048;
#pragma unroll
        for (int bj = 0; bj < 2; ++bj) {
            const int seg = u.pn * 2 + bj, c0 = u.pn * 256 + bj * 128 + wc * 32 + 8 * fq;
            const int type = (seg <= 4) ? 1 : (seg == 5 ? 2 : ((seg >= 14 && seg <= 17) ? 3 : 0));
            const int xf = (seg <= 3 || (seg >= 6 && seg <= 9)) ? 1 : ((seg >= 18 && seg <= 21) ? 2 : ((seg >= 22 && seg <= 29) ? 3 : ((seg == 38 || seg == 39) ? 4 : 0)));
#pragma unroll
            for (int ai = 0; ai < 2; ++ai)
#pragma unroll
                for (int m = 0; m < 4; ++m) {
                    const int row = row0 + ai * 128 + m * 16;
                    f32x4 v0 = acc[ai][bj][m][0], v1 = acc[ai][bj][m][1];
                    if (type <= 1) {
                        if (type == 1 && row < LATR) {
                            const int t = row & 2047, pp0 = (c0 & 63) >> 1;
                            const int n = (pp0 < 16) ? (t >> 6) : (t & 63);
                            const float* cs = rope + n * 16 + (pp0 & 15);
                            const f32x4 cv = *(const f32x4*)cs, sv = *(const f32x4*)(cs + 1024);
                            f32x4 r0, r1;
                            r0.x = v0.x * cv.x - v0.y * sv.x; r0.y = v0.y * cv.x + v0.x * sv.x;
                            r0.z = v0.z * cv.y - v0.w * sv.y; r0.w = v0.w * cv.y + v0.z * sv.y;
                            r1.x = v1.x * cv.z - v1.y * sv.z; r1.y = v1.y * cv.z + v1.x * sv.z;
                            r1.z = v1.z * cv.w - v1.w * sv.w; r1.w = v1.w * cv.w + v1.z * sv.w;
                            v0 = r0; v1 = r1;
                        }
                        if (xf == 1) { v0 = v0 * QSCALE2; v1 = v1 * QSCALE2; }
                        else if (xf == 4) { v0 = v0 * 0.125f; v1 = v1 * 0.125f; }
                        else if (xf == 2) {
#pragma unroll
                            for (int e = 0; e < 4; ++e) { v0[e] = v0[e] * sigm(v0[e]); v1[e] = v1[e] * sigm(v1[e]); }
                        } else if (xf == 3) {
#pragma unroll
                            for (int e = 0; e < 4; ++e) { v0[e] = sigm(v0[e]); v1[e] = sigm(v1[e]); }
                        }
                        u32x4 w; w.x = pk2(v0.x, v0.y); w.y = pk2(v0.z, v0.w); w.z = pk2(v1.x, v1.y); w.w = pk2(v1.z, v1.w);
                        *(u32x4*)(Z + (size_t)row * ZW + c0) = w;
                    } else {
                        int bl, tok;
                        if (row < LATR) { bl = row >> 11; tok = row & 2047; } else { const int r2 = row - LATR; bl = r2 >> 8; tok = 2048 + (r2 & 255); }
                        const int cc = c0 - (type == 2 ? ZA_V : ZB_V), head = cc >> 6, dim0 = cc & 63, H = (type == 2) ? 2 : 8;
                        bf16_t* base = (type == 2 ? vta : vtb) + ((size_t)(bl * H + head) * 64 + dim0) * VTS + tok;
                        base[0 * VTS] = f2bf(v0.x); base[1 * VTS] = f2bf(v0.y); base[2 * VTS] = f2bf(v0.z); base[3 * VTS] = f2bf(v0.w);
                        base[4 * VTS] = f2bf(v1.x); base[5 * VTS] = f2bf(v1.y); base[6 * VTS] = f2bf(v1.z); base[7 * VTS] = f2bf(v1.w);
                    }
                }
        }
    }
};
struct EpiBranch {
    static constexpr bool PERM = true, AFTER_DRAIN = false;
    const bf16_t* Z; bf16_t* macc; int nMfull;
    __device__ __forceinline__ void operator()(const f32x4 (&acc)[2][2][4][2], const pg8::Unit& u, int wr, int wc, int fr, int fq) const {
        const int j = u.pm / nMfull, pm = u.pm - j * nMfull, pn = u.pn & 3;
        const int row0 = pm * 256 + wr * 64 + fr, col0 = pn * 256 + wc * 32 + 8 * fq;
        const bf16_t* gbase = Z + (size_t)row0 * ZW + ZMERGE + j * 1024 + col0;
        bf16_t* mbase = macc + (size_t)row0 * 1024 + col0;
#pragma unroll
        for (int ai = 0; ai < 2; ++ai) {
            u32x4 gw[4][2], pv[4][2];
#pragma unroll
            for (int m = 0; m < 4; ++m)
#pragma unroll
                for (int bj = 0; bj < 2; ++bj) {
                    const size_t ro = (size_t)(ai * 128 + m * 16);
                    gw[m][bj] = *(const u32x4*)(gbase + ro * ZW + bj * 128);
                    pv[m][bj] = (j > 0) ? *(const u32x4*)(mbase + ro * 1024 + bj * 128) : (u32x4){0u, 0u, 0u, 0u};
                }
#pragma unroll
            for (int m = 0; m < 4; ++m)
#pragma unroll
                for (int bj = 0; bj < 2; ++bj) {
                    const u32x4 g = gw[m][bj], q = pv[m][bj];
                    const f32x4 v0 = acc[ai][bj][m][0], v1 = acc[ai][bj][m][1];
                    const float t0 = v0.x * sigm(lo16(g.x)) + lo16(q.x), t1 = v0.y * sigm(hi16(g.x)) + hi16(q.x), t2 = v0.z * sigm(lo16(g.y)) + lo16(q.y), t3 = v0.w * sigm(hi16(g.y)) + hi16(q.y);
                    const float t4 = v1.x * sigm(lo16(g.z)) + lo16(q.z), t5 = v1.y * sigm(hi16(g.z)) + hi16(q.z), t6 = v1.z * sigm(lo16(g.w)) + lo16(q.w), t7 = v1.w * sigm(hi16(g.w)) + hi16(q.w);
                    u32x4 w; w.x = pk2(t0, t1); w.y = pk2(t2, t3); w.z = pk2(t4, t5); w.w = pk2(t6, t7);
                    *(u32x4*)(mbase + (size_t)(ai * 128 + m * 16) * 1024 + bj * 128) = w;
                }
        }
    }
};
struct BranchOrder {
    int nM, nMfull, G, c;
    __device__ __forceinline__ bool next(int i, pg8::Unit& u) const {
        const int j = i & 3; const int v = (c & 7) * (G >> 3) + (c >> 3);
        const long T = (long)(i >> 2) * G + v;
        if (T >= (long)nM * 4) return false;
        u.pm = j * nMfull + (int)(T >> 2); u.pn = j * 4 + (int)(T & 3); u.ko = 0; return true;
    }
    __device__ __forceinline__ void a_ready(const pg8::Unit&) const {}
    __device__ __forceinline__ void done(const pg8::Unit&) const {}
};
struct EpiRelu2 {
    static constexpr bool PERM = true, AFTER_DRAIN = false;
    bf16_t* O; int ldc;
    __device__ __forceinline__ void operator()(const f32x4 (&acc)[2][2][4][2], const pg8::Unit& u, int wr, int wc, int fr, int fq) const {
        const int row0 = u.pm * 256 + wr * 64 + fr, col0 = u.pn * 256 + wc * 32 + 8 * fq;
#pragma unroll
        for (int ai = 0; ai < 2; ++ai)
#pragma unroll
            for (int m = 0; m < 4; ++m) {
                bf16_t* rowp = O + (size_t)(row0 + ai * 128 + m * 16) * ldc + col0;
#pragma unroll
                for (int bj = 0; bj < 2; ++bj) {
                    f32x4 v0 = acc[ai][bj][m][0], v1 = acc[ai][bj][m][1];
#pragma unroll
                    for (int e = 0; e < 4; ++e) { const float a = fmaxf(v0[e], 0.f), b = fmaxf(v1[e], 0.f); v0[e] = a * a; v1[e] = b * b; }
                    u32x4 w; w.x = pk2(v0.x, v0.y); w.y = pk2(v0.z, v0.w); w.z = pk2(v1.x, v1.y); w.w = pk2(v1.z, v1.w);
                    *(u32x4*)(rowp + bj * 128) = w;
                }
            }
    }
};

struct CtxBranchOrder {
    int nMfull, pm0, nT, G, c;
    __device__ __forceinline__ bool next(int i, pg8::Unit& u) const {
        const long L = (long)i * G + c; if (L >= (long)nT * 4) return false;
        const int j = (int)(L & 3), t = (int)(L >> 2);
        u.pm = j * nMfull + pm0 + (t >> 2); u.pn = j * 4 + (t & 3); u.ko = 0; return true;
    }
    __device__ __forceinline__ void a_ready(const pg8::Unit&) const {}
    __device__ __forceinline__ void done(const pg8::Unit&) const {}
};
struct EpiBranchCtx {
    static constexpr bool PERM = true, AFTER_DRAIN = false;
    const bf16_t* Z; bf16_t* P; int nMfull, pm0;
    __device__ __forceinline__ void operator()(const f32x4 (&acc)[2][2][4][2], const pg8::Unit& u, int wr, int wc, int fr, int fq) const {
        const int j = u.pm / nMfull, pm = u.pm - j * nMfull, pn = u.pn & 3;
        const int row0 = pm * 256 + wr * 64 + fr, col0 = pn * 256 + wc * 32 + 8 * fq;
        const bf16_t* gbase = Z + (size_t)row0 * ZW + ZMERGE + j * 1024 + col0;
        bf16_t* pbase = P + (size_t)(row0 - pm0 * 256) * 4096 + j * 1024 + col0;
#pragma unroll
        for (int ai = 0; ai < 2; ++ai) {
            u32x4 gw[4][2];
#pragma unroll
            for (int m = 0; m < 4; ++m)
#pragma unroll
                for (int bj = 0; bj < 2; ++bj) gw[m][bj] = *(const u32x4*)(gbase + (size_t)(ai * 128 + m * 16) * ZW + bj * 128);
#pragma unroll
            for (int m = 0; m < 4; ++m)
#pragma unroll
                for (int bj = 0; bj < 2; ++bj) {
                    const u32x4 g = gw[m][bj];
                    const f32x4 v0 = acc[ai][bj][m][0], v1 = acc[ai][bj][m][1];
                    u32x4 w; w.x = pk2(v0.x * sigm(lo16(g.x)), v0.y * sigm(hi16(g.x))); w.y = pk2(v0.z * sigm(lo16(g.y)), v0.w * sigm(hi16(g.y)));
                    w.z = pk2(v1.x * sigm(lo16(g.z)), v1.y * sigm(hi16(g.z))); w.w = pk2(v1.z * sigm(lo16(g.w)), v1.w * sigm(hi16(g.w)));
                    *(u32x4*)(pbase + (size_t)(ai * 128 + m * 16) * 4096 + bj * 128) = w;
                }
        }
    }
};
struct SplitOrder {
    int pm0, nT, SPLIT, Kl, G, c;
    __device__ __forceinline__ bool next(int i, pg8::Unit& u) const {
        const long L = (long)i * G + c; if (L >= (long)nT * 4 * SPLIT) return false;
        const int ks = (int)(L % SPLIT), t = (int)(L / SPLIT);
        u.pm = pm0 + (t >> 2); u.pn = t & 3; u.ko = ks * Kl; return true;
    }
    __device__ __forceinline__ void a_ready(const pg8::Unit&) const {}
    __device__ __forceinline__ void done(const pg8::Unit&) const {}
};
struct EpiSlab {
    static constexpr bool PERM = false, AFTER_DRAIN = false;
    float* S; int pm0, nrows, Kl;
    __device__ __forceinline__ void operator()(const f32x4 (&acc)[2][2][4][2], const pg8::Unit& u, int wr, int wc, int fr, int fq) const {
        const int ks = u.ko / Kl;
        const int row0 = (u.pm - pm0) * 256 + wr * 64 + fr, col0 = u.pn * 256 + wc * 32 + 4 * fq;
        float* base = S + (size_t)ks * nrows * 1024;
#pragma unroll
        for (int ai = 0; ai < 2; ++ai)
#pragma unroll
            for (int m = 0; m < 4; ++m) { float* rowp = base + (size_t)(row0 + ai * 128 + m * 16) * 1024 + col0;
#pragma unroll
                for (int bj = 0; bj < 2; ++bj)
#pragma unroll
                    for (int n = 0; n < 2; ++n) *(f32x4*)(rowp + bj * 128 + n * 16) = acc[ai][bj][m][n]; }
    }
};

#define MFMA16(a, b, c) __builtin_amdgcn_mfma_f32_16x16x32_bf16((a), (b), (c), 0, 0, 0)
__device__ __forceinline__ void attn_wave(PPtr p, int l, int kind, int idx, int lane, const LAS float* biasL) {
    const int fr = lane & 15, fq = lane >> 4;
    const int LATR = p->GB * 2048, MG = p->MG;
    const bf16_t* Z = (const bf16_t*)(p->ws + p->o_z);
    const bool isA = (kind == 1 || kind == 2);
    int bl, hk, qrow0, r = 0, q0 = 0;
    if (kind == 0) { bl = idx >> 8; hk = (idx >> 5) & 7; r = idx & 31; qrow0 = bl * 2048 + r * 64; }
    else if (kind == 1) { bl = idx >> 8; hk = (idx >> 7) & 1; q0 = (idx & 127) * 16; qrow0 = bl * 2048 + q0; }
    else if (kind == 2) { bl = idx >> 5; hk = (idx >> 4) & 1; qrow0 = LATR + bl * 256 + (idx & 15) * 16; }
    else { bl = idx >> 5; hk = (idx >> 2) & 7; qrow0 = LATR + bl * 256 + (idx & 3) * 64; }
    const int qrstep = isA ? 0 : 16, qcstep = isA ? 64 : 0;
    const int qcol0 = isA ? (ZA_Q + hk * 4 * 64) : (ZB_Q + hk * 64);
    const int kcol = isA ? (ZA_K + hk * 64) : (ZB_K + hk * 64);
    const bf16_t* vt = isA ? ((const bf16_t*)(p->ws + p->o_vta) + (size_t)(bl * 2 + hk) * 64 * VTS) : ((const bf16_t*)(p->ws + p->o_vtb) + (size_t)(bl * 8 + hk) * 64 * VTS);
    bf16_t* yo = (bf16_t*)(p->ws + p->o_y4) + (isA ? (size_t)0 : (size_t)MG * 512);
    const int ocol0 = isA ? hk * 4 * 64 : hk * 64;
    const int krow_ctx0 = LATR + bl * 256, krow_lat0 = bl * 2048;

    bf16x8 Q[4][2];
#pragma unroll
    for (int s = 0; s < 4; ++s)
#pragma unroll
        for (int ks = 0; ks < 2; ++ks) Q[s][ks] = *(const bf16x8*)(Z + (size_t)(qrow0 + s * qrstep + fr) * ZW + qcol0 + s * qcstep + ks * 32 + fq * 8);
    f32x4 O[4][4]; float mrun[4], lrun[4];
#pragma unroll
    for (int s = 0; s < 4; ++s) { mrun[s] = -1e30f; lrun[s] = 0.f;
#pragma unroll
        for (int dt = 0; dt < 4; ++dt) O[s][dt] = (f32x4){0.f, 0.f, 0.f, 0.f}; }

    auto do_block = [&](int krow, int vtoff, int mode, int a0, int a1) {
        bf16x8 Kf[2][2];
#pragma unroll
        for (int kt = 0; kt < 2; ++kt)
#pragma unroll
            for (int ks = 0; ks < 2; ++ks) Kf[kt][ks] = *(const bf16x8*)(Z + (size_t)(krow + kt * 16 + fr) * ZW + kcol + ks * 32 + fq * 8);
        bf16x8 Vf[4];
#pragma unroll
        for (int dt = 0; dt < 4; ++dt) {
            const bf16_t* vp = vt + (size_t)(dt * 16 + fr) * VTS + vtoff + fq * 4;
            const u32x2 lo = *(const u32x2*)vp, hi = *(const u32x2*)(vp + 16);
            u32x4 w; w.x = lo.x; w.y = lo.y; w.z = hi.x; w.w = hi.y;
            Vf[dt] = __builtin_bit_cast(bf16x8, w);
        }
#pragma unroll
        for (int s = 0; s < 4; ++s) {
            const bool active = (mode != 2) || !((s == 0 && a1 == 1) || (s == 3 && a1 == 0));
            if (active) {
                f32x4 S0 = (f32x4){0.f, 0.f, 0.f, 0.f}, S1 = (f32x4){0.f, 0.f, 0.f, 0.f};
                S0 = MFMA16(Kf[0][0], Q[s][0], S0); S0 = MFMA16(Kf[0][1], Q[s][1], S0);
                S1 = MFMA16(Kf[1][0], Q[s][0], S1); S1 = MFMA16(Kf[1][1], Q[s][1], S1);
                float sc[8];
#pragma unroll
                for (int j = 0; j < 4; ++j) { sc[j] = S0[j]; sc[4 + j] = S1[j]; }
                if (mode == 1) {
                    const int qpos = q0 + fr;
#pragma unroll
                    for (int e = 0; e < 8; ++e) { const int kpos = a0 + (e >> 2) * 16 + fq * 4 + (e & 3); const int d = kpos - qpos; if (d > 128 || d < -128) sc[e] = -1e30f; }
                } else if (mode == 2) {
                    const int qc = 16 * s + fr; const int cs = min(max(qc - 8, 0), 48);
                    const LAS float* bp = biasL + hk * 465 + a0 * 31;
#pragma unroll
                    for (int e = 0; e < 8; ++e) {
                        const int kc = a1 * 32 + (e >> 2) * 16 + fq * 4 + (e & 3);
                        const int dc = min(max(kc - qc + 15, 0), 30);
                        const float bv = bp[dc];
                        sc[e] = (kc >= cs && kc < cs + 16) ? (sc[e] + bv) : -1e30f;
                    }
                }
                float ml = fmaxf(fmaxf(fmaxf(sc[0], sc[1]), fmaxf(sc[2], sc[3])), fmaxf(fmaxf(sc[4], sc[5]), fmaxf(sc[6], sc[7])));
                ml = xrow16_max(ml);
                const float mold = mrun[s], mn = fmaxf(mold, ml), alpha = __builtin_amdgcn_exp2f(mold - mn);
                mrun[s] = mn;
                float pv[8], ls = 0.f;
#pragma unroll
                for (int e = 0; e < 8; ++e) { pv[e] = __builtin_amdgcn_exp2f(sc[e] - mn); ls += pv[e]; }
                ls = xrow16_sum(ls);
                lrun[s] = lrun[s] * alpha + ls;
                u32x4 pw; pw.x = pk2(pv[0], pv[1]); pw.y = pk2(pv[2], pv[3]); pw.z = pk2(pv[4], pv[5]); pw.w = pk2(pv[6], pv[7]);
                const bf16x8 P = __builtin_bit_cast(bf16x8, pw);
                if (__builtin_amdgcn_ballot_w64(mn > mold) != 0ull) {
#pragma unroll
                    for (int dt = 0; dt < 4; ++dt) O[s][dt] = O[s][dt] * alpha;
                }
#pragma unroll
                for (int dt = 0; dt < 4; ++dt) O[s][dt] = MFMA16(Vf[dt], P, O[s][dt]);
            }
            __builtin_amdgcn_sched_barrier(0);
        }
    };
    int nloc = 0, lo = 0, r0 = 0;
    if (kind == 1) { lo = max(0, q0 - 128) & ~31; const int hi = min(2048, (q0 + 16 + 128 + 31) & ~31); nloc = (hi - lo) >> 5; }
    else if (kind == 0) { r0 = min(max(r - 4, 0), 24); nloc = 16; }
#pragma unroll 1
    for (int i = 0; i < 8 + nloc; ++i) {
        int krow, vtoff, mode, a0, a1;
        if (i < 8) { krow = krow_ctx0 + 32 * i; vtoff = 2048 + 32 * i; mode = 0; a0 = 0; a1 = 0; }
        else if (kind == 1) { const int kb = lo + 32 * (i - 8); krow = krow_lat0 + kb; vtoff = kb; mode = 1; a0 = kb; a1 = 0; }
        else { const int jj = i - 8, kr = r0 + (jj >> 1), hb = jj & 1; krow = krow_lat0 + kr * 64 + hb * 32; vtoff = kr * 64 + hb * 32; mode = 2; a0 = kr - r + 7; a1 = hb; }
        do_block(krow, vtoff, mode, a0, a1);
    }
#pragma unroll
    for (int s = 0; s < 4; ++s) {
        float fac;
        if (isA) { const float sk = p->a_sink[l * 8 + hk * 4 + s] * LOG2E; const float M = fmaxf(mrun[s], sk); const float e1 = __builtin_amdgcn_exp2f(mrun[s] - M); fac = e1 / (lrun[s] * e1 + __builtin_amdgcn_exp2f(sk - M)); }
        else fac = 1.0f / lrun[s];
        bf16_t* op = yo + (size_t)(qrow0 + s * qrstep + fr) * 512 + ocol0 + s * qcstep + fq * 4;
#pragma unroll
        for (int dt = 0; dt < 4; ++dt) { const f32x4 o = O[s][dt] * fac; u32x2 w; w.x = pk2(o.x, o.y); w.y = pk2(o.z, o.w); *(u32x2*)(op + dt * 16) = w; }
    }
}

constexpr int SCAN_BUF = 41472;
constexpr int BIAS_OFF = 3 * SCAN_BUF;
template <int DK, bool ISC>
__device__ __forceinline__ void scan_task(PPtr p, int l, int bl, int h, int dir, LAS unsigned char* lds) {
    constexpr int KPW = DK / 8, NTG = 64 / KPW, TPG = 32 / NTG, QS = (DK + 8) * 2, NKT = DK / 16;
    const int tid = ltid(), w = tid >> 6, lane = tid & 63, fr = lane & 15, fq = lane >> 4;
    const int kl = lane % KPW, tg = lane / KPW, kch = w * KPW + kl;
    const int vcol = tid & 127, vg = tid >> 7;
    LAS unsigned char* qt = lds; LAS unsigned char* kt_ = qt + 32 * QS; LAS unsigned char* khT = kt_ + 32 * QS; LAS unsigned char* vT = khT + DK * 80;
    LAS unsigned char* att = vT + 128 * 80; LAS float* dvec = (LAS float*)(att + 32 * 80); LAS float* evec = dvec + DK;
    const bf16_t* Z = (const bf16_t*)(p->ws + p->o_z);
    const int LATR = p->GB * 2048, MG = p->MG;
    const int qc = ISC ? (ZC_Q + h * 128 + kch) : (ZD_Q + h * 64 + kch);
    const int kc = ISC ? ((dir ? ZC_FB : ZC_FF) + h * 128 + kch) : (ZD_K + h * 64 + kch);
    const int vc = (ISC ? ZC_I : ZD_V) + h * 128 + vcol;
    const int gcol = ZD_GK + dir * 16;
    float lbv = 0.f, oml = 1.f, up[16], gb = 0.f;
#pragma unroll
    for (int r = 0; r < 16; ++r) up[r] = 0.f;
    if (ISC) { lbv = ((const float*)(p->ws + p->o_lb))[l * 512 + h * 128 + kch]; oml = 1.0f - lbv; }
    else {
#pragma unroll
        for (int r = 0; r < 16; ++r) up[r] = p->d_gate_up[((size_t)(l * 2 + dir) * 16 + r) * 256 + h * 64 + kch];
        gb = p->d_gate_bias[(l * 2 + dir) * 256 + h * 64 + kch];
    }
    bf16_t* odst = (dir == 0) ? ((bf16_t*)(p->ws + p->o_y4) + (size_t)(ISC ? 2 : 3) * MG * 512) : ((bf16_t*)(p->ws + p->o_ob) + (size_t)(ISC ? 0 : 1) * MG * 512);
    f32x4 S[NKT];
#pragma unroll
    for (int i = 0; i < NKT; ++i) S[i] = (f32x4){0.f, 0.f, 0.f, 0.f};
    auto rowof = [&](int cc, int i) -> int {
        const bool isctx = cc < 8; const int L = isctx ? 256 : 2048, base = isctx ? (LATR + bl * 256) : (bl * 2048), c = isctx ? cc : cc - 8;
        const int pos = c * 32 + i; return base + (dir ? (L - 1 - pos) : pos);
    };
    bf16_t rq[TPG], rk[TPG], rv[8]; u32x4 rz[TPG][2];
    auto load_raw = [&](int cc) {
#pragma unroll
        for (int e = 0; e < TPG; ++e) {
            const bf16_t* zr = Z + (size_t)rowof(cc, tg * TPG + e) * ZW;
            rq[e] = zr[qc]; rk[e] = zr[kc];
            if (!ISC) { rz[e][0] = *(const u32x4*)(zr + gcol); rz[e][1] = *(const u32x4*)(zr + gcol + 8); }
        }
#pragma unroll
        for (int e = 0; e < 8; ++e) rv[e] = Z[(size_t)rowof(cc, vg * 8 + e) * ZW + vc];
    };
    load_raw(0);
    for (int cc = 0; cc < 72; ++cc) {
        __syncthreads();
        {
            float gq[TPG], gk[TPG], cum[TPG]; float run = 0.f;
#pragma unroll
            for (int e = 0; e < TPG; ++e) {
                const float zq = bf2f(rq[e]), zk = bf2f(rk[e]); float g, key, q;
                if (ISC) { const float sg = zk; g = __logf(lbv + oml * sg); key = oml * (1.0f - sg); q = zq; }
                else {
                    float a = gb;
                    const u32x4 z0 = rz[e][0], z1 = rz[e][1];
                    a += lo16(z0.x) * up[0] + hi16(z0.x) * up[1] + lo16(z0.y) * up[2] + hi16(z0.y) * up[3] + lo16(z0.z) * up[4] + hi16(z0.z) * up[5] + lo16(z0.w) * up[6] + hi16(z0.w) * up[7];
                    a += lo16(z1.x) * up[8] + hi16(z1.x) * up[9] + lo16(z1.y) * up[10] + hi16(z1.y) * up[11] + lo16(z1.z) * up[12] + hi16(z1.z) * up[13] + lo16(z1.w) * up[14] + hi16(z1.w) * up[15];
                    g = (fminf(a, 0.f) - __logf(1.0f + __expf(-fabsf(a)))) * (1.0f / 16.0f); key = zk; q = zq;
                }
                run += g; cum[e] = run; gq[e] = q; gk[e] = key;
            }
            float pre = 0.f, total = 0.f, cref = 0.f;
#pragma unroll
            for (int t = 0; t < NTG; ++t) { const float tt = __shfl(run, kl + KPW * t); if (t < tg) pre += tt; if (t < NTG / 2) cref += tt; total += tt; }
            float khv[TPG]; const float etc = __expf(total - cref);
#pragma unroll
            for (int e = 0; e < TPG; ++e) {
                const float c = cum[e] + pre; const int i = tg * TPG + e;
                const float E = __expf(c - cref), kE = gk[e] * __builtin_amdgcn_rcpf(E);
                *(LAS bf16_t*)(qt + i * QS + kch * 2) = f2bf1(gq[e] * E);
                *(LAS bf16_t*)(kt_ + i * QS + kch * 2) = f2bf1(kE);
                khv[e] = kE * etc;
            }
            if constexpr (TPG == 8) { u32x4 o; o.x = pk2(khv[0], khv[1]); o.y = pk2(khv[2], khv[3]); o.z = pk2(khv[4], khv[5]); o.w = pk2(khv[6], khv[7]); *(LAS u32x4*)(khT + kch * 80 + tg * 16) = o; }
            else { u32x2 o; o.x = pk2(khv[0], khv[1]); o.y = pk2(khv[2], khv[3]); *(LAS u32x2*)(khT + kch * 80 + tg * 8) = o; }
            if (tg == 0) { dvec[kch] = __expf(total); evec[kch] = __expf(cref); }
            u32x4 vo; vo.x = (unsigned)rv[0] | ((unsigned)rv[1] << 16); vo.y = (unsigned)rv[2] | ((unsigned)rv[3] << 16); vo.z = (unsigned)rv[4] | ((unsigned)rv[5] << 16); vo.w = (unsigned)rv[6] | ((unsigned)rv[7] << 16);
            *(LAS u32x4*)(vT + vcol * 80 + vg * 16) = vo;
        }
        if (cc + 1 < 72) load_raw(cc + 1);
        __syncthreads();
        if (w < 3) {
            const int tt = (w == 0) ? 0 : 1, st = (w == 2) ? 1 : 0;
            f32x4 a = (f32x4){0.f, 0.f, 0.f, 0.f};
#pragma unroll
            for (int ks = 0; ks < DK / 32; ++ks) {
                const bf16x8 A = *(const LAS bf16x8*)(qt + (tt * 16 + fr) * QS + (ks * 32 + fq * 8) * 2);
                const bf16x8 B = *(const LAS bf16x8*)(kt_ + (st * 16 + fr) * QS + (ks * 32 + fq * 8) * 2);
                a = MFMA16(A, B, a);
            }
#pragma unroll
            for (int j = 0; j < 4; ++j) { const int t = tt * 16 + fq * 4 + j, s = st * 16 + fr; *(LAS bf16_t*)(att + t * 80 + s * 2) = f2bf1(s <= t ? a[j] : 0.f); }
        } else if (w == 3) {
#pragma unroll
            for (int j = 0; j < 4; ++j) { const int t = fq * 4 + j, s = 16 + fr; *(LAS bf16_t*)(att + t * 80 + s * 2) = (bf16_t)0; }
        }
        __syncthreads();
        {
            const int vs = w * 16;
            const bf16x8 Bv = *(const LAS bf16x8*)(vT + (vs + fr) * 80 + fq * 16);
            bf16x8 Sb[NKT / 2];
#pragma unroll
            for (int kp = 0; kp < NKT / 2; ++kp) {
                const f32x4 e0 = *(const LAS f32x4*)(evec + (2 * kp) * 16 + fq * 4), e1 = *(const LAS f32x4*)(evec + (2 * kp + 1) * 16 + fq * 4);
                const f32x4 s0 = S[2 * kp] * e0, s1 = S[2 * kp + 1] * e1;
                u32x4 sw; sw.x = pk2(s0.x, s0.y); sw.y = pk2(s0.z, s0.w); sw.z = pk2(s1.x, s1.y); sw.w = pk2(s1.z, s1.w);
                Sb[kp] = __builtin_bit_cast(bf16x8, sw);
            }
#pragma unroll
            for (int tt = 0; tt < 2; ++tt) {
                f32x4 o = (f32x4){0.f, 0.f, 0.f, 0.f};
#pragma unroll
                for (int kp = 0; kp < NKT / 2; ++kp) {
                    const u32x2 lo = *(const LAS u32x2*)(qt + (tt * 16 + fr) * QS + ((2 * kp) * 16 + fq * 4) * 2);
                    const u32x2 hi = *(const LAS u32x2*)(qt + (tt * 16 + fr) * QS + ((2 * kp + 1) * 16 + fq * 4) * 2);
                    u32x4 aw; aw.x = lo.x; aw.y = lo.y; aw.z = hi.x; aw.w = hi.y;
                    o = MFMA16(__builtin_bit_cast(bf16x8, aw), Sb[kp], o);
                }
                const bf16x8 A2 = *(const LAS bf16x8*)(att + (tt * 16 + fr) * 80 + fq * 16);
                o = MFMA16(A2, Bv, o);
#pragma unroll
                for (int j = 0; j < 4; ++j) { const int row = rowof(cc, tt * 16 + fq * 4 + j); odst[(size_t)row * 512 + h * 128 + vs + fr] = f2bf1(o[j]); }
            }
#pragma unroll
            for (int k2 = 0; k2 < NKT; ++k2) {
                const f32x4 d = *(const LAS f32x4*)(dvec + k2 * 16 + fq * 4);
                S[k2] = S[k2] * d;
                const bf16x8 A3 = *(const LAS bf16x8*)(khT + (k2 * 16 + fr) * 80 + fq * 16);
                S[k2] = MFMA16(A3, Bv, S[k2]);
            }
        }
    }
    __syncthreads();
}

__device__ __forceinline__ void mixer(PPtr p, int l, int g, LAS unsigned char* lds, unsigned long long* tscan = nullptr) {
    const int tid = ltid(), w = tid >> 6, lane = tid & 63;
    LAS float* biasL = (LAS float*)(lds + BIAS_OFF);
    for (int i = tid; i < 8 * 465; i += 512) biasL[i] = p->b_rel_bias[(size_t)l * 8 * 465 + i] * LOG2E;
    __syncthreads();
    const int GB = p->GB, NSC = GB * 8, NS = GB * 16;
    const unsigned long long ts0 = tscan ? __builtin_amdgcn_s_memrealtime() : 0ull;
    for (int st = blockIdx.x; st < NS; st += gridDim.x) {
        if (st < NSC) { scan_task<128, true>(p, l, st >> 3, (st >> 1) & 3, st & 1, lds); }
        else { const int s2 = st - NSC; scan_task<64, false>(p, l, s2 >> 3, (s2 >> 1) & 3, s2 & 1, lds); }
    }
    if (tscan) *tscan += __builtin_amdgcn_s_memrealtime() - ts0;
    unsigned* ctr = (unsigned*)p->ws + (l * 16 + g);
    const int NB0 = GB * 32, NB1 = GB * 32, NB2 = (l < DEPTH - 1) ? GB * 4 : 0, NB3 = NB2, NBT = NB0 + NB1 + NB2 + NB3;
    LAS int* tw = (LAS int*)(lds + CTRL_OFF);
    for (;;) {
        if (tid == 0) *tw = (int)atomicAdd(ctr, 1u);
        __syncthreads();
        const int bt = *tw;
        __syncthreads();
        if (bt >= NBT) break;
        int kind, idx;
        if (bt < NB0) { kind = 0; idx = bt * 8 + w; }
        else if (bt < NB0 + NB1) { kind = 1; idx = (bt - NB0) * 8 + w; }
        else if (bt < NB0 + NB1 + NB2) { kind = 2; idx = (bt - NB0 - NB1) * 8 + w; }
        else { kind = 3; idx = (bt - NB0 - NB1 - NB2) * 8 + w; }
        attn_wave(p, l, kind, idx, lane, biasL);
    }
}

__device__ __forceinline__ void postpass(PPtr p, int l, int nrows) {
    const int lane = ltid() & 63, gw = blockIdx.x * 8 + (ltid() >> 6), NGW = gridDim.x * 8, MG = p->MG;
    const bf16_t* Z = (const bf16_t*)(p->ws + p->o_z);
    for (int it = gw; it < nrows * 2; it += NGW) {
        const int row = it >> 1, br = it & 1;
        bf16_t* yf = (bf16_t*)(p->ws + p->o_y4) + (size_t)(2 + br) * MG * 512 + (size_t)row * 512 + lane * 8;
        const bf16_t* yb = (const bf16_t*)(p->ws + p->o_ob) + (size_t)br * MG * 512 + (size_t)row * 512 + lane * 8;
        const u32x4 a = *(const u32x4*)yf, b = *(const u32x4*)yb;
        const u32x4 gt = *(const u32x4*)(Z + (size_t)row * ZW + (br ? ZD_G : ZC_G) + lane * 8);
        const float* gain = (br ? p->d_norm : p->c_norm) + l * 128 + (lane & 15) * 8;
        float o[8], gv[8];
        o[0] = lo16(a.x) + lo16(b.x); o[1] = hi16(a.x) + hi16(b.x); o[2] = lo16(a.y) + lo16(b.y); o[3] = hi16(a.y) + hi16(b.y);
        o[4] = lo16(a.z) + lo16(b.z); o[5] = hi16(a.z) + hi16(b.z); o[6] = lo16(a.w) + lo16(b.w); o[7] = hi16(a.w) + hi16(b.w);
        gv[0] = lo16(gt.x); gv[1] = hi16(gt.x); gv[2] = lo16(gt.y); gv[3] = hi16(gt.y); gv[4] = lo16(gt.z); gv[5] = hi16(gt.z); gv[6] = lo16(gt.w); gv[7] = hi16(gt.w);
        float ss = 0.f;
#pragma unroll
        for (int e = 0; e < 8; ++e) ss += o[e] * o[e];
        ss = row16_sum(ss);
        const float rs = rsqrtf(ss * (1.0f / 128.0f) + EPS);
        const f32x4 g0 = *(const f32x4*)gain, g1 = *(const f32x4*)(gain + 4);
        float y[8];
#pragma unroll
        for (int e = 0; e < 8; ++e) { const float gn = (e < 4) ? g0[e & 3] : g1[e & 3]; y[e] = o[e] * rs * gn * (gv[e] * sigm(gv[e])); }
        u32x4 wv; wv.x = pk2(y[0], y[1]); wv.y = pk2(y[2], y[3]); wv.z = pk2(y[4], y[5]); wv.w = pk2(y[6], y[7]);
        *(u32x4*)yf = wv;
    }
}

#define NOINL __device__ __forceinline__
NOINL void ph_prologue(PPtr pc, LAS unsigned char* lds) { PPtr p = pc; asm volatile("" : "+s"(p)); prologue(p, lds); }
NOINL void ph_rowpass(PPtr pc, int l, int g, int mode, int nrows, int conv_l, LAS unsigned char* lds) { PPtr p = pc; asm volatile("" : "+s"(p)); rowpass(p, l, g, mode, nrows); if (conv_l >= 0) convert_weights(p, conv_l, lds); }
NOINL void ph_inproj(PPtr pc, LAS unsigned char* lds) {
    PPtr p = pc; asm volatile("" : "+s"(p)); const int G = (int)gridDim.x, c = (int)blockIdx.x;
    pg8::Gemm gm{(const bf16_t*)(p->ws + p->o_h), (const bf16_t*)(p->ws + p->o_win), p->MG, ZW, 1024, 1024}; pg8::StaticOrder S; S.init(p->MG, ZW, G, c);
    EpiInproj E{(bf16_t*)(p->ws + p->o_z), (bf16_t*)(p->ws + p->o_vta), (bf16_t*)(p->ws + p->o_vtb), (const float*)(p->ws + p->o_rope), p->GB};
    pg8::gemm_phase<EpiInproj, pg8::StaticOrder>(lds, gm, S, E, nullptr);
}
NOINL void ph_mixer(PPtr pc, int l, int g, LAS unsigned char* lds, unsigned long long* tscan = nullptr) { PPtr p = pc; asm volatile("" : "+s"(p)); mixer(p, l, g, lds, tscan); }
NOINL void ph_post(PPtr pc, int l, int nrows) { PPtr p = pc; asm volatile("" : "+s"(p)); postpass(p, l, nrows); }
NOINL void ph_branch(PPtr pc, int Mr, LAS unsigned char* lds) {
    PPtr p = pc; asm volatile("" : "+s"(p)); const int G = (int)gridDim.x, c = (int)blockIdx.x;
    const int LATR = p->GB * 2048, nMfull = p->MG / 256;
    pg8::Gemm gm{(const bf16_t*)(p->ws + p->o_y4), (const bf16_t*)(p->ws + p->o_wb), Mr, 1024, 512, 512};
    { BranchOrder S{LATR / 256, nMfull, G, c};
      EpiBranch E{(const bf16_t*)(p->ws + p->o_z), (bf16_t*)(p->ws + p->o_h), nMfull};
      pg8::gemm_phase<EpiBranch, BranchOrder>(lds, gm, S, E, nullptr); }
    if (Mr > LATR) {
        CtxBranchOrder S{nMfull, LATR / 256, (Mr - LATR) / 256 * 4, G, c};
        EpiBranchCtx E{(const bf16_t*)(p->ws + p->o_z), (bf16_t*)(p->ws + p->o_ob), nMfull, LATR / 256};
        pg8::gemm_phase<EpiBranchCtx, CtxBranchOrder>(lds, gm, S, E, nullptr);
    }
}
NOINL void ph_gemm_f32(PPtr pc, int which, int Mr, LAS unsigned char* lds) {
    PPtr p = pc; asm volatile("" : "+s"(p)); const int G = (int)gridDim.x, c = (int)blockIdx.x;
    const int LATR = p->GB * 2048;
    const bf16_t* hid = (const bf16_t*)(p->ws + p->o_z + (size_t)p->MG * 1024 * 4);
    { const bf16_t* A = which ? hid : (const bf16_t*)(p->ws + p->o_h);
      const bf16_t* Bt = which ? (const bf16_t*)(p->ws + p->o_w2) : (const bf16_t*)(p->ws + p->o_wo);
      const int K = which ? 4096 : 1024;
      pg8::Gemm gm{A, Bt, LATR, 1024, K, K}; pg8::StaticOrder S; S.init(LATR, 1024, G, c);
      pg8::EpiF32 E{(float*)(p->ws + p->o_z), 1024, nullptr};
      pg8::gemm_phase<pg8::EpiF32, pg8::StaticOrder>(lds, gm, S, E, nullptr); }
    if (Mr > LATR) {
        const bf16_t* A = which ? hid : ((const bf16_t*)(p->ws + p->o_ob) - (size_t)LATR * 4096);
        const bf16_t* Bt = which ? (const bf16_t*)(p->ws + p->o_w2) : (const bf16_t*)(p->ws + p->o_wo4);
        pg8::Gemm gm{A, Bt, Mr, 1024, 4096, 512};
        SplitOrder S{LATR / 256, (Mr - LATR) / 256, 8, 512, G, c};
        EpiSlab E{(float*)(p->ws + p->o_z + (size_t)p->MG * 12288), LATR / 256, Mr - LATR, 512};
        pg8::gemm_phase<EpiSlab, SplitOrder>(lds, gm, S, E, nullptr);
    }
}
NOINL void ph_ffn1(PPtr pc, int Mr, LAS unsigned char* lds) {
    PPtr p = pc; asm volatile("" : "+s"(p)); const int G = (int)gridDim.x, c = (int)blockIdx.x;
    pg8::Gemm gm{(const bf16_t*)(p->ws + p->o_h), (const bf16_t*)(p->ws + p->o_w1), Mr, 4096, 1024, 1024}; pg8::StaticOrder S; S.init(Mr, 4096, G, c);
    EpiRelu2 E{(bf16_t*)(p->ws + p->o_z + (size_t)p->MG * 1024 * 4), 4096};
    pg8::gemm_phase<EpiRelu2, pg8::StaticOrder>(lds, gm, S, E, nullptr);
}

#define XB_SETUP() volatile LAS unsigned* xb_st = (volatile LAS unsigned*)(lds + CTRL_OFF + 64); unsigned* xb_bar = (unsigned*)(pc->ws + 4096); { XcdBarrier xb0 = xcd_barrier_post(xb_bar, xb_st); (void)xb0; }
#define GSYNC() { XcdBarrier xb_; xb_.bar = (unsigned*)(pc->ws + 4096); xb_.x = xb_xcc_id(); xb_.st = (volatile LAS unsigned*)(lds + CTRL_OFF + 64); xcd_barrier(xb_); }
#ifdef PROBE_MASK
__global__ void __launch_bounds__(512) hybrid_fwd(Params pk) {
    extern __shared__ __attribute__((aligned(16))) unsigned char smem[];
    LAS unsigned char* lds = (LAS unsigned char*)smem;
    cg::grid_group grid = cg::this_grid();
    PPtr pc = (PPtr)__builtin_amdgcn_kernarg_segment_ptr();
    const int GB = pc->GB, MG = pc->MG, NGRP = pc->NGRP, LATR = GB * 2048;
    unsigned long long tacc = 0, t0_ = __builtin_amdgcn_s_memrealtime();
#define PT(kind) { const unsigned long long t1_ = __builtin_amdgcn_s_memrealtime(); if ((PROBE_MASK >> (kind)) & 1) tacc += t1_ - t0_; t0_ = t1_; }
    ph_prologue(pc, lds);
    grid.sync();
    XB_SETUP(); PT(0)
    for (int l = 0; l < DEPTH; ++l) {
        const int Mr = (l < DEPTH - 1) ? MG : LATR;
        for (int g = 0; g < NGRP; ++g) {
            ph_rowpass(pc, l, g, 1, MG, -1, lds);
            GSYNC(); PT(1)
            ph_inproj(pc, lds);
            GSYNC(); PT(2)
            { unsigned long long tsc = 0; ph_mixer(pc, l, g, lds, &tsc); if ((PROBE_MASK >> 11) & 1) tacc += tsc; }
            GSYNC(); PT(3)
            ph_post(pc, l, Mr);
            GSYNC(); PT(4)
            ph_branch(pc, Mr, lds);
            GSYNC(); PT(5)
            ph_gemm_f32(pc, 0, Mr, lds);
            GSYNC(); PT(6)
            ph_rowpass(pc, l, g, 2, Mr, -1, lds);
            GSYNC(); PT(7)
            ph_ffn1(pc, Mr, lds);
            GSYNC(); PT(8)
            ph_gemm_f32(pc, 1, Mr, lds);
            GSYNC(); PT(9)
            ph_rowpass(pc, l, g, 3, Mr, (g == NGRP - 1 && l + 1 < DEPTH) ? l + 1 : -1, lds);
            GSYNC(); PT(10)
        }
    }
    if (blockIdx.x == 0) { const unsigned M = (unsigned)(tacc / 100ull); float* o = pc->out; for (unsigned i2 = threadIdx.x; i2 < M; i2 += 512) o[i2] += 0.125f; }
}

#else
__global__ void __launch_bounds__(512) hybrid_fwd(Params pk) {
    extern __shared__ __attribute__((aligned(16))) unsigned char smem[];
    LAS unsigned char* lds = (LAS unsigned char*)smem;
    cg::grid_group grid = cg::this_grid();
    PPtr pc = (PPtr)__builtin_amdgcn_kernarg_segment_ptr();
    const int GB = pc->GB, MG = pc->MG, NGRP = pc->NGRP, LATR = GB * 2048;
    ph_prologue(pc, lds);
    grid.sync();
    XB_SETUP();
    for (int l = 0; l < DEPTH; ++l) {
        const int Mr = (l < DEPTH - 1) ? MG : LATR;
        for (int g = 0; g < NGRP; ++g) {
            ph_rowpass(pc, l, g, 1, MG, -1, lds);
            GSYNC();
            ph_inproj(pc, lds);
            GSYNC();
            ph_mixer(pc, l, g, lds);
            GSYNC();
            ph_post(pc, l, Mr);
            GSYNC();
            ph_branch(pc, Mr, lds);
            GSYNC();
            ph_gemm_f32(pc, 0, Mr, lds);
            GSYNC();
            ph_rowpass(pc, l, g, 2, Mr, -1, lds);
            GSYNC();
            ph_ffn1(pc, Mr, lds);
            GSYNC();
            ph_gemm_f32(pc, 1, Mr, lds);
            GSYNC();
            ph_rowpass(pc, l, g, 3, Mr, (g == NGRP - 1 && l + 1 < DEPTH) ? l + 1 : -1, lds);
            GSYNC();
        }
    }
}

#endif
extern "C" void kernel_launch(void* const* d_in, const int* in_sizes, int n_in, void* d_out, int out_size, void* d_ws, size_t ws_size, hipStream_t stream) {
    static int grid_blocks = 0;
    if (grid_blocks == 0) {
        int dev = 0, cus = 0, per_cu = 0;
        hipGetDevice(&dev);
        hipDeviceGetAttribute(&cus, hipDeviceAttributeMultiprocessorCount, dev);
        if (hipFuncSetAttribute((const void*)hybrid_fwd, hipFuncAttributeMaxDynamicSharedMemorySize, LDS_BYTES) != hipSuccess) fprintf(stderr, "hipFuncSetAttribute failed\n");
        if (hipOccupancyMaxActiveBlocksPerMultiprocessor(&per_cu, (const void*)hybrid_fwd, 512, LDS_BYTES) != hipSuccess || per_cu < 1) { fprintf(stderr, "occupancy query: %d\n", per_cu); per_cu = 1; }
        (void)hipGetLastError();
        grid_blocks = cus * 1;
        if (grid_blocks <= 0) grid_blocks = 256;
    }
    Params p{};
    const float* const* in = (const float* const*)d_in;
    p.x = in[0]; p.c = in[1]; p.ctx = in[2]; p.c_ctx = in[3]; p.w_mod = in[4]; p.b_mod = in[5]; p.norm_gains = in[6]; p.w_in = in[7]; p.a_sink = in[8]; p.b_rel_bias = in[9];
    p.c_lb = in[10]; p.c_norm = in[11]; p.d_gate_up = in[12]; p.d_gate_bias = in[13]; p.d_norm = in[14]; p.w_branch = in[15]; p.w_out = in[16]; p.w_ff1 = in[17]; p.w_ff2 = in[18];
    p.out = (float*)d_out; p.ws = (unsigned char*)d_ws;
    auto al = [](unsigned long long v) { return (v + 255ull) & ~255ull; };
    unsigned long long off = 32768;
    p.o_mod = off; off = al(off + 4ull * 17 * 6144 * 4);
    p.o_lb = off; off = al(off + 4ull * 512 * 4);
    p.o_rope = off; off = al(off + 2048ull * 4);
    p.o_xc = off; off = al(off + 4096ull * 1024 * 4);
    p.o_win = off; off = al(off + (unsigned long long)ZW * 1024 * 2);
    p.o_wb = off; off = al(off + 4096ull * 512 * 2);
    p.o_wo = off; off = al(off + 1024ull * 1024 * 2);
    p.o_w1 = off; off = al(off + 4096ull * 1024 * 2);
    p.o_w2 = off; off = al(off + 1024ull * 4096 * 2);
    p.o_wo4 = off; off = al(off + 1024ull * 4096 * 2);
    const unsigned long long fixed = off;
    int GB = 16;
    for (; GB > 1; GB >>= 1) {
        const unsigned long long MGt = (unsigned long long)GB * 2304;
        const unsigned long long need = fixed + MGt * (2048ull + (unsigned long long)ZW * 2 + 4096ull + 2048ull) + (unsigned long long)GB * 10 * 64 * VTS * 2 + 8 * 256;
        if (need <= (unsigned long long)ws_size) break;
    }
    p.GB = GB; p.NGRP = 16 / GB; p.MG = GB * 2304;
    const unsigned long long MGu = (unsigned long long)p.MG;
    p.o_h = off; off = al(off + MGu * 1024 * 2);
    p.o_z = off; off = al(off + MGu * ZW * 2);
    p.o_y4 = off; off = al(off + MGu * 2048 * 2);
    p.o_ob = off; off = al(off + MGu * 1024 * 2);
    p.o_vta = off; off = al(off + (unsigned long long)GB * 2 * 64 * VTS * 2);
    p.o_vtb = off; off = al(off + (unsigned long long)GB * 8 * 64 * VTS * 2);
    hipMemsetAsync(d_ws, 0, 32768, stream);
    void* args[] = {&p};
    hipError_t e = hipLaunchCooperativeKernel((const void*)hybrid_fwd, dim3(grid_blocks), dim3(512), args, LDS_BYTES, stream);
    if (e != hipSuccess) fprintf(stderr, "cooperative launch failed: %s (grid %d)\n", hipGetErrorString(e), grid_blocks);
}
```

```cpp
#include <hip/hip_runtime.h>
#include <hip/hip_cooperative_groups.h>
#include <cstdio>
namespace cg = cooperative_groups;
__device__ __forceinline__ int ltid() { int t = (int)threadIdx.x; asm volatile("" : "+v"(t)); return t; }
#define LAS __attribute__((address_space(3)))
namespace pg8 {
#define PG8_LAS __attribute__((address_space(3)))
typedef unsigned short bf16_t;
typedef short bf16x8 __attribute__((ext_vector_type(8)));
typedef float f32x4 __attribute__((ext_vector_type(4)));
typedef unsigned u32x4 __attribute__((ext_vector_type(4)));
constexpr int BM = 256, BK = 64, HALF = 128, HTB = HALF * BK * 2  , STAGE_BYTES = 8 * HTB, NXCD = 8, WGM = 8;

__host__ __device__ __forceinline__ int lds_byte(int r, int c) { const int st = (r >> 4) * 2 + (c >> 5), rr = r & 15, cc = c & 31, ob = rr * 64 + cc * 2; return st * 1024 + (ob ^ (((ob >> 9) & 1) << 5)); }
__host__ __device__ __forceinline__ void stage_rc(int b, int& R, int& C) { const int st = b / 1024, sb = b % 1024, swz = sb ^ (((sb >> 9) & 1) << 5); R = (st >> 1) * 16 + swz / 64; C = (st & 1) * 32 + (swz % 64) / 2; }
__host__ __device__ __forceinline__ int perm32(int rho) { const int n = rho >> 4, i = rho & 15; return 8 * (i >> 2) + 4 * n + (i & 3); }

struct Unit { int pm, pn, ko; };
struct Gemm { const bf16_t* A; const bf16_t* Bt; int M, N, K, Kl; };

struct StaticOrder {
    int nM, nN, nwg, G, c;
    __host__ __device__ void init(int M, int N, int G_, int c_) { nM = M / BM; nN = N / BM; nwg = nM * nN; G = G_; c = c_; }
    __host__ __device__ bool next(int i, Unit& u) const {
        const long L = (long)i * G + c; if (L >= nwg) return false;
        int wgid = (int)L; { const int q = nwg / NXCD, r = nwg % NXCD, xcd = wgid % NXCD, off = wgid / NXCD; wgid = (xcd < r ? xcd * (q + 1) : r * (q + 1) + (xcd - r) * q) + off; }
        const int nig = WGM * nN, gid = wgid / nig, fm = gid * WGM, gsz = (nM - fm) < WGM ? (nM - fm) : WGM;
        u.pm = fm + ((wgid % nig) % gsz); u.pn = (wgid % nig) / gsz; u.ko = 0; return true;
    }
    __device__ __forceinline__ void a_ready(const Unit&) const {}
    __device__ __forceinline__ void done(const Unit&) const {}
};
__device__ __forceinline__ unsigned cvt_pk_bf16(float lo, float hi) { unsigned r; asm volatile("v_cvt_pk_bf16_f32 %0, %1, %2" : "=v"(r) : "v"(lo), "v"(hi)); return r; }
struct EpiF32 {
    static constexpr bool PERM = false, AFTER_DRAIN = false;
    float* C; int ldc; const float* bias;
    __device__ __forceinline__ void operator()(const f32x4 (&acc)[2][2][4][2], const Unit& u, int wr, int wc, int fr, int fq) const {
        const int row0 = u.pm * BM + wr * 64 + fr, col0 = u.pn * BM + wc * 32 + 4 * fq;
        f32x4 bv[2][2];
#pragma unroll
        for (int bj = 0; bj < 2; ++bj)
#pragma unroll
            for (int n = 0; n < 2; ++n) bv[bj][n] = bias ? *(const f32x4*)(bias + col0 + bj * HALF + n * 16) : (f32x4){0.f, 0.f, 0.f, 0.f};
#pragma unroll
        for (int ai = 0; ai < 2; ++ai)
#pragma unroll
            for (int m = 0; m < 4; ++m) { float* rowp = C + (size_t)(row0 + ai * HALF + m * 16) * ldc + col0;
#pragma unroll
                for (int bj = 0; bj < 2; ++bj)
#pragma unroll
                    for (int n = 0; n < 2; ++n) *(f32x4*)(rowp + bj * HALF + n * 16) = acc[ai][bj][m][n] + bv[bj][n]; }
    }
};
template <class Epi, class Sched, bool STAMP = false>
__device__ __forceinline__ void gemm_phase(PG8_LAS unsigned char* lds, const Gemm g, const Sched& S, const Epi& E, unsigned long long* stamps) {
    const int tid = ltid(), wid = __builtin_amdgcn_readfirstlane(tid >> 6), lane = tid & 63, wr = wid >> 2, wc = wid & 3, fr = lane & 15, fq = lane >> 4;
    const int K = g.K, nt = g.Kl / BK;
    int ts_lo = 0, ts_hi = 0, nts = 0; const unsigned long long rt_entry = STAMP ? (unsigned long long)wall_clock64() : 0ull;
#define PG8_STAMP() do { if (STAMP && wid == 0 && nts < 64) { const unsigned long long _c = (unsigned long long)clock64(); \
        ts_lo = (lane == nts) ? (int)(unsigned)_c : ts_lo; ts_hi = (lane == nts) ? (int)(unsigned)(_c >> 32) : ts_hi; ++nts; } } while (0)
    PG8_STAMP();
    unsigned voffA[2], voffB[2];
#pragma unroll
    for (int i = 0; i < 2; ++i) { int R, C; stage_rc(tid * 16 + i * 8192, R, C); const int Rb = Epi::PERM ? ((R & ~31) + perm32(R & 31)) : R;
        voffA[i] = (unsigned)(R * K + C) * 2u; voffB[i] = (unsigned)(Rb * K + C) * 2u; }
    const size_t kstep = (size_t)(BK * 2);
    const size_t hstep = (size_t)HALF * K * 2;
    const size_t tstep = 2 * hstep;
    const unsigned ldsw = (unsigned)wid * 1024u;
    const int aoff = lds_byte(wr * 64 + fr, fq * 8), boff = lds_byte(wc * 32 + fr, fq * 8);
#define PG8_SA(b, h) (((b) * 2 + (h)) * HTB)
#define PG8_SB(b, h) ((4 + (b) * 2 + (h)) * HTB)
#define PG8_STAGE(bufoff, gbase, voff) do { _Pragma("unroll") for (int _i = 0; _i < 2; ++_i) \
        __builtin_amdgcn_global_load_lds((const unsigned*)((const char*)(gbase) + (voff)[_i]), (PG8_LAS unsigned*)(lds + (bufoff) + ldsw + _i * 8192), 16, 0, 0); } while (0)
#define PG8_LDA(dst, b, h) do { _Pragma("unroll") for (int m = 0; m < 4; ++m) _Pragma("unroll") for (int k = 0; k < 2; ++k) dst[m][k] = *(const PG8_LAS bf16x8*)(lds + PG8_SA(b, h) + aoff + m * 2048 + k * 1024); } while (0)
#define PG8_LDB(dst, b, h) do { _Pragma("unroll") for (int n = 0; n < 2; ++n) _Pragma("unroll") for (int k = 0; k < 2; ++k) dst[n][k] = *(const PG8_LAS bf16x8*)(lds + PG8_SB(b, h) + boff + n * 2048 + k * 1024); } while (0)
#define PG8_MMA(ai, bj, At, Bt) do { __builtin_amdgcn_s_setprio(1); _Pragma("unroll") for (int m = 0; m < 4; ++m) _Pragma("unroll") for (int n = 0; n < 2; ++n) _Pragma("unroll") for (int k = 0; k < 2; ++k) \
        acc[ai][bj][m][n] = __builtin_amdgcn_mfma_f32_16x16x32_bf16(Bt[n][k], At[m][k], acc[ai][bj][m][n], 0, 0, 0); __builtin_amdgcn_s_setprio(0); } while (0)
#define PG8_WAIT_V(n) asm volatile("s_waitcnt vmcnt(" #n ")" ::: "memory")
#define PG8_WAIT_L(n) asm volatile("s_waitcnt lgkmcnt(" #n ")" ::: "memory")
#define PG8_BAR __builtin_amdgcn_s_barrier()
#define PG8_SCHED __builtin_amdgcn_sched_barrier(0)
    Unit cur, nxt; int ui = 0;
    if (!S.next(0, cur)) return;
    f32x4 acc[2][2][4][2];
#pragma unroll
    for (int a = 0; a < 2; ++a)
#pragma unroll
        for (int b = 0; b < 2; ++b)
#pragma unroll
            for (int m = 0; m < 4; ++m)
#pragma unroll
                for (int n = 0; n < 2; ++n) acc[a][b][m][n] = (f32x4){0.f, 0.f, 0.f, 0.f};
    bf16x8 At[4][2], B0[2][2], B1[2][2];
    const char* cA = (const char*)g.A + (size_t)cur.pm * tstep + (size_t)cur.ko * 2; const char* cB = (const char*)g.Bt + (size_t)cur.pn * tstep + (size_t)cur.ko * 2;
    S.a_ready(cur);
    PG8_STAGE(PG8_SB(0, 0), cB, voffB); PG8_STAGE(PG8_SA(0, 0), cA, voffA); PG8_STAGE(PG8_SB(0, 1), cB + hstep, voffB); PG8_STAGE(PG8_SA(0, 1), cA + hstep, voffA);
    if (wr == 1) PG8_BAR;
    PG8_WAIT_V(4); PG8_BAR;
    PG8_STAGE(PG8_SB(1, 0), cB + kstep, voffB); PG8_STAGE(PG8_SA(1, 0), cA + kstep, voffA); PG8_STAGE(PG8_SB(1, 1), cB + hstep + kstep, voffB);
    PG8_WAIT_V(6); PG8_BAR;
    PG8_STAMP();
    for (;;) {
        const bool has_next = S.next(ui + 1, nxt);
        const char* nA = has_next ? (const char*)g.A + (size_t)nxt.pm * tstep + (size_t)nxt.ko * 2 : cA; const char* nB = has_next ? (const char*)g.Bt + (size_t)nxt.pn * tstep + (size_t)nxt.ko * 2 : cB;
        for (int t = 0; t < nt; t += 2) {
            const bool last = (t == nt - 2);
            const char* a1 = cA + (size_t)(t + 1) * kstep;
            const char* a2 = last ? nA : cA + (size_t)(t + 2) * kstep; const char* b2 = last ? nB : cB + (size_t)(t + 2) * kstep;
            const char* a3 = a2 + kstep; const char* b3 = b2 + kstep;
            if (last && has_next) S.a_ready(nxt);
            PG8_LDB(B0, 0, 0); PG8_SCHED; PG8_LDA(At, 0, 0); PG8_STAGE(PG8_SA(1, 1), a1 + hstep, voffA);
            PG8_WAIT_L(8); PG8_BAR; PG8_WAIT_L(0); PG8_MMA(0, 0, At, B0); PG8_BAR; PG8_SCHED;
            PG8_LDB(B1, 0, 1); PG8_STAGE(PG8_SB(0, 0), b2, voffB);
            PG8_BAR; PG8_WAIT_L(0); PG8_MMA(0, 1, At, B1); PG8_BAR;
            PG8_LDA(At, 0, 1); PG8_STAGE(PG8_SA(0, 0), a2, voffA);
            PG8_BAR; PG8_WAIT_L(0); PG8_MMA(1, 0, At, B0); PG8_BAR; PG8_SCHED;
            PG8_STAGE(PG8_SB(0, 1), b2 + hstep, voffB);
            PG8_WAIT_V(6); PG8_BAR; PG8_MMA(1, 1, At, B1); PG8_BAR;
            PG8_LDB(B0, 1, 0); PG8_SCHED; PG8_LDA(At, 1, 0); PG8_STAGE(PG8_SA(0, 1), a2 + hstep, voffA);
            PG8_WAIT_L(8); PG8_BAR; PG8_WAIT_L(0); PG8_MMA(0, 0, At, B0); PG8_BAR; PG8_SCHED;
            PG8_LDB(B1, 1, 1); PG8_STAGE(PG8_SB(1, 0), b3, voffB);
            PG8_BAR; PG8_WAIT_L(0); PG8_MMA(0, 1, At, B1); PG8_BAR;
            PG8_LDA(At, 1, 1); PG8_STAGE(PG8_SA(1, 0), a3, voffA);
            PG8_BAR; PG8_WAIT_L(0); PG8_MMA(1, 0, At, B0); PG8_BAR; PG8_SCHED;
            PG8_STAGE(PG8_SB(1, 1), b3 + hstep, voffB);
            PG8_WAIT_V(6); PG8_BAR; PG8_MMA(1, 1, At, B1); PG8_BAR;
        }
        PG8_STAMP();
        if constexpr (!Epi::AFTER_DRAIN) { E(acc, cur, wr, wc, fr, fq); S.done(cur); }
        PG8_STAMP();
        if (!has_next) break;
#pragma unroll
        for (int a = 0; a < 2; ++a)
#pragma unroll
            for (int b = 0; b < 2; ++b)
#pragma unroll
                for (int m = 0; m < 4; ++m)
#pragma unroll
                    for (int n = 0; n < 2; ++n) acc[a][b][m][n] = (f32x4){0.f, 0.f, 0.f, 0.f};
        cur = nxt; cA = nA; cB = nB; ++ui;
    }
    PG8_WAIT_V(0);
    if (wr == 0) PG8_BAR;
    PG8_BAR;
    if constexpr (Epi::AFTER_DRAIN) { E.fused(acc, cur, wr, wc, fr, fq, lds, wid, lane); S.done(cur); }
    PG8_STAMP();
    if (STAMP && wid == 0) { stamps[lane] = lane < nts ? (((unsigned long long)(unsigned)ts_hi << 32) | (unsigned)ts_lo) : 0ull;
        if (lane == 62) stamps[62] = rt_entry; if (lane == 63) stamps[63] = (unsigned long long)wall_clock64(); }
#undef PG8_STAMP
#undef PG8_SA
#undef PG8_SB
#undef PG8_STAGE
#undef PG8_LDA
#undef PG8_LDB
#undef PG8_MMA
#undef PG8_WAIT_V
#undef PG8_WAIT_L
#undef PG8_BAR
#undef PG8_SCHED
}
}
#define XB_TMO      128
#define XB_XCNT(j)  (256  + 64 * (j))
#define XB_XSUB(j)  (1280 + 64 * (j))
#define XB_XGEN(j)  (2304 + 64 * (j))
#define XB_TOP      3328
#define XB_TOPGEN   3392
#define XCD_BAR_WORDS 3456
#define XB_SPIN_CAP (1u << 18)

__device__ __forceinline__ unsigned xb_ld(unsigned* p)              { return __hip_atomic_load(p, __ATOMIC_RELAXED, __HIP_MEMORY_SCOPE_AGENT); }
__device__ __forceinline__ unsigned xb_add(unsigned* p, unsigned v) { return __hip_atomic_fetch_add(p, v, __ATOMIC_RELAXED, __HIP_MEMORY_SCOPE_AGENT); }
__device__ __forceinline__ unsigned xb_xcc_id() { return (unsigned)__builtin_amdgcn_s_getreg((3 << 11) | 20) & 0xFu; }
#define XB_SPIN(cond, bar) do { unsigned _sp = 0; while (cond) { __builtin_amdgcn_s_sleep(1); \
    if ((++_sp & 255u) == 0u) { if (xb_ld(&(bar)[XB_TMO])) break; if (_sp > XB_SPIN_CAP) { atomicAdd(&(bar)[XB_TMO], 1u); break; } } } } while (0)

struct XcdBarrier {
    unsigned* bar; unsigned x;
    volatile LAS unsigned* st;
};

__device__ __forceinline__ XcdBarrier xcd_barrier_post(unsigned* bar, volatile LAS unsigned* st) {
    XcdBarrier b; b.bar = bar; b.x = xb_xcc_id(); b.st = st;
    if (threadIdx.x == 0) (void)xb_add(&bar[XB_XCNT(b.x)], 1u);
    return b;
}
__device__ __forceinline__ void xcd_barrier_complete(unsigned* bar, unsigned x, unsigned& nloc, unsigned& nx) {
    const unsigned G = gridDim.x * gridDim.y * gridDim.z;
    unsigned sum, cnt, mine, sp = 0u;
    for (;;) {
        sum = 0u; cnt = 0u; mine = 0u;
#pragma unroll
        for (unsigned j = 0; j < 16; ++j) { const unsigned c = xb_ld(&bar[XB_XCNT(j)]); sum += c; cnt += (c > 0u) ? 1u : 0u; mine = (j == x) ? c : mine; }
        if (sum == G) break;
        __builtin_amdgcn_s_sleep(1);
        if ((++sp & 255u) == 0u) { if (xb_ld(&bar[XB_TMO])) break; if (sp > XB_SPIN_CAP) { atomicAdd(&bar[XB_TMO], 1u); break; } }
    }
    nloc = mine > 0u ? mine : 1u; nx = cnt > 0u ? cnt : 1u;
}

__device__ __forceinline__ void xcd_barrier(const XcdBarrier& b) {
    asm volatile("s_waitcnt vmcnt(0)" ::: "memory");
    __syncthreads();
    if (threadIdx.x == 0) {
        unsigned* bar = b.bar;
        __builtin_amdgcn_s_waitcnt(0);
        unsigned nloc = b.st[0], nx = b.st[1];
        if (nloc == 0u) { xcd_barrier_complete(bar, b.x, nloc, nx); b.st[0] = nloc; b.st[1] = nx; }
        const unsigned old = xb_add(&bar[XB_XSUB(b.x)], 1u);
        const unsigned gen = old / nloc;
        if (old + 1u == (gen + 1u) * nloc) {
            __builtin_amdgcn_fence(__ATOMIC_RELEASE, "agent");
            asm volatile("s_waitcnt vmcnt(0)" ::: "memory");
            const unsigned og = xb_add(&bar[XB_TOP], 1u);
            const unsigned tg = og / nx;
            if (og + 1u == (tg + 1u) * nx) xb_add(&bar[XB_TOPGEN], 1u);
            else XB_SPIN(xb_ld(&bar[XB_TOPGEN]) == tg, bar);
            __builtin_amdgcn_fence(__ATOMIC_ACQUIRE, "agent");
            xb_add(&bar[XB_XGEN(b.x)], 1u);
            asm volatile("s_waitcnt vmcnt(0)" ::: "memory");
        } else {
            XB_SPIN(xb_ld(&bar[XB_XGEN(b.x)]) == gen, bar);
            __builtin_amdgcn_fence(__ATOMIC_ACQUIRE, "agent");
            asm volatile("s_waitcnt vmcnt(0)" ::: "memory");
        }
    }
    __syncthreads();
}

typedef unsigned short bf16_t;
typedef pg8::bf16x8 bf16x8;
typedef pg8::f32x4 f32x4;
typedef pg8::u32x4 u32x4;
typedef unsigned u32x2 __attribute__((ext_vector_type(2)));

constexpr int DM = 1024, NB = 16, SEQ = 2048, DEPTH = 4, CTXL = 256, DFF = 4096;
constexpr int ZW = 10752;
constexpr int INW = 10528;
constexpr int ZA_Q = 0, ZA_K = 512, ZA_V = 640, ZB_Q = 768, ZB_K = 1280, ZB_V = 1792, ZC_Q = 2304, ZC_FF = 2816, ZC_FB = 3328, ZC_I = 3840, ZC_G = 4352,
              ZD_Q = 4864, ZD_K = 5120, ZD_V = 5376, ZD_GK = 5888, ZD_G = 6016, ZMERGE = 6656;
constexpr int VTS = 2304;
constexpr int LDS_BYTES = 144 * 1024;
constexpr int CTRL_OFF = LDS_BYTES - 256;
constexpr float EPS = 1e-6f;
constexpr float LOG2E = 1.4426950408889634f;
constexpr float QSCALE2 = 0.125f * LOG2E;

struct Params {
    const float *x, *c, *ctx, *c_ctx, *w_mod, *b_mod, *norm_gains, *w_in, *a_sink, *b_rel_bias, *c_lb, *c_norm, *d_gate_up, *d_gate_bias, *d_norm, *w_branch, *w_out, *w_ff1, *w_ff2;
    float* out;
    unsigned char* ws;
    unsigned long long o_mod, o_lb, o_rope, o_xc, o_win, o_wb, o_wo, o_w1, o_w2, o_h, o_z, o_y4, o_ob, o_vta, o_vtb, o_wo4;
    int GB, NGRP, MG, pad0;
};
typedef const Params __attribute__((address_space(4)))* PPtr;

__device__ __forceinline__ float bf2f(unsigned v) { return __uint_as_float(v << 16); }
__device__ __forceinline__ bf16_t f2bf(float f) { unsigned u = __float_as_uint(f); u += 0x7FFFu + ((u >> 16) & 1u); return (bf16_t)(u >> 16); }
typedef __bf16 bf16v2_t __attribute__((ext_vector_type(2)));
typedef float f32v2_t __attribute__((ext_vector_type(2)));
__device__ __forceinline__ unsigned pk2(float lo, float hi) { const f32v2_t v = {lo, hi}; const bf16v2_t b = __builtin_convertvector(v, bf16v2_t); return __builtin_bit_cast(unsigned, b); }
template <int CTRL> __device__ __forceinline__ float dpp(float x) { return __builtin_bit_cast(float, __builtin_amdgcn_mov_dpp(__builtin_bit_cast(int, x), CTRL, 0xf, 0xf, true)); }
constexpr int XOR1 = 0xB1, XOR2 = 0x4E, XOR7 = 0x141, XOR8 = 0x128;
__device__ __forceinline__ float xrow16_max(float x) {
    auto s = __builtin_amdgcn_permlane16_swap(__float_as_uint(x), __float_as_uint(x), false, false);
    x = fmaxf(__uint_as_float(s[0]), __uint_as_float(s[1]));
    auto t = __builtin_amdgcn_permlane32_swap(__float_as_uint(x), __float_as_uint(x), false, false);
    return fmaxf(__uint_as_float(t[0]), __uint_as_float(t[1]));
}
__device__ __forceinline__ float xrow16_sum(float x) {
    auto s = __builtin_amdgcn_permlane16_swap(__float_as_uint(x), __float_as_uint(x), false, false);
    x = __uint_as_float(s[0]) + __uint_as_float(s[1]);
    auto t = __builtin_amdgcn_permlane32_swap(__float_as_uint(x), __float_as_uint(x), false, false);
    return __uint_as_float(t[0]) + __uint_as_float(t[1]);
}
__device__ __forceinline__ float row16_sum(float v) {
    v += dpp<XOR1>(v); v += dpp<XOR2>(v); v += dpp<XOR7>(v); v += dpp<XOR8>(v);
    return v;
}
__device__ __forceinline__ float wave_sum(float v) { return xrow16_sum(row16_sum(v)); }
__device__ __forceinline__ float lo16(unsigned w) { return __uint_as_float(w << 16); }
__device__ __forceinline__ float hi16(unsigned w) { return __uint_as_float(w & 0xffff0000u); }
__device__ __forceinline__ float sigm(float x) { return __builtin_amdgcn_rcpf(1.0f + __builtin_amdgcn_exp2f(-LOG2E * x)); }
__device__ __forceinline__ bf16_t f2bf1(float x) { return (bf16_t)pk2(x, 0.f); }

__device__ __forceinline__ int src_col(int n) {
    if (n < 640) {
        const int p = n & 63, base = n - p, pp = p >> 1, wh = p & 1;
        const int dim = (pp < 16) ? (wh ? 16 + pp : pp) : (wh ? 48 + (pp - 16) : 32 + (pp - 16));
        return base + dim;
    }
    if (n < 5920) return n;
    if (n < 6016) return -1;
    if (n < 6528) return n - 96;
    if (n < 6656) return -1;
    return 6432 + (n - 6656);
}

__device__ __forceinline__ void conv_tile(const float* src, int Nsrc, int k0, int n0, bool inmap, bf16_t* dst, int Kd, LAS float* t) {
    const int tid = ltid(), nl = tid & 63, ks = tid >> 6;
    const int sc = inmap ? src_col(n0 + nl) : (n0 + nl);
#pragma unroll
    for (int i = 0; i < 8; ++i) { const int kk = ks + 8 * i; t[nl * 65 + kk] = (sc >= 0) ? src[(size_t)(k0 + kk) * Nsrc + sc] : 0.f; }
    __syncthreads();
    const int kl = (tid & 31) * 2, ns = tid >> 5;
#pragma unroll
    for (int i = 0; i < 4; ++i) { const int n = ns + 16 * i; *(unsigned*)(dst + (size_t)(n0 + n) * Kd + k0 + kl) = pk2(t[n * 65 + kl], t[n * 65 + kl + 1]); }
    __syncthreads();
}
__device__ __forceinline__ void convert_weights(PPtr p, int l, LAS unsigned char* lds) {
    LAS float* t = (LAS float*)lds;
    bf16_t* WinT = (bf16_t*)(p->ws + p->o_win); bf16_t* WbT = (bf16_t*)(p->ws + p->o_wb); bf16_t* WoT = (bf16_t*)(p->ws + p->o_wo);
    bf16_t* W1T = (bf16_t*)(p->ws + p->o_w1); bf16_t* W2T = (bf16_t*)(p->ws + p->o_w2);
    constexpr int T_IN = 16 * 168, T_BR = 4 * 8 * 16, T_O = 16 * 16, T_1 = 16 * 64, T_2 = 64 * 16, T_ALL = T_IN + T_BR + T_O + T_1 + T_2;
    for (int it = blockIdx.x; it < T_ALL; it += gridDim.x) {
        int r = it;
        if (r < T_IN) { const int kb = r / 168, nb = r % 168; conv_tile(p->w_in + (size_t)l * 1024 * INW, INW, kb * 64, nb * 64, true, WinT, 1024, t); continue; } r -= T_IN;
        if (r < T_BR) { const int j = r / 128, q = r % 128, kb = q / 16, nb = q % 16; conv_tile(p->w_branch + (size_t)(l * 4 + j) * 512 * 1024, 1024, kb * 64, nb * 64, false, WbT + (size_t)j * 1024 * 512, 512, t); continue; } r -= T_BR;
        if (r < T_O) { const int kb = r / 16, nb = r % 16; conv_tile(p->w_out + (size_t)l * 1024 * 1024, 1024, kb * 64, nb * 64, false, WoT, 1024, t);
#pragma unroll 1
            for (int cpy = 0; cpy < 4; ++cpy) conv_tile(p->w_out + (size_t)l * 1024 * 1024, 1024, kb * 64, nb * 64, false, (bf16_t*)(p->ws + p->o_wo4) + cpy * 1024, 4096, t);
            continue; } r -= T_O;
        if (r < T_1) { const int kb = r / 64, nb = r % 64; conv_tile(p->w_ff1 + (size_t)l * 1024 * 4096, 4096, kb * 64, nb * 64, false, W1T, 1024, t); continue; } r -= T_1;
        { const int kb = r / 16, nb = r % 16; conv_tile(p->w_ff2 + (size_t)l * 4096 * 1024, 1024, kb * 64, nb * 64, false, W2T, 4096, t); }
    }
}

__device__ __forceinline__ void prologue(PPtr p, LAS unsigned char* lds) {
    const int tid = ltid();
    if (blockIdx.x == 0) {
        if (tid < 64) atomicExch((unsigned*)p->ws + tid, 0u);
        for (int i = tid; i < XCD_BAR_WORDS; i += 512) __hip_atomic_store((unsigned*)(p->ws + 4096) + i, 0u, __ATOMIC_RELAXED, __HIP_MEMORY_SCOPE_AGENT);
    }
    if (tid < 4) *((LAS unsigned*)(lds + CTRL_OFF + 64) + tid) = 0u;
    float* modb = (float*)(p->ws + p->o_mod);
    LAS float* sl = (LAS float*)lds;
    LAS float* red = sl + 17 * 1024;
    bool loaded = false;
    for (int task = blockIdx.x; task < 192; task += gridDim.x) {
        if (!loaded) {
            for (int i = tid; i < 17 * 1024; i += 512) { const int b = i >> 10, k = i & 1023; const float v = (b < 16) ? p->c[b * 1024 + k] : p->c_ctx[k]; sl[i] = v * sigm(v); }
            loaded = true;
        }
        __syncthreads();
        const int l = task / 48, nc = task % 48, nn = tid & 127, n = nc * 128 + nn, kq = tid >> 7;
        float acc[17];
#pragma unroll
        for (int b = 0; b < 17; ++b) acc[b] = 0.f;
        const float* w = p->w_mod + ((size_t)l * 1024 + kq * 256) * 6144 + n;
#pragma unroll 4
        for (int k = 0; k < 256; ++k) {
            const float wv = w[(size_t)k * 6144];
#pragma unroll
            for (int b = 0; b < 17; ++b) acc[b] += sl[b * 1024 + kq * 256 + k] * wv;
        }
#pragma unroll
        for (int b = 0; b < 17; ++b) red[(kq * 17 + b) * 128 + nn] = acc[b];
        __syncthreads();
        if (kq == 0) {
            const float bm = p->b_mod[l * 6144 + n];
#pragma unroll
            for (int b = 0; b < 17; ++b) modb[((size_t)l * 17 + b) * 6144 + n] = red[b * 128 + nn] + red[(17 + b) * 128 + nn] + red[(34 + b) * 128 + nn] + red[(51 + b) * 128 + nn] + bm;
        }
        __syncthreads();
    }
    if (blockIdx.x == gridDim.x - 1) {
        float* lb = (float*)(p->ws + p->o_lb);
        {
            const int ch = tid;
            float v[4], mx = -1e30f;
#pragma unroll
            for (int l = 0; l < 4; ++l) { v[l] = p->c_lb[l * 512 + ch]; mx = fmaxf(mx, v[l]); }
            float s = 0.f;
#pragma unroll
            for (int l = 0; l < 4; ++l) { v[l] = __expf(v[l] - mx); s += v[l]; }
            const float inv = 1.0f / s, s0 = v[0] * inv; float cum = 0.f;
#pragma unroll
            for (int l = 0; l < 4; ++l) { cum += v[l] * inv; lb[l * 512 + ch] = cum - s0; }
        }
        float* rt = (float*)(p->ws + p->o_rope);
        for (int i = tid; i < 1024; i += 512) {
            const int n = i >> 4, f = i & 15;
            const float inv = __expf(-((float)(2 * f) / 32.0f) * 9.210340371976184f);
            const float a = (float)n * inv;
            const float kf = rintf(a * 0.15915494309189535f);
            const float rr = fmaf(-kf, 6.2831854820251465f, a) + kf * 1.7484556e-7f;
            rt[i] = __cosf(rr); rt[1024 + i] = __sinf(rr);
        }
    }
    __syncthreads();
    convert_weights(p, 0, lds);
}

__device__ __forceinline__ void rowpass(PPtr p, int l, int g, int mode, int nrows) {
    const int lane = ltid() & 63, gw = blockIdx.x * 8 + (ltid() >> 6), NGW = gridDim.x * 8;
    const int LATR = p->GB * 2048, GB = p->GB;
    const float* ng = p->norm_gains + (size_t)l * 4 * 1024;
    const float* modb = (const float*)(p->ws + p->o_mod) + (size_t)l * 17 * 6144;
    bf16_t* hb = (bf16_t*)(p->ws + p->o_h);
    const float* yf = (const float*)(p->ws + p->o_z);
    float* xcb = (float*)(p->ws + p->o_xc);
    const bool first = (l == 0 && mode <= 2);
    const float* xlat = first ? p->x : (const float*)p->out;
    const float* xctx = first ? p->ctx : (const float*)xcb;
    auto xsrc = [&](int row) -> const float* {
        if (row < LATR) return xlat + ((size_t)(g * GB + (row >> 11)) * 2048 + (row & 2047)) * 1024;
        const int r2 = row - LATR; return xctx + ((size_t)(g * GB + (r2 >> 8)) * 256 + (r2 & 255)) * 1024;
    };
    const float* slab = (const float*)(p->ws + p->o_z + (size_t)p->MG * 12288);
    const size_t slab_stride = (size_t)(p->MG - LATR) * 1024;
    auto yload = [&](int row, f32x4 (&yv)[4]) {
        if (row < LATR) {
            const bf16_t* yb = (const bf16_t*)yf + (size_t)row * 1024 + lane * 4;
#pragma unroll
            for (int j = 0; j < 4; ++j) { const u32x2 w = *(const u32x2*)(yb + 256 * j); yv[j] = (f32x4){lo16(w.x), hi16(w.x), lo16(w.y), hi16(w.y)}; }
        } else {
            const float* s0 = slab + (size_t)(row - LATR) * 1024 + lane * 4;
#pragma unroll
            for (int j = 0; j < 4; ++j) yv[j] = *(const f32x4*)(s0 + 256 * j);
#pragma unroll
            for (int ks = 1; ks < 8; ++ks)
#pragma unroll
                for (int j = 0; j < 4; ++j) yv[j] = yv[j] + *(const f32x4*)(s0 + ks * slab_stride + 256 * j);
        }
    };
    f32x4 xv[4], yv[4];
    int row = gw;
    if (row < nrows) {
        const float* xs = xsrc(row);
#pragma unroll
        for (int j = 0; j < 4; ++j) xv[j] = *(const f32x4*)(xs + lane * 4 + 256 * j);
        if (mode >= 2) yload(row, yv);
    }
    while (row < nrows) {
        const int nrow = row + NGW;
        f32x4 xn[4], yn[4];
        if (nrow < nrows) {
            const float* xs = xsrc(nrow);
#pragma unroll
            for (int j = 0; j < 4; ++j) xn[j] = *(const f32x4*)(xs + lane * 4 + 256 * j);
            if (mode >= 2) yload(nrow, yn);
        }
        const bool lat = row < LATR;
        int b; size_t xrow;
        if (lat) { b = g * GB + (row >> 11); xrow = (size_t)b * 2048 + (row & 2047); }
        else { const int r2 = row - LATR; b = g * GB + (r2 >> 8); xrow = (size_t)b * 256 + (r2 & 255); }
        float* xd = (lat ? p->out : xcb) + xrow * 1024;
        const float* m = modb + (size_t)(lat ? b : 16) * 6144;
        if (mode >= 2) {
            float ss = 0.f;
#pragma unroll
            for (int j = 0; j < 4; ++j) ss += yv[j].x * yv[j].x + yv[j].y * yv[j].y + yv[j].z * yv[j].z + yv[j].w * yv[j].w;
            ss = wave_sum(ss);
            const float rs = rsqrtf(ss * (1.0f / 1024.0f) + EPS);
            const float* gate = m + (mode == 2 ? 2048 : 5120); const float* gn = ng + (mode == 2 ? 1024 : 3072);
#pragma unroll
            for (int j = 0; j < 4; ++j) {
                const int c = lane * 4 + 256 * j;
                const f32x4 gv = *(const f32x4*)(gate + c), nv = *(const f32x4*)(gn + c);
                xv[j] = xv[j] + gv * (yv[j] * rs * nv);
                *(f32x4*)(xd + c) = xv[j];
            }
        }
        if (mode <= 2) {
            float ss = 0.f;
#pragma unroll
            for (int j = 0; j < 4; ++j) ss += xv[j].x * xv[j].x + xv[j].y * xv[j].y + xv[j].z * xv[j].z + xv[j].w * xv[j].w;
            ss = wave_sum(ss);
            const float rs = rsqrtf(ss * (1.0f / 1024.0f) + EPS);
            const float* sh = m + (mode == 1 ? 0 : 3072); const float* sc = m + (mode == 1 ? 1024 : 4096); const float* gn = ng + (mode == 1 ? 0 : 2048);
#pragma unroll
            for (int j = 0; j < 4; ++j) {
                const int c = lane * 4 + 256 * j;
                const f32x4 shv = *(const f32x4*)(sh + c), scv = *(const f32x4*)(sc + c), nv = *(const f32x4*)(gn + c);
                const f32x4 hv = (xv[j] * rs * nv) * (scv + 1.0f) + shv;
                u32x2 o; o.x = pk2(hv.x, hv.y); o.y = pk2(hv.z, hv.w);
                *(u32x2*)(hb + (size_t)row * 1024 + c) = o;
            }
        }
#pragma unroll
        for (int j = 0; j < 4; ++j) { xv[j] = xn[j]; yv[j] = yn[j]; }
        row = nrow;
    }
}

struct EpiInproj {
    static constexpr bool PERM = true, AFTER_DRAIN = false;
    bf16_t* Z; bf16_t* vta; bf16_t* vtb; const float* rope; int GB;
    __device__ __forceinline__ void operator()(const f32x4 (&acc)[2][2][4][2], const pg8::Unit& u, int wr, int wc, int fr, int fq) const {
        const int row0 = u.pm * 256 + wr * 64 + fr, LATR = GB * 2048;
#pragma unroll
        for (int bj = 0; bj < 2; ++bj) {
            const int seg = u.pn * 2 + bj, c0 = u.pn * 256 + bj * 128 + wc * 32 + 8 * fq;
            const int type = (seg <= 4) ? 1 : (seg == 5 ? 2 : ((seg >= 14 && seg <= 17) ? 3 : 0));
            const int xf = (seg <= 3 || (seg >= 6 && seg <= 9)) ? 1 : ((seg >= 18 && seg <= 21) ? 2 : ((seg >= 22 && seg <= 29) ? 3 : ((seg == 38 || seg == 39) ? 4 : 0)));
#pragma unroll
            for (int ai = 0; ai < 2; ++ai)
#pragma unroll
                for (int m = 0; m < 4; ++m) {
                    const int row = row0 + ai * 128 + m * 16;
                    f32x4 v0 = acc[ai][bj][m][0], v1 = acc[ai][bj][m][1];
                    if (type <= 1) {
                        if (type == 1 && row < LATR) {
                            const int t = row & 2047, pp0 = (c0 & 63) >> 1;
                            const int n = (pp0 < 16) ? (t >> 6) : (t & 63);
                            const float* cs = rope + n * 16 + (pp0 & 15);
                            const f32x4 cv = *(const f32x4*)cs, sv = *(const f32x4*)(cs + 1024);
                            f32x4 r0, r1;
                            r0.x = v0.x * cv.x - v0.y * sv.x; r0.y = v0.y * cv.x + v0.x * sv.x;
                            r0.z = v0.z * cv.y - v0.w * sv.y; r0.w = v0.w * cv.y + v0.z * sv.y;
                            r1.x = v1.x * cv.z - v1.y * sv.z; r1.y = v1.y * cv.z + v1.x * sv.z;
                            r1.z = v1.z * cv.w - v1.w * sv.w; r1.w = v1.w * cv.w + v1.z * sv.w;
                            v0 = r0; v1 = r1;
                        }
                        if (xf == 1) { v0 = v0 * QSCALE2; v1 = v1 * QSCALE2; }
                        else if (xf == 4) { v0 = v0 * 0.125f; v1 = v1 * 0.125f; }
                        else if (xf == 2) {
#pragma unroll
                            for (int e = 0; e < 4; ++e) { v0[e] = v0[e] * sigm(v0[e]); v1[e] = v1[e] * sigm(v1[e]); }
                        } else if (xf == 3) {
#pragma unroll
                            for (int e = 0; e < 4; ++e) { v0[e] = sigm(v0[e]); v1[e] = sigm(v1[e]); }
                        }
                        u32x4 w; w.x = pk2(v0.x, v0.y); w.y = pk2(v0.z, v0.w); w.z = pk2(v1.x, v1.y); w.w = pk2(v1.z, v1.w);
                        *(u32x4*)(Z + (size_t)row * ZW + c0) = w;
                    } else {
                        int bl, tok;
                        if (row < LATR) { bl = row >> 11; tok = row & 2047; } else { const int r2 = row - LATR; bl = r2 >> 8; tok = 2048 + (r2 & 255); }
                        const int cc = c0 - (type == 2 ? ZA_V : ZB_V), head = cc >> 6, dim0 = cc & 63, H = (type == 2) ? 2 : 8;
                        bf16_t* base = (type == 2 ? vta : vtb) + ((size_t)(bl * H + head) * 64 + dim0) * VTS + tok;
                        base[0 * VTS] = f2bf(v0.x); base[1 * VTS] = f2bf(v0.y); base[2 * VTS] = f2bf(v0.z); base[3 * VTS] = f2bf(v0.w);
                        base[4 * VTS] = f2bf(v1.x); base[5 * VTS] = f2bf(v1.y); base[6 * VTS] = f2bf(v1.z); base[7 * VTS] = f2bf(v1.w);
                    }
                }
        }
    }
};
struct EpiBranch {
    static constexpr bool PERM = true, AFTER_DRAIN = false;
    const bf16_t* Z; bf16_t* macc; int nMfull;
    __device__ __forceinline__ void operator()(const f32x4 (&acc)[2][2][4][2], const pg8::Unit& u, int wr, int wc, int fr, int fq) const {
        const int j = u.pm / nMfull, pm = u.pm - j * nMfull, pn = u.pn & 3;
        const int row0 = pm * 256 + wr * 64 + fr, col0 = pn * 256 + wc * 32 + 8 * fq;
        const bf16_t* gbase = Z + (size_t)row0 * ZW + ZMERGE + j * 1024 + col0;
        bf16_t* mbase = macc + (size_t)row0 * 1024 + col0;
#pragma unroll
        for (int ai = 0; ai < 2; ++ai) {
            u32x4 gw[4][2], pv[4][2];
#pragma unroll
            for (int m = 0; m < 4; ++m)
#pragma unroll
                for (int bj = 0; bj < 2; ++bj) {
                    const size_t ro = (size_t)(ai * 128 + m * 16);
                    gw[m][bj] = *(const u32x4*)(gbase + ro * ZW + bj * 128);
                    pv[m][bj] = (j > 0) ? *(const u32x4*)(mbase + ro * 1024 + bj * 128) : (u32x4){0u, 0u, 0u, 0u};
                }
#pragma unroll
            for (int m = 0; m < 4; ++m)
#pragma unroll
                for (int bj = 0; bj < 2; ++bj) {
                    const u32x4 g = gw[m][bj], q = pv[m][bj];
                    const f32x4 v0 = acc[ai][bj][m][0], v1 = acc[ai][bj][m][1];
                    const float t0 = v0.x * sigm(lo16(g.x)) + lo16(q.x), t1 = v0.y * sigm(hi16(g.x)) + hi16(q.x), t2 = v0.z * sigm(lo16(g.y)) + lo16(q.y), t3 = v0.w * sigm(hi16(g.y)) + hi16(q.y);
                    const float t4 = v1.x * sigm(lo16(g.z)) + lo16(q.z), t5 = v1.y * sigm(hi16(g.z)) + hi16(q.z), t6 = v1.z * sigm(lo16(g.w)) + lo16(q.w), t7 = v1.w * sigm(hi16(g.w)) + hi16(q.w);
                    u32x4 w; w.x = pk2(t0, t1); w.y = pk2(t2, t3); w.z = pk2(t4, t5); w.w = pk2(t6, t7);
                    *(u32x4*)(mbase + (size_t)(ai * 128 + m * 16) * 1024 + bj * 128) = w;
                }
        }
    }
};
struct BranchOrder {
    int nM, nMfull, G, c;
    __device__ __forceinline__ bool next(int i, pg8::Unit& u) const {
        const int j = i & 3; const int v = (c & 7) * (G >> 3) + (c >> 3);
        const long T = (long)(i >> 2) * G + v;
        if (T >= (long)nM * 4) return false;
        u.pm = j * nMfull + (int)(T >> 2); u.pn = j * 4 + (int)(T & 3); u.ko = 0; return true;
    }
    __device__ __forceinline__ void a_ready(const pg8::Unit&) const {}
    __device__ __forceinline__ void done(const pg8::Unit&) const {}
};
struct EpiBf16Y {
    static constexpr bool PERM = true, AFTER_DRAIN = false;
    bf16_t* O; int ldc;
    __device__ __forceinline__ void operator()(const f32x4 (&acc)[2][2][4][2], const pg8::Unit& u, int wr, int wc, int fr, int fq) const {
        const int row0 = u.pm * 256 + wr * 64 + fr, col0 = u.pn * 256 + wc * 32 + 8 * fq;
#pragma unroll
        for (int ai = 0; ai < 2; ++ai)
#pragma unroll
            for (int m = 0; m < 4; ++m) {
                bf16_t* rowp = O + (size_t)(row0 + ai * 128 + m * 16) * ldc + col0;
#pragma unroll
                for (int bj = 0; bj < 2; ++bj) {
                    const f32x4 v0 = acc[ai][bj][m][0], v1 = acc[ai][bj][m][1];
                    u32x4 w; w.x = pk2(v0.x, v0.y); w.y = pk2(v0.z, v0.w); w.z = pk2(v1.x, v1.y); w.w = pk2(v1.z, v1.w);
                    *(u32x4*)(rowp + bj * 128) = w;
                }
            }
    }
};
struct EpiRelu2 {
    static constexpr bool PERM = true, AFTER_DRAIN = false;
    bf16_t* O; int ldc;
    __device__ __forceinline__ void operator()(const f32x4 (&acc)[2][2][4][2], const pg8::Unit& u, int wr, int wc, int fr, int fq) const {
        const int row0 = u.pm * 256 + wr * 64 + fr, col0 = u.pn * 256 + wc * 32 + 8 * fq;
#pragma unroll
        for (int ai = 0; ai < 2; ++ai)
#pragma unroll
            for (int m = 0; m < 4; ++m) {
                bf16_t* rowp = O + (size_t)(row0 + ai * 128 + m * 16) * ldc + col0;
#pragma unroll
                for (int bj = 0; bj < 2; ++bj) {
                    f32x4 v0 = acc[ai][bj][m][0], v1 = acc[ai][bj][m][1];
#pragma unroll
                    for (int e = 0; e < 4; ++e) { const float a = fmaxf(v0[e], 0.f), b = fmaxf(v1[e], 0.f); v0[e] = a * a; v1[e] = b * b; }
                    u32x4 w; w.x = pk2(v0.x, v0.y); w.y = pk2(v0.z, v0.w); w.z = pk2(v1.x, v1.y); w.w = pk2(v1.z, v1.w);
                    *(u32x4*)(rowp + bj * 128) = w;
                }
            }
    }
};

struct CtxBranchOrder {
    int nMfull, pm0, nT, G, c;
    __device__ __forceinline__ bool next(int i, pg8::Unit& u) const {
        const long L = (long)i * G + c; if (L >= (long)nT * 4) return false;
        const int j = (int)(L & 3), t = (int)(L >> 2);
        u.pm = j * nMfull + pm0 + (t >> 2); u.pn = j * 4 + (t & 3); u.ko = 0; return true;
    }
    __device__ __forceinline__ void a_ready(const pg8::Unit&) const {}
    __device__ __forceinline__ void done(const pg8::Unit&) const {}
};
struct EpiBranchCtx {
    static constexpr bool PERM = true, AFTER_DRAIN = false;
    const bf16_t* Z; bf16_t* P; int nMfull, pm0;
    __device__ __forceinline__ void operator()(const f32x4 (&acc)[2][2][4][2], const pg8::Unit& u, int wr, int wc, int fr, int fq) const {
        const int j = u.pm / nMfull, pm = u.pm - j * nMfull, pn = u.pn & 3;
        const int row0 = pm * 256 + wr * 64 + fr, col0 = pn * 256 + wc * 32 + 8 * fq;
        const bf16_t* gbase = Z + (size_t)row0 * ZW + ZMERGE + j * 1024 + col0;
        bf16_t* pbase = P + (size_t)(row0 - pm0 * 256) * 4096 + j * 1024 + col0;
#pragma unroll
        for (int ai = 0; ai < 2; ++ai) {
            u32x4 gw[4][2];
#pragma unroll
            for (int m = 0; m < 4; ++m)
#pragma unroll
                for (int bj = 0; bj < 2; ++bj) gw[m][bj] = *(const u32x4*)(gbase + (size_t)(ai * 128 + m * 16) * ZW + bj * 128);
#pragma unroll
            for (int m = 0; m < 4; ++m)
#pragma unroll
                for (int bj = 0; bj < 2; ++bj) {
                    const u32x4 g = gw[m][bj];
                    const f32x4 v0 = acc[ai][bj][m][0], v1 = acc[ai][bj][m][1];
                    u32x4 w; w.x = pk2(v0.x * sigm(lo16(g.x)), v0.y * sigm(hi16(g.x))); w.y = pk2(v0.z * sigm(lo16(g.y)), v0.w * sigm(hi16(g.y)));
                    w.z = pk2(v1.x * sigm(lo16(g.z)), v1.y * sigm(hi16(g.z))); w.w = pk2(v1.z * sigm(lo16(g.w)), v1.w * sigm(hi16(g.w)));
                    *(u32x4*)(pbase + (size_t)(ai * 128 + m * 16) * 4096 + bj * 128) = w;
                }
        }
    }
};
struct SplitOrder {
    int pm0, nT, SPLIT, Kl, G, c;
    __device__ __forceinline__ bool next(int i, pg8::Unit& u) const {
        const long L = (long)i * G + c; if (L >= (long)nT * 4 * SPLIT) return false;
        const int ks = (int)(L % SPLIT), t = (int)(L / SPLIT);
        u.pm = pm0 + (t >> 2); u.pn = t & 3; u.ko = ks * Kl; return true;
    }
    __device__ __forceinline__ void a_ready(const pg8::Unit&) const {}
    __device__ __forceinline__ void done(const pg8::Unit&) const {}
};
struct EpiSlab {
    static constexpr bool PERM = false, AFTER_DRAIN = false;
    float* S; int pm0, nrows, Kl;
    __device__ __forceinline__ void operator()(const f32x4 (&acc)[2][2][4][2], const pg8::Unit& u, int wr, int wc, int fr, int fq) const {
        const int ks = u.ko / Kl;
        const int row0 = (u.pm - pm0) * 256 + wr * 64 + fr, col0 = u.pn * 256 + wc * 32 + 4 * fq;
        float* base = S + (size_t)ks * nrows * 1024;
#pragma unroll
        for (int ai = 0; ai < 2; ++ai)
#pragma unroll
            for (int m = 0; m < 4; ++m) { float* rowp = base + (size_t)(row0 + ai * 128 + m * 16) * 1024 + col0;
#pragma unroll
                for (int bj = 0; bj < 2; ++bj)
#pragma unroll
                    for (int n = 0; n < 2; ++n) *(f32x4*)(rowp + bj * 128 + n * 16) = acc[ai][bj][m][n]; }
    }
};

#define MFMA16(a, b, c) __builtin_amdgcn_mfma_f32_16x16x32_bf16((a), (b), (c), 0, 0, 0)
__device__ __forceinline__ void attn_wave(PPtr p, int l, int kind, int idx, int lane, const LAS float* biasL) {
    const int fr = lane & 15, fq = lane >> 4;
    const int LATR = p->GB * 2048, MG = p->MG;
    const bf16_t* Z = (const bf16_t*)(p->ws + p->o_z);
    const bool isA = (kind == 1 || kind == 2);
    int bl, hk, qrow0, r = 0, q0 = 0;
    if (kind == 0) { bl = idx >> 8; hk = (idx >> 5) & 7; r = idx & 31; qrow0 = bl * 2048 + r * 64; }
    else if (kind == 1) { bl = idx >> 8; hk = (idx >> 7) & 1; q0 = (idx & 127) * 16; qrow0 = bl * 2048 + q0; }
    else if (kind == 2) { bl = idx >> 5; hk = (idx >> 4) & 1; qrow0 = LATR + bl * 256 + (idx & 15) * 16; }
    else { bl = idx >> 5; hk = (idx >> 2) & 7; qrow0 = LATR + bl * 256 + (idx & 3) * 64; }
    const int qrstep = isA ? 0 : 16, qcstep = isA ? 64 : 0;
    const int qcol0 = isA ? (ZA_Q + hk * 4 * 64) : (ZB_Q + hk * 64);
    const int kcol = isA ? (ZA_K + hk * 64) : (ZB_K + hk * 64);
    const bf16_t* vt = isA ? ((const bf16_t*)(p->ws + p->o_vta) + (size_t)(bl * 2 + hk) * 64 * VTS) : ((const bf16_t*)(p->ws + p->o_vtb) + (size_t)(bl * 8 + hk) * 64 * VTS);
    bf16_t* yo = (bf16_t*)(p->ws + p->o_y4) + (isA ? (size_t)0 : (size_t)MG * 512);
    const int ocol0 = isA ? hk * 4 * 64 : hk * 64;
    const int krow_ctx0 = LATR + bl * 256, krow_lat0 = bl * 2048;

    bf16x8 Q[4][2];
#pragma unroll
    for (int s = 0; s < 4; ++s)
#pragma unroll
        for (int ks = 0; ks < 2; ++ks) Q[s][ks] = *(const bf16x8*)(Z + (size_t)(qrow0 + s * qrstep + fr) * ZW + qcol0 + s * qcstep + ks * 32 + fq * 8);
    f32x4 O[4][4]; float mrun[4], lrun[4];
#pragma unroll
    for (int s = 0; s < 4; ++s) { mrun[s] = -1e30f; lrun[s] = 0.f;
#pragma unroll
        for (int dt = 0; dt < 4; ++dt) O[s][dt] = (f32x4){0.f, 0.f, 0.f, 0.f}; }

    auto do_block = [&](int krow, int vtoff, int mode, int a0, int a1) {
        bf16x8 Kf[2][2];
#pragma unroll
        for (int kt = 0; kt < 2; ++kt)
#pragma unroll
            for (int ks = 0; ks < 2; ++ks) Kf[kt][ks] = *(const bf16x8*)(Z + (size_t)(krow + kt * 16 + fr) * ZW + kcol + ks * 32 + fq * 8);
        bf16x8 Vf[4];
#pragma unroll
        for (int dt = 0; dt < 4; ++dt) {
            const bf16_t* vp = vt + (size_t)(dt * 16 + fr) * VTS + vtoff + fq * 4;
            const u32x2 lo = *(const u32x2*)vp, hi = *(const u32x2*)(vp + 16);
            u32x4 w; w.x = lo.x; w.y = lo.y; w.z = hi.x; w.w = hi.y;
            Vf[dt] = __builtin_bit_cast(bf16x8, w);
        }
#pragma unroll
        for (int s = 0; s < 4; ++s) {
            const bool active = (mode != 2) || !((s == 0 && a1 == 1) || (s == 3 && a1 == 0));
            if (active) {
                f32x4 S0 = (f32x4){0.f, 0.f, 0.f, 0.f}, S1 = (f32x4){0.f, 0.f, 0.f, 0.f};
                S0 = MFMA16(Kf[0][0], Q[s][0], S0); S0 = MFMA16(Kf[0][1], Q[s][1], S0);
                S1 = MFMA16(Kf[1][0], Q[s][0], S1); S1 = MFMA16(Kf[1][1], Q[s][1], S1);
                float sc[8];
#pragma unroll
                for (int j = 0; j < 4; ++j) { sc[j] = S0[j]; sc[4 + j] = S1[j]; }
                if (mode == 1) {
                    const int qpos = q0 + fr;
#pragma unroll
                    for (int e = 0; e < 8; ++e) { const int kpos = a0 + (e >> 2) * 16 + fq * 4 + (e & 3); const int d = kpos - qpos; if (d > 128 || d < -128) sc[e] = -1e30f; }
                } else if (mode == 2) {
                    const int qc = 16 * s + fr; const int cs = min(max(qc - 8, 0), 48);
                    const LAS float* bp = biasL + hk * 465 + a0 * 31;
#pragma unroll
                    for (int e = 0; e < 8; ++e) {
                        const int kc = a1 * 32 + (e >> 2) * 16 + fq * 4 + (e & 3);
                        const int dc = min(max(kc - qc + 15, 0), 30);
                        const float bv = bp[dc];
                        sc[e] = (kc >= cs && kc < cs + 16) ? (sc[e] + bv) : -1e30f;
                    }
                }
                float ml = fmaxf(fmaxf(fmaxf(sc[0], sc[1]), fmaxf(sc[2], sc[3])), fmaxf(fmaxf(sc[4], sc[5]), fmaxf(sc[6], sc[7])));
                ml = xrow16_max(ml);
                const float mold = mrun[s], mn = fmaxf(mold, ml), alpha = __builtin_amdgcn_exp2f(mold - mn);
                mrun[s] = mn;
                float pv[8], ls = 0.f;
#pragma unroll
                for (int e = 0; e < 8; ++e) { pv[e] = __builtin_amdgcn_exp2f(sc[e] - mn); ls += pv[e]; }
                ls = xrow16_sum(ls);
                lrun[s] = lrun[s] * alpha + ls;
                u32x4 pw; pw.x = pk2(pv[0], pv[1]); pw.y = pk2(pv[2], pv[3]); pw.z = pk2(pv[4], pv[5]); pw.w = pk2(pv[6], pv[7]);
                const bf16x8 P = __builtin_bit_cast(bf16x8, pw);
                if (__builtin_amdgcn_ballot_w64(mn > mold) != 0ull) {
#pragma unroll
                    for (int dt = 0; dt < 4; ++dt) O[s][dt] = O[s][dt] * alpha;
                }
#pragma unroll
                for (int dt = 0; dt < 4; ++dt) O[s][dt] = MFMA16(Vf[dt], P, O[s][dt]);
            }
            __builtin_amdgcn_sched_barrier(0);
        }
    };
    int nloc = 0, lo = 0, r0 = 0;
    if (kind == 1) { lo = max(0, q0 - 128) & ~31; const int hi = min(2048, (q0 + 16 + 128 + 31) & ~31); nloc = (hi - lo) >> 5; }
    else if (kind == 0) { r0 = min(max(r - 4, 0), 24); nloc = 16; }
#pragma unroll 1
    for (int i = 0; i < 8 + nloc; ++i) {
        int krow, vtoff, mode, a0, a1;
        if (i < 8) { krow = krow_ctx0 + 32 * i; vtoff = 2048 + 32 * i; mode = 0; a0 = 0; a1 = 0; }
        else if (kind == 1) { const int kb = lo + 32 * (i - 8); krow = krow_lat0 + kb; vtoff = kb; mode = 1; a0 = kb; a1 = 0; }
        else { const int jj = i - 8, kr = r0 + (jj >> 1), hb = jj & 1; krow = krow_lat0 + kr * 64 + hb * 32; vtoff = kr * 64 + hb * 32; mode = 2; a0 = kr - r + 7; a1 = hb; }
        do_block(krow, vtoff, mode, a0, a1);
    }
#pragma unroll
    for (int s = 0; s < 4; ++s) {
        float fac;
        if (isA) { const float sk = p->a_sink[l * 8 + hk * 4 + s] * LOG2E; const float M = fmaxf(mrun[s], sk); const float e1 = __builtin_amdgcn_exp2f(mrun[s] - M); fac = e1 / (lrun[s] * e1 + __builtin_amdgcn_exp2f(sk - M)); }
        else fac = 1.0f / lrun[s];
        bf16_t* op = yo + (size_t)(qrow0 + s * qrstep + fr) * 512 + ocol0 + s * qcstep + fq * 4;
#pragma unroll
        for (int dt = 0; dt < 4; ++dt) { const f32x4 o = O[s][dt] * fac; u32x2 w; w.x = pk2(o.x, o.y); w.y = pk2(o.z, o.w); *(u32x2*)(op + dt * 16) = w; }
    }
}

constexpr int SCAN_BUF = 41472;
constexpr int BIAS_OFF = 3 * SCAN_BUF;
template <int DK, bool ISC>
__device__ __forceinline__ void scan_task(PPtr p, int l, int bl, int h, int dir, LAS unsigned char* lds) {
    constexpr int KPW = DK / 8, NTG = 64 / KPW, TPG = 32 / NTG, QS = (DK + 8) * 2, NKT = DK / 16;
    const int tid = ltid(), w = tid >> 6, lane = tid & 63, fr = lane & 15, fq = lane >> 4;
    const int kl = lane % KPW, tg = lane / KPW, kch = w * KPW + kl;
    const int vcol = tid & 127, vg = tid >> 7;
    LAS unsigned char* qt = lds; LAS unsigned char* kt_ = qt + 32 * QS; LAS unsigned char* khT = kt_ + 32 * QS; LAS unsigned char* vT = khT + DK * 80;
    LAS unsigned char* att = vT + 128 * 80; LAS float* dvec = (LAS float*)(att + 32 * 80); LAS float* evec = dvec + DK;
    const bf16_t* Z = (const bf16_t*)(p->ws + p->o_z);
    const int LATR = p->GB * 2048, MG = p->MG;
    const int qc = ISC ? (ZC_Q + h * 128 + kch) : (ZD_Q + h * 64 + kch);
    const int kc = ISC ? ((dir ? ZC_FB : ZC_FF) + h * 128 + kch) : (ZD_K + h * 64 + kch);
    const int vc = (ISC ? ZC_I : ZD_V) + h * 128 + vcol;
    const int gcol = ZD_GK + dir * 16;
    float lbv = 0.f, oml = 1.f, up[16], gb = 0.f;
#pragma unroll
    for (int r = 0; r < 16; ++r) up[r] = 0.f;
    if (ISC) { lbv = ((const float*)(p->ws + p->o_lb))[l * 512 + h * 128 + kch]; oml = 1.0f - lbv; }
    else {
#pragma unroll
        for (int r = 0; r < 16; ++r) up[r] = p->d_gate_up[((size_t)(l * 2 + dir) * 16 + r) * 256 + h * 64 + kch];
        gb = p->d_gate_bias[(l * 2 + dir) * 256 + h * 64 + kch];
    }
    bf16_t* odst = (dir == 0) ? ((bf16_t*)(p->ws + p->o_y4) + (size_t)(ISC ? 2 : 3) * MG * 512) : ((bf16_t*)(p->ws + p->o_ob) + (size_t)(ISC ? 0 : 1) * MG * 512);
    f32x4 S[NKT];
#pragma unroll
    for (int i = 0; i < NKT; ++i) S[i] = (f32x4){0.f, 0.f, 0.f, 0.f};
    auto rowof = [&](int cc, int i) -> int {
        const bool isctx = cc < 8; const int L = isctx ? 256 : 2048, base = isctx ? (LATR + bl * 256) : (bl * 2048), c = isctx ? cc : cc - 8;
        const int pos = c * 32 + i; return base + (dir ? (L - 1 - pos) : pos);
    };
    bf16_t rq[TPG], rk[TPG], rv[8]; u32x4 rz[TPG][2];
    auto load_raw = [&](int cc) {
#pragma unroll
        for (int e = 0; e < TPG; ++e) {
            const bf16_t* zr = Z + (size_t)rowof(cc, tg * TPG + e) * ZW;
            rq[e] = zr[qc]; rk[e] = zr[kc];
            if (!ISC) { rz[e][0] = *(const u32x4*)(zr + gcol); rz[e][1] = *(const u32x4*)(zr + gcol + 8); }
        }
#pragma unroll
        for (int e = 0; e < 8; ++e) rv[e] = Z[(size_t)rowof(cc, vg * 8 + e) * ZW + vc];
    };
    load_raw(0);
    for (int cc = 0; cc < 72; ++cc) {
        __syncthreads();
        {
            float gq[TPG], gk[TPG], cum[TPG]; float run = 0.f;
#pragma unroll
            for (int e = 0; e < TPG; ++e) {
                const float zq = bf2f(rq[e]), zk = bf2f(rk[e]); float g, key, q;
                if (ISC) { const float sg = zk; g = __logf(lbv + oml * sg); key = oml * (1.0f - sg); q = zq; }
                else {
                    float a = gb;
                    const u32x4 z0 = rz[e][0], z1 = rz[e][1];
                    a += lo16(z0.x) * up[0] + hi16(z0.x) * up[1] + lo16(z0.y) * up[2] + hi16(z0.y) * up[3] + lo16(z0.z) * up[4] + hi16(z0.z) * up[5] + lo16(z0.w) * up[6] + hi16(z0.w) * up[7];
                    a += lo16(z1.x) * up[8] + hi16(z1.x) * up[9] + lo16(z1.y) * up[10] + hi16(z1.y) * up[11] + lo16(z1.z) * up[12] + hi16(z1.z) * up[13] + lo16(z1.w) * up[14] + hi16(z1.w) * up[15];
                    g = (fminf(a, 0.f) - __logf(1.0f + __expf(-fabsf(a)))) * (1.0f / 16.0f); key = zk; q = zq;
                }
                run += g; cum[e] = run; gq[e] = q; gk[e] = key;
            }
            float pre = 0.f, total = 0.f, cref = 0.f;
#pragma unroll
            for (int t = 0; t < NTG; ++t) { const float tt = __shfl(run, kl + KPW * t); if (t < tg) pre += tt; if (t < NTG / 2) cref += tt; total += tt; }
            float khv[TPG]; const float etc = __expf(total - cref);
#pragma unroll
            for (int e = 0; e < TPG; ++e) {
                const float c = cum[e] + pre; const int i = tg * TPG + e;
                const float E = __expf(c - cref), kE = gk[e] * __builtin_amdgcn_rcpf(E);
                *(LAS bf16_t*)(qt + i * QS + kch * 2) = f2bf1(gq[e] * E);
                *(LAS bf16_t*)(kt_ + i * QS + kch * 2) = f2bf1(kE);
                khv[e] = kE * etc;
            }
            if constexpr (TPG == 8) { u32x4 o; o.x = pk2(khv[0], khv[1]); o.y = pk2(khv[2], khv[3]); o.z = pk2(khv[4], khv[5]); o.w = pk2(khv[6], khv[7]); *(LAS u32x4*)(khT + kch * 80 + tg * 16) = o; }
            else { u32x2 o; o.x = pk2(khv[0], khv[1]); o.y = pk2(khv[2], khv[3]); *(LAS u32x2*)(khT + kch * 80 + tg * 8) = o; }
            if (tg == 0) { dvec[kch] = __expf(total); evec[kch] = __expf(cref); }
            u32x4 vo; vo.x = (unsigned)rv[0] | ((unsigned)rv[1] << 16); vo.y = (unsigned)rv[2] | ((unsigned)rv[3] << 16); vo.z = (unsigned)rv[4] | ((unsigned)rv[5] << 16); vo.w = (unsigned)rv[6] | ((unsigned)rv[7] << 16);
            *(LAS u32x4*)(vT + vcol * 80 + vg * 16) = vo;
        }
        if (cc + 1 < 72) load_raw(cc + 1);
        __syncthreads();
        if (w < 3) {
            const int tt = (w == 0) ? 0 : 1, st = (w == 2) ? 1 : 0;
            f32x4 a = (f32x4){0.f, 0.f, 0.f, 0.f};
#pragma unroll
            for (int ks = 0; ks < DK / 32; ++ks) {
                const bf16x8 A = *(const LAS bf16x8*)(qt + (tt * 16 + fr) * QS + (ks * 32 + fq * 8) * 2);
                const bf16x8 B = *(const LAS bf16x8*)(kt_ + (st * 16 + fr) * QS + (ks * 32 + fq * 8) * 2);
                a = MFMA16(A, B, a);
            }
#pragma unroll
            for (int j = 0; j < 4; ++j) { const int t = tt * 16 + fq * 4 + j, s = st * 16 + fr; *(LAS bf16_t*)(att + t * 80 + s * 2) = f2bf1(s <= t ? a[j] : 0.f); }
        } else if (w == 3) {
#pragma unroll
            for (int j = 0; j < 4; ++j) { const int t = fq * 4 + j, s = 16 + fr; *(LAS bf16_t*)(att + t * 80 + s * 2) = (bf16_t)0; }
        }
        __syncthreads();
        {
            const int vs = w * 16;
            const bf16x8 Bv = *(const LAS bf16x8*)(vT + (vs + fr) * 80 + fq * 16);
            bf16x8 Sb[NKT / 2];
#pragma unroll
            for (int kp = 0; kp < NKT / 2; ++kp) {
                const f32x4 e0 = *(const LAS f32x4*)(evec + (2 * kp) * 16 + fq * 4), e1 = *(const LAS f32x4*)(evec + (2 * kp + 1) * 16 + fq * 4);
                const f32x4 s0 = S[2 * kp] * e0, s1 = S[2 * kp + 1] * e1;
                u32x4 sw; sw.x = pk2(s0.x, s0.y); sw.y = pk2(s0.z, s0.w); sw.z = pk2(s1.x, s1.y); sw.w = pk2(s1.z, s1.w);
                Sb[kp] = __builtin_bit_cast(bf16x8, sw);
            }
#pragma unroll
            for (int tt = 0; tt < 2; ++tt) {
                f32x4 o = (f32x4){0.f, 0.f, 0.f, 0.f};
#pragma unroll
                for (int kp = 0; kp < NKT / 2; ++kp) {
                    const u32x2 lo = *(const LAS u32x2*)(qt + (tt * 16 + fr) * QS + ((2 * kp) * 16 + fq * 4) * 2);
                    const u32x2 hi = *(const LAS u32x2*)(qt + (tt * 16 + fr) * QS + ((2 * kp + 1) * 16 + fq * 4) * 2);
                    u32x4 aw; aw.x = lo.x; aw.y = lo.y; aw.z = hi.x; aw.w = hi.y;
                    o = MFMA16(__builtin_bit_cast(bf16x8, aw), Sb[kp], o);
                }
                const bf16x8 A2 = *(const LAS bf16x8*)(att + (tt * 16 + fr) * 80 + fq * 16);
                o = MFMA16(A2, Bv, o);
#pragma unroll
                for (int j = 0; j < 4; ++j) { const int row = rowof(cc, tt * 16 + fq * 4 + j); odst[(size_t)row * 512 + h * 128 + vs + fr] = f2bf1(o[j]); }
            }
#pragma unroll
            for (int k2 = 0; k2 < NKT; ++k2) {
                const f32x4 d = *(const LAS f32x4*)(dvec + k2 * 16 + fq * 4);
                S[k2] = S[k2] * d;
                const bf16x8 A3 = *(const LAS bf16x8*)(khT + (k2 * 16 + fr) * 80 + fq * 16);
                S[k2] = MFMA16(A3, Bv, S[k2]);
            }
        }
    }
    __syncthreads();
}

__device__ __forceinline__ void mixer(PPtr p, int l, int g, LAS unsigned char* lds, unsigned long long* tscan = nullptr) {
    const int tid = ltid(), w = tid >> 6, lane = tid & 63;
    LAS float* biasL = (LAS float*)(lds + BIAS_OFF);
    for (int i = tid; i < 8 * 465; i += 512) biasL[i] = p->b_rel_bias[(size_t)l * 8 * 465 + i] * LOG2E;
    __syncthreads();
    const int GB = p->GB, NSC = GB * 8, NS = GB * 16;
    const unsigned long long ts0 = tscan ? __builtin_amdgcn_s_memrealtime() : 0ull;
    for (int st = blockIdx.x; st < NS; st += gridDim.x) {
        if (st < NSC) { scan_task<128, true>(p, l, st >> 3, (st >> 1) & 3, st & 1, lds); }
        else { const int s2 = st - NSC; scan_task<64, false>(p, l, s2 >> 3, (s2 >> 1) & 3, s2 & 1, lds); }
    }
    if (tscan) *tscan += __builtin_amdgcn_s_memrealtime() - ts0;
    unsigned* ctr = (unsigned*)p->ws + (l * 16 + g);
    const int NB0 = GB * 32, NB1 = GB * 32, NB2 = (l < DEPTH - 1) ? GB * 4 : 0, NB3 = NB2, NBT = NB0 + NB1 + NB2 + NB3;
    LAS int* tw = (LAS int*)(lds + CTRL_OFF);
    for (;;) {
        if (tid == 0) *tw = (int)atomicAdd(ctr, 1u);
        __syncthreads();
        const int bt = *tw;
        __syncthreads();
        if (bt >= NBT) break;
        int kind, idx;
        if (bt < NB0) { kind = 0; idx = bt * 8 + w; }
        else if (bt < NB0 + NB1) { kind = 1; idx = (bt - NB0) * 8 + w; }
        else if (bt < NB0 + NB1 + NB2) { kind = 2; idx = (bt - NB0 - NB1) * 8 + w; }
        else { kind = 3; idx = (bt - NB0 - NB1 - NB2) * 8 + w; }
        attn_wave(p, l, kind, idx, lane, biasL);
    }
}

__device__ __forceinline__ void postpass(PPtr p, int l, int nrows) {
    const int lane = ltid() & 63, gw = blockIdx.x * 8 + (ltid() >> 6), NGW = gridDim.x * 8, MG = p->MG;
    const bf16_t* Z = (const bf16_t*)(p->ws + p->o_z);
    for (int it = gw; it < nrows * 2; it += NGW) {
        const int row = it >> 1, br = it & 1;
        bf16_t* yf = (bf16_t*)(p->ws + p->o_y4) + (size_t)(2 + br) * MG * 512 + (size_t)row * 512 + lane * 8;
        const bf16_t* yb = (const bf16_t*)(p->ws + p->o_ob) + (size_t)br * MG * 512 + (size_t)row * 512 + lane * 8;
        const u32x4 a = *(const u32x4*)yf, b = *(const u32x4*)yb;
        const u32x4 gt = *(const u32x4*)(Z + (size_t)row * ZW + (br ? ZD_G : ZC_G) + lane * 8);
        const float* gain = (br ? p->d_norm : p->c_norm) + l * 128 + (lane & 15) * 8;
        float o[8], gv[8];
        o[0] = lo16(a.x) + lo16(b.x); o[1] = hi16(a.x) + hi16(b.x); o[2] = lo16(a.y) + lo16(b.y); o[3] = hi16(a.y) + hi16(b.y);
        o[4] = lo16(a.z) + lo16(b.z); o[5] = hi16(a.z) + hi16(b.z); o[6] = lo16(a.w) + lo16(b.w); o[7] = hi16(a.w) + hi16(b.w);
        gv[0] = lo16(gt.x); gv[1] = hi16(gt.x); gv[2] = lo16(gt.y); gv[3] = hi16(gt.y); gv[4] = lo16(gt.z); gv[5] = hi16(gt.z); gv[6] = lo16(gt.w); gv[7] = hi16(gt.w);
        float ss = 0.f;
#pragma unroll
        for (int e = 0; e < 8; ++e) ss += o[e] * o[e];
        ss = row16_sum(ss);
        const float rs = rsqrtf(ss * (1.0f / 128.0f) + EPS);
        const f32x4 g0 = *(const f32x4*)gain, g1 = *(const f32x4*)(gain + 4);
        float y[8];
#pragma unroll
        for (int e = 0; e < 8; ++e) { const float gn = (e < 4) ? g0[e & 3] : g1[e & 3]; y[e] = o[e] * rs * gn * (gv[e] * sigm(gv[e])); }
        u32x4 wv; wv.x = pk2(y[0], y[1]); wv.y = pk2(y[2], y[3]); wv.z = pk2(y[4], y[5]); wv.w = pk2(y[6], y[7]);
        *(u32x4*)yf = wv;
    }
}

#define NOINL __device__ __forceinline__
NOINL void ph_prologue(PPtr pc, LAS unsigned char* lds) { PPtr p = pc; asm volatile("" : "+s"(p)); prologue(p, lds); }
NOINL void ph_rowpass(PPtr pc, int l, int g, int mode, int nrows, int conv_l, LAS unsigned char* lds) { PPtr p = pc; asm volatile("" : "+s"(p)); rowpass(p, l, g, mode, nrows); if (conv_l >= 0) convert_weights(p, conv_l, lds); }
NOINL void ph_rowpass_tail(PPtr pc, int l, int g, int nrows, int conv_l, int nl, int ng, int nrows_next, LAS unsigned char* lds) {
    PPtr p = pc; asm volatile("" : "+s"(p));
    rowpass(p, l, g, 3, nrows);
    if (nl >= 0) rowpass(p, nl, ng, 1, nrows_next);
    if (conv_l >= 0) convert_weights(p, conv_l, lds);
}
NOINL void ph_inproj(PPtr pc, LAS unsigned char* lds) {
    PPtr p = pc; asm volatile("" : "+s"(p)); const int G = (int)gridDim.x, c = (int)blockIdx.x;
    pg8::Gemm gm{(const bf16_t*)(p->ws + p->o_h), (const bf16_t*)(p->ws + p->o_win), p->MG, ZW, 1024, 1024}; pg8::StaticOrder S; S.init(p->MG, ZW, G, c);
    EpiInproj E{(bf16_t*)(p->ws + p->o_z), (bf16_t*)(p->ws + p->o_vta), (bf16_t*)(p->ws + p->o_vtb), (const float*)(p->ws + p->o_rope), p->GB};
    pg8::gemm_phase<EpiInproj, pg8::StaticOrder>(lds, gm, S, E, nullptr);
}
NOINL void ph_mixer(PPtr pc, int l, int g, LAS unsigned char* lds, unsigned long long* tscan = nullptr) { PPtr p = pc; asm volatile("" : "+s"(p)); mixer(p, l, g, lds, tscan); }
NOINL void ph_post(PPtr pc, int l, int nrows) { PPtr p = pc; asm volatile("" : "+s"(p)); postpass(p, l, nrows); }
NOINL void ph_branch(PPtr pc, int Mr, LAS unsigned char* lds) {
    PPtr p = pc; asm volatile("" : "+s"(p)); const int G = (int)gridDim.x, c = (int)blockIdx.x;
    const int LATR = p->GB * 2048, nMfull = p->MG / 256;
    pg8::Gemm gm{(const bf16_t*)(p->ws + p->o_y4), (const bf16_t*)(p->ws + p->o_wb), Mr, 1024, 512, 512};
    { BranchOrder S{LATR / 256, nMfull, G, c};
      EpiBranch E{(const bf16_t*)(p->ws + p->o_z), (bf16_t*)(p->ws + p->o_h), nMfull};
      pg8::gemm_phase<EpiBranch, BranchOrder>(lds, gm, S, E, nullptr); }
    if (Mr > LATR) {
        CtxBranchOrder S{nMfull, LATR / 256, (Mr - LATR) / 256 * 4, G, c};
        EpiBranchCtx E{(const bf16_t*)(p->ws + p->o_z), (bf16_t*)(p->ws + p->o_ob), nMfull, LATR / 256};
        pg8::gemm_phase<EpiBranchCtx, CtxBranchOrder>(lds, gm, S, E, nullptr);
    }
}
NOINL void ph_gemm_f32(PPtr pc, int which, int Mr, LAS unsigned char* lds) {
    PPtr p = pc; asm volatile("" : "+s"(p)); const int G = (int)gridDim.x, c = (int)blockIdx.x;
    const int LATR = p->GB * 2048;
    const bf16_t* hid = (const bf16_t*)(p->ws + p->o_z + (size_t)p->MG * 1024 * 4);
    { const bf16_t* A = which ? hid : (const bf16_t*)(p->ws + p->o_h);
      const bf16_t* Bt = which ? (const bf16_t*)(p->ws + p->o_w2) : (const bf16_t*)(p->ws + p->o_wo);
      const int K = which ? 4096 : 1024;
      pg8::Gemm gm{A, Bt, LATR, 1024, K, K}; pg8::StaticOrder S; S.init(LATR, 1024, G, c);
      EpiBf16Y E{(bf16_t*)(p->ws + p->o_z), 1024};
      pg8::gemm_phase<EpiBf16Y, pg8::StaticOrder>(lds, gm, S, E, nullptr); }
    if (Mr > LATR) {
        const bf16_t* A = which ? hid : ((const bf16_t*)(p->ws + p->o_ob) - (size_t)LATR * 4096);
        const bf16_t* Bt = which ? (const bf16_t*)(p->ws + p->o_w2) : (const bf16_t*)(p->ws + p->o_wo4);
        pg8::Gemm gm{A, Bt, Mr, 1024, 4096, 512};
        SplitOrder S{LATR / 256, (Mr - LATR) / 256, 8, 512, G, c};
        EpiSlab E{(float*)(p->ws + p->o_z + (size_t)p->MG * 12288), LATR / 256, Mr - LATR, 512};
        pg8::gemm_phase<EpiSlab, SplitOrder>(lds, gm, S, E, nullptr);
    }
}
NOINL void ph_ffn1(PPtr pc, int Mr, LAS unsigned char* lds) {
    PPtr p = pc; asm volatile("" : "+s"(p)); const int G = (int)gridDim.x, c = (int)blockIdx.x;
    pg8::Gemm gm{(const bf16_t*)(p->ws + p->o_h), (const bf16_t*)(p->ws + p->o_w1), Mr, 4096, 1024, 1024}; pg8::StaticOrder S; S.init(Mr, 4096, G, c);
    EpiRelu2 E{(bf16_t*)(p->ws + p->o_z + (size_t)p->MG * 1024 * 4), 4096};
    pg8::gemm_phase<EpiRelu2, pg8::StaticOrder>(lds, gm, S, E, nullptr);
}

#define XB_SETUP() volatile LAS unsigned* xb_st = (volatile LAS unsigned*)(lds + CTRL_OFF + 64); unsigned* xb_bar = (unsigned*)(pc->ws + 4096); { XcdBarrier xb0 = xcd_barrier_post(xb_bar, xb_st); (void)xb0; }
#define GSYNC() { XcdBarrier xb_; xb_.bar = (unsigned*)(pc->ws + 4096); xb_.x = xb_xcc_id(); xb_.st = (volatile LAS unsigned*)(lds + CTRL_OFF + 64); xcd_barrier(xb_); }
#ifdef PROBE_MASK
__global__ void __launch_bounds__(512) hybrid_fwd(Params pk) {
    extern __shared__ __attribute__((aligned(16))) unsigned char smem[];
    LAS unsigned char* lds = (LAS unsigned char*)smem;
    cg::grid_group grid = cg::this_grid();
    PPtr pc = (PPtr)__builtin_amdgcn_kernarg_segment_ptr();
    const int GB = pc->GB, MG = pc->MG, NGRP = pc->NGRP, LATR = GB * 2048;
    unsigned long long tacc = 0, t0_ = __builtin_amdgcn_s_memrealtime();
#define PT(kind) { const unsigned long long t1_ = __builtin_amdgcn_s_memrealtime(); if ((PROBE_MASK >> (kind)) & 1) tacc += t1_ - t0_; t0_ = t1_; }
    ph_prologue(pc, lds);
    grid.sync();
    XB_SETUP(); PT(0)
    for (int l = 0; l < DEPTH; ++l) {
        const int Mr = (l < DEPTH - 1) ? MG : LATR;
        for (int g = 0; g < NGRP; ++g) {
            ph_rowpass(pc, l, g, 1, MG, -1, lds);
            GSYNC(); PT(1)
            ph_inproj(pc, lds);
            GSYNC(); PT(2)
            { unsigned long long tsc = 0; ph_mixer(pc, l, g, lds, &tsc); if ((PROBE_MASK >> 11) & 1) tacc += tsc; }
            GSYNC(); PT(3)
            ph_post(pc, l, Mr);
            GSYNC(); PT(4)
            ph_branch(pc, Mr, lds);
            GSYNC(); PT(5)
            ph_gemm_f32(pc, 0, Mr, lds);
            GSYNC(); PT(6)
            ph_rowpass(pc, l, g, 2, Mr, -1, lds);
            GSYNC(); PT(7)
            ph_ffn1(pc, Mr, lds);
            GSYNC(); PT(8)
            ph_gemm_f32(pc, 1, Mr, lds);
            GSYNC(); PT(9)
            ph_rowpass(pc, l, g, 3, Mr, (g == NGRP - 1 && l + 1 < DEPTH) ? l + 1 : -1, lds);
            GSYNC(); PT(10)
        }
    }
    if (blockIdx.x == 0) { const unsigned M = (unsigned)(tacc / 100ull); float* o = pc->out; for (unsigned i2 = threadIdx.x; i2 < M; i2 += 512) o[i2] += 0.125f; }
}

#else
__global__ void __launch_bounds__(512) hybrid_fwd(Params pk) {
    extern __shared__ __attribute__((aligned(16))) unsigned char smem[];
    LAS unsigned char* lds = (LAS unsigned char*)smem;
    cg::grid_group grid = cg::this_grid();
    PPtr pc = (PPtr)__builtin_amdgcn_kernarg_segment_ptr();
    const int GB = pc->GB, MG = pc->MG, NGRP = pc->NGRP, LATR = GB * 2048;
    ph_prologue(pc, lds);
    grid.sync();
    XB_SETUP();
    for (int l = 0; l < DEPTH; ++l) {
        const int Mr = (l < DEPTH - 1) ? MG : LATR;
        for (int g = 0; g < NGRP; ++g) {
            if ((l == 0 && g == 0) || NGRP == 1) { ph_rowpass(pc, l, g, 1, MG, -1, lds); GSYNC(); }
            ph_inproj(pc, lds);
            GSYNC();
            ph_mixer(pc, l, g, lds);
            GSYNC();
            ph_post(pc, l, Mr);
            GSYNC();
            ph_branch(pc, Mr, lds);
            GSYNC();
            ph_gemm_f32(pc, 0, Mr, lds);
            GSYNC();
            ph_rowpass(pc, l, g, 2, Mr, -1, lds);
            GSYNC();
            ph_ffn1(pc, Mr, lds);
            GSYNC();
            ph_gemm_f32(pc, 1, Mr, lds);
            GSYNC();
            {
                const bool lastg = (g == NGRP - 1);
                const int nl = (NGRP == 1) ? -1 : (lastg ? (l + 1 < DEPTH ? l + 1 : -1) : l), ng = lastg ? 0 : g + 1;
                ph_rowpass_tail(pc, l, g, Mr, (lastg && l + 1 < DEPTH) ? l + 1 : -1, nl, ng, MG, lds);
            }
            if (!(l == DEPTH - 1 && g == NGRP - 1)) GSYNC();
        }
    }
}

#endif
extern "C" void kernel_launch(void* const* d_in, const int* in_sizes, int n_in, void* d_out, int out_size, void* d_ws, size_t ws_size, hipStream_t stream) {
    static int grid_blocks = 0;
    if (grid_blocks == 0) {
        int dev = 0, cus = 0, per_cu = 0;
        hipGetDevice(&dev);
        hipDeviceGetAttribute(&cus, hipDeviceAttributeMultiprocessorCount, dev);
        if (hipFuncSetAttribute((const void*)hybrid_fwd, hipFuncAttributeMaxDynamicSharedMemorySize, LDS_BYTES) != hipSuccess) fprintf(stderr, "hipFuncSetAttribute failed\n");
        if (hipOccupancyMaxActiveBlocksPerMultiprocessor(&per_cu, (const void*)hybrid_fwd, 512, LDS_BYTES) != hipSuccess || per_cu < 1) { fprintf(stderr, "occupancy query: %d\n", per_cu); per_cu = 1; }
        (void)hipGetLastError();
        grid_blocks = cus * 1;
        if (grid_blocks <= 0) grid_blocks = 256;
    }
    Params p{};
    const float* const* in = (const float* const*)d_in;
    p.x = in[0]; p.c = in[1]; p.ctx = in[2]; p.c_ctx = in[3]; p.w_mod = in[4]; p.b_mod = in[5]; p.norm_gains = in[6]; p.w_in = in[7]; p.a_sink = in[8]; p.b_rel_bias = in[9];
    p.c_lb = in[10]; p.c_norm = in[11]; p.d_gate_up = in[12]; p.d_gate_bias = in[13]; p.d_norm = in[14]; p.w_branch = in[15]; p.w_out = in[16]; p.w_ff1 = in[17]; p.w_ff2 = in[18];
    p.out = (float*)d_out; p.ws = (unsigned char*)d_ws;
    auto al = [](unsigned long long v) { return (v + 255ull) & ~255ull; };
    unsigned long long off = 32768;
    p.o_mod = off; off = al(off + 4ull * 17 * 6144 * 4);
    p.o_lb = off; off = al(off + 4ull * 512 * 4);
    p.o_rope = off; off = al(off + 2048ull * 4);
    p.o_xc = off; off = al(off + 4096ull * 1024 * 4);
    p.o_win = off; off = al(off + (unsigned long long)ZW * 1024 * 2);
    p.o_wb = off; off = al(off + 4096ull * 512 * 2);
    p.o_wo = off; off = al(off + 1024ull * 1024 * 2);
    p.o_w1 = off; off = al(off + 4096ull * 1024 * 2);
    p.o_w2 = off; off = al(off + 1024ull * 4096 * 2);
    p.o_wo4 = off; off = al(off + 1024ull * 4096 * 2);
    const unsigned long long fixed = off;
    int GB = 16;
    for (; GB > 1; GB >>= 1) {
        const unsigned long long MGt = (unsigned long long)GB * 2304;
        const unsigned long long need = fixed + MGt * (2048ull + (unsigned long long)ZW * 2 + 4096ull + 2048ull) + (unsigned long long)GB * 10 * 64 * VTS * 2 + 8 * 256;
        if (need <= (unsigned long long)ws_size) break;
    }
    p.GB = GB; p.NGRP = 16 / GB; p.MG = GB * 2304;
    const unsigned long long MGu = (unsigned long long)p.MG;
    p.o_h = off; off = al(off + MGu * 1024 * 2);
    p.o_z = off; off = al(off + MGu * ZW * 2);
    p.o_y4 = off; off = al(off + MGu * 2048 * 2);
    p.o_ob = off; off = al(off + MGu * 1024 * 2);
    p.o_vta = off; off = al(off + (unsigned long long)GB * 2 * 64 * VTS * 2);
    p.o_vtb = off; off = al(off + (unsigned long long)GB * 8 * 64 * VTS * 2);
    hipMemsetAsync(d_ws, 0, 32768, stream);
    void* args[] = {&p};
    hipError_t e = hipLaunchCooperativeKernel((const void*)hybrid_fwd, dim3(grid_blocks), dim3(512), args, LDS_BYTES, stream);
    if (e != hipSuccess) fprintf(stderr, "cooperative launch failed: %s (grid %d)\n", hipGetErrorString(e), grid_blocks);
}
```

```cpp
#include <hip/hip_runtime.h>
#include <hip/hip_cooperative_groups.h>
#include <cstdio>
namespace cg = cooperative_groups;
__device__ __forceinline__ int ltid() { int t = (int)threadIdx.x; asm volatile("" : "+v"(t)); return t; }
#define LAS __attribute__((address_space(3)))
namespace pg8 {
#define PG8_LAS __attribute__((address_space(3)))
typedef unsigned short bf16_t;
typedef short bf16x8 __attribute__((ext_vector_type(8)));
typedef float f32x4 __attribute__((ext_vector_type(4)));
typedef unsigned u32x4 __attribute__((ext_vector_type(4)));
constexpr int BM = 256, BK = 64, HALF = 128, HTB = HALF * BK * 2  , STAGE_BYTES = 8 * HTB, NXCD = 8, WGM = 8;

__host__ __device__ __forceinline__ int lds_byte(int r, int c) { const int st = (r >> 4) * 2 + (c >> 5), rr = r & 15, cc = c & 31, ob = rr * 64 + cc * 2; return st * 1024 + (ob ^ (((ob >> 9) & 1) << 5)); }
__host__ __device__ __forceinline__ void stage_rc(int b, int& R, int& C) { const int st = b / 1024, sb = b % 1024, swz = sb ^ (((sb >> 9) & 1) << 5); R = (st >> 1) * 16 + swz / 64; C = (st & 1) * 32 + (swz % 64) / 2; }
__host__ __device__ __forceinline__ int perm32(int rho) { const int n = rho >> 4, i = rho & 15; return 8 * (i >> 2) + 4 * n + (i & 3); }

struct Unit { int pm, pn, ko; };
struct Gemm { const bf16_t* A; const bf16_t* Bt; int M, N, K, Kl; };

struct StaticOrder {
    int nM, nN, nwg, G, c;
    __host__ __device__ void init(int M, int N, int G_, int c_) { nM = M / BM; nN = N / BM; nwg = nM * nN; G = G_; c = c_; }
    __host__ __device__ bool next(int i, Unit& u) const {
        const long L = (long)i * G + c; if (L >= nwg) return false;
        int wgid = (int)L; { const int q = nwg / NXCD, r = nwg % NXCD, xcd = wgid % NXCD, off = wgid / NXCD; wgid = (xcd < r ? xcd * (q + 1) : r * (q + 1) + (xcd - r) * q) + off; }
        const int nig = WGM * nN, gid = wgid / nig, fm = gid * WGM, gsz = (nM - fm) < WGM ? (nM - fm) : WGM;
        u.pm = fm + ((wgid % nig) % gsz); u.pn = (wgid % nig) / gsz; u.ko = 0; return true;
    }
    __device__ __forceinline__ void a_ready(const Unit&) const {}
    __device__ __forceinline__ void done(const Unit&) const {}
};
__device__ __forceinline__ unsigned cvt_pk_bf16(float lo, float hi) { unsigned r; asm volatile("v_cvt_pk_bf16_f32 %0, %1, %2" : "=v"(r) : "v"(lo), "v"(hi)); return r; }
struct EpiF32 {
    static constexpr bool PERM = false, AFTER_DRAIN = false;
    float* C; int ldc; const float* bias;
    __device__ __forceinline__ void operator()(const f32x4 (&acc)[2][2][4][2], const Unit& u, int wr, int wc, int fr, int fq) const {
        const int row0 = u.pm * BM + wr * 64 + fr, col0 = u.pn * BM + wc * 32 + 4 * fq;
        f32x4 bv[2][2];
#pragma unroll
        for (int bj = 0; bj < 2; ++bj)
#pragma unroll
            for (int n = 0; n < 2; ++n) bv[bj][n] = bias ? *(const f32x4*)(bias + col0 + bj * HALF + n * 16) : (f32x4){0.f, 0.f, 0.f, 0.f};
#pragma unroll
        for (int ai = 0; ai < 2; ++ai)
#pragma unroll
            for (int m = 0; m < 4; ++m) { float* rowp = C + (size_t)(row0 + ai * HALF + m * 16) * ldc + col0;
#pragma unroll
                for (int bj = 0; bj < 2; ++bj)
#pragma unroll
                    for (int n = 0; n < 2; ++n) *(f32x4*)(rowp + bj * HALF + n * 16) = acc[ai][bj][m][n] + bv[bj][n]; }
    }
};
template <class Epi, class Sched, bool STAMP = false>
__device__ __forceinline__ void gemm_phase(PG8_LAS unsigned char* lds, const Gemm g, const Sched& S, const Epi& E, unsigned long long* stamps) {
    const int tid = ltid(), wid = __builtin_amdgcn_readfirstlane(tid >> 6), lane = tid & 63, wr = wid >> 2, wc = wid & 3, fr = lane & 15, fq = lane >> 4;
    const int K = g.K, nt = g.Kl / BK;
    int ts_lo = 0, ts_hi = 0, nts = 0; const unsigned long long rt_entry = STAMP ? (unsigned long long)wall_clock64() : 0ull;
#define PG8_STAMP() do { if (STAMP && wid == 0 && nts < 64) { const unsigned long long _c = (unsigned long long)clock64(); \
        ts_lo = (lane == nts) ? (int)(unsigned)_c : ts_lo; ts_hi = (lane == nts) ? (int)(unsigned)(_c >> 32) : ts_hi; ++nts; } } while (0)
    PG8_STAMP();
    unsigned voffA[2], voffB[2];
#pragma unroll
    for (int i = 0; i < 2; ++i) { int R, C; stage_rc(tid * 16 + i * 8192, R, C); const int Rb = Epi::PERM ? ((R & ~31) + perm32(R & 31)) : R;
        voffA[i] = (unsigned)(R * K + C) * 2u; voffB[i] = (unsigned)(Rb * K + C) * 2u; }
    const size_t kstep = (size_t)(BK * 2);
    const size_t hstep = (size_t)HALF * K * 2;
    const size_t tstep = 2 * hstep;
    const unsigned ldsw = (unsigned)wid * 1024u;
    const int aoff = lds_byte(wr * 64 + fr, fq * 8), boff = lds_byte(wc * 32 + fr, fq * 8);
#define PG8_SA(b, h) (((b) * 2 + (h)) * HTB)
#define PG8_SB(b, h) ((4 + (b) * 2 + (h)) * HTB)
#define PG8_STAGE(bufoff, gbase, voff) do { _Pragma("unroll") for (int _i = 0; _i < 2; ++_i) \
        __builtin_amdgcn_global_load_lds((const unsigned*)((const char*)(gbase) + (voff)[_i]), (PG8_LAS unsigned*)(lds + (bufoff) + ldsw + _i * 8192), 16, 0, 0); } while (0)
#define PG8_LDA(dst, b, h) do { _Pragma("unroll") for (int m = 0; m < 4; ++m) _Pragma("unroll") for (int k = 0; k < 2; ++k) dst[m][k] = *(const PG8_LAS bf16x8*)(lds + PG8_SA(b, h) + aoff + m * 2048 + k * 1024); } while (0)
#define PG8_LDB(dst, b, h) do { _Pragma("unroll") for (int n = 0; n < 2; ++n) _Pragma("unroll") for (int k = 0; k < 2; ++k) dst[n][k] = *(const PG8_LAS bf16x8*)(lds + PG8_SB(b, h) + boff + n * 2048 + k * 1024); } while (0)
#define PG8_MMA(ai, bj, At, Bt) do { __builtin_amdgcn_s_setprio(1); _Pragma("unroll") for (int m = 0; m < 4; ++m) _Pragma("unroll") for (int n = 0; n < 2; ++n) _Pragma("unroll") for (int k = 0; k < 2; ++k) \
        acc[ai][bj][m][n] = __builtin_amdgcn_mfma_f32_16x16x32_bf16(Bt[n][k], At[m][k], acc[ai][bj][m][n], 0, 0, 0); __builtin_amdgcn_s_setprio(0); } while (0)
#define PG8_WAIT_V(n) asm volatile("s_waitcnt vmcnt(" #n ")" ::: "memory")
#define PG8_WAIT_L(n) asm volatile("s_waitcnt lgkmcnt(" #n ")" ::: "memory")
#define PG8_BAR __builtin_amdgcn_s_barrier()
#define PG8_SCHED __builtin_amdgcn_sched_barrier(0)
    Unit cur, nxt; int ui = 0;
    if (!S.next(0, cur)) return;
    f32x4 acc[2][2][4][2];
#pragma unroll
    for (int a = 0; a < 2; ++a)
#pragma unroll
        for (int b = 0; b < 2; ++b)
#pragma unroll
            for (int m = 0; m < 4; ++m)
#pragma unroll
                for (int n = 0; n < 2; ++n) acc[a][b][m][n] = (f32x4){0.f, 0.f, 0.f, 0.f};
    bf16x8 At[4][2], B0[2][2], B1[2][2];
    const char* cA = (const char*)g.A + (size_t)cur.pm * tstep + (size_t)cur.ko * 2; const char* cB = (const char*)g.Bt + (size_t)cur.pn * tstep + (size_t)cur.ko * 2;
    S.a_ready(cur);
    PG8_STAGE(PG8_SB(0, 0), cB, voffB); PG8_STAGE(PG8_SA(0, 0), cA, voffA); PG8_STAGE(PG8_SB(0, 1), cB + hstep, voffB); PG8_STAGE(PG8_SA(0, 1), cA + hstep, voffA);
    if (wr == 1) PG8_BAR;
    PG8_WAIT_V(4); PG8_BAR;
    PG8_STAGE(PG8_SB(1, 0), cB + kstep, voffB); PG8_STAGE(PG8_SA(1, 0), cA + kstep, voffA); PG8_STAGE(PG8_SB(1, 1), cB + hstep + kstep, voffB);
    PG8_WAIT_V(6); PG8_BAR;
    PG8_STAMP();
    for (;;) {
        const bool has_next = S.next(ui + 1, nxt);
        const char* nA = has_next ? (const char*)g.A + (size_t)nxt.pm * tstep + (size_t)nxt.ko * 2 : cA; const char* nB = has_next ? (const char*)g.Bt + (size_t)nxt.pn * tstep + (size_t)nxt.ko * 2 : cB;
        for (int t = 0; t < nt; t += 2) {
            const bool last = (t == nt - 2);
            const char* a1 = cA + (size_t)(t + 1) * kstep;
            const char* a2 = last ? nA : cA + (size_t)(t + 2) * kstep; const char* b2 = last ? nB : cB + (size_t)(t + 2) * kstep;
            const char* a3 = a2 + kstep; const char* b3 = b2 + kstep;
            if (last && has_next) S.a_ready(nxt);
            PG8_LDB(B0, 0, 0); PG8_SCHED; PG8_LDA(At, 0, 0); PG8_STAGE(PG8_SA(1, 1), a1 + hstep, voffA);
            PG8_WAIT_L(8); PG8_BAR; PG8_WAIT_L(0); PG8_MMA(0, 0, At, B0); PG8_BAR; PG8_SCHED;
            PG8_LDB(B1, 0, 1); PG8_STAGE(PG8_SB(0, 0), b2, voffB);
            PG8_BAR; PG8_WAIT_L(0); PG8_MMA(0, 1, At, B1); PG8_BAR;
            PG8_LDA(At, 0, 1); PG8_STAGE(PG8_SA(0, 0), a2, voffA);
            PG8_BAR; PG8_WAIT_L(0); PG8_MMA(1, 0, At, B0); PG8_BAR; PG8_SCHED;
            PG8_STAGE(PG8_SB(0, 1), b2 + hstep, voffB);
            PG8_WAIT_V(6); PG8_BAR; PG8_MMA(1, 1, At, B1); PG8_BAR;
            PG8_LDB(B0, 1, 0); PG8_SCHED; PG8_LDA(At, 1, 0); PG8_STAGE(PG8_SA(0, 1), a2 + hstep, voffA);
            PG8_WAIT_L(8); PG8_BAR; PG8_WAIT_L(0); PG8_MMA(0, 0, At, B0); PG8_BAR; PG8_SCHED;
            PG8_LDB(B1, 1, 1); PG8_STAGE(PG8_SB(1, 0), b3, voffB);
            PG8_BAR; PG8_WAIT_L(0); PG8_MMA(0, 1, At, B1); PG8_BAR;
            PG8_LDA(At, 1, 1); PG8_STAGE(PG8_SA(1, 0), a3, voffA);
            PG8_BAR; PG8_WAIT_L(0); PG8_MMA(1, 0, At, B0); PG8_BAR; PG8_SCHED;
            PG8_STAGE(PG8_SB(1, 1), b3 + hstep, voffB);
            PG8_WAIT_V(6); PG8_BAR; PG8_MMA(1, 1, At, B1); PG8_BAR;
        }
        PG8_STAMP();
        if constexpr (!Epi::AFTER_DRAIN) { E(acc, cur, wr, wc, fr, fq); S.done(cur); }
        PG8_STAMP();
        if (!has_next) break;
#pragma unroll
        for (int a = 0; a < 2; ++a)
#pragma unroll
            for (int b = 0; b < 2; ++b)
#pragma unroll
                for (int m = 0; m < 4; ++m)
#pragma unroll
                    for (int n = 0; n < 2; ++n) acc[a][b][m][n] = (f32x4){0.f, 0.f, 0.f, 0.f};
        cur = nxt; cA = nA; cB = nB; ++ui;
    }
    PG8_WAIT_V(0);
    if (wr == 0) PG8_BAR;
    PG8_BAR;
    if constexpr (Epi::AFTER_DRAIN) { E.fused(acc, cur, wr, wc, fr, fq, lds, wid, lane); S.done(cur); }
    PG8_STAMP();
    if (STAMP && wid == 0) { stamps[lane] = lane < nts ? (((unsigned long long)(unsigned)ts_hi << 32) | (unsigned)ts_lo) : 0ull;
        if (lane == 62) stamps[62] = rt_entry; if (lane == 63) stamps[63] = (unsigned long long)wall_clock64(); }
#undef PG8_STAMP
#undef PG8_SA
#undef PG8_SB
#undef PG8_STAGE
#undef PG8_LDA
#undef PG8_LDB
#undef PG8_MMA
#undef PG8_WAIT_V
#undef PG8_WAIT_L
#undef PG8_BAR
#undef PG8_SCHED
}
}
#define XB_TMO      128
#define XB_XCNT(j)  (256  + 64 * (j))
#define XB_XSUB(j)  (1280 + 64 * (j))
#define XB_XGEN(j)  (2304 + 64 * (j))
#define XB_TOP      3328
#define XB_TOPGEN   3392
#define XCD_BAR_WORDS 3456
#define XB_SPIN_CAP (1u << 18)

__device__ __forceinline__ unsigned xb_ld(unsigned* p)              { return __hip_atomic_load(p, __ATOMIC_RELAXED, __HIP_MEMORY_SCOPE_AGENT); }
__device__ __forceinline__ unsigned xb_add(unsigned* p, unsigned v) { return __hip_atomic_fetch_add(p, v, __ATOMIC_RELAXED, __HIP_MEMORY_SCOPE_AGENT); }
__device__ __forceinline__ unsigned xb_xcc_id() { return (unsigned)__builtin_amdgcn_s_getreg((3 << 11) | 20) & 0xFu; }
#define XB_SPIN(cond, bar) do { unsigned _sp = 0; while (cond) { __builtin_amdgcn_s_sleep(1); \
    if ((++_sp & 255u) == 0u) { if (xb_ld(&(bar)[XB_TMO])) break; if (_sp > XB_SPIN_CAP) { atomicAdd(&(bar)[XB_TMO], 1u); break; } } } } while (0)

struct XcdBarrier {
    unsigned* bar; unsigned x;
    volatile LAS unsigned* st;
};

__device__ __forceinline__ XcdBarrier xcd_barrier_post(unsigned* bar, volatile LAS unsigned* st) {
    XcdBarrier b; b.bar = bar; b.x = xb_xcc_id(); b.st = st;
    if (threadIdx.x == 0) (void)xb_add(&bar[XB_XCNT(b.x)], 1u);
    return b;
}
__device__ __forceinline__ void xcd_barrier_complete(unsigned* bar, unsigned x, unsigned& nloc, unsigned& nx) {
    const unsigned G = gridDim.x * gridDim.y * gridDim.z;
    unsigned sum, cnt, mine, sp = 0u;
    for (;;) {
        sum = 0u; cnt = 0u; mine = 0u;
#pragma unroll
        for (unsigned j = 0; j < 16; ++j) { const unsigned c = xb_ld(&bar[XB_XCNT(j)]); sum += c; cnt += (c > 0u) ? 1u : 0u; mine = (j == x) ? c : mine; }
        if (sum == G) break;
        __builtin_amdgcn_s_sleep(1);
        if ((++sp & 255u) == 0u) { if (xb_ld(&bar[XB_TMO])) break; if (sp > XB_SPIN_CAP) { atomicAdd(&bar[XB_TMO], 1u); break; } }
    }
    nloc = mine > 0u ? mine : 1u; nx = cnt > 0u ? cnt : 1u;
}

__device__ __forceinline__ void xcd_barrier(const XcdBarrier& b) {
    asm volatile("s_waitcnt vmcnt(0)" ::: "memory");
    __syncthreads();
    if (threadIdx.x == 0) {
        unsigned* bar = b.bar;
        __builtin_amdgcn_s_waitcnt(0);
        unsigned nloc = b.st[0], nx = b.st[1];
        if (nloc == 0u) { xcd_barrier_complete(bar, b.x, nloc, nx); b.st[0] = nloc; b.st[1] = nx; }
        const unsigned old = xb_add(&bar[XB_XSUB(b.x)], 1u);
        const unsigned gen = old / nloc;
        if (old + 1u == (gen + 1u) * nloc) {
            __builtin_amdgcn_fence(__ATOMIC_RELEASE, "agent");
            asm volatile("s_waitcnt vmcnt(0)" ::: "memory");
            const unsigned og = xb_add(&bar[XB_TOP], 1u);
            const unsigned tg = og / nx;
            if (og + 1u == (tg + 1u) * nx) xb_add(&bar[XB_TOPGEN], 1u);
            else XB_SPIN(xb_ld(&bar[XB_TOPGEN]) == tg, bar);
            __builtin_amdgcn_fence(__ATOMIC_ACQUIRE, "agent");
            xb_add(&bar[XB_XGEN(b.x)], 1u);
            asm volatile("s_waitcnt vmcnt(0)" ::: "memory");
        } else {
            XB_SPIN(xb_ld(&bar[XB_XGEN(b.x)]) == gen, bar);
            __builtin_amdgcn_fence(__ATOMIC_ACQUIRE, "agent");
            asm volatile("s_waitcnt vmcnt(0)" ::: "memory");
        }
    }
    __syncthreads();
}

typedef unsigned short bf16_t;
typedef pg8::bf16x8 bf16x8;
typedef pg8::f32x4 f32x4;
typedef pg8::u32x4 u32x4;
typedef unsigned u32x2 __attribute__((ext_vector_type(2)));

constexpr int DM = 1024, NB = 16, SEQ = 2048, DEPTH = 4, CTXL = 256, DFF = 4096;
constexpr int ZW = 10752;
constexpr int INW = 10528;
constexpr int ZA_Q = 0, ZA_K = 512, ZA_V = 640, ZB_Q = 768, ZB_K = 1280, ZB_V = 1792, ZC_Q = 2304, ZC_FF = 2816, ZC_FB = 3328, ZC_I = 3840, ZC_G = 4352,
              ZD_Q = 4864, ZD_K = 5120, ZD_V = 5376, ZD_GK = 5888, ZD_G = 6016, ZMERGE = 6656;
constexpr int VTS = 2304;
constexpr int LDS_BYTES = 144 * 1024;
constexpr int CTRL_OFF = LDS_BYTES - 256;
constexpr float EPS = 1e-6f;
constexpr float LOG2E = 1.4426950408889634f;
constexpr float QSCALE2 = 0.125f * LOG2E;

struct Params {
    const float *x, *c, *ctx, *c_ctx, *w_mod, *b_mod, *norm_gains, *w_in, *a_sink, *b_rel_bias, *c_lb, *c_norm, *d_gate_up, *d_gate_bias, *d_norm, *w_branch, *w_out, *w_ff1, *w_ff2;
    float* out;
    unsigned char* ws;
    unsigned long long o_mod, o_lb, o_rope, o_xc, o_win, o_wb, o_wo, o_w1, o_w2, o_h, o_z, o_y4, o_ob, o_vta, o_vtb, o_wo4;
    int GB, NGRP, MG, pad0;
};
typedef const Params __attribute__((address_space(4)))* PPtr;

__device__ __forceinline__ float bf2f(unsigned v) { return __uint_as_float(v << 16); }
__device__ __forceinline__ bf16_t f2bf(float f) { unsigned u = __float_as_uint(f); u += 0x7FFFu + ((u >> 16) & 1u); return (bf16_t)(u >> 16); }
typedef __bf16 bf16v2_t __attribute__((ext_vector_type(2)));
typedef float f32v2_t __attribute__((ext_vector_type(2)));
__device__ __forceinline__ unsigned pk2(float lo, float hi) { const f32v2_t v = {lo, hi}; const bf16v2_t b = __builtin_convertvector(v, bf16v2_t); return __builtin_bit_cast(unsigned, b); }
template <int CTRL> __device__ __forceinline__ float dpp(float x) { return __builtin_bit_cast(float, __builtin_amdgcn_mov_dpp(__builtin_bit_cast(int, x), CTRL, 0xf, 0xf, true)); }
constexpr int XOR1 = 0xB1, XOR2 = 0x4E, XOR7 = 0x141, XOR8 = 0x128;
__device__ __forceinline__ float xrow16_max(float x) {
    auto s = __builtin_amdgcn_permlane16_swap(__float_as_uint(x), __float_as_uint(x), false, false);
    x = fmaxf(__uint_as_float(s[0]), __uint_as_float(s[1]));
    auto t = __builtin_amdgcn_permlane32_swap(__float_as_uint(x), __float_as_uint(x), false, false);
    return fmaxf(__uint_as_float(t[0]), __uint_as_float(t[1]));
}
__device__ __forceinline__ float xrow16_sum(float x) {
    auto s = __builtin_amdgcn_permlane16_swap(__float_as_uint(x), __float_as_uint(x), false, false);
    x = __uint_as_float(s[0]) + __uint_as_float(s[1]);
    auto t = __builtin_amdgcn_permlane32_swap(__float_as_uint(x), __float_as_uint(x), false, false);
    return __uint_as_float(t[0]) + __uint_as_float(t[1]);
}
__device__ __forceinline__ float row16_sum(float v) {
    v += dpp<XOR1>(v); v += dpp<XOR2>(v); v += dpp<XOR7>(v); v += dpp<XOR8>(v);
    return v;
}
__device__ __forceinline__ float wave_sum(float v) { return xrow16_sum(row16_sum(v)); }
__device__ __forceinline__ float lo16(unsigned w) { return __uint_as_float(w << 16); }
__device__ __forceinline__ float hi16(unsigned w) { return __uint_as_float(w & 0xffff0000u); }
__device__ __forceinline__ float sigm(float x) { return __builtin_amdgcn_rcpf(1.0f + __builtin_amdgcn_exp2f(-LOG2E * x)); }
__device__ __forceinline__ bf16_t f2bf1(float x) { return (bf16_t)pk2(x, 0.f); }

__device__ __forceinline__ int src_col(int n) {
    if (n < 640) {
        const int p = n & 63, base = n - p, pp = p >> 1, wh = p & 1;
        const int dim = (pp < 16) ? (wh ? 16 + pp : pp) : (wh ? 48 + (pp - 16) : 32 + (pp - 16));
        return base + dim;
    }
    if (n < 5920) return n;
    if (n < 6016) return -1;
    if (n < 6528) return n - 96;
    if (n < 6656) return -1;
    return 6432 + (n - 6656);
}

__device__ __forceinline__ void conv_tile(const float* src, int Nsrc, int k0, int n0, bool inmap, bf16_t* dst, int Kd, LAS float* t) {
    const int tid = ltid(), nl = tid & 63, ks = tid >> 6;
    const int sc = inmap ? src_col(n0 + nl) : (n0 + nl);
#pragma unroll
    for (int i = 0; i < 8; ++i) { const int kk = ks + 8 * i; t[nl * 65 + kk] = (sc >= 0) ? src[(size_t)(k0 + kk) * Nsrc + sc] : 0.f; }
    __syncthreads();
    const int kl = (tid & 31) * 2, ns = tid >> 5;
#pragma unroll
    for (int i = 0; i < 4; ++i) { const int n = ns + 16 * i; *(unsigned*)(dst + (size_t)(n0 + n) * Kd + k0 + kl) = pk2(t[n * 65 + kl], t[n * 65 + kl + 1]); }
    __syncthreads();
}
__device__ __forceinline__ void convert_weights(PPtr p, int l, LAS unsigned char* lds) {
    LAS float* t = (LAS float*)lds;
    bf16_t* WinT = (bf16_t*)(p->ws + p->o_win); bf16_t* WbT = (bf16_t*)(p->ws + p->o_wb); bf16_t* WoT = (bf16_t*)(p->ws + p->o_wo);
    bf16_t* W1T = (bf16_t*)(p->ws + p->o_w1); bf16_t* W2T = (bf16_t*)(p->ws + p->o_w2);
    constexpr int T_IN = 16 * 168, T_BR = 4 * 8 * 16, T_O = 16 * 16, T_1 = 16 * 64, T_2 = 64 * 16, T_ALL = T_IN + T_BR + T_O + T_1 + T_2;
    for (int it = blockIdx.x; it < T_ALL; it += gridDim.x) {
        int r = it;
        if (r < T_IN) { const int kb = r / 168, nb = r % 168; conv_tile(p->w_in + (size_t)l * 1024 * INW, INW, kb * 64, nb * 64, true, WinT, 1024, t); continue; } r -= T_IN;
        if (r < T_BR) { const int j = r / 128, q = r % 128, kb = q / 16, nb = q % 16; conv_tile(p->w_branch + (size_t)(l * 4 + j) * 512 * 1024, 1024, kb * 64, nb * 64, false, WbT + (size_t)j * 1024 * 512, 512, t); continue; } r -= T_BR;
        if (r < T_O) { const int kb = r / 16, nb = r % 16; conv_tile(p->w_out + (size_t)l * 1024 * 1024, 1024, kb * 64, nb * 64, false, WoT, 1024, t);
#pragma unroll 1
            for (int cpy = 0; cpy < 4; ++cpy) conv_tile(p->w_out + (size_t)l * 1024 * 1024, 1024, kb * 64, nb * 64, false, (bf16_t*)(p->ws + p->o_wo4) + cpy * 1024, 4096, t);
            continue; } r -= T_O;
        if (r < T_1) { const int kb = r / 64, nb = r % 64; conv_tile(p->w_ff1 + (size_t)l * 1024 * 4096, 4096, kb * 64, nb * 64, false, W1T, 1024, t); continue; } r -= T_1;
        { const int kb = r / 16, nb = r % 16; conv_tile(p->w_ff2 + (size_t)l * 4096 * 1024, 1024, kb * 64, nb * 64, false, W2T, 4096, t); }
    }
}

__device__ __forceinline__ void prologue(PPtr p, LAS unsigned char* lds) {
    const int tid = ltid();
    if (blockIdx.x == 0) {
        if (tid < 64) atomicExch((unsigned*)p->ws + tid, 0u);
        for (int i = tid; i < XCD_BAR_WORDS; i += 512) __hip_atomic_store((unsigned*)(p->ws + 4096) + i, 0u, __ATOMIC_RELAXED, __HIP_MEMORY_SCOPE_AGENT);
    }
    if (tid < 4) *((LAS unsigned*)(lds + CTRL_OFF + 64) + tid) = 0u;
    float* modb = (float*)(p->ws + p->o_mod);
    LAS float* sl = (LAS float*)lds;
    LAS float* red = sl + 17 * 1024;
    bool loaded = false;
    for (int task = blockIdx.x; task < 192; task += gridDim.x) {
        if (!loaded) {
            for (int i = tid; i < 17 * 1024; i += 512) { const int b = i >> 10, k = i & 1023; const float v = (b < 16) ? p->c[b * 1024 + k] : p->c_ctx[k]; sl[i] = v * sigm(v); }
            loaded = true;
        }
        __syncthreads();
        const int l = task / 48, nc = task % 48, nn = tid & 127, n = nc * 128 + nn, kq = tid >> 7;
        float acc[17];
#pragma unroll
        for (int b = 0; b < 17; ++b) acc[b] = 0.f;
        const float* w = p->w_mod + ((size_t)l * 1024 + kq * 256) * 6144 + n;
#pragma unroll 4
        for (int k = 0; k < 256; ++k) {
            const float wv = w[(size_t)k * 6144];
#pragma unroll
            for (int b = 0; b < 17; ++b) acc[b] += sl[b * 1024 + kq * 256 + k] * wv;
        }
#pragma unroll
        for (int b = 0; b < 17; ++b) red[(kq * 17 + b) * 128 + nn] = acc[b];
        __syncthreads();
        if (kq == 0) {
            const float bm = p->b_mod[l * 6144 + n];
#pragma unroll
            for (int b = 0; b < 17; ++b) modb[((size_t)l * 17 + b) * 6144 + n] = red[b * 128 + nn] + red[(17 + b) * 128 + nn] + red[(34 + b) * 128 + nn] + red[(51 + b) * 128 + nn] + bm;
        }
        __syncthreads();
    }
    if (blockIdx.x == gridDim.x - 1) {
        float* lb = (float*)(p->ws + p->o_lb);
        {
            const int ch = tid;
            float v[4], mx = -1e30f;
#pragma unroll
            for (int l = 0; l < 4; ++l) { v[l] = p->c_lb[l * 512 + ch]; mx = fmaxf(mx, v[l]); }
            float s = 0.f;
#pragma unroll
            for (int l = 0; l < 4; ++l) { v[l] = __expf(v[l] - mx); s += v[l]; }
            const float inv = 1.0f / s, s0 = v[0] * inv; float cum = 0.f;
#pragma unroll
            for (int l = 0; l < 4; ++l) { cum += v[l] * inv; lb[l * 512 + ch] = cum - s0; }
        }
        float* rt = (float*)(p->ws + p->o_rope);
        for (int i = tid; i < 1024; i += 512) {
            const int n = i >> 4, f = i & 15;
            const float inv = __expf(-((float)(2 * f) / 32.0f) * 9.210340371976184f);
            const float a = (float)n * inv;
            const float kf = rintf(a * 0.15915494309189535f);
            const float rr = fmaf(-kf, 6.2831854820251465f, a) + kf * 1.7484556e-7f;
            rt[i] = __cosf(rr); rt[1024 + i] = __sinf(rr);
        }
    }
    __syncthreads();
    convert_weights(p, 0, lds);
}

__device__ __forceinline__ void rowpass(PPtr p, int l, int g, int mode, int nrows) {
    const int lane = ltid() & 63, gw = blockIdx.x * 8 + (ltid() >> 6), NGW = gridDim.x * 8;
    const int LATR = p->GB * 2048, GB = p->GB;
    const float* ng = p->norm_gains + (size_t)l * 4 * 1024;
    const float* modb = (const float*)(p->ws + p->o_mod) + (size_t)l * 17 * 6144;
    bf16_t* hb = (bf16_t*)(p->ws + p->o_h);
    const float* yf = (const float*)(p->ws + p->o_z);
    float* xcb = (float*)(p->ws + p->o_xc);
    const bool first = (l == 0 && mode <= 2);
    const float* xlat = first ? p->x : (const float*)p->out;
    const float* xctx = first ? p->ctx : (const float*)xcb;
    auto xsrc = [&](int row) -> const float* {
        if (row < LATR) return xlat + ((size_t)(g * GB + (row >> 11)) * 2048 + (row & 2047)) * 1024;
        const int r2 = row - LATR; return xctx + ((size_t)(g * GB + (r2 >> 8)) * 256 + (r2 & 255)) * 1024;
    };
    const bf16_t* slab = (const bf16_t*)(p->ws + p->o_z + (size_t)p->MG * 12288);
    const size_t slab_stride = (size_t)(p->MG - LATR) * 1024;
    auto yload = [&](int row, f32x4 (&yv)[4]) {
        if (row < LATR) {
            const bf16_t* yb = (const bf16_t*)yf + (size_t)row * 1024 + lane * 4;
#pragma unroll
            for (int j = 0; j < 4; ++j) { const u32x2 w = *(const u32x2*)(yb + 256 * j); yv[j] = (f32x4){lo16(w.x), hi16(w.x), lo16(w.y), hi16(w.y)}; }
        } else {
            const bf16_t* s0 = slab + (size_t)(row - LATR) * 1024 + lane * 4;
#pragma unroll
            for (int j = 0; j < 4; ++j) { const u32x2 w = *(const u32x2*)(s0 + 256 * j); yv[j] = (f32x4){lo16(w.x), hi16(w.x), lo16(w.y), hi16(w.y)}; }
#pragma unroll
            for (int ks = 1; ks < 8; ++ks)
#pragma unroll
                for (int j = 0; j < 4; ++j) { const u32x2 w = *(const u32x2*)(s0 + ks * slab_stride + 256 * j); yv[j] = yv[j] + (f32x4){lo16(w.x), hi16(w.x), lo16(w.y), hi16(w.y)}; }
        }
    };
    f32x4 xv[4], yv[4];
    int row = gw;
    if (row < nrows) {
        const float* xs = xsrc(row);
#pragma unroll
        for (int j = 0; j < 4; ++j) xv[j] = *(const f32x4*)(xs + lane * 4 + 256 * j);
        if (mode >= 2) yload(row, yv);
    }
    while (row < nrows) {
        const int nrow = row + NGW;
        f32x4 xn[4], yn[4];
        if (nrow < nrows) {
            const float* xs = xsrc(nrow);
#pragma unroll
            for (int j = 0; j < 4; ++j) xn[j] = *(const f32x4*)(xs + lane * 4 + 256 * j);
            if (mode >= 2) yload(nrow, yn);
        }
        const bool lat = row < LATR;
        int b; size_t xrow;
        if (lat) { b = g * GB + (row >> 11); xrow = (size_t)b * 2048 + (row & 2047); }
        else { const int r2 = row - LATR; b = g * GB + (r2 >> 8); xrow = (size_t)b * 256 + (r2 & 255); }
        float* xd = (lat ? p->out : xcb) + xrow * 1024;
        const float* m = modb + (size_t)(lat ? b : 16) * 6144;
        f32x4 tgv[4], tnv[4], tsh[4], tsc[4], tn2[4];
        {
            const float* gate = m + (mode == 2 ? 2048 : 5120); const float* gn = ng + (mode == 2 ? 1024 : 3072);
            const float* sh = m + (mode == 1 ? 0 : 3072); const float* sc = m + (mode == 1 ? 1024 : 4096); const float* gn2 = ng + (mode == 1 ? 0 : 2048);
#pragma unroll
            for (int j = 0; j < 4; ++j) {
                const int c = lane * 4 + 256 * j;
                if (mode >= 2) { tgv[j] = *(const f32x4*)(gate + c); tnv[j] = *(const f32x4*)(gn + c); }
                if (mode <= 2) { tsh[j] = *(const f32x4*)(sh + c); tsc[j] = *(const f32x4*)(sc + c); tn2[j] = *(const f32x4*)(gn2 + c); }
            }
        }
        if (mode >= 2) {
            float ss = 0.f;
#pragma unroll
            for (int j = 0; j < 4; ++j) ss += yv[j].x * yv[j].x + yv[j].y * yv[j].y + yv[j].z * yv[j].z + yv[j].w * yv[j].w;
            ss = wave_sum(ss);
            const float rs = rsqrtf(ss * (1.0f / 1024.0f) + EPS);
#pragma unroll
            for (int j = 0; j < 4; ++j) {
                const int c = lane * 4 + 256 * j;
                const f32x4 gv = tgv[j], nv = tnv[j];
                xv[j] = xv[j] + gv * (yv[j] * rs * nv);
                *(f32x4*)(xd + c) = xv[j];
            }
        }
        if (mode <= 2) {
            float ss = 0.f;
#pragma unroll
            for (int j = 0; j < 4; ++j) ss += xv[j].x * xv[j].x + xv[j].y * xv[j].y + xv[j].z * xv[j].z + xv[j].w * xv[j].w;
            ss = wave_sum(ss);
            const float rs = rsqrtf(ss * (1.0f / 1024.0f) + EPS);
#pragma unroll
            for (int j = 0; j < 4; ++j) {
                const int c = lane * 4 + 256 * j;
                const f32x4 shv = tsh[j], scv = tsc[j], nv = tn2[j];
                const f32x4 hv = (xv[j] * rs * nv) * (scv + 1.0f) + shv;
                u32x2 o; o.x = pk2(hv.x, hv.y); o.y = pk2(hv.z, hv.w);
                *(u32x2*)(hb + (size_t)row * 1024 + c) = o;
            }
        }
#pragma unroll
        for (int j = 0; j < 4; ++j) { xv[j] = xn[j]; yv[j] = yn[j]; }
        row = nrow;
    }
}

struct EpiInproj {
    static constexpr bool PERM = true, AFTER_DRAIN = false;
    bf16_t* Z; bf16_t* vta; bf16_t* vtb; const float* rope; int GB;
    __device__ __forceinline__ void operator()(const f32x4 (&acc)[2][2][4][2], const pg8::Unit& u, int wr, int wc, int fr, int fq) const {
        const int row0 = u.pm * 256 + wr * 64 + fr, LATR = GB * 2048;
#pragma unroll
        for (int bj = 0; bj < 2; ++bj) {
            const int seg = u.pn * 2 + bj, c0 = u.pn * 256 + bj * 128 + wc * 32 + 8 * fq;
            const int type = (seg <= 4) ? 1 : (seg == 5 ? 2 : ((seg >= 14 && seg <= 17) ? 3 : 0));
            const int xf = (seg <= 3 || (seg >= 6 && seg <= 9)) ? 1 : ((seg >= 18 && seg <= 21) ? 2 : ((seg >= 22 && seg <= 29) ? 3 : ((seg == 38 || seg == 39) ? 4 : 0)));
#pragma unroll
            for (int ai = 0; ai < 2; ++ai)
#pragma unroll
                for (int m = 0; m < 4; ++m) {
                    const int row = row0 + ai * 128 + m * 16;
                    f32x4 v0 = acc[ai][bj][m][0], v1 = acc[ai][bj][m][1];
                    if (type <= 1) {
                        if (type == 1 && row < LATR) {
                            const int t = row & 2047, pp0 = (c0 & 63) >> 1;
                            const int n = (pp0 < 16) ? (t >> 6) : (t & 63);
                            const float* cs = rope + n * 16 + (pp0 & 15);
                            const f32x4 cv = *(const f32x4*)cs, sv = *(const f32x4*)(cs + 1024);
                            f32x4 r0, r1;
                            r0.x = v0.x * cv.x - v0.y * sv.x; r0.y = v0.y * cv.x + v0.x * sv.x;
                            r0.z = v0.z * cv.y - v0.w * sv.y; r0.w = v0.w * cv.y + v0.z * sv.y;
                            r1.x = v1.x * cv.z - v1.y * sv.z; r1.y = v1.y * cv.z + v1.x * sv.z;
                            r1.z = v1.z * cv.w - v1.w * sv.w; r1.w = v1.w * cv.w + v1.z * sv.w;
                            v0 = r0; v1 = r1;
                        }
                        if (xf == 1) { v0 = v0 * QSCALE2; v1 = v1 * QSCALE2; }
                        else if (xf == 4) { v0 = v0 * 0.125f; v1 = v1 * 0.125f; }
                        else if (xf == 2) {
#pragma unroll
                            for (int e = 0; e < 4; ++e) { v0[e] = v0[e] * sigm(v0[e]); v1[e] = v1[e] * sigm(v1[e]); }
                        } else if (xf == 3) {
#pragma unroll
                            for (int e = 0; e < 4; ++e) { v0[e] = sigm(v0[e]); v1[e] = sigm(v1[e]); }
                        }
                        u32x4 w; w.x = pk2(v0.x, v0.y); w.y = pk2(v0.z, v0.w); w.z = pk2(v1.x, v1.y); w.w = pk2(v1.z, v1.w);
                        *(u32x4*)(Z + (size_t)row * ZW + c0) = w;
                    } else {
                        int bl, tok;
                        if (row < LATR) { bl = row >> 11; tok = row & 2047; } else { const int r2 = row - LATR; bl = r2 >> 8; tok = 2048 + (r2 & 255); }
                        const int cc = c0 - (type == 2 ? ZA_V : ZB_V), head = cc >> 6, dim0 = cc & 63, H = (type == 2) ? 2 : 8;
                        bf16_t* base = (type == 2 ? vta : vtb) + ((size_t)(bl * H + head) * 64 + dim0) * VTS + tok;
                        base[0 * VTS] = f2bf(v0.x); base[1 * VTS] = f2bf(v0.y); base[2 * VTS] = f2bf(v0.z); base[3 * VTS] = f2bf(v0.w);
                        base[4 * VTS] = f2bf(v1.x); base[5 * VTS] = f2bf(v1.y); base[6 * VTS] = f2bf(v1.z); base[7 * VTS] = f2bf(v1.w);
                    }
                }
        }
    }
};
struct EpiBranch {
    static constexpr bool PERM = true, AFTER_DRAIN = false;
    const bf16_t* Z; bf16_t* macc; int nMfull;
    __device__ __forceinline__ void operator()(const f32x4 (&acc)[2][2][4][2], const pg8::Unit& u, int wr, int wc, int fr, int fq) const {
        const int j = u.pm / nMfull, pm = u.pm - j * nMfull, pn = u.pn & 3;
        const int row0 = pm * 256 + wr * 64 + fr, col0 = pn * 256 + wc * 32 + 8 * fq;
        const bf16_t* gbase = Z + (size_t)row0 * ZW + ZMERGE + j * 1024 + col0;
        bf16_t* mbase = macc + (size_t)row0 * 1024 + col0;
#pragma unroll
        for (int ai = 0; ai < 2; ++ai) {
            u32x4 gw[4][2], pv[4][2];
#pragma unroll
            for (int m = 0; m < 4; ++m)
#pragma unroll
                for (int bj = 0; bj < 2; ++bj) {
                    const size_t ro = (size_t)(ai * 128 + m * 16);
                    gw[m][bj] = *(const u32x4*)(gbase + ro * ZW + bj * 128);
                    pv[m][bj] = (j > 0) ? *(const u32x4*)(mbase + ro * 1024 + bj * 128) : (u32x4){0u, 0u, 0u, 0u};
                }
#pragma unroll
            for (int m = 0; m < 4; ++m)
#pragma unroll
                for (int bj = 0; bj < 2; ++bj) {
                    const u32x4 g = gw[m][bj], q = pv[m][bj];
                    const f32x4 v0 = acc[ai][bj][m][0], v1 = acc[ai][bj][m][1];
                    const float t0 = v0.x * sigm(lo16(g.x)) + lo16(q.x), t1 = v0.y * sigm(hi16(g.x)) + hi16(q.x), t2 = v0.z * sigm(lo16(g.y)) + lo16(q.y), t3 = v0.w * sigm(hi16(g.y)) + hi16(q.y);
                    const float t4 = v1.x * sigm(lo16(g.z)) + lo16(q.z), t5 = v1.y * sigm(hi16(g.z)) + hi16(q.z), t6 = v1.z * sigm(lo16(g.w)) + lo16(q.w), t7 = v1.w * sigm(hi16(g.w)) + hi16(q.w);
                    u32x4 w; w.x = pk2(t0, t1); w.y = pk2(t2, t3); w.z = pk2(t4, t5); w.w = pk2(t6, t7);
                    *(u32x4*)(mbase + (size_t)(ai * 128 + m * 16) * 1024 + bj * 128) = w;
                }
        }
    }
};
struct BranchOrder {
    int nM, nMfull, G, c;
    __device__ __forceinline__ bool next(int i, pg8::Unit& u) const {
        const int j = i & 3; const int v = (c & 7) * (G >> 3) + (c >> 3);
        const long T = (long)(i >> 2) * G + v;
        if (T >= (long)nM * 4) return false;
        u.pm = j * nMfull + (int)(T >> 2); u.pn = j * 4 + (int)(T & 3); u.ko = 0; return true;
    }
    __device__ __forceinline__ void a_ready(const pg8::Unit&) const {}
    __device__ __forceinline__ void done(const pg8::Unit&) const {}
};
struct EpiBf16Y {
    static constexpr bool PERM = true, AFTER_DRAIN = false;
    bf16_t* O; int ldc;
    __device__ __forceinline__ void operator()(const f32x4 (&acc)[2][2][4][2], const pg8::Unit& u, int wr, int wc, int fr, int fq) const {
        const int row0 = u.pm * 256 + wr * 64 + fr, col0 = u.pn * 256 + wc * 32 + 8 * fq;
#pragma unroll
        for (int ai = 0; ai < 2; ++ai)
#pragma unroll
            for (int m = 0; m < 4; ++m) {
                bf16_t* rowp = O + (size_t)(row0 + ai * 128 + m * 16) * ldc + col0;
#pragma unroll
                for (int bj = 0; bj < 2; ++bj) {
                    const f32x4 v0 = acc[ai][bj][m][0], v1 = acc[ai][bj][m][1];
                    u32x4 w; w.x = pk2(v0.x, v0.y); w.y = pk2(v0.z, v0.w); w.z = pk2(v1.x, v1.y); w.w = pk2(v1.z, v1.w);
                    *(u32x4*)(rowp + bj * 128) = w;
                }
            }
    }
};
struct EpiRelu2 {
    static constexpr bool PERM = true, AFTER_DRAIN = false;
    bf16_t* O; int ldc;
    __device__ __forceinline__ void operator()(const f32x4 (&acc)[2][2][4][2], const pg8::Unit& u, int wr, int wc, int fr, int fq) const {
        const int row0 = u.pm * 256 + wr * 64 + fr, col0 = u.pn * 256 + wc * 32 + 8 * fq;
#pragma unroll
        for (int ai = 0; ai < 2; ++ai)
#pragma unroll
            for (int m = 0; m < 4; ++m) {
                bf16_t* rowp = O + (size_t)(row0 + ai * 128 + m * 16) * ldc + col0;
#pragma unroll
                for (int bj = 0; bj < 2; ++bj) {
                    f32x4 v0 = acc[ai][bj][m][0], v1 = acc[ai][bj][m][1];
#pragma unroll
                    for (int e = 0; e < 4; ++e) { const float a = fmaxf(v0[e], 0.f), b = fmaxf(v1[e], 0.f); v0[e] = a * a; v1[e] = b * b; }
                    u32x4 w; w.x = pk2(v0.x, v0.y); w.y = pk2(v0.z, v0.w); w.z = pk2(v1.x, v1.y); w.w = pk2(v1.z, v1.w);
                    *(u32x4*)(rowp + bj * 128) = w;
                }
            }
    }
};

struct CtxBranchOrder {
    int nMfull, pm0, nT, G, c;
    __device__ __forceinline__ bool next(int i, pg8::Unit& u) const {
        const long L = (long)i * G + c; if (L >= (long)nT * 4) return false;
        const int j = (int)(L & 3), t = (int)(L >> 2);
        u.pm = j * nMfull + pm0 + (t >> 2); u.pn = j * 4 + (t & 3); u.ko = 0; return true;
    }
    __device__ __forceinline__ void a_ready(const pg8::Unit&) const {}
    __device__ __forceinline__ void done(const pg8::Unit&) const {}
};
struct EpiBranchCtx {
    static constexpr bool PERM = true, AFTER_DRAIN = false;
    const bf16_t* Z; bf16_t* P; int nMfull, pm0;
    __device__ __forceinline__ void operator()(const f32x4 (&acc)[2][2][4][2], const pg8::Unit& u, int wr, int wc, int fr, int fq) const {
        const int j = u.pm / nMfull, pm = u.pm - j * nMfull, pn = u.pn & 3;
        const int row0 = pm * 256 + wr * 64 + fr, col0 = pn * 256 + wc * 32 + 8 * fq;
        const bf16_t* gbase = Z + (size_t)row0 * ZW + ZMERGE + j * 1024 + col0;
        bf16_t* pbase = P + (size_t)(row0 - pm0 * 256) * 4096 + j * 1024 + col0;
#pragma unroll
        for (int ai = 0; ai < 2; ++ai) {
            u32x4 gw[4][2];
#pragma unroll
            for (int m = 0; m < 4; ++m)
#pragma unroll
                for (int bj = 0; bj < 2; ++bj) gw[m][bj] = *(const u32x4*)(gbase + (size_t)(ai * 128 + m * 16) * ZW + bj * 128);
#pragma unroll
            for (int m = 0; m < 4; ++m)
#pragma unroll
                for (int bj = 0; bj < 2; ++bj) {
                    const u32x4 g = gw[m][bj];
                    const f32x4 v0 = acc[ai][bj][m][0], v1 = acc[ai][bj][m][1];
                    u32x4 w; w.x = pk2(v0.x * sigm(lo16(g.x)), v0.y * sigm(hi16(g.x))); w.y = pk2(v0.z * sigm(lo16(g.y)), v0.w * sigm(hi16(g.y)));
                    w.z = pk2(v1.x * sigm(lo16(g.z)), v1.y * sigm(hi16(g.z))); w.w = pk2(v1.z * sigm(lo16(g.w)), v1.w * sigm(hi16(g.w)));
                    *(u32x4*)(pbase + (size_t)(ai * 128 + m * 16) * 4096 + bj * 128) = w;
                }
        }
    }
};
struct SplitOrder {
    int pm0, nT, SPLIT, Kl, G, c;
    __device__ __forceinline__ bool next(int i, pg8::Unit& u) const {
        const long L = (long)i * G + c; if (L >= (long)nT * 4 * SPLIT) return false;
        const int ks = (int)(L % SPLIT), t = (int)(L / SPLIT);
        u.pm = pm0 + (t >> 2); u.pn = t & 3; u.ko = ks * Kl; return true;
    }
    __device__ __forceinline__ void a_ready(const pg8::Unit&) const {}
    __device__ __forceinline__ void done(const pg8::Unit&) const {}
};
struct EpiSlab {
    static constexpr bool PERM = true, AFTER_DRAIN = false;
    bf16_t* S; int pm0, nrows, Kl;
    __device__ __forceinline__ void operator()(const f32x4 (&acc)[2][2][4][2], const pg8::Unit& u, int wr, int wc, int fr, int fq) const {
        const int ks = u.ko / Kl;
        const int row0 = (u.pm - pm0) * 256 + wr * 64 + fr, col0 = u.pn * 256 + wc * 32 + 8 * fq;
        bf16_t* base = S + (size_t)ks * nrows * 1024;
#pragma unroll
        for (int ai = 0; ai < 2; ++ai)
#pragma unroll
            for (int m = 0; m < 4; ++m) { bf16_t* rowp = base + (size_t)(row0 + ai * 128 + m * 16) * 1024 + col0;
#pragma unroll
                for (int bj = 0; bj < 2; ++bj) {
                    const f32x4 v0 = acc[ai][bj][m][0], v1 = acc[ai][bj][m][1];
                    u32x4 w; w.x = pk2(v0.x, v0.y); w.y = pk2(v0.z, v0.w); w.z = pk2(v1.x, v1.y); w.w = pk2(v1.z, v1.w);
                    *(u32x4*)(rowp + bj * 128) = w;
                } }
    }
};

#define MFMA16(a, b, c) __builtin_amdgcn_mfma_f32_16x16x32_bf16((a), (b), (c), 0, 0, 0)
__device__ __forceinline__ void attn_wave(PPtr p, int l, int kind, int idx, int lane, const LAS float* biasL) {
    const int fr = lane & 15, fq = lane >> 4;
    const int LATR = p->GB * 2048, MG = p->MG;
    const bf16_t* Z = (const bf16_t*)(p->ws + p->o_z);
    const bool isA = (kind == 1 || kind == 2);
    int bl, hk, qrow0, r = 0, q0 = 0;
    if (kind == 0) { bl = idx >> 8; hk = (idx >> 5) & 7; r = idx & 31; qrow0 = bl * 2048 + r * 64; }
    else if (kind == 1) { bl = idx >> 8; hk = (idx >> 7) & 1; q0 = (idx & 127) * 16; qrow0 = bl * 2048 + q0; }
    else if (kind == 2) { bl = idx >> 5; hk = (idx >> 4) & 1; qrow0 = LATR + bl * 256 + (idx & 15) * 16; }
    else { bl = idx >> 5; hk = (idx >> 2) & 7; qrow0 = LATR + bl * 256 + (idx & 3) * 64; }
    const int qrstep = isA ? 0 : 16, qcstep = isA ? 64 : 0;
    const int qcol0 = isA ? (ZA_Q + hk * 4 * 64) : (ZB_Q + hk * 64);
    const int kcol = isA ? (ZA_K + hk * 64) : (ZB_K + hk * 64);
    const bf16_t* vt = isA ? ((const bf16_t*)(p->ws + p->o_vta) + (size_t)(bl * 2 + hk) * 64 * VTS) : ((const bf16_t*)(p->ws + p->o_vtb) + (size_t)(bl * 8 + hk) * 64 * VTS);
    bf16_t* yo = (bf16_t*)(p->ws + p->o_y4) + (isA ? (size_t)0 : (size_t)MG * 512);
    const int ocol0 = isA ? hk * 4 * 64 : hk * 64;
    const int krow_ctx0 = LATR + bl * 256, krow_lat0 = bl * 2048;

    bf16x8 Q[4][2];
#pragma unroll
    for (int s = 0; s < 4; ++s)
#pragma unroll
        for (int ks = 0; ks < 2; ++ks) Q[s][ks] = *(const bf16x8*)(Z + (size_t)(qrow0 + s * qrstep + fr) * ZW + qcol0 + s * qcstep + ks * 32 + fq * 8);
    f32x4 O[4][4]; float mrun[4], lrun[4];
#pragma unroll
    for (int s = 0; s < 4; ++s) { mrun[s] = -1e30f; lrun[s] = 0.f;
#pragma unroll
        for (int dt = 0; dt < 4; ++dt) O[s][dt] = (f32x4){0.f, 0.f, 0.f, 0.f}; }

    auto do_block = [&](int krow, int vtoff, int mode, int a0, int a1) {
        bf16x8 Kf[2][2];
#pragma unroll
        for (int kt = 0; kt < 2; ++kt)
#pragma unroll
            for (int ks = 0; ks < 2; ++ks) Kf[kt][ks] = *(const bf16x8*)(Z + (size_t)(krow + kt * 16 + fr) * ZW + kcol + ks * 32 + fq * 8);
        bf16x8 Vf[4];
#pragma unroll
        for (int dt = 0; dt < 4; ++dt) {
            const bf16_t* vp = vt + (size_t)(dt * 16 + fr) * VTS + vtoff + fq * 4;
            const u32x2 lo = *(const u32x2*)vp, hi = *(const u32x2*)(vp + 16);
            u32x4 w; w.x = lo.x; w.y = lo.y; w.z = hi.x; w.w = hi.y;
            Vf[dt] = __builtin_bit_cast(bf16x8, w);
        }
#pragma unroll
        for (int s = 0; s < 4; ++s) {
            const bool active = (mode != 2) || !((s == 0 && a1 == 1) || (s == 3 && a1 == 0));
            if (active) {
                f32x4 S0 = (f32x4){0.f, 0.f, 0.f, 0.f}, S1 = (f32x4){0.f, 0.f, 0.f, 0.f};
                S0 = MFMA16(Kf[0][0], Q[s][0], S0); S0 = MFMA16(Kf[0][1], Q[s][1], S0);
                S1 = MFMA16(Kf[1][0], Q[s][0], S1); S1 = MFMA16(Kf[1][1], Q[s][1], S1);
                float sc[8];
#pragma unroll
                for (int j = 0; j < 4; ++j) { sc[j] = S0[j]; sc[4 + j] = S1[j]; }
                if (mode == 1) {
                    const int qpos = q0 + fr;
#pragma unroll
                    for (int e = 0; e < 8; ++e) { const int kpos = a0 + (e >> 2) * 16 + fq * 4 + (e & 3); const int d = kpos - qpos; if (d > 128 || d < -128) sc[e] = -1e30f; }
                } else if (mode == 2) {
                    const int qc = 16 * s + fr; const int cs = min(max(qc - 8, 0), 48);
                    const LAS float* bp = biasL + hk * 465 + a0 * 31;
#pragma unroll
                    for (int e = 0; e < 8; ++e) {
                        const int kc = a1 * 32 + (e >> 2) * 16 + fq * 4 + (e & 3);
                        const int dc = min(max(kc - qc + 15, 0), 30);
                        const float bv = bp[dc];
                        sc[e] = (kc >= cs && kc < cs + 16) ? (sc[e] + bv) : -1e30f;
                    }
                }
                float ml = fmaxf(fmaxf(fmaxf(sc[0], sc[1]), fmaxf(sc[2], sc[3])), fmaxf(fmaxf(sc[4], sc[5]), fmaxf(sc[6], sc[7])));
                ml = xrow16_max(ml);
                const float mold = mrun[s], mn = fmaxf(mold, ml), alpha = __builtin_amdgcn_exp2f(mold - mn);
                mrun[s] = mn;
                float pv[8], ls = 0.f;
#pragma unroll
                for (int e = 0; e < 8; ++e) { pv[e] = __builtin_amdgcn_exp2f(sc[e] - mn); ls += pv[e]; }
                ls = xrow16_sum(ls);
                lrun[s] = lrun[s] * alpha + ls;
                u32x4 pw; pw.x = pk2(pv[0], pv[1]); pw.y = pk2(pv[2], pv[3]); pw.z = pk2(pv[4], pv[5]); pw.w = pk2(pv[6], pv[7]);
                const bf16x8 P = __builtin_bit_cast(bf16x8, pw);
                if (__builtin_amdgcn_ballot_w64(mn > mold) != 0ull) {
#pragma unroll
                    for (int dt = 0; dt < 4; ++dt) O[s][dt] = O[s][dt] * alpha;
                }
#pragma unroll
                for (int dt = 0; dt < 4; ++dt) O[s][dt] = MFMA16(Vf[dt], P, O[s][dt]);
            }
            __builtin_amdgcn_sched_barrier(0);
        }
    };
    int nloc = 0, lo = 0, r0 = 0;
    if (kind == 1) { lo = max(0, q0 - 128) & ~31; const int hi = min(2048, (q0 + 16 + 128 + 31) & ~31); nloc = (hi - lo) >> 5; }
    else if (kind == 0) { r0 = min(max(r - 4, 0), 24); nloc = 16; }
#pragma unroll 1
    for (int i = 0; i < 8 + nloc; ++i) {
        int krow, vtoff, mode, a0, a1;
        if (i < 8) { krow = krow_ctx0 + 32 * i; vtoff = 2048 + 32 * i; mode = 0; a0 = 0; a1 = 0; }
        else if (kind == 1) { const int kb = lo + 32 * (i - 8); krow = krow_lat0 + kb; vtoff = kb; mode = 1; a0 = kb; a1 = 0; }
        else { const int jj = i - 8, kr = r0 + (jj >> 1), hb = jj & 1; krow = krow_lat0 + kr * 64 + hb * 32; vtoff = kr * 64 + hb * 32; mode = 2; a0 = kr - r + 7; a1 = hb; }
        do_block(krow, vtoff, mode, a0, a1);
    }
#pragma unroll
    for (int s = 0; s < 4; ++s) {
        float fac;
        if (isA) { const float sk = p->a_sink[l * 8 + hk * 4 + s] * LOG2E; const float M = fmaxf(mrun[s], sk); const float e1 = __builtin_amdgcn_exp2f(mrun[s] - M); fac = e1 / (lrun[s] * e1 + __builtin_amdgcn_exp2f(sk - M)); }
        else fac = 1.0f / lrun[s];
        bf16_t* op = yo + (size_t)(qrow0 + s * qrstep + fr) * 512 + ocol0 + s * qcstep + fq * 4;
#pragma unroll
        for (int dt = 0; dt < 4; ++dt) { const f32x4 o = O[s][dt] * fac; u32x2 w; w.x = pk2(o.x, o.y); w.y = pk2(o.z, o.w); *(u32x2*)(op + dt * 16) = w; }
    }
}

constexpr int SCAN_BUF = 41472;
constexpr int BIAS_OFF = 3 * SCAN_BUF;
template <int DK, bool ISC>
__device__ __forceinline__ void scan_task(PPtr p, int l, int bl, int h, int dir, LAS unsigned char* lds) {
    constexpr int KPW = DK / 8, NTG = 64 / KPW, TPG = 32 / NTG, QS = (DK + 8) * 2, NKT = DK / 16;
    const int tid = ltid(), w = tid >> 6, lane = tid & 63, fr = lane & 15, fq = lane >> 4;
    const int kl = lane % KPW, tg = lane / KPW, kch = w * KPW + kl;
    const int vcol = tid & 127, vg = tid >> 7;
    LAS unsigned char* qt = lds; LAS unsigned char* kt_ = qt + 32 * QS; LAS unsigned char* khT = kt_ + 32 * QS; LAS unsigned char* vT = khT + DK * 80;
    LAS unsigned char* att = vT + 128 * 80; LAS float* dvec = (LAS float*)(att + 32 * 80); LAS float* evec = dvec + DK;
    const bf16_t* Z = (const bf16_t*)(p->ws + p->o_z);
    const int LATR = p->GB * 2048, MG = p->MG;
    const int qc = ISC ? (ZC_Q + h * 128 + kch) : (ZD_Q + h * 64 + kch);
    const int kc = ISC ? ((dir ? ZC_FB : ZC_FF) + h * 128 + kch) : (ZD_K + h * 64 + kch);
    const int vc = (ISC ? ZC_I : ZD_V) + h * 128 + vcol;
    const int gcol = ZD_GK + dir * 16;
    float lbv = 0.f, oml = 1.f, up[16], gb = 0.f;
#pragma unroll
    for (int r = 0; r < 16; ++r) up[r] = 0.f;
    if (ISC) { lbv = ((const float*)(p->ws + p->o_lb))[l * 512 + h * 128 + kch]; oml = 1.0f - lbv; }
    else {
#pragma unroll
        for (int r = 0; r < 16; ++r) up[r] = p->d_gate_up[((size_t)(l * 2 + dir) * 16 + r) * 256 + h * 64 + kch];
        gb = p->d_gate_bias[(l * 2 + dir) * 256 + h * 64 + kch];
    }
    bf16_t* odst = (dir == 0) ? ((bf16_t*)(p->ws + p->o_y4) + (size_t)(ISC ? 2 : 3) * MG * 512) : ((bf16_t*)(p->ws + p->o_ob) + (size_t)(ISC ? 0 : 1) * MG * 512);
    f32x4 S[NKT];
#pragma unroll
    for (int i = 0; i < NKT; ++i) S[i] = (f32x4){0.f, 0.f, 0.f, 0.f};
    auto rowof = [&](int cc, int i) -> int {
        const bool isctx = cc < 8; const int L = isctx ? 256 : 2048, base = isctx ? (LATR + bl * 256) : (bl * 2048), c = isctx ? cc : cc - 8;
        const int pos = c * 32 + i; return base + (dir ? (L - 1 - pos) : pos);
    };
    bf16_t rq[TPG], rk[TPG], rv[8]; u32x4 rz[TPG][2];
    auto load_raw = [&](int cc) {
#pragma unroll
        for (int e = 0; e < TPG; ++e) {
            const bf16_t* zr = Z + (size_t)rowof(cc, tg * TPG + e) * ZW;
            rq[e] = zr[qc]; rk[e] = zr[kc];
            if (!ISC) { rz[e][0] = *(const u32x4*)(zr + gcol); rz[e][1] = *(const u32x4*)(zr + gcol + 8); }
        }
#pragma unroll
        for (int e = 0; e < 8; ++e) rv[e] = Z[(size_t)rowof(cc, vg * 8 + e) * ZW + vc];
    };
    load_raw(0);
    for (int cc = 0; cc < 72; ++cc) {
        __syncthreads();
        {
            float gq[TPG], gk[TPG], cum[TPG]; float run = 0.f;
#pragma unroll
            for (int e = 0; e < TPG; ++e) {
                const float zq = bf2f(rq[e]), zk = bf2f(rk[e]); float g, key, q;
                if (ISC) { const float sg = zk; g = __logf(lbv + oml * sg); key = oml * (1.0f - sg); q = zq; }
                else {
                    float a = gb;
                    const u32x4 z0 = rz[e][0], z1 = rz[e][1];
                    a += lo16(z0.x) * up[0] + hi16(z0.x) * up[1] + lo16(z0.y) * up[2] + hi16(z0.y) * up[3] + lo16(z0.z) * up[4] + hi16(z0.z) * up[5] + lo16(z0.w) * up[6] + hi16(z0.w) * up[7];
                    a += lo16(z1.x) * up[8] + hi16(z1.x) * up[9] + lo16(z1.y) * up[10] + hi16(z1.y) * up[11] + lo16(z1.z) * up[12] + hi16(z1.z) * up[13] + lo16(z1.w) * up[14] + hi16(z1.w) * up[15];
                    g = (fminf(a, 0.f) - __logf(1.0f + __expf(-fabsf(a)))) * (1.0f / 16.0f); key = zk; q = zq;
                }
                run += g; cum[e] = run; gq[e] = q; gk[e] = key;
            }
            float pre = 0.f, total = 0.f, cref = 0.f;
#pragma unroll
            for (int t = 0; t < NTG; ++t) { const float tt = __shfl(run, kl + KPW * t); if (t < tg) pre += tt; if (t < NTG / 2) cref += tt; total += tt; }
            float khv[TPG]; const float etc = __expf(total - cref);
#pragma unroll
            for (int e = 0; e < TPG; ++e) {
                const float c = cum[e] + pre; const int i = tg * TPG + e;
                const float E = __expf(c - cref), kE = gk[e] * __builtin_amdgcn_rcpf(E);
                *(LAS bf16_t*)(qt + i * QS + kch * 2) = f2bf1(gq[e] * E);
                *(LAS bf16_t*)(kt_ + i * QS + kch * 2) = f2bf1(kE);
                khv[e] = kE * etc;
            }
            if constexpr (TPG == 8) { u32x4 o; o.x = pk2(khv[0], khv[1]); o.y = pk2(khv[2], khv[3]); o.z = pk2(khv[4], khv[5]); o.w = pk2(khv[6], khv[7]); *(LAS u32x4*)(khT + kch * 80 + tg * 16) = o; }
            else { u32x2 o; o.x = pk2(khv[0], khv[1]); o.y = pk2(khv[2], khv[3]); *(LAS u32x2*)(khT + kch * 80 + tg * 8) = o; }
            if (tg == 0) { dvec[kch] = __expf(total); evec[kch] = __expf(cref); }
            u32x4 vo; vo.x = (unsigned)rv[0] | ((unsigned)rv[1] << 16); vo.y = (unsigned)rv[2] | ((unsigned)rv[3] << 16); vo.z = (unsigned)rv[4] | ((unsigned)rv[5] << 16); vo.w = (unsigned)rv[6] | ((unsigned)rv[7] << 16);
            *(LAS u32x4*)(vT + vcol * 80 + vg * 16) = vo;
        }
        if (cc + 1 < 72) load_raw(cc + 1);
        __syncthreads();
        if (w < 3) {
            const int tt = (w == 0) ? 0 : 1, st = (w == 2) ? 1 : 0;
            f32x4 a = (f32x4){0.f, 0.f, 0.f, 0.f};
#pragma unroll
            for (int ks = 0; ks < DK / 32; ++ks) {
                const bf16x8 A = *(const LAS bf16x8*)(qt + (tt * 16 + fr) * QS + (ks * 32 + fq * 8) * 2);
                const bf16x8 B = *(const LAS bf16x8*)(kt_ + (st * 16 + fr) * QS + (ks * 32 + fq * 8) * 2);
                a = MFMA16(A, B, a);
            }
#pragma unroll
            for (int j = 0; j < 4; ++j) { const int t = tt * 16 + fq * 4 + j, s = st * 16 + fr; *(LAS bf16_t*)(att + t * 80 + s * 2) = f2bf1(s <= t ? a[j] : 0.f); }
        } else if (w == 3) {
#pragma unroll
            for (int j = 0; j < 4; ++j) { const int t = fq * 4 + j, s = 16 + fr; *(LAS bf16_t*)(att + t * 80 + s * 2) = (bf16_t)0; }
        }
        __syncthreads();
        {
            const int vs = w * 16;
            const bf16x8 Bv = *(const LAS bf16x8*)(vT + (vs + fr) * 80 + fq * 16);
            bf16x8 Sb[NKT / 2];
#pragma unroll
            for (int kp = 0; kp < NKT / 2; ++kp) {
                const f32x4 e0 = *(const LAS f32x4*)(evec + (2 * kp) * 16 + fq * 4), e1 = *(const LAS f32x4*)(evec + (2 * kp + 1) * 16 + fq * 4);
                const f32x4 s0 = S[2 * kp] * e0, s1 = S[2 * kp + 1] * e1;
                u32x4 sw; sw.x = pk2(s0.x, s0.y); sw.y = pk2(s0.z, s0.w); sw.z = pk2(s1.x, s1.y); sw.w = pk2(s1.z, s1.w);
                Sb[kp] = __builtin_bit_cast(bf16x8, sw);
            }
#pragma unroll
            for (int tt = 0; tt < 2; ++tt) {
                f32x4 o = (f32x4){0.f, 0.f, 0.f, 0.f};
#pragma unroll
                for (int kp = 0; kp < NKT / 2; ++kp) {
                    const u32x2 lo = *(const LAS u32x2*)(qt + (tt * 16 + fr) * QS + ((2 * kp) * 16 + fq * 4) * 2);
                    const u32x2 hi = *(const LAS u32x2*)(qt + (tt * 16 + fr) * QS + ((2 * kp + 1) * 16 + fq * 4) * 2);
                    u32x4 aw; aw.x = lo.x; aw.y = lo.y; aw.z = hi.x; aw.w = hi.y;
                    o = MFMA16(__builtin_bit_cast(bf16x8, aw), Sb[kp], o);
                }
                const bf16x8 A2 = *(const LAS bf16x8*)(att + (tt * 16 + fr) * 80 + fq * 16);
                o = MFMA16(A2, Bv, o);
#pragma unroll
                for (int j = 0; j < 4; ++j) { const int row = rowof(cc, tt * 16 + fq * 4 + j); odst[(size_t)row * 512 + h * 128 + vs + fr] = f2bf1(o[j]); }
            }
#pragma unroll
            for (int k2 = 0; k2 < NKT; ++k2) {
                const f32x4 d = *(const LAS f32x4*)(dvec + k2 * 16 + fq * 4);
                S[k2] = S[k2] * d;
                const bf16x8 A3 = *(const LAS bf16x8*)(khT + (k2 * 16 + fr) * 80 + fq * 16);
                S[k2] = MFMA16(A3, Bv, S[k2]);
            }
        }
    }
    __syncthreads();
}

__device__ __forceinline__ void mixer(PPtr p, int l, int g, LAS unsigned char* lds, unsigned long long* tscan = nullptr) {
    const int tid = ltid(), w = tid >> 6, lane = tid & 63;
    LAS float* biasL = (LAS float*)(lds + BIAS_OFF);
    for (int i = tid; i < 8 * 465; i += 512) biasL[i] = p->b_rel_bias[(size_t)l * 8 * 465 + i] * LOG2E;
    __syncthreads();
    const int GB = p->GB, NSC = GB * 8, NS = GB * 16;
    const unsigned long long ts0 = tscan ? __builtin_amdgcn_s_memrealtime() : 0ull;
    for (int st = blockIdx.x; st < NS; st += gridDim.x) {
        if (st < NSC) { scan_task<128, true>(p, l, st >> 3, (st >> 1) & 3, st & 1, lds); }
        else { const int s2 = st - NSC; scan_task<64, false>(p, l, s2 >> 3, (s2 >> 1) & 3, s2 & 1, lds); }
    }
    if (tscan) *tscan += __builtin_amdgcn_s_memrealtime() - ts0;
    unsigned* ctr = (unsigned*)p->ws + (l * 16 + g);
    const int NB0 = GB * 32, NB1 = GB * 32, NB2 = (l < DEPTH - 1) ? GB * 4 : 0, NB3 = NB2, NBT = NB0 + NB1 + NB2 + NB3;
    LAS int* tw = (LAS int*)(lds + CTRL_OFF);
    for (;;) {
        if (tid == 0) *tw = (int)atomicAdd(ctr, 1u);
        __syncthreads();
        const int bt = *tw;
        __syncthreads();
        if (bt >= NBT) break;
        int kind, idx;
        if (bt < NB0) { kind = 0; idx = bt * 8 + w; }
        else if (bt < NB0 + NB1) { kind = 1; idx = (bt - NB0) * 8 + w; }
        else if (bt < NB0 + NB1 + NB2) { kind = 2; idx = (bt - NB0 - NB1) * 8 + w; }
        else { kind = 3; idx = (bt - NB0 - NB1 - NB2) * 8 + w; }
        attn_wave(p, l, kind, idx, lane, biasL);
    }
}

__device__ __forceinline__ void postpass(PPtr p, int l, int nrows) {
    const int lane = ltid() & 63, gw = blockIdx.x * 8 + (ltid() >> 6), NGW = gridDim.x * 8, MG = p->MG;
    const bf16_t* Z = (const bf16_t*)(p->ws + p->o_z);
    for (int it = gw; it < nrows * 2; it += NGW) {
        const int row = it >> 1, br = it & 1;
        bf16_t* yf = (bf16_t*)(p->ws + p->o_y4) + (size_t)(2 + br) * MG * 512 + (size_t)row * 512 + lane * 8;
        const bf16_t* yb = (const bf16_t*)(p->ws + p->o_ob) + (size_t)br * MG * 512 + (size_t)row * 512 + lane * 8;
        const u32x4 a = *(const u32x4*)yf, b = *(const u32x4*)yb;
        const u32x4 gt = *(const u32x4*)(Z + (size_t)row * ZW + (br ? ZD_G : ZC_G) + lane * 8);
        const float* gain = (br ? p->d_norm : p->c_norm) + l * 128 + (lane & 15) * 8;
        float o[8], gv[8];
        o[0] = lo16(a.x) + lo16(b.x); o[1] = hi16(a.x) + hi16(b.x); o[2] = lo16(a.y) + lo16(b.y); o[3] = hi16(a.y) + hi16(b.y);
        o[4] = lo16(a.z) + lo16(b.z); o[5] = hi16(a.z) + hi16(b.z); o[6] = lo16(a.w) + lo16(b.w); o[7] = hi16(a.w) + hi16(b.w);
        gv[0] = lo16(gt.x); gv[1] = hi16(gt.x); gv[2] = lo16(gt.y); gv[3] = hi16(gt.y); gv[4] = lo16(gt.z); gv[5] = hi16(gt.z); gv[6] = lo16(gt.w); gv[7] = hi16(gt.w);
        float ss = 0.f;
#pragma unroll
        for (int e = 0; e < 8; ++e) ss += o[e] * o[e];
        ss = row16_sum(ss);
        const float rs = rsqrtf(ss * (1.0f / 128.0f) + EPS);
        const f32x4 g0 = *(const f32x4*)gain, g1 = *(const f32x4*)(gain + 4);
        float y[8];
#pragma unroll
        for (int e = 0; e < 8; ++e) { const float gn = (e < 4) ? g0[e & 3] : g1[e & 3]; y[e] = o[e] * rs * gn * (gv[e] * sigm(gv[e])); }
        u32x4 wv; wv.x = pk2(y[0], y[1]); wv.y = pk2(y[2], y[3]); wv.z = pk2(y[4], y[5]); wv.w = pk2(y[6], y[7]);
        *(u32x4*)yf = wv;
    }
}

#define NOINL __device__ __forceinline__
NOINL void ph_prologue(PPtr pc, LAS unsigned char* lds) { PPtr p = pc; asm volatile("" : "+s"(p)); prologue(p, lds); }
NOINL void ph_rowpass(PPtr pc, int l, int g, int mode, int nrows, int conv_l, LAS unsigned char* lds) { PPtr p = pc; asm volatile("" : "+s"(p)); rowpass(p, l, g, mode, nrows); if (conv_l >= 0) convert_weights(p, conv_l, lds); }
NOINL void ph_rowpass_tail(PPtr pc, int l, int g, int nrows, int conv_l, int nl, int ng, int nrows_next, LAS unsigned char* lds) {
    PPtr p = pc; asm volatile("" : "+s"(p));
    rowpass(p, l, g, 3, nrows);
    if (nl >= 0) rowpass(p, nl, ng, 1, nrows_next);
    if (conv_l >= 0) convert_weights(p, conv_l, lds);
}
NOINL void ph_inproj(PPtr pc, LAS unsigned char* lds) {
    PPtr p = pc; asm volatile("" : "+s"(p)); const int G = (int)gridDim.x, c = (int)blockIdx.x;
    pg8::Gemm gm{(const bf16_t*)(p->ws + p->o_h), (const bf16_t*)(p->ws + p->o_win), p->MG, ZW, 1024, 1024}; pg8::StaticOrder S; S.init(p->MG, ZW, G, c);
    EpiInproj E{(bf16_t*)(p->ws + p->o_z), (bf16_t*)(p->ws + p->o_vta), (bf16_t*)(p->ws + p->o_vtb), (const float*)(p->ws + p->o_rope), p->GB};
    pg8::gemm_phase<EpiInproj, pg8::StaticOrder>(lds, gm, S, E, nullptr);
}
NOINL void ph_mixer(PPtr pc, int l, int g, LAS unsigned char* lds, unsigned long long* tscan = nullptr) { PPtr p = pc; asm volatile("" : "+s"(p)); mixer(p, l, g, lds, tscan); }
NOINL void ph_post(PPtr pc, int l, int nrows) { PPtr p = pc; asm volatile("" : "+s"(p)); postpass(p, l, nrows); }
NOINL void ph_branch(PPtr pc, int Mr, LAS unsigned char* lds) {
    PPtr p = pc; asm volatile("" : "+s"(p)); const int G = (int)gridDim.x, c = (int)blockIdx.x;
    const int LATR = p->GB * 2048, nMfull = p->MG / 256;
    pg8::Gemm gm{(const bf16_t*)(p->ws + p->o_y4), (const bf16_t*)(p->ws + p->o_wb), Mr, 1024, 512, 512};
    { BranchOrder S{LATR / 256, nMfull, G, c};
      EpiBranch E{(const bf16_t*)(p->ws + p->o_z), (bf16_t*)(p->ws + p->o_h), nMfull};
      pg8::gemm_phase<EpiBranch, BranchOrder>(lds, gm, S, E, nullptr); }
    if (Mr > LATR) {
        CtxBranchOrder S{nMfull, LATR / 256, (Mr - LATR) / 256 * 4, G, c};
        EpiBranchCtx E{(const bf16_t*)(p->ws + p->o_z), (bf16_t*)(p->ws + p->o_ob), nMfull, LATR / 256};
        pg8::gemm_phase<EpiBranchCtx, CtxBranchOrder>(lds, gm, S, E, nullptr);
    }
}
NOINL void ph_gemm_f32(PPtr pc, int which, int Mr, LAS unsigned char* lds) {
    PPtr p = pc; asm volatile("" : "+s"(p)); const int G = (int)gridDim.x, c = (int)blockIdx.x;
    const int LATR = p->GB * 2048;
    const bf16_t* hid = (const bf16_t*)(p->ws + p->o_z + (size_t)p->MG * 1024 * 4);
    { const bf16_t* A = which ? hid : (const bf16_t*)(p->ws + p->o_h);
      const bf16_t* Bt = which ? (const bf16_t*)(p->ws + p->o_w2) : (const bf16_t*)(p->ws + p->o_wo);
      const int K = which ? 4096 : 1024;
      pg8::Gemm gm{A, Bt, LATR, 1024, K, K}; pg8::StaticOrder S; S.init(LATR, 1024, G, c);
      EpiBf16Y E{(bf16_t*)(p->ws + p->o_z), 1024};
      pg8::gemm_phase<EpiBf16Y, pg8::StaticOrder>(lds, gm, S, E, nullptr); }
    if (Mr > LATR) {
        const bf16_t* A = which ? hid : ((const bf16_t*)(p->ws + p->o_ob) - (size_t)LATR * 4096);
        const bf16_t* Bt = which ? (const bf16_t*)(p->ws + p->o_w2) : (const bf16_t*)(p->ws + p->o_wo4);
        pg8::Gemm gm{A, Bt, Mr, 1024, 4096, 512};
        SplitOrder S{LATR / 256, (Mr - LATR) / 256, 8, 512, G, c};
        EpiSlab E{(bf16_t*)(p->ws + p->o_z + (size_t)p->MG * 12288), LATR / 256, Mr - LATR, 512};
        pg8::gemm_phase<EpiSlab, SplitOrder>(lds, gm, S, E, nullptr);
    }
}
NOINL void ph_ffn1(PPtr pc, int Mr, LAS unsigned char* lds) {
    PPtr p = pc; asm volatile("" : "+s"(p)); const int G = (int)gridDim.x, c = (int)blockIdx.x;
    pg8::Gemm gm{(const bf16_t*)(p->ws + p->o_h), (const bf16_t*)(p->ws + p->o_w1), Mr, 4096, 1024, 1024}; pg8::StaticOrder S; S.init(Mr, 4096, G, c);
    EpiRelu2 E{(bf16_t*)(p->ws + p->o_z + (size_t)p->MG * 1024 * 4), 4096};
    pg8::gemm_phase<EpiRelu2, pg8::StaticOrder>(lds, gm, S, E, nullptr);
}

#define XB_SETUP() volatile LAS unsigned* xb_st = (volatile LAS unsigned*)(lds + CTRL_OFF + 64); unsigned* xb_bar = (unsigned*)(pc->ws + 4096); { XcdBarrier xb0 = xcd_barrier_post(xb_bar, xb_st); (void)xb0; }
#define GSYNC() { XcdBarrier xb_; xb_.bar = (unsigned*)(pc->ws + 4096); xb_.x = xb_xcc_id(); xb_.st = (volatile LAS unsigned*)(lds + CTRL_OFF + 64); xcd_barrier(xb_); }
#ifdef PROBE_MASK
__global__ void __launch_bounds__(512) hybrid_fwd(Params pk) {
    extern __shared__ __attribute__((aligned(16))) unsigned char smem[];
    LAS unsigned char* lds = (LAS unsigned char*)smem;
    cg::grid_group grid = cg::this_grid();
    PPtr pc = (PPtr)__builtin_amdgcn_kernarg_segment_ptr();
    const int GB = pc->GB, MG = pc->MG, NGRP = pc->NGRP, LATR = GB * 2048;
    unsigned long long tacc = 0, t0_ = __builtin_amdgcn_s_memrealtime();
#define PT(kind) { const unsigned long long t1_ = __builtin_amdgcn_s_memrealtime(); if ((PROBE_MASK >> (kind)) & 1) tacc += t1_ - t0_; t0_ = t1_; }
    ph_prologue(pc, lds);
    grid.sync();
    XB_SETUP(); PT(0)
    for (int l = 0; l < DEPTH; ++l) {
        const int Mr = (l < DEPTH - 1) ? MG : LATR;
        for (int g = 0; g < NGRP; ++g) {
            ph_rowpass(pc, l, g, 1, MG, -1, lds);
            GSYNC(); PT(1)
            ph_inproj(pc, lds);
            GSYNC(); PT(2)
            { unsigned long long tsc = 0; ph_mixer(pc, l, g, lds, &tsc); if ((PROBE_MASK >> 11) & 1) tacc += tsc; }
            GSYNC(); PT(3)
            ph_post(pc, l, Mr);
            GSYNC(); PT(4)
            ph_branch(pc, Mr, lds);
            GSYNC(); PT(5)
            ph_gemm_f32(pc, 0, Mr, lds);
            GSYNC(); PT(6)
            ph_rowpass(pc, l, g, 2, Mr, -1, lds);
            GSYNC(); PT(7)
            ph_ffn1(pc, Mr, lds);
            GSYNC(); PT(8)
            ph_gemm_f32(pc, 1, Mr, lds);
            GSYNC(); PT(9)
            ph_rowpass(pc, l, g, 3, Mr, (g == NGRP - 1 && l + 1 < DEPTH) ? l + 1 : -1, lds);
            GSYNC(); PT(10)
        }
    }
    if (blockIdx.x == 0) { const unsigned M = (unsigned)(tacc / 100ull); float* o = pc->out; for (unsigned i2 = threadIdx.x; i2 < M; i2 += 512) o[i2] += 0.125f; }
}

#else
__global__ void __launch_bounds__(512) hybrid_fwd(Params pk) {
    extern __shared__ __attribute__((aligned(16))) unsigned char smem[];
    LAS unsigned char* lds = (LAS unsigned char*)smem;
    cg::grid_group grid = cg::this_grid();
    PPtr pc = (PPtr)__builtin_amdgcn_kernarg_segment_ptr();
    const int GB = pc->GB, MG = pc->MG, NGRP = pc->NGRP, LATR = GB * 2048;
    ph_prologue(pc, lds);
    grid.sync();
    XB_SETUP();
    for (int l = 0; l < DEPTH; ++l) {
        const int Mr = (l < DEPTH - 1) ? MG : LATR;
        for (int g = 0; g < NGRP; ++g) {
            if ((l == 0 && g == 0) || NGRP == 1) { ph_rowpass(pc, l, g, 1, MG, -1, lds); GSYNC(); }
            ph_inproj(pc, lds);
            GSYNC();
            ph_mixer(pc, l, g, lds);
            GSYNC();
            ph_post(pc, l, Mr);
            GSYNC();
            ph_branch(pc, Mr, lds);
            GSYNC();
            ph_gemm_f32(pc, 0, Mr, lds);
            GSYNC();
            ph_rowpass(pc, l, g, 2, Mr, -1, lds);
            GSYNC();
            ph_ffn1(pc, Mr, lds);
            GSYNC();
            ph_gemm_f32(pc, 1, Mr, lds);
            GSYNC();
            {
                const bool lastg = (g == NGRP - 1);
                const int nl = (NGRP == 1) ? -1 : (lastg ? (l + 1 < DEPTH ? l + 1 : -1) : l), ng = lastg ? 0 : g + 1;
                ph_rowpass_tail(pc, l, g, Mr, (lastg && l + 1 < DEPTH) ? l + 1 : -1, nl, ng, MG, lds);
            }
            if (!(l == DEPTH - 1 && g == NGRP - 1)) GSYNC();
        }
    }
}

#endif
extern "C" void kernel_launch(void* const* d_in, const int* in_sizes, int n_in, void* d_out, int out_size, void* d_ws, size_t ws_size, hipStream_t stream) {
    static int grid_blocks = 0;
    if (grid_blocks == 0) {
        int dev = 0, cus = 0, per_cu = 0;
        hipGetDevice(&dev);
        hipDeviceGetAttribute(&cus, hipDeviceAttributeMultiprocessorCount, dev);
        if (hipFuncSetAttribute((const void*)hybrid_fwd, hipFuncAttributeMaxDynamicSharedMemorySize, LDS_BYTES) != hipSuccess) fprintf(stderr, "hipFuncSetAttribute failed\n");
        if (hipOccupancyMaxActiveBlocksPerMultiprocessor(&per_cu, (const void*)hybrid_fwd, 512, LDS_BYTES) != hipSuccess || per_cu < 1) { fprintf(stderr, "occupancy query: %d\n", per_cu); per_cu = 1; }
        (void)hipGetLastError();
        grid_blocks = cus * 1;
        if (grid_blocks <= 0) grid_blocks = 256;
    }
    Params p{};
    const float* const* in = (const float* const*)d_in;
    p.x = in[0]; p.c = in[1]; p.ctx = in[2]; p.c_ctx = in[3]; p.w_mod = in[4]; p.b_mod = in[5]; p.norm_gains = in[6]; p.w_in = in[7]; p.a_sink = in[8]; p.b_rel_bias = in[9];
    p.c_lb = in[10]; p.c_norm = in[11]; p.d_gate_up = in[12]; p.d_gate_bias = in[13]; p.d_norm = in[14]; p.w_branch = in[15]; p.w_out = in[16]; p.w_ff1 = in[17]; p.w_ff2 = in[18];
    p.out = (float*)d_out; p.ws = (unsigned char*)d_ws;
    auto al = [](unsigned long long v) { return (v + 255ull) & ~255ull; };
    unsigned long long off = 32768;
    p.o_mod = off; off = al(off + 4ull * 17 * 6144 * 4);
    p.o_lb = off; off = al(off + 4ull * 512 * 4);
    p.o_rope = off; off = al(off + 2048ull * 4);
    p.o_xc = off; off = al(off + 4096ull * 1024 * 4);
    p.o_win = off; off = al(off + (unsigned long long)ZW * 1024 * 2);
    p.o_wb = off; off = al(off + 4096ull * 512 * 2);
    p.o_wo = off; off = al(off + 1024ull * 1024 * 2);
    p.o_w1 = off; off = al(off + 4096ull * 1024 * 2);
    p.o_w2 = off; off = al(off + 1024ull * 4096 * 2);
    p.o_wo4 = off; off = al(off + 1024ull * 4096 * 2);
    const unsigned long long fixed = off;
    int GB = 16;
    for (; GB > 1; GB >>= 1) {
        const unsigned long long MGt = (unsigned long long)GB * 2304;
        const unsigned long long need = fixed + MGt * (2048ull + (unsigned long long)ZW * 2 + 4096ull + 2048ull) + (unsigned long long)GB * 10 * 64 * VTS * 2 + 8 * 256;
        if (need <= (unsigned long long)ws_size) break;
    }
    p.GB = GB; p.NGRP = 16 / GB; p.MG = GB * 2304;
    const unsigned long long MGu = (unsigned long long)p.MG;
    p.o_h = off; off = al(off + MGu * 1024 * 2);
    p.o_z = off; off = al(off + MGu * ZW * 2);
    p.o_y4 = off; off = al(off + MGu * 2048 * 2);
    p.o_ob = off; off = al(off + MGu * 1024 * 2);
    p.o_vta = off; off = al(off + (unsigned long long)GB * 2 * 64 * VTS * 2);
    p.o_vtb = off; off = al(off + (unsigned long long)GB * 8 * 64 * VTS * 2);
    hipMemsetAsync(d_ws, 0, 32768, stream);
    void* args[] = {&p};
    hipError_t e = hipLaunchCooperativeKernel((const void*)hybrid_fwd, dim3(grid_blocks), dim3(512), args, LDS_BYTES, stream);
    if (e != hipSuccess) fprintf(stderr, "cooperative launch failed: %s (grid %d)\n", hipGetErrorString(e), grid_blocks);
}
```

```cpp
#include <hip/hip_runtime.h>
#include <hip/hip_cooperative_groups.h>
#include <cstdio>
namespace cg = cooperative_groups;
__device__ __forceinline__ int ltid() { int t = (int)threadIdx.x; asm volatile("" : "+v"(t)); return t; }
#define LAS __attribute__((address_space(3)))
namespace pg8 {
#define PG8_LAS __attribute__((address_space(3)))
typedef unsigned short bf16_t;
typedef short bf16x8 __attribute__((ext_vector_type(8)));
typedef float f32x4 __attribute__((ext_vector_type(4)));
typedef unsigned u32x4 __attribute__((ext_vector_type(4)));
constexpr int BM = 256, BK = 64, HALF = 128, HTB = HALF * BK * 2  , STAGE_BYTES = 8 * HTB, NXCD = 8, WGM = 8;

__host__ __device__ __forceinline__ int lds_byte(int r, int c) { const int st = (r >> 4) * 2 + (c >> 5), rr = r & 15, cc = c & 31, ob = rr * 64 + cc * 2; return st * 1024 + (ob ^ (((ob >> 9) & 1) << 5)); }
__host__ __device__ __forceinline__ void stage_rc(int b, int& R, int& C) { const int st = b / 1024, sb = b % 1024, swz = sb ^ (((sb >> 9) & 1) << 5); R = (st >> 1) * 16 + swz / 64; C = (st & 1) * 32 + (swz % 64) / 2; }
__host__ __device__ __forceinline__ int perm32(int rho) { const int n = rho >> 4, i = rho & 15; return 8 * (i >> 2) + 4 * n + (i & 3); }

struct Unit { int pm, pn, ko; };
struct Gemm { const bf16_t* A; const bf16_t* Bt; int M, N, K, Kl; };

struct StaticOrder {
    int nM, nN, nwg, G, c;
    __host__ __device__ void init(int M, int N, int G_, int c_) { nM = M / BM; nN = N / BM; nwg = nM * nN; G = G_; c = c_; }
    __host__ __device__ bool next(int i, Unit& u) const {
        const long L = (long)i * G + c; if (L >= nwg) return false;
        int wgid = (int)L; { const int q = nwg / NXCD, r = nwg % NXCD, xcd = wgid % NXCD, off = wgid / NXCD; wgid = (xcd < r ? xcd * (q + 1) : r * (q + 1) + (xcd - r) * q) + off; }
        const int nig = WGM * nN, gid = wgid / nig, fm = gid * WGM, gsz = (nM - fm) < WGM ? (nM - fm) : WGM;
        u.pm = fm + ((wgid % nig) % gsz); u.pn = (wgid % nig) / gsz; u.ko = 0; return true;
    }
    __device__ __forceinline__ void a_ready(const Unit&) const {}
    __device__ __forceinline__ void done(const Unit&) const {}
};
__device__ __forceinline__ unsigned cvt_pk_bf16(float lo, float hi) { unsigned r; asm volatile("v_cvt_pk_bf16_f32 %0, %1, %2" : "=v"(r) : "v"(lo), "v"(hi)); return r; }
struct EpiF32 {
    static constexpr bool PERM = false, AFTER_DRAIN = false;
    float* C; int ldc; const float* bias;
    __device__ __forceinline__ void operator()(const f32x4 (&acc)[2][2][4][2], const Unit& u, int wr, int wc, int fr, int fq) const {
        const int row0 = u.pm * BM + wr * 64 + fr, col0 = u.pn * BM + wc * 32 + 4 * fq;
        f32x4 bv[2][2];
#pragma unroll
        for (int bj = 0; bj < 2; ++bj)
#pragma unroll
            for (int n = 0; n < 2; ++n) bv[bj][n] = bias ? *(const f32x4*)(bias + col0 + bj * HALF + n * 16) : (f32x4){0.f, 0.f, 0.f, 0.f};
#pragma unroll
        for (int ai = 0; ai < 2; ++ai)
#pragma unroll
            for (int m = 0; m < 4; ++m) { float* rowp = C + (size_t)(row0 + ai * HALF + m * 16) * ldc + col0;
#pragma unroll
                for (int bj = 0; bj < 2; ++bj)
#pragma unroll
                    for (int n = 0; n < 2; ++n) *(f32x4*)(rowp + bj * HALF + n * 16) = acc[ai][bj][m][n] + bv[bj][n]; }
    }
};
template <class Epi, class Sched, bool STAMP = false>
__device__ __forceinline__ void gemm_phase(PG8_LAS unsigned char* lds, const Gemm g, const Sched& S, const Epi& E, unsigned long long* stamps) {
    const int tid = ltid(), wid = __builtin_amdgcn_readfirstlane(tid >> 6), lane = tid & 63, wr = wid >> 2, wc = wid & 3, fr = lane & 15, fq = lane >> 4;
    const int K = g.K, nt = g.Kl / BK;
    int ts_lo = 0, ts_hi = 0, nts = 0; const unsigned long long rt_entry = STAMP ? (unsigned long long)wall_clock64() : 0ull;
#define PG8_STAMP() do { if (STAMP && wid == 0 && nts < 64) { const unsigned long long _c = (unsigned long long)clock64(); \
        ts_lo = (lane == nts) ? (int)(unsigned)_c : ts_lo; ts_hi = (lane == nts) ? (int)(unsigned)(_c >> 32) : ts_hi; ++nts; } } while (0)
    PG8_STAMP();
    unsigned voffA[2], voffB[2];
#pragma unroll
    for (int i = 0; i < 2; ++i) { int R, C; stage_rc(tid * 16 + i * 8192, R, C); const int Rb = Epi::PERM ? ((R & ~31) + perm32(R & 31)) : R;
        voffA[i] = (unsigned)(R * K + C) * 2u; voffB[i] = (unsigned)(Rb * K + C) * 2u; }
    const size_t kstep = (size_t)(BK * 2);
    const size_t hstep = (size_t)HALF * K * 2;
    const size_t tstep = 2 * hstep;
    const unsigned ldsw = (unsigned)wid * 1024u;
    const int aoff = lds_byte(wr * 64 + fr, fq * 8), boff = lds_byte(wc * 32 + fr, fq * 8);
#define PG8_SA(b, h) (((b) * 2 + (h)) * HTB)
#define PG8_SB(b, h) ((4 + (b) * 2 + (h)) * HTB)
#define PG8_STAGE(bufoff, gbase, voff) do { _Pragma("unroll") for (int _i = 0; _i < 2; ++_i) \
        __builtin_amdgcn_global_load_lds((const unsigned*)((const char*)(gbase) + (voff)[_i]), (PG8_LAS unsigned*)(lds + (bufoff) + ldsw + _i * 8192), 16, 0, 0); } while (0)
#define PG8_LDA(dst, b, h) do { _Pragma("unroll") for (int m = 0; m < 4; ++m) _Pragma("unroll") for (int k = 0; k < 2; ++k) dst[m][k] = *(const PG8_LAS bf16x8*)(lds + PG8_SA(b, h) + aoff + m * 2048 + k * 1024); } while (0)
#define PG8_LDB(dst, b, h) do { _Pragma("unroll") for (int n = 0; n < 2; ++n) _Pragma("unroll") for (int k = 0; k < 2; ++k) dst[n][k] = *(const PG8_LAS bf16x8*)(lds + PG8_SB(b, h) + boff + n * 2048 + k * 1024); } while (0)
#define PG8_MMA(ai, bj, At, Bt) do { __builtin_amdgcn_s_setprio(1); _Pragma("unroll") for (int m = 0; m < 4; ++m) _Pragma("unroll") for (int n = 0; n < 2; ++n) _Pragma("unroll") for (int k = 0; k < 2; ++k) \
        acc[ai][bj][m][n] = __builtin_amdgcn_mfma_f32_16x16x32_bf16(Bt[n][k], At[m][k], acc[ai][bj][m][n], 0, 0, 0); __builtin_amdgcn_s_setprio(0); } while (0)
#define PG8_WAIT_V(n) asm volatile("s_waitcnt vmcnt(" #n ")" ::: "memory")
#define PG8_WAIT_L(n) asm volatile("s_waitcnt lgkmcnt(" #n ")" ::: "memory")
#define PG8_BAR __builtin_amdgcn_s_barrier()
#define PG8_SCHED __builtin_amdgcn_sched_barrier(0)
    Unit cur, nxt; int ui = 0;
    if (!S.next(0, cur)) return;
    f32x4 acc[2][2][4][2];
#pragma unroll
    for (int a = 0; a < 2; ++a)
#pragma unroll
        for (int b = 0; b < 2; ++b)
#pragma unroll
            for (int m = 0; m < 4; ++m)
#pragma unroll
                for (int n = 0; n < 2; ++n) acc[a][b][m][n] = (f32x4){0.f, 0.f, 0.f, 0.f};
    bf16x8 At[4][2], B0[2][2], B1[2][2];
    const char* cA = (const char*)g.A + (size_t)cur.pm * tstep + (size_t)cur.ko * 2; const char* cB = (const char*)g.Bt + (size_t)cur.pn * tstep + (size_t)cur.ko * 2;
    S.a_ready(cur);
    PG8_STAGE(PG8_SB(0, 0), cB, voffB); PG8_STAGE(PG8_SA(0, 0), cA, voffA); PG8_STAGE(PG8_SB(0, 1), cB + hstep, voffB); PG8_STAGE(PG8_SA(0, 1), cA + hstep, voffA);
    if (wr == 1) PG8_BAR;
    PG8_WAIT_V(4); PG8_BAR;
    PG8_STAGE(PG8_SB(1, 0), cB + kstep, voffB); PG8_STAGE(PG8_SA(1, 0), cA + kstep, voffA); PG8_STAGE(PG8_SB(1, 1), cB + hstep + kstep, voffB);
    PG8_WAIT_V(6); PG8_BAR;
    PG8_STAMP();
    for (;;) {
        const bool has_next = S.next(ui + 1, nxt);
        const char* nA = has_next ? (const char*)g.A + (size_t)nxt.pm * tstep + (size_t)nxt.ko * 2 : cA; const char* nB = has_next ? (const char*)g.Bt + (size_t)nxt.pn * tstep + (size_t)nxt.ko * 2 : cB;
        for (int t = 0; t < nt; t += 2) {
            const bool last = (t == nt - 2);
            const char* a1 = cA + (size_t)(t + 1) * kstep;
            const char* a2 = last ? nA : cA + (size_t)(t + 2) * kstep; const char* b2 = last ? nB : cB + (size_t)(t + 2) * kstep;
            const char* a3 = a2 + kstep; const char* b3 = b2 + kstep;
            if (last && has_next) S.a_ready(nxt);
            PG8_LDB(B0, 0, 0); PG8_SCHED; PG8_LDA(At, 0, 0); PG8_STAGE(PG8_SA(1, 1), a1 + hstep, voffA);
            PG8_WAIT_L(8); PG8_BAR; PG8_WAIT_L(0); PG8_MMA(0, 0, At, B0); PG8_BAR; PG8_SCHED;
            PG8_LDB(B1, 0, 1); PG8_STAGE(PG8_SB(0, 0), b2, voffB);
            PG8_BAR; PG8_WAIT_L(0); PG8_MMA(0, 1, At, B1); PG8_BAR;
            PG8_LDA(At, 0, 1); PG8_STAGE(PG8_SA(0, 0), a2, voffA);
            PG8_BAR; PG8_WAIT_L(0); PG8_MMA(1, 0, At, B0); PG8_BAR; PG8_SCHED;
            PG8_STAGE(PG8_SB(0, 1), b2 + hstep, voffB);
            PG8_WAIT_V(6); PG8_BAR; PG8_MMA(1, 1, At, B1); PG8_BAR;
            PG8_LDB(B0, 1, 0); PG8_SCHED; PG8_LDA(At, 1, 0); PG8_STAGE(PG8_SA(0, 1), a2 + hstep, voffA);
            PG8_WAIT_L(8); PG8_BAR; PG8_WAIT_L(0); PG8_MMA(0, 0, At, B0); PG8_BAR; PG8_SCHED;
            PG8_LDB(B1, 1, 1); PG8_STAGE(PG8_SB(1, 0), b3, voffB);
            PG8_BAR; PG8_WAIT_L(0); PG8_MMA(0, 1, At, B1); PG8_BAR;
            PG8_LDA(At, 1, 1); PG8_STAGE(PG8_SA(1, 0), a3, voffA);
            PG8_BAR; PG8_WAIT_L(0); PG8_MMA(1, 0, At, B0); PG8_BAR; PG8_SCHED;
            PG8_STAGE(PG8_SB(1, 1), b3 + hstep, voffB);
            PG8_WAIT_V(6); PG8_BAR; PG8_MMA(1, 1, At, B1); PG8_BAR;
        }
        PG8_STAMP();
        if constexpr (!Epi::AFTER_DRAIN) { E(acc, cur, wr, wc, fr, fq); S.done(cur); }
        PG8_STAMP();
        if (!has_next) break;
#pragma unroll
        for (int a = 0; a < 2; ++a)
#pragma unroll
            for (int b = 0; b < 2; ++b)
#pragma unroll
                for (int m = 0; m < 4; ++m)
#pragma unroll
                    for (int n = 0; n < 2; ++n) acc[a][b][m][n] = (f32x4){0.f, 0.f, 0.f, 0.f};
        cur = nxt; cA = nA; cB = nB; ++ui;
    }
    PG8_WAIT_V(0);
    if (wr == 0) PG8_BAR;
    PG8_BAR;
    if constexpr (Epi::AFTER_DRAIN) { E.fused(acc, cur, wr, wc, fr, fq, lds, wid, lane); S.done(cur); }
    PG8_STAMP();
    if (STAMP && wid == 0) { stamps[lane] = lane < nts ? (((unsigned long long)(unsigned)ts_hi << 32) | (unsigned)ts_lo) : 0ull;
        if (lane == 62) stamps[62] = rt_entry; if (lane == 63) stamps[63] = (unsigned long long)wall_clock64(); }
#undef PG8_STAMP
#undef PG8_SA
#undef PG8_SB
#undef PG8_STAGE
#undef PG8_LDA
#undef PG8_LDB
#undef PG8_MMA
#undef PG8_WAIT_V
#undef PG8_WAIT_L
#undef PG8_BAR
#undef PG8_SCHED
}
}
#define XB_TMO      128
#define XB_XCNT(j)  (256  + 64 * (j))
#define XB_XSUB(j)  (1280 + 64 * (j))
#define XB_XGEN(j)  (2304 + 64 * (j))
#define XB_TOP      3328
#define XB_TOPGEN   3392
#define XCD_BAR_WORDS 3456
#define XB_SPIN_CAP (1u << 18)

__device__ __forceinline__ unsigned xb_ld(unsigned* p)              { return __hip_atomic_load(p, __ATOMIC_RELAXED, __HIP_MEMORY_SCOPE_AGENT); }
__device__ __forceinline__ unsigned xb_add(unsigned* p, unsigned v) { return __hip_atomic_fetch_add(p, v, __ATOMIC_RELAXED, __HIP_MEMORY_SCOPE_AGENT); }
__device__ __forceinline__ unsigned xb_xcc_id() { return (unsigned)__builtin_amdgcn_s_getreg((3 << 11) | 20) & 0xFu; }
#define XB_SPIN(cond, bar) do { unsigned _sp = 0; while (cond) { __builtin_amdgcn_s_sleep(1); \
    if ((++_sp & 255u) == 0u) { if (xb_ld(&(bar)[XB_TMO])) break; if (_sp > XB_SPIN_CAP) { atomicAdd(&(bar)[XB_TMO], 1u); break; } } } } while (0)

struct XcdBarrier {
    unsigned* bar; unsigned x;
    volatile LAS unsigned* st;
};

__device__ __forceinline__ XcdBarrier xcd_barrier_post(unsigned* bar, volatile LAS unsigned* st) {
    XcdBarrier b; b.bar = bar; b.x = xb_xcc_id(); b.st = st;
    if (threadIdx.x == 0) (void)xb_add(&bar[XB_XCNT(b.x)], 1u);
    return b;
}
__device__ __forceinline__ void xcd_barrier_complete(unsigned* bar, unsigned x, unsigned& nloc, unsigned& nx) {
    const unsigned G = gridDim.x * gridDim.y * gridDim.z;
    unsigned sum, cnt, mine, sp = 0u;
    for (;;) {
        sum = 0u; cnt = 0u; mine = 0u;
#pragma unroll
        for (unsigned j = 0; j < 16; ++j) { const unsigned c = xb_ld(&bar[XB_XCNT(j)]); sum += c; cnt += (c > 0u) ? 1u : 0u; mine = (j == x) ? c : mine; }
        if (sum == G) break;
        __builtin_amdgcn_s_sleep(1);
        if ((++sp & 255u) == 0u) { if (xb_ld(&bar[XB_TMO])) break; if (sp > XB_SPIN_CAP) { atomicAdd(&bar[XB_TMO], 1u); break; } }
    }
    nloc = mine > 0u ? mine : 1u; nx = cnt > 0u ? cnt : 1u;
}

__device__ __forceinline__ void xcd_barrier(const XcdBarrier& b) {
    asm volatile("s_waitcnt vmcnt(0)" ::: "memory");
    __syncthreads();
    if (threadIdx.x == 0) {
        unsigned* bar = b.bar;
        __builtin_amdgcn_s_waitcnt(0);
        unsigned nloc = b.st[0], nx = b.st[1];
        if (nloc == 0u) { xcd_barrier_complete(bar, b.x, nloc, nx); b.st[0] = nloc; b.st[1] = nx; }
        const unsigned old = xb_add(&bar[XB_XSUB(b.x)], 1u);
        const unsigned gen = old / nloc;
        if (old + 1u == (gen + 1u) * nloc) {
            __builtin_amdgcn_fence(__ATOMIC_RELEASE, "agent");
            asm volatile("s_waitcnt vmcnt(0)" ::: "memory");
            const unsigned og = xb_add(&bar[XB_TOP], 1u);
            const unsigned tg = og / nx;
            if (og + 1u == (tg + 1u) * nx) xb_add(&bar[XB_TOPGEN], 1u);
            else XB_SPIN(xb_ld(&bar[XB_TOPGEN]) == tg, bar);
            __builtin_amdgcn_fence(__ATOMIC_ACQUIRE, "agent");
            xb_add(&bar[XB_XGEN(b.x)], 1u);
            asm volatile("s_waitcnt vmcnt(0)" ::: "memory");
        } else {
            XB_SPIN(xb_ld(&bar[XB_XGEN(b.x)]) == gen, bar);
            __builtin_amdgcn_fence(__ATOMIC_ACQUIRE, "agent");
            asm volatile("s_waitcnt vmcnt(0)" ::: "memory");
        }
    }
    __syncthreads();
}

typedef unsigned short bf16_t;
typedef pg8::bf16x8 bf16x8;
typedef pg8::f32x4 f32x4;
typedef pg8::u32x4 u32x4;
typedef unsigned u32x2 __attribute__((ext_vector_type(2)));

constexpr int DM = 1024, NB = 16, SEQ = 2048, DEPTH = 4, CTXL = 256, DFF = 4096;
constexpr int ZW = 10752;
constexpr int INW = 10528;
constexpr int ZA_Q = 0, ZA_K = 512, ZA_V = 640, ZB_Q = 768, ZB_K = 1280, ZB_V = 1792, ZC_Q = 2304, ZC_FF = 2816, ZC_FB = 3328, ZC_I = 3840, ZC_G = 4352,
              ZD_Q = 4864, ZD_K = 5120, ZD_V = 5376, ZD_GK = 5888, ZD_G = 6016, ZMERGE = 6656;
constexpr int VTS = 2304;
constexpr int LDS_BYTES = 144 * 1024;
constexpr int CTRL_OFF = LDS_BYTES - 256;
constexpr float EPS = 1e-6f;
constexpr float LOG2E = 1.4426950408889634f;
constexpr float QSCALE2 = 0.125f * LOG2E;

struct Params {
    const float *x, *c, *ctx, *c_ctx, *w_mod, *b_mod, *norm_gains, *w_in, *a_sink, *b_rel_bias, *c_lb, *c_norm, *d_gate_up, *d_gate_bias, *d_norm, *w_branch, *w_out, *w_ff1, *w_ff2;
    float* out;
    unsigned char* ws;
    unsigned long long o_mod, o_lb, o_rope, o_xc, o_win, o_wb, o_wo, o_w1, o_w2, o_h, o_z, o_y4, o_ob, o_vta, o_vtb, o_wo4;
    int GB, NGRP, MG, pad0;
};
typedef const Params __attribute__((address_space(4)))* PPtr;

__device__ __forceinline__ float bf2f(unsigned v) { return __uint_as_float(v << 16); }
__device__ __forceinline__ bf16_t f2bf(float f) { unsigned u = __float_as_uint(f); u += 0x7FFFu + ((u >> 16) & 1u); return (bf16_t)(u >> 16); }
typedef __bf16 bf16v2_t __attribute__((ext_vector_type(2)));
typedef float f32v2_t __attribute__((ext_vector_type(2)));
__device__ __forceinline__ unsigned pk2(float lo, float hi) { const f32v2_t v = {lo, hi}; const bf16v2_t b = __builtin_convertvector(v, bf16v2_t); return __builtin_bit_cast(unsigned, b); }
template <int CTRL> __device__ __forceinline__ float dpp(float x) { return __builtin_bit_cast(float, __builtin_amdgcn_mov_dpp(__builtin_bit_cast(int, x), CTRL, 0xf, 0xf, true)); }
constexpr int XOR1 = 0xB1, XOR2 = 0x4E, XOR7 = 0x141, XOR8 = 0x128;
__device__ __forceinline__ float xrow16_max(float x) {
    auto s = __builtin_amdgcn_permlane16_swap(__float_as_uint(x), __float_as_uint(x), false, false);
    x = fmaxf(__uint_as_float(s[0]), __uint_as_float(s[1]));
    auto t = __builtin_amdgcn_permlane32_swap(__float_as_uint(x), __float_as_uint(x), false, false);
    return fmaxf(__uint_as_float(t[0]), __uint_as_float(t[1]));
}
__device__ __forceinline__ float xrow16_sum(float x) {
    auto s = __builtin_amdgcn_permlane16_swap(__float_as_uint(x), __float_as_uint(x), false, false);
    x = __uint_as_float(s[0]) + __uint_as_float(s[1]);
    auto t = __builtin_amdgcn_permlane32_swap(__float_as_uint(x), __float_as_uint(x), false, false);
    return __uint_as_float(t[0]) + __uint_as_float(t[1]);
}
__device__ __forceinline__ float row16_sum(float v) {
    v += dpp<XOR1>(v); v += dpp<XOR2>(v); v += dpp<XOR7>(v); v += dpp<XOR8>(v);
    return v;
}
__device__ __forceinline__ float wave_sum(float v) { return xrow16_sum(row16_sum(v)); }
__device__ __forceinline__ float lo16(unsigned w) { return __uint_as_float(w << 16); }
__device__ __forceinline__ float hi16(unsigned w) { return __uint_as_float(w & 0xffff0000u); }
__device__ __forceinline__ float sigm(float x) { return __builtin_amdgcn_rcpf(1.0f + __builtin_amdgcn_exp2f(-LOG2E * x)); }
__device__ __forceinline__ bf16_t f2bf1(float x) { return (bf16_t)pk2(x, 0.f); }

__device__ __forceinline__ int src_col(int n) {
    if (n < 640) {
        const int p = n & 63, base = n - p, pp = p >> 1, wh = p & 1;
        const int dim = (pp < 16) ? (wh ? 16 + pp : pp) : (wh ? 48 + (pp - 16) : 32 + (pp - 16));
        return base + dim;
    }
    if (n < 5920) return n;
    if (n < 6016) return -1;
    if (n < 6528) return n - 96;
    if (n < 6656) return -1;
    return 6432 + (n - 6656);
}

__device__ __forceinline__ void conv_tile(const float* src, int Nsrc, int k0, int n0, bool inmap, bf16_t* dst, int Kd, LAS float* t) {
    const int tid = ltid(), nl = tid & 63, ks = tid >> 6;
    const int sc = inmap ? src_col(n0 + nl) : (n0 + nl);
#pragma unroll
    for (int i = 0; i < 8; ++i) { const int kk = ks + 8 * i; t[nl * 65 + kk] = (sc >= 0) ? src[(size_t)(k0 + kk) * Nsrc + sc] : 0.f; }
    __syncthreads();
    const int kl = (tid & 31) * 2, ns = tid >> 5;
#pragma unroll
    for (int i = 0; i < 4; ++i) { const int n = ns + 16 * i; *(unsigned*)(dst + (size_t)(n0 + n) * Kd + k0 + kl) = pk2(t[n * 65 + kl], t[n * 65 + kl + 1]); }
    __syncthreads();
}
__device__ __forceinline__ void convert_weights(PPtr p, int l, LAS unsigned char* lds) {
    LAS float* t = (LAS float*)lds;
    bf16_t* WinT = (bf16_t*)(p->ws + p->o_win); bf16_t* WbT = (bf16_t*)(p->ws + p->o_wb); bf16_t* WoT = (bf16_t*)(p->ws + p->o_wo);
    bf16_t* W1T = (bf16_t*)(p->ws + p->o_w1); bf16_t* W2T = (bf16_t*)(p->ws + p->o_w2);
    constexpr int T_IN = 16 * 168, T_BR = 4 * 8 * 16, T_O = 16 * 16, T_1 = 16 * 64, T_2 = 64 * 16, T_ALL = T_IN + T_BR + T_O + T_1 + T_2;
    for (int it = blockIdx.x; it < T_ALL; it += gridDim.x) {
        int r = it;
        if (r < T_IN) { const int kb = r / 168, nb = r % 168; conv_tile(p->w_in + (size_t)l * 1024 * INW, INW, kb * 64, nb * 64, true, WinT, 1024, t); continue; } r -= T_IN;
        if (r < T_BR) { const int j = r / 128, q = r % 128, kb = q / 16, nb = q % 16; conv_tile(p->w_branch + (size_t)(l * 4 + j) * 512 * 1024, 1024, kb * 64, nb * 64, false, WbT + (size_t)j * 1024 * 512, 512, t); continue; } r -= T_BR;
        if (r < T_O) { const int kb = r / 16, nb = r % 16; conv_tile(p->w_out + (size_t)l * 1024 * 1024, 1024, kb * 64, nb * 64, false, WoT, 1024, t);
#pragma unroll 1
            for (int cpy = 0; cpy < 4; ++cpy) conv_tile(p->w_out + (size_t)l * 1024 * 1024, 1024, kb * 64, nb * 64, false, (bf16_t*)(p->ws + p->o_wo4) + cpy * 1024, 4096, t);
            continue; } r -= T_O;
        if (r < T_1) { const int kb = r / 64, nb = r % 64; conv_tile(p->w_ff1 + (size_t)l * 1024 * 4096, 4096, kb * 64, nb * 64, false, W1T, 1024, t); continue; } r -= T_1;
        { const int kb = r / 16, nb = r % 16; conv_tile(p->w_ff2 + (size_t)l * 4096 * 1024, 1024, kb * 64, nb * 64, false, W2T, 4096, t); }
    }
}

__device__ __forceinline__ void prologue(PPtr p, LAS unsigned char* lds) {
    const int tid = ltid();
    if (blockIdx.x == 0) {
        if (tid < 64) atomicExch((unsigned*)p->ws + tid, 0u);
        for (int i = tid; i < XCD_BAR_WORDS; i += 512) __hip_atomic_store((unsigned*)(p->ws + 4096) + i, 0u, __ATOMIC_RELAXED, __HIP_MEMORY_SCOPE_AGENT);
    }
    if (tid < 4) *((LAS unsigned*)(lds + CTRL_OFF + 64) + tid) = 0u;
    float* modb = (float*)(p->ws + p->o_mod);
    LAS float* sl = (LAS float*)lds;
    LAS float* red = sl + 17 * 1024;
    bool loaded = false;
    for (int task = blockIdx.x; task < 192; task += gridDim.x) {
        if (!loaded) {
            for (int i = tid; i < 17 * 1024; i += 512) { const int b = i >> 10, k = i & 1023; const float v = (b < 16) ? p->c[b * 1024 + k] : p->c_ctx[k]; sl[i] = v * sigm(v); }
            loaded = true;
        }
        __syncthreads();
        const int l = task / 48, nc = task % 48, nn = tid & 127, n = nc * 128 + nn, kq = tid >> 7;
        float acc[17];
#pragma unroll
        for (int b = 0; b < 17; ++b) acc[b] = 0.f;
        const float* w = p->w_mod + ((size_t)l * 1024 + kq * 256) * 6144 + n;
#pragma unroll 1
        for (int k = 0; k < 256; k += 4) {
            const float w0 = w[(size_t)k * 6144], w1 = w[(size_t)(k + 1) * 6144], w2 = w[(size_t)(k + 2) * 6144], w3 = w[(size_t)(k + 3) * 6144];
#pragma unroll
            for (int b = 0; b < 17; ++b) { const f32x4 sv = *(const LAS f32x4*)(sl + b * 1024 + kq * 256 + k); acc[b] += (sv.x * w0 + sv.y * w1) + (sv.z * w2 + sv.w * w3); }
        }
#pragma unroll
        for (int b = 0; b < 17; ++b) red[(kq * 17 + b) * 128 + nn] = acc[b];
        __syncthreads();
        if (kq == 0) {
            const float bm = p->b_mod[l * 6144 + n];
#pragma unroll
            for (int b = 0; b < 17; ++b) modb[((size_t)l * 17 + b) * 6144 + n] = red[b * 128 + nn] + red[(17 + b) * 128 + nn] + red[(34 + b) * 128 + nn] + red[(51 + b) * 128 + nn] + bm;
        }
        __syncthreads();
    }
    if (blockIdx.x == gridDim.x - 1) {
        float* lb = (float*)(p->ws + p->o_lb);
        {
            const int ch = tid;
            float v[4], mx = -1e30f;
#pragma unroll
            for (int l = 0; l < 4; ++l) { v[l] = p->c_lb[l * 512 + ch]; mx = fmaxf(mx, v[l]); }
            float s = 0.f;
#pragma unroll
            for (int l = 0; l < 4; ++l) { v[l] = __expf(v[l] - mx); s += v[l]; }
            const float inv = 1.0f / s, s0 = v[0] * inv; float cum = 0.f;
#pragma unroll
            for (int l = 0; l < 4; ++l) { cum += v[l] * inv; lb[l * 512 + ch] = cum - s0; }
        }
        float* rt = (float*)(p->ws + p->o_rope);
        for (int i = tid; i < 1024; i += 512) {
            const int n = i >> 4, f = i & 15;
            const float inv = __expf(-((float)(2 * f) / 32.0f) * 9.210340371976184f);
            const float a = (float)n * inv;
            const float kf = rintf(a * 0.15915494309189535f);
            const float rr = fmaf(-kf, 6.2831854820251465f, a) + kf * 1.7484556e-7f;
            rt[i] = __cosf(rr); rt[1024 + i] = __sinf(rr);
        }
    }
    __syncthreads();
    convert_weights(p, 0, lds);
}

__device__ __forceinline__ void rowpass(PPtr p, int l, int g, int mode, int nrows) {
    const int lane = ltid() & 63, gw = blockIdx.x * 8 + (ltid() >> 6), NGW = gridDim.x * 8;
    const int LATR = p->GB * 2048, GB = p->GB;
    const float* ng = p->norm_gains + (size_t)l * 4 * 1024;
    const float* modb = (const float*)(p->ws + p->o_mod) + (size_t)l * 17 * 6144;
    bf16_t* hb = (bf16_t*)(p->ws + p->o_h);
    const float* yf = (const float*)(p->ws + p->o_z);
    float* xcb = (float*)(p->ws + p->o_xc);
    const bool first = (l == 0 && mode <= 2);
    const float* xlat = first ? p->x : (const float*)p->out;
    const float* xctx = first ? p->ctx : (const float*)xcb;
    auto xsrc = [&](int row) -> const float* {
        if (row < LATR) return xlat + ((size_t)(g * GB + (row >> 11)) * 2048 + (row & 2047)) * 1024;
        const int r2 = row - LATR; return xctx + ((size_t)(g * GB + (r2 >> 8)) * 256 + (r2 & 255)) * 1024;
    };
    const bf16_t* slab = (const bf16_t*)(p->ws + p->o_z + (size_t)p->MG * 12288);
    const size_t slab_stride = (size_t)(p->MG - LATR) * 1024;
    auto yload = [&](int row, f32x4 (&yv)[4]) {
        if (row < LATR) {
            const bf16_t* yb = (const bf16_t*)yf + (size_t)row * 1024 + lane * 4;
#pragma unroll
            for (int j = 0; j < 4; ++j) { const u32x2 w = *(const u32x2*)(yb + 256 * j); yv[j] = (f32x4){lo16(w.x), hi16(w.x), lo16(w.y), hi16(w.y)}; }
        } else {
            const bf16_t* s0 = slab + (size_t)(row - LATR) * 1024 + lane * 4;
#pragma unroll
            for (int j = 0; j < 4; ++j) { const u32x2 w = *(const u32x2*)(s0 + 256 * j); yv[j] = (f32x4){lo16(w.x), hi16(w.x), lo16(w.y), hi16(w.y)}; }
#pragma unroll
            for (int ks = 1; ks < 8; ++ks)
#pragma unroll
                for (int j = 0; j < 4; ++j) { const u32x2 w = *(const u32x2*)(s0 + ks * slab_stride + 256 * j); yv[j] = yv[j] + (f32x4){lo16(w.x), hi16(w.x), lo16(w.y), hi16(w.y)}; }
        }
    };
    f32x4 xv[4], yv[4];
    int row = gw;
    if (row < nrows) {
        const float* xs = xsrc(row);
#pragma unroll
        for (int j = 0; j < 4; ++j) xv[j] = *(const f32x4*)(xs + lane * 4 + 256 * j);
        if (mode >= 2) yload(row, yv);
    }
    while (row < nrows) {
        const int nrow = row + NGW;
        f32x4 xn[4], yn[4];
        if (nrow < nrows) {
            const float* xs = xsrc(nrow);
#pragma unroll
            for (int j = 0; j < 4; ++j) xn[j] = *(const f32x4*)(xs + lane * 4 + 256 * j);
            if (mode >= 2) yload(nrow, yn);
        }
        const bool lat = row < LATR;
        int b; size_t xrow;
        if (lat) { b = g * GB + (row >> 11); xrow = (size_t)b * 2048 + (row & 2047); }
        else { const int r2 = row - LATR; b = g * GB + (r2 >> 8); xrow = (size_t)b * 256 + (r2 & 255); }
        float* xd = (lat ? p->out : xcb) + xrow * 1024;
        const float* m = modb + (size_t)(lat ? b : 16) * 6144;
        f32x4 tgv[4], tnv[4], tsh[4], tsc[4], tn2[4];
        {
            const float* gate = m + (mode == 2 ? 2048 : 5120); const float* gn = ng + (mode == 2 ? 1024 : 3072);
            const float* sh = m + (mode == 1 ? 0 : 3072); const float* sc = m + (mode == 1 ? 1024 : 4096); const float* gn2 = ng + (mode == 1 ? 0 : 2048);
#pragma unroll
            for (int j = 0; j < 4; ++j) {
                const int c = lane * 4 + 256 * j;
                if (mode >= 2) { tgv[j] = *(const f32x4*)(gate + c); tnv[j] = *(const f32x4*)(gn + c); }
                if (mode <= 2) { tsh[j] = *(const f32x4*)(sh + c); tsc[j] = *(const f32x4*)(sc + c); tn2[j] = *(const f32x4*)(gn2 + c); }
            }
        }
        if (mode >= 2) {
            float ss = 0.f;
#pragma unroll
            for (int j = 0; j < 4; ++j) ss += yv[j].x * yv[j].x + yv[j].y * yv[j].y + yv[j].z * yv[j].z + yv[j].w * yv[j].w;
            ss = wave_sum(ss);
            const float rs = rsqrtf(ss * (1.0f / 1024.0f) + EPS);
#pragma unroll
            for (int j = 0; j < 4; ++j) {
                const int c = lane * 4 + 256 * j;
                const f32x4 gv = tgv[j], nv = tnv[j];
                xv[j] = xv[j] + gv * (yv[j] * rs * nv);
                *(f32x4*)(xd + c) = xv[j];
            }
        }
        if (mode <= 2) {
            float ss = 0.f;
#pragma unroll
            for (int j = 0; j < 4; ++j) ss += xv[j].x * xv[j].x + xv[j].y * xv[j].y + xv[j].z * xv[j].z + xv[j].w * xv[j].w;
            ss = wave_sum(ss);
            const float rs = rsqrtf(ss * (1.0f / 1024.0f) + EPS);
#pragma unroll
            for (int j = 0; j < 4; ++j) {
                const int c = lane * 4 + 256 * j;
                const f32x4 shv = tsh[j], scv = tsc[j], nv = tn2[j];
                const f32x4 hv = (xv[j] * rs * nv) * (scv + 1.0f) + shv;
                u32x2 o; o.x = pk2(hv.x, hv.y); o.y = pk2(hv.z, hv.w);
                *(u32x2*)(hb + (size_t)row * 1024 + c) = o;
            }
        }
#pragma unroll
        for (int j = 0; j < 4; ++j) { xv[j] = xn[j]; yv[j] = yn[j]; }
        row = nrow;
    }
}

struct EpiInproj {
    static constexpr bool PERM = true, AFTER_DRAIN = false;
    bf16_t* Z; bf16_t* vta; bf16_t* vtb; const float* rope; int GB;
    __device__ __forceinline__ void operator()(const f32x4 (&acc)[2][2][4][2], const pg8::Unit& u, int wr, int wc, int fr, int fq) const {
        const int row0 = u.pm * 256 + wr * 64 + fr, LATR = GB * 2048;
#pragma unroll
        for (int bj = 0; bj < 2; ++bj) {
            const int seg = u.pn * 2 + bj, c0 = u.pn * 256 + bj * 128 + wc * 32 + 8 * fq;
            const int type = (seg <= 4) ? 1 : (seg == 5 ? 2 : ((seg >= 14 && seg <= 17) ? 3 : 0));
            const int xf = (seg <= 3 || (seg >= 6 && seg <= 9)) ? 1 : ((seg >= 18 && seg <= 21) ? 2 : ((seg >= 22 && seg <= 29) ? 3 : ((seg == 38 || seg == 39) ? 4 : 0)));
#pragma unroll
            for (int ai = 0; ai < 2; ++ai)
#pragma unroll
                for (int m = 0; m < 4; ++m) {
                    const int row = row0 + ai * 128 + m * 16;
                    f32x4 v0 = acc[ai][bj][m][0], v1 = acc[ai][bj][m][1];
                    if (type <= 1) {
                        if (type == 1 && row < LATR) {
                            const int t = row & 2047, pp0 = (c0 & 63) >> 1;
                            const int n = (pp0 < 16) ? (t >> 6) : (t & 63);
                            const float* cs = rope + n * 16 + (pp0 & 15);
                            const f32x4 cv = *(const f32x4*)cs, sv = *(const f32x4*)(cs + 1024);
                            f32x4 r0, r1;
                            r0.x = v0.x * cv.x - v0.y * sv.x; r0.y = v0.y * cv.x + v0.x * sv.x;
                            r0.z = v0.z * cv.y - v0.w * sv.y; r0.w = v0.w * cv.y + v0.z * sv.y;
                            r1.x = v1.x * cv.z - v1.y * sv.z; r1.y = v1.y * cv.z + v1.x * sv.z;
                            r1.z = v1.z * cv.w - v1.w * sv.w; r1.w = v1.w * cv.w + v1.z * sv.w;
                            v0 = r0; v1 = r1;
                        }
                        if (xf == 1) { v0 = v0 * QSCALE2; v1 = v1 * QSCALE2; }
                        else if (xf == 4) { v0 = v0 * 0.125f; v1 = v1 * 0.125f; }
                        else if (xf == 2) {
#pragma unroll
                            for (int e = 0; e < 4; ++e) { v0[e] = v0[e] * sigm(v0[e]); v1[e] = v1[e] * sigm(v1[e]); }
                        } else if (xf == 3) {
#pragma unroll
                            for (int e = 0; e < 4; ++e) { v0[e] = sigm(v0[e]); v1[e] = sigm(v1[e]); }
                        }
                        u32x4 w; w.x = pk2(v0.x, v0.y); w.y = pk2(v0.z, v0.w); w.z = pk2(v1.x, v1.y); w.w = pk2(v1.z, v1.w);
                        *(u32x4*)(Z + (size_t)row * ZW + c0) = w;
                    } else {
                        int bl, tok;
                        if (row < LATR) { bl = row >> 11; tok = row & 2047; } else { const int r2 = row - LATR; bl = r2 >> 8; tok = 2048 + (r2 & 255); }
                        const int cc = c0 - (type == 2 ? ZA_V : ZB_V), head = cc >> 6, dim0 = cc & 63, H = (type == 2) ? 2 : 8;
                        bf16_t* base = (type == 2 ? vta : vtb) + ((size_t)(bl * H + head) * 64 + dim0) * VTS + tok;
                        base[0 * VTS] = f2bf(v0.x); base[1 * VTS] = f2bf(v0.y); base[2 * VTS] = f2bf(v0.z); base[3 * VTS] = f2bf(v0.w);
                        base[4 * VTS] = f2bf(v1.x); base[5 * VTS] = f2bf(v1.y); base[6 * VTS] = f2bf(v1.z); base[7 * VTS] = f2bf(v1.w);
                    }
                }
        }
    }
};
struct EpiBranch {
    static constexpr bool PERM = true, AFTER_DRAIN = false;
    const bf16_t* Z; bf16_t* macc; int nMfull;
    __device__ __forceinline__ void operator()(const f32x4 (&acc)[2][2][4][2], const pg8::Unit& u, int wr, int wc, int fr, int fq) const {
        const int j = u.pm / nMfull, pm = u.pm - j * nMfull, pn = u.pn & 3;
        const int row0 = pm * 256 + wr * 64 + fr, col0 = pn * 256 + wc * 32 + 8 * fq;
        const bf16_t* gbase = Z + (size_t)row0 * ZW + ZMERGE + j * 1024 + col0;
        bf16_t* mbase = macc + (size_t)row0 * 1024 + col0;
#pragma unroll
        for (int ai = 0; ai < 2; ++ai) {
            u32x4 gw[4][2], pv[4][2];
#pragma unroll
            for (int m = 0; m < 4; ++m)
#pragma unroll
                for (int bj = 0; bj < 2; ++bj) {
                    const size_t ro = (size_t)(ai * 128 + m * 16);
                    gw[m][bj] = *(const u32x4*)(gbase + ro * ZW + bj * 128);
                    pv[m][bj] = (j > 0) ? *(const u32x4*)(mbase + ro * 1024 + bj * 128) : (u32x4){0u, 0u, 0u, 0u};
                }
#pragma unroll
            for (int m = 0; m < 4; ++m)
#pragma unroll
                for (int bj = 0; bj < 2; ++bj) {
                    const u32x4 g = gw[m][bj], q = pv[m][bj];
                    const f32x4 v0 = acc[ai][bj][m][0], v1 = acc[ai][bj][m][1];
                    const float t0 = v0.x * sigm(lo16(g.x)) + lo16(q.x), t1 = v0.y * sigm(hi16(g.x)) + hi16(q.x), t2 = v0.z * sigm(lo16(g.y)) + lo16(q.y), t3 = v0.w * sigm(hi16(g.y)) + hi16(q.y);
                    const float t4 = v1.x * sigm(lo16(g.z)) + lo16(q.z), t5 = v1.y * sigm(hi16(g.z)) + hi16(q.z), t6 = v1.z * sigm(lo16(g.w)) + lo16(q.w), t7 = v1.w * sigm(hi16(g.w)) + hi16(q.w);
                    u32x4 w; w.x = pk2(t0, t1); w.y = pk2(t2, t3); w.z = pk2(t4, t5); w.w = pk2(t6, t7);
                    *(u32x4*)(mbase + (size_t)(ai * 128 + m * 16) * 1024 + bj * 128) = w;
                }
        }
    }
};
struct BranchOrder {
    int nM, nMfull, G, c;
    __device__ __forceinline__ bool next(int i, pg8::Unit& u) const {
        const int j = i & 3; const int v = (c & 7) * (G >> 3) + (c >> 3);
        const long T = (long)(i >> 2) * G + v;
        if (T >= (long)nM * 4) return false;
        u.pm = j * nMfull + (int)(T >> 2); u.pn = j * 4 + (int)(T & 3); u.ko = 0; return true;
    }
    __device__ __forceinline__ void a_ready(const pg8::Unit&) const {}
    __device__ __forceinline__ void done(const pg8::Unit&) const {}
};
struct EpiBf16Y {
    static constexpr bool PERM = true, AFTER_DRAIN = false;
    bf16_t* O; int ldc;
    __device__ __forceinline__ void operator()(const f32x4 (&acc)[2][2][4][2], const pg8::Unit& u, int wr, int wc, int fr, int fq) const {
        const int row0 = u.pm * 256 + wr * 64 + fr, col0 = u.pn * 256 + wc * 32 + 8 * fq;
#pragma unroll
        for (int ai = 0; ai < 2; ++ai)
#pragma unroll
            for (int m = 0; m < 4; ++m) {
                bf16_t* rowp = O + (size_t)(row0 + ai * 128 + m * 16) * ldc + col0;
#pragma unroll
                for (int bj = 0; bj < 2; ++bj) {
                    const f32x4 v0 = acc[ai][bj][m][0], v1 = acc[ai][bj][m][1];
                    u32x4 w; w.x = pk2(v0.x, v0.y); w.y = pk2(v0.z, v0.w); w.z = pk2(v1.x, v1.y); w.w = pk2(v1.z, v1.w);
                    *(u32x4*)(rowp + bj * 128) = w;
                }
            }
    }
};
struct EpiRelu2 {
    static constexpr bool PERM = true, AFTER_DRAIN = false;
    bf16_t* O; int ldc;
    __device__ __forceinline__ void operator()(const f32x4 (&acc)[2][2][4][2], const pg8::Unit& u, int wr, int wc, int fr, int fq) const {
        const int row0 = u.pm * 256 + wr * 64 + fr, col0 = u.pn * 256 + wc * 32 + 8 * fq;
#pragma unroll
        for (int ai = 0; ai < 2; ++ai)
#pragma unroll
            for (int m = 0; m < 4; ++m) {
                bf16_t* rowp = O + (size_t)(row0 + ai * 128 + m * 16) * ldc + col0;
#pragma unroll
                for (int bj = 0; bj < 2; ++bj) {
                    f32x4 v0 = acc[ai][bj][m][0], v1 = acc[ai][bj][m][1];
#pragma unroll
                    for (int e = 0; e < 4; ++e) { const float a = fmaxf(v0[e], 0.f), b = fmaxf(v1[e], 0.f); v0[e] = a * a; v1[e] = b * b; }
                    u32x4 w; w.x = pk2(v0.x, v0.y); w.y = pk2(v0.z, v0.w); w.z = pk2(v1.x, v1.y); w.w = pk2(v1.z, v1.w);
                    *(u32x4*)(rowp + bj * 128) = w;
                }
            }
    }
};

struct CtxBranchOrder {
    int nMfull, pm0, nT, G, c;
    __device__ __forceinline__ bool next(int i, pg8::Unit& u) const {
        const long L = (long)i * G + c; if (L >= (long)nT * 4) return false;
        const int j = (int)(L & 3), t = (int)(L >> 2);
        u.pm = j * nMfull + pm0 + (t >> 2); u.pn = j * 4 + (t & 3); u.ko = 0; return true;
    }
    __device__ __forceinline__ void a_ready(const pg8::Unit&) const {}
    __device__ __forceinline__ void done(const pg8::Unit&) const {}
};
struct EpiBranchCtx {
    static constexpr bool PERM = true, AFTER_DRAIN = false;
    const bf16_t* Z; bf16_t* P; int nMfull, pm0;
    __device__ __forceinline__ void operator()(const f32x4 (&acc)[2][2][4][2], const pg8::Unit& u, int wr, int wc, int fr, int fq) const {
        const int j = u.pm / nMfull, pm = u.pm - j * nMfull, pn = u.pn & 3;
        const int row0 = pm * 256 + wr * 64 + fr, col0 = pn * 256 + wc * 32 + 8 * fq;
        const bf16_t* gbase = Z + (size_t)row0 * ZW + ZMERGE + j * 1024 + col0;
        bf16_t* pbase = P + (size_t)(row0 - pm0 * 256) * 4096 + j * 1024 + col0;
#pragma unroll
        for (int ai = 0; ai < 2; ++ai) {
            u32x4 gw[4][2];
#pragma unroll
            for (int m = 0; m < 4; ++m)
#pragma unroll
                for (int bj = 0; bj < 2; ++bj) gw[m][bj] = *(const u32x4*)(gbase + (size_t)(ai * 128 + m * 16) * ZW + bj * 128);
#pragma unroll
            for (int m = 0; m < 4; ++m)
#pragma unroll
                for (int bj = 0; bj < 2; ++bj) {
                    const u32x4 g = gw[m][bj];
                    const f32x4 v0 = acc[ai][bj][m][0], v1 = acc[ai][bj][m][1];
                    u32x4 w; w.x = pk2(v0.x * sigm(lo16(g.x)), v0.y * sigm(hi16(g.x))); w.y = pk2(v0.z * sigm(lo16(g.y)), v0.w * sigm(hi16(g.y)));
                    w.z = pk2(v1.x * sigm(lo16(g.z)), v1.y * sigm(hi16(g.z))); w.w = pk2(v1.z * sigm(lo16(g.w)), v1.w * sigm(hi16(g.w)));
                    *(u32x4*)(pbase + (size_t)(ai * 128 + m * 16) * 4096 + bj * 128) = w;
                }
        }
    }
};
struct SplitOrder {
    int pm0, nT, SPLIT, Kl, G, c;
    __device__ __forceinline__ bool next(int i, pg8::Unit& u) const {
        const long L = (long)i * G + c; if (L >= (long)nT * 4 * SPLIT) return false;
        const int ks = (int)(L % SPLIT), t = (int)(L / SPLIT);
        u.pm = pm0 + (t >> 2); u.pn = t & 3; u.ko = ks * Kl; return true;
    }
    __device__ __forceinline__ void a_ready(const pg8::Unit&) const {}
    __device__ __forceinline__ void done(const pg8::Unit&) const {}
};
struct EpiSlab {
    static constexpr bool PERM = true, AFTER_DRAIN = false;
    bf16_t* S; int pm0, nrows, Kl;
    __device__ __forceinline__ void operator()(const f32x4 (&acc)[2][2][4][2], const pg8::Unit& u, int wr, int wc, int fr, int fq) const {
        const int ks = u.ko / Kl;
        const int row0 = (u.pm - pm0) * 256 + wr * 64 + fr, col0 = u.pn * 256 + wc * 32 + 8 * fq;
        bf16_t* base = S + (size_t)ks * nrows * 1024;
#pragma unroll
        for (int ai = 0; ai < 2; ++ai)
#pragma unroll
            for (int m = 0; m < 4; ++m) { bf16_t* rowp = base + (size_t)(row0 + ai * 128 + m * 16) * 1024 + col0;
#pragma unroll
                for (int bj = 0; bj < 2; ++bj) {
                    const f32x4 v0 = acc[ai][bj][m][0], v1 = acc[ai][bj][m][1];
                    u32x4 w; w.x = pk2(v0.x, v0.y); w.y = pk2(v0.z, v0.w); w.z = pk2(v1.x, v1.y); w.w = pk2(v1.z, v1.w);
                    *(u32x4*)(rowp + bj * 128) = w;
                } }
    }
};

#define MFMA16(a, b, c) __builtin_amdgcn_mfma_f32_16x16x32_bf16((a), (b), (c), 0, 0, 0)
__device__ __forceinline__ void attn_wave(PPtr p, int l, int kind, int idx, int lane, const LAS float* biasL) {
    const int fr = lane & 15, fq = lane >> 4;
    const int LATR = p->GB * 2048, MG = p->MG;
    const bf16_t* Z = (const bf16_t*)(p->ws + p->o_z);
    const bool isA = (kind == 1 || kind == 2);
    int bl, hk, qrow0, r = 0, q0 = 0;
    if (kind == 0) { bl = idx >> 8; hk = (idx >> 5) & 7; r = idx & 31; qrow0 = bl * 2048 + r * 64; }
    else if (kind == 1) { bl = idx >> 8; hk = (idx >> 7) & 1; q0 = (idx & 127) * 16; qrow0 = bl * 2048 + q0; }
    else if (kind == 2) { bl = idx >> 5; hk = (idx >> 4) & 1; qrow0 = LATR + bl * 256 + (idx & 15) * 16; }
    else { bl = idx >> 5; hk = (idx >> 2) & 7; qrow0 = LATR + bl * 256 + (idx & 3) * 64; }
    const int qrstep = isA ? 0 : 16, qcstep = isA ? 64 : 0;
    const int qcol0 = isA ? (ZA_Q + hk * 4 * 64) : (ZB_Q + hk * 64);
    const int kcol = isA ? (ZA_K + hk * 64) : (ZB_K + hk * 64);
    const bf16_t* vt = isA ? ((const bf16_t*)(p->ws + p->o_vta) + (size_t)(bl * 2 + hk) * 64 * VTS) : ((const bf16_t*)(p->ws + p->o_vtb) + (size_t)(bl * 8 + hk) * 64 * VTS);
    bf16_t* yo = (bf16_t*)(p->ws + p->o_y4) + (isA ? (size_t)0 : (size_t)MG * 512);
    const int ocol0 = isA ? hk * 4 * 64 : hk * 64;
    const int krow_ctx0 = LATR + bl * 256, krow_lat0 = bl * 2048;

    bf16x8 Q[4][2];
#pragma unroll
    for (int s = 0; s < 4; ++s)
#pragma unroll
        for (int ks = 0; ks < 2; ++ks) Q[s][ks] = *(const bf16x8*)(Z + (size_t)(qrow0 + s * qrstep + fr) * ZW + qcol0 + s * qcstep + ks * 32 + fq * 8);
    f32x4 O[4][4]; float mrun[4], lrun[4];
#pragma unroll
    for (int s = 0; s < 4; ++s) { mrun[s] = -1e30f; lrun[s] = 0.f;
#pragma unroll
        for (int dt = 0; dt < 4; ++dt) O[s][dt] = (f32x4){0.f, 0.f, 0.f, 0.f}; }

    auto do_block = [&](int krow, int vtoff, int mode, int a0, int a1) {
        bf16x8 Kf[2][2];
#pragma unroll
        for (int kt = 0; kt < 2; ++kt)
#pragma unroll
            for (int ks = 0; ks < 2; ++ks) Kf[kt][ks] = *(const bf16x8*)(Z + (size_t)(krow + kt * 16 + fr) * ZW + kcol + ks * 32 + fq * 8);
        bf16x8 Vf[4];
#pragma unroll
        for (int dt = 0; dt < 4; ++dt) {
            const bf16_t* vp = vt + (size_t)(dt * 16 + fr) * VTS + vtoff + fq * 4;
            const u32x2 lo = *(const u32x2*)vp, hi = *(const u32x2*)(vp + 16);
            u32x4 w; w.x = lo.x; w.y = lo.y; w.z = hi.x; w.w = hi.y;
            Vf[dt] = __builtin_bit_cast(bf16x8, w);
        }
#pragma unroll
        for (int s = 0; s < 4; ++s) {
            const bool active = (mode != 2) || !((s == 0 && a1 == 1) || (s == 3 && a1 == 0));
            if (active) {
                f32x4 S0 = (f32x4){0.f, 0.f, 0.f, 0.f}, S1 = (f32x4){0.f, 0.f, 0.f, 0.f};
                S0 = MFMA16(Kf[0][0], Q[s][0], S0); S0 = MFMA16(Kf[0][1], Q[s][1], S0);
                S1 = MFMA16(Kf[1][0], Q[s][0], S1); S1 = MFMA16(Kf[1][1], Q[s][1], S1);
                float sc[8];
#pragma unroll
                for (int j = 0; j < 4; ++j) { sc[j] = S0[j]; sc[4 + j] = S1[j]; }
                if (mode == 1) {
                    const int qpos = q0 + fr;
#pragma unroll
                    for (int e = 0; e < 8; ++e) { const int kpos = a0 + (e >> 2) * 16 + fq * 4 + (e & 3); const int d = kpos - qpos; if (d > 128 || d < -128) sc[e] = -1e30f; }
                } else if (mode == 2) {
                    const int qc = 16 * s + fr; const int cs = min(max(qc - 8, 0), 48);
                    const LAS float* bp = biasL + hk * 465 + a0 * 31;
#pragma unroll
                    for (int e = 0; e < 8; ++e) {
                        const int kc = a1 * 32 + (e >> 2) * 16 + fq * 4 + (e & 3);
                        const int dc = min(max(kc - qc + 15, 0), 30);
                        const float bv = bp[dc];
                        sc[e] = (kc >= cs && kc < cs + 16) ? (sc[e] + bv) : -1e30f;
                    }
                }
                float ml = fmaxf(fmaxf(fmaxf(sc[0], sc[1]), fmaxf(sc[2], sc[3])), fmaxf(fmaxf(sc[4], sc[5]), fmaxf(sc[6], sc[7])));
                ml = xrow16_max(ml);
                const float mold = mrun[s], mn = fmaxf(mold, ml), alpha = __builtin_amdgcn_exp2f(mold - mn);
                mrun[s] = mn;
                float pv[8], ls = 0.f;
#pragma unroll
                for (int e = 0; e < 8; ++e) { pv[e] = __builtin_amdgcn_exp2f(sc[e] - mn); ls += pv[e]; }
                ls = xrow16_sum(ls);
                lrun[s] = lrun[s] * alpha + ls;
                u32x4 pw; pw.x = pk2(pv[0], pv[1]); pw.y = pk2(pv[2], pv[3]); pw.z = pk2(pv[4], pv[5]); pw.w = pk2(pv[6], pv[7]);
                const bf16x8 P = __builtin_bit_cast(bf16x8, pw);
                if (__builtin_amdgcn_ballot_w64(mn > mold) != 0ull) {
#pragma unroll
                    for (int dt = 0; dt < 4; ++dt) O[s][dt] = O[s][dt] * alpha;
                }
#pragma unroll
                for (int dt = 0; dt < 4; ++dt) O[s][dt] = MFMA16(Vf[dt], P, O[s][dt]);
            }
            __builtin_amdgcn_sched_barrier(0);
        }
    };
    int nloc = 0, lo = 0, r0 = 0;
    if (kind == 1) { lo = max(0, q0 - 128) & ~31; const int hi = min(2048, (q0 + 16 + 128 + 31) & ~31); nloc = (hi - lo) >> 5; }
    else if (kind == 0) { r0 = min(max(r - 4, 0), 24); nloc = 16; }
#pragma unroll 1
    for (int i = 0; i < 8 + nloc; ++i) {
        int krow, vtoff, mode, a0, a1;
        if (i < 8) { krow = krow_ctx0 + 32 * i; vtoff = 2048 + 32 * i; mode = 0; a0 = 0; a1 = 0; }
        else if (kind == 1) { const int kb = lo + 32 * (i - 8); krow = krow_lat0 + kb; vtoff = kb; mode = 1; a0 = kb; a1 = 0; }
        else { const int jj = i - 8, kr = r0 + (jj >> 1), hb = jj & 1; krow = krow_lat0 + kr * 64 + hb * 32; vtoff = kr * 64 + hb * 32; mode = 2; a0 = kr - r + 7; a1 = hb; }
        do_block(krow, vtoff, mode, a0, a1);
    }
#pragma unroll
    for (int s = 0; s < 4; ++s) {
        float fac;
        if (isA) { const float sk = p->a_sink[l * 8 + hk * 4 + s] * LOG2E; const float M = fmaxf(mrun[s], sk); const float e1 = __builtin_amdgcn_exp2f(mrun[s] - M); fac = e1 / (lrun[s] * e1 + __builtin_amdgcn_exp2f(sk - M)); }
        else fac = 1.0f / lrun[s];
        bf16_t* op = yo + (size_t)(qrow0 + s * qrstep + fr) * 512 + ocol0 + s * qcstep + fq * 4;
#pragma unroll
        for (int dt = 0; dt < 4; ++dt) { const f32x4 o = O[s][dt] * fac; u32x2 w; w.x = pk2(o.x, o.y); w.y = pk2(o.z, o.w); *(u32x2*)(op + dt * 16) = w; }
    }
}

constexpr int SCAN_BUF = 41472;
constexpr int BIAS_OFF = 3 * SCAN_BUF;
template <int DK, bool ISC>
__device__ __forceinline__ void scan_task(PPtr p, int l, int bl, int h, int dir, LAS unsigned char* lds) {
    constexpr int KPW = DK / 8, NTG = 64 / KPW, TPG = 32 / NTG, QS = (DK + 8) * 2, NKT = DK / 16;
    const int tid = ltid(), w = tid >> 6, lane = tid & 63, fr = lane & 15, fq = lane >> 4;
    const int kl = lane % KPW, tg = lane / KPW, kch = w * KPW + kl;
    const int vcol = tid & 127, vg = tid >> 7;
    LAS unsigned char* qt = lds; LAS unsigned char* kt_ = qt + 32 * QS; LAS unsigned char* khT = kt_ + 32 * QS; LAS unsigned char* vT = khT + DK * 80;
    LAS unsigned char* att = vT + 128 * 80; LAS float* dvec = (LAS float*)(att + 32 * 80); LAS float* evec = dvec + DK;
    const bf16_t* Z = (const bf16_t*)(p->ws + p->o_z);
    const int LATR = p->GB * 2048, MG = p->MG;
    const int qc = ISC ? (ZC_Q + h * 128 + kch) : (ZD_Q + h * 64 + kch);
    const int kc = ISC ? ((dir ? ZC_FB : ZC_FF) + h * 128 + kch) : (ZD_K + h * 64 + kch);
    const int vc = (ISC ? ZC_I : ZD_V) + h * 128 + vcol;
    const int gcol = ZD_GK + dir * 16;
    float lbv = 0.f, oml = 1.f, up[16], gb = 0.f;
#pragma unroll
    for (int r = 0; r < 16; ++r) up[r] = 0.f;
    if (ISC) { lbv = ((const float*)(p->ws + p->o_lb))[l * 512 + h * 128 + kch]; oml = 1.0f - lbv; }
    else {
#pragma unroll
        for (int r = 0; r < 16; ++r) up[r] = p->d_gate_up[((size_t)(l * 2 + dir) * 16 + r) * 256 + h * 64 + kch];
        gb = p->d_gate_bias[(l * 2 + dir) * 256 + h * 64 + kch];
    }
    bf16_t* odst = (dir == 0) ? ((bf16_t*)(p->ws + p->o_y4) + (size_t)(ISC ? 2 : 3) * MG * 512) : ((bf16_t*)(p->ws + p->o_ob) + (size_t)(ISC ? 0 : 1) * MG * 512);
    f32x4 S[NKT];
#pragma unroll
    for (int i = 0; i < NKT; ++i) S[i] = (f32x4){0.f, 0.f, 0.f, 0.f};
    const int sgn = dir ? -1 : 1;
    const long zstep = (long)sgn * ZW, ostep = (long)sgn * 512;
    auto row0of = [&](int cc) -> int {
        const bool isctx = cc < 8; const int L = isctx ? 256 : 2048, base = isctx ? (LATR + bl * 256) : (bl * 2048), c = isctx ? cc : cc - 8;
        return base + (dir ? (L - 1 - c * 32) : c * 32);
    };
    bf16_t rq[TPG], rk[TPG], rv[8]; u32x4 rz[TPG][2];
    auto load_raw = [&](int cc) {
        const int r0 = row0of(cc);
        const bf16_t* zq = Z + (size_t)(r0 + tg * TPG * sgn) * ZW;
#pragma unroll
        for (int e = 0; e < TPG; ++e) {
            const bf16_t* zr = zq + e * zstep;
            rq[e] = zr[qc]; rk[e] = zr[kc];
            if (!ISC) { rz[e][0] = *(const u32x4*)(zr + gcol); rz[e][1] = *(const u32x4*)(zr + gcol + 8); }
        }
        const bf16_t* zv = Z + (size_t)(r0 + vg * 8 * sgn) * ZW + vc;
#pragma unroll
        for (int e = 0; e < 8; ++e) rv[e] = zv[e * zstep];
    };
    load_raw(0);
    for (int cc = 0; cc < 72; ++cc) {
        __syncthreads();
        {
            float gq[TPG], gk[TPG], cum[TPG]; float run = 0.f;
#pragma unroll
            for (int e = 0; e < TPG; ++e) {
                const float zq = bf2f(rq[e]), zk = bf2f(rk[e]); float g, key, q;
                if (ISC) { const float sg = zk; g = __logf(lbv + oml * sg); key = oml * (1.0f - sg); q = zq; }
                else {
                    float a = gb;
                    const u32x4 z0 = rz[e][0], z1 = rz[e][1];
                    a += lo16(z0.x) * up[0] + hi16(z0.x) * up[1] + lo16(z0.y) * up[2] + hi16(z0.y) * up[3] + lo16(z0.z) * up[4] + hi16(z0.z) * up[5] + lo16(z0.w) * up[6] + hi16(z0.w) * up[7];
                    a += lo16(z1.x) * up[8] + hi16(z1.x) * up[9] + lo16(z1.y) * up[10] + hi16(z1.y) * up[11] + lo16(z1.z) * up[12] + hi16(z1.z) * up[13] + lo16(z1.w) * up[14] + hi16(z1.w) * up[15];
                    g = (fminf(a, 0.f) - __logf(1.0f + __expf(-fabsf(a)))) * (1.0f / 16.0f); key = zk; q = zq;
                }
                run += g; cum[e] = run; gq[e] = q; gk[e] = key;
            }
            float pre = 0.f, total = 0.f, cref = 0.f;
#pragma unroll
            for (int t = 0; t < NTG; ++t) { const float tt = __shfl(run, kl + KPW * t); if (t < tg) pre += tt; if (t < NTG / 2) cref += tt; total += tt; }
            float khv[TPG]; const float etc = __expf(total - cref);
#pragma unroll
            for (int e = 0; e < TPG; ++e) {
                const float c = cum[e] + pre; const int i = tg * TPG + e;
                const float E = __expf(c - cref), kE = gk[e] * __builtin_amdgcn_rcpf(E);
                *(LAS bf16_t*)(qt + i * QS + kch * 2) = f2bf1(gq[e] * E);
                *(LAS bf16_t*)(kt_ + i * QS + kch * 2) = f2bf1(kE);
                khv[e] = kE * etc;
            }
            if constexpr (TPG == 8) { u32x4 o; o.x = pk2(khv[0], khv[1]); o.y = pk2(khv[2], khv[3]); o.z = pk2(khv[4], khv[5]); o.w = pk2(khv[6], khv[7]); *(LAS u32x4*)(khT + kch * 80 + tg * 16) = o; }
            else { u32x2 o; o.x = pk2(khv[0], khv[1]); o.y = pk2(khv[2], khv[3]); *(LAS u32x2*)(khT + kch * 80 + tg * 8) = o; }
            if (tg == 0) { dvec[kch] = __expf(total); evec[kch] = __expf(cref); }
            u32x4 vo; vo.x = (unsigned)rv[0] | ((unsigned)rv[1] << 16); vo.y = (unsigned)rv[2] | ((unsigned)rv[3] << 16); vo.z = (unsigned)rv[4] | ((unsigned)rv[5] << 16); vo.w = (unsigned)rv[6] | ((unsigned)rv[7] << 16);
            *(LAS u32x4*)(vT + vcol * 80 + vg * 16) = vo;
        }
        if (cc + 1 < 72) load_raw(cc + 1);
        __syncthreads();
        if (w < 3) {
            const int tt = (w == 0) ? 0 : 1, st = (w == 2) ? 1 : 0;
            f32x4 a = (f32x4){0.f, 0.f, 0.f, 0.f};
#pragma unroll
            for (int ks = 0; ks < DK / 32; ++ks) {
                const bf16x8 A = *(const LAS bf16x8*)(qt + (tt * 16 + fr) * QS + (ks * 32 + fq * 8) * 2);
                const bf16x8 B = *(const LAS bf16x8*)(kt_ + (st * 16 + fr) * QS + (ks * 32 + fq * 8) * 2);
                a = MFMA16(A, B, a);
            }
#pragma unroll
            for (int j = 0; j < 4; ++j) { const int t = tt * 16 + fq * 4 + j, s = st * 16 + fr; *(LAS bf16_t*)(att + t * 80 + s * 2) = f2bf1(s <= t ? a[j] : 0.f); }
        } else if (w == 3) {
#pragma unroll
            for (int j = 0; j < 4; ++j) { const int t = fq * 4 + j, s = 16 + fr; *(LAS bf16_t*)(att + t * 80 + s * 2) = (bf16_t)0; }
        }
        __syncthreads();
        {
            const int vs = w * 16;
            bf16_t* ob0 = odst + (size_t)(row0of(cc) + fq * 4 * sgn) * 512 + h * 128 + vs + fr;
            const bf16x8 Bv = *(const LAS bf16x8*)(vT + (vs + fr) * 80 + fq * 16);
            bf16x8 Sb[NKT / 2];
#pragma unroll
            for (int kp = 0; kp < NKT / 2; ++kp) {
                const f32x4 e0 = *(const LAS f32x4*)(evec + (2 * kp) * 16 + fq * 4), e1 = *(const LAS f32x4*)(evec + (2 * kp + 1) * 16 + fq * 4);
                const f32x4 s0 = S[2 * kp] * e0, s1 = S[2 * kp + 1] * e1;
                u32x4 sw; sw.x = pk2(s0.x, s0.y); sw.y = pk2(s0.z, s0.w); sw.z = pk2(s1.x, s1.y); sw.w = pk2(s1.z, s1.w);
                Sb[kp] = __builtin_bit_cast(bf16x8, sw);
            }
#pragma unroll
            for (int tt = 0; tt < 2; ++tt) {
                f32x4 o = (f32x4){0.f, 0.f, 0.f, 0.f};
#pragma unroll
                for (int kp = 0; kp < NKT / 2; ++kp) {
                    const u32x2 lo = *(const LAS u32x2*)(qt + (tt * 16 + fr) * QS + ((2 * kp) * 16 + fq * 4) * 2);
                    const u32x2 hi = *(const LAS u32x2*)(qt + (tt * 16 + fr) * QS + ((2 * kp + 1) * 16 + fq * 4) * 2);
                    u32x4 aw; aw.x = lo.x; aw.y = lo.y; aw.z = hi.x; aw.w = hi.y;
                    o = MFMA16(__builtin_bit_cast(bf16x8, aw), Sb[kp], o);
                }
                const bf16x8 A2 = *(const LAS bf16x8*)(att + (tt * 16 + fr) * 80 + fq * 16);
                o = MFMA16(A2, Bv, o);
#pragma unroll
                for (int j = 0; j < 4; ++j) ob0[(tt * 16 + j) * ostep] = f2bf1(o[j]);
            }
#pragma unroll
            for (int k2 = 0; k2 < NKT; ++k2) {
                const f32x4 d = *(const LAS f32x4*)(dvec + k2 * 16 + fq * 4);
                S[k2] = S[k2] * d;
                const bf16x8 A3 = *(const LAS bf16x8*)(khT + (k2 * 16 + fr) * 80 + fq * 16);
                S[k2] = MFMA16(A3, Bv, S[k2]);
            }
        }
    }
    __syncthreads();
}

__device__ __forceinline__ void mixer(PPtr p, int l, int g, LAS unsigned char* lds, unsigned long long* tscan = nullptr) {
    const int tid = ltid(), w = tid >> 6, lane = tid & 63;
    LAS float* biasL = (LAS float*)(lds + BIAS_OFF);
    for (int i = tid; i < 8 * 465; i += 512) biasL[i] = p->b_rel_bias[(size_t)l * 8 * 465 + i] * LOG2E;
    __syncthreads();
    const int GB = p->GB, NSC = GB * 8, NS = GB * 16;
    const unsigned long long ts0 = tscan ? __builtin_amdgcn_s_memrealtime() : 0ull;
    for (int st = blockIdx.x; st < NS; st += gridDim.x) {
        if (st < NSC) { scan_task<128, true>(p, l, st >> 3, (st >> 1) & 3, st & 1, lds); }
        else { const int s2 = st - NSC; scan_task<64, false>(p, l, s2 >> 3, (s2 >> 1) & 3, s2 & 1, lds); }
    }
    if (tscan) *tscan += __builtin_amdgcn_s_memrealtime() - ts0;
    unsigned* ctr = (unsigned*)p->ws + (l * 16 + g);
    const int NB0 = GB * 32, NB1 = GB * 32, NB2 = (l < DEPTH - 1) ? GB * 4 : 0, NB3 = NB2, NBT = NB0 + NB1 + NB2 + NB3;
    LAS int* tw = (LAS int*)(lds + CTRL_OFF);
    for (;;) {
        if (tid == 0) *tw = (int)atomicAdd(ctr, 1u);
        __syncthreads();
        const int bt = *tw;
        __syncthreads();
        if (bt >= NBT) break;
        int kind, idx;
        if (bt < NB0) { kind = 0; idx = bt * 8 + w; }
        else if (bt < NB0 + NB1) { kind = 1; idx = (bt - NB0) * 8 + w; }
        else if (bt < NB0 + NB1 + NB2) { kind = 2; idx = (bt - NB0 - NB1) * 8 + w; }
        else { kind = 3; idx = (bt - NB0 - NB1 - NB2) * 8 + w; }
        attn_wave(p, l, kind, idx, lane, biasL);
    }
}

__device__ __forceinline__ void postpass(PPtr p, int l, int nrows) {
    const int lane = ltid() & 63, gw = blockIdx.x * 8 + (ltid() >> 6), NGW = gridDim.x * 8, MG = p->MG;
    const bf16_t* Z = (const bf16_t*)(p->ws + p->o_z);
    for (int it = gw; it < nrows * 2; it += NGW) {
        const int row = it >> 1, br = it & 1;
        bf16_t* yf = (bf16_t*)(p->ws + p->o_y4) + (size_t)(2 + br) * MG * 512 + (size_t)row * 512 + lane * 8;
        const bf16_t* yb = (const bf16_t*)(p->ws + p->o_ob) + (size_t)br * MG * 512 + (size_t)row * 512 + lane * 8;
        const u32x4 a = *(const u32x4*)yf, b = *(const u32x4*)yb;
        const u32x4 gt = *(const u32x4*)(Z + (size_t)row * ZW + (br ? ZD_G : ZC_G) + lane * 8);
        const float* gain = (br ? p->d_norm : p->c_norm) + l * 128 + (lane & 15) * 8;
        float o[8], gv[8];
        o[0] = lo16(a.x) + lo16(b.x); o[1] = hi16(a.x) + hi16(b.x); o[2] = lo16(a.y) + lo16(b.y); o[3] = hi16(a.y) + hi16(b.y);
        o[4] = lo16(a.z) + lo16(b.z); o[5] = hi16(a.z) + hi16(b.z); o[6] = lo16(a.w) + lo16(b.w); o[7] = hi16(a.w) + hi16(b.w);
        gv[0] = lo16(gt.x); gv[1] = hi16(gt.x); gv[2] = lo16(gt.y); gv[3] = hi16(gt.y); gv[4] = lo16(gt.z); gv[5] = hi16(gt.z); gv[6] = lo16(gt.w); gv[7] = hi16(gt.w);
        float ss = 0.f;
#pragma unroll
        for (int e = 0; e < 8; ++e) ss += o[e] * o[e];
        ss = row16_sum(ss);
        const float rs = rsqrtf(ss * (1.0f / 128.0f) + EPS);
        const f32x4 g0 = *(const f32x4*)gain, g1 = *(const f32x4*)(gain + 4);
        float y[8];
#pragma unroll
        for (int e = 0; e < 8; ++e) { const float gn = (e < 4) ? g0[e & 3] : g1[e & 3]; y[e] = o[e] * rs * gn * (gv[e] * sigm(gv[e])); }
        u32x4 wv; wv.x = pk2(y[0], y[1]); wv.y = pk2(y[2], y[3]); wv.z = pk2(y[4], y[5]); wv.w = pk2(y[6], y[7]);
        *(u32x4*)yf = wv;
    }
}

#define NOINL __device__ __forceinline__
NOINL void ph_prologue(PPtr pc, LAS unsigned char* lds) { PPtr p = pc; asm volatile("" : "+s"(p)); prologue(p, lds); }
NOINL void ph_rowpass(PPtr pc, int l, int g, int mode, int nrows, int conv_l, LAS unsigned char* lds) { PPtr p = pc; asm volatile("" : "+s"(p)); rowpass(p, l, g, mode, nrows); if (conv_l >= 0) convert_weights(p, conv_l, lds); }
NOINL void ph_rowpass_tail(PPtr pc, int l, int g, int nrows, int conv_l, int nl, int ng, int nrows_next, LAS unsigned char* lds) {
    PPtr p = pc; asm volatile("" : "+s"(p));
    rowpass(p, l, g, 3, nrows);
    if (nl >= 0) rowpass(p, nl, ng, 1, nrows_next);
    if (conv_l >= 0) convert_weights(p, conv_l, lds);
}
NOINL void ph_inproj(PPtr pc, LAS unsigned char* lds) {
    PPtr p = pc; asm volatile("" : "+s"(p)); const int G = (int)gridDim.x, c = (int)blockIdx.x;
    pg8::Gemm gm{(const bf16_t*)(p->ws + p->o_h), (const bf16_t*)(p->ws + p->o_win), p->MG, ZW, 1024, 1024}; pg8::StaticOrder S; S.init(p->MG, ZW, G, c);
    EpiInproj E{(bf16_t*)(p->ws + p->o_z), (bf16_t*)(p->ws + p->o_vta), (bf16_t*)(p->ws + p->o_vtb), (const float*)(p->ws + p->o_rope), p->GB};
    pg8::gemm_phase<EpiInproj, pg8::StaticOrder>(lds, gm, S, E, nullptr);
}
NOINL void ph_mixer(PPtr pc, int l, int g, LAS unsigned char* lds, unsigned long long* tscan = nullptr) { PPtr p = pc; asm volatile("" : "+s"(p)); mixer(p, l, g, lds, tscan); }
NOINL void ph_post(PPtr pc, int l, int nrows) { PPtr p = pc; asm volatile("" : "+s"(p)); postpass(p, l, nrows); }
NOINL void ph_branch(PPtr pc, int Mr, LAS unsigned char* lds) {
    PPtr p = pc; asm volatile("" : "+s"(p)); const int G = (int)gridDim.x, c = (int)blockIdx.x;
    const int LATR = p->GB * 2048, nMfull = p->MG / 256;
    pg8::Gemm gm{(const bf16_t*)(p->ws + p->o_y4), (const bf16_t*)(p->ws + p->o_wb), Mr, 1024, 512, 512};
    { BranchOrder S{LATR / 256, nMfull, G, c};
      EpiBranch E{(const bf16_t*)(p->ws + p->o_z), (bf16_t*)(p->ws + p->o_h), nMfull};
      pg8::gemm_phase<EpiBranch, BranchOrder>(lds, gm, S, E, nullptr); }
    if (Mr > LATR) {
        CtxBranchOrder S{nMfull, LATR / 256, (Mr - LATR) / 256 * 4, G, c};
        EpiBranchCtx E{(const bf16_t*)(p->ws + p->o_z), (bf16_t*)(p->ws + p->o_ob), nMfull, LATR / 256};
        pg8::gemm_phase<EpiBranchCtx, CtxBranchOrder>(lds, gm, S, E, nullptr);
    }
}
NOINL void ph_gemm_f32(PPtr pc, int which, int Mr, LAS unsigned char* lds) {
    PPtr p = pc; asm volatile("" : "+s"(p)); const int G = (int)gridDim.x, c = (int)blockIdx.x;
    const int LATR = p->GB * 2048;
    const bf16_t* hid = (const bf16_t*)(p->ws + p->o_z + (size_t)p->MG * 1024 * 4);
    { const bf16_t* A = which ? hid : (const bf16_t*)(p->ws + p->o_h);
      const bf16_t* Bt = which ? (const bf16_t*)(p->ws + p->o_w2) : (const bf16_t*)(p->ws + p->o_wo);
      const int K = which ? 4096 : 1024;
      pg8::Gemm gm{A, Bt, LATR, 1024, K, K}; pg8::StaticOrder S; S.init(LATR, 1024, G, c);
      EpiBf16Y E{(bf16_t*)(p->ws + p->o_z), 1024};
      pg8::gemm_phase<EpiBf16Y, pg8::StaticOrder>(lds, gm, S, E, nullptr); }
    if (Mr > LATR) {
        const bf16_t* A = which ? hid : ((const bf16_t*)(p->ws + p->o_ob) - (size_t)LATR * 4096);
        const bf16_t* Bt = which ? (const bf16_t*)(p->ws + p->o_w2) : (const bf16_t*)(p->ws + p->o_wo4);
        pg8::Gemm gm{A, Bt, Mr, 1024, 4096, 512};
        SplitOrder S{LATR / 256, (Mr - LATR) / 256, 8, 512, G, c};
        EpiSlab E{(bf16_t*)(p->ws + p->o_z + (size_t)p->MG * 12288), LATR / 256, Mr - LATR, 512};
        pg8::gemm_phase<EpiSlab, SplitOrder>(lds, gm, S, E, nullptr);
    }
}
NOINL void ph_ffn1(PPtr pc, int Mr, LAS unsigned char* lds) {
    PPtr p = pc; asm volatile("" : "+s"(p)); const int G = (int)gridDim.x, c = (int)blockIdx.x;
    pg8::Gemm gm{(const bf16_t*)(p->ws + p->o_h), (const bf16_t*)(p->ws + p->o_w1), Mr, 4096, 1024, 1024}; pg8::StaticOrder S; S.init(Mr, 4096, G, c);
    EpiRelu2 E{(bf16_t*)(p->ws + p->o_z + (size_t)p->MG * 1024 * 4), 4096};
    pg8::gemm_phase<EpiRelu2, pg8::StaticOrder>(lds, gm, S, E, nullptr);
}

#define XB_SETUP() volatile LAS unsigned* xb_st = (volatile LAS unsigned*)(lds + CTRL_OFF + 64); unsigned* xb_bar = (unsigned*)(pc->ws + 4096); { XcdBarrier xb0 = xcd_barrier_post(xb_bar, xb_st); (void)xb0; }
#define GSYNC() { XcdBarrier xb_; xb_.bar = (unsigned*)(pc->ws + 4096); xb_.x = xb_xcc_id(); xb_.st = (volatile LAS unsigned*)(lds + CTRL_OFF + 64); xcd_barrier(xb_); }
#ifdef PROBE_MASK
__global__ void __launch_bounds__(512) hybrid_fwd(Params pk) {
    extern __shared__ __attribute__((aligned(16))) unsigned char smem[];
    LAS unsigned char* lds = (LAS unsigned char*)smem;
    cg::grid_group grid = cg::this_grid();
    PPtr pc = (PPtr)__builtin_amdgcn_kernarg_segment_ptr();
    const int GB = pc->GB, MG = pc->MG, NGRP = pc->NGRP, LATR = GB * 2048;
    unsigned long long tacc = 0, t0_ = __builtin_amdgcn_s_memrealtime();
#define PT(kind) { const unsigned long long t1_ = __builtin_amdgcn_s_memrealtime(); if ((PROBE_MASK >> (kind)) & 1) tacc += t1_ - t0_; t0_ = t1_; }
    ph_prologue(pc, lds);
    grid.sync();
    XB_SETUP(); PT(0)
    for (int l = 0; l < DEPTH; ++l) {
        const int Mr = (l < DEPTH - 1) ? MG : LATR;
        for (int g = 0; g < NGRP; ++g) {
            ph_rowpass(pc, l, g, 1, MG, -1, lds);
            GSYNC(); PT(1)
            ph_inproj(pc, lds);
            GSYNC(); PT(2)
            { unsigned long long tsc = 0; ph_mixer(pc, l, g, lds, &tsc); if ((PROBE_MASK >> 11) & 1) tacc += tsc; }
            GSYNC(); PT(3)
            ph_post(pc, l, Mr);
            GSYNC(); PT(4)
            ph_branch(pc, Mr, lds);
            GSYNC(); PT(5)
            ph_gemm_f32(pc, 0, Mr, lds);
            GSYNC(); PT(6)
            ph_rowpass(pc, l, g, 2, Mr, -1, lds);
            GSYNC(); PT(7)
            ph_ffn1(pc, Mr, lds);
            GSYNC(); PT(8)
            ph_gemm_f32(pc, 1, Mr, lds);
            GSYNC(); PT(9)
            ph_rowpass(pc, l, g, 3, Mr, (g == NGRP - 1 && l + 1 < DEPTH) ? l + 1 : -1, lds);
            GSYNC(); PT(10)
        }
    }
    if (blockIdx.x == 0) { const unsigned M = (unsigned)(tacc / 100ull); float* o = pc->out; for (unsigned i2 = threadIdx.x; i2 < M; i2 += 512) o[i2] += 0.125f; }
}

#else
__global__ void __launch_bounds__(512) hybrid_fwd(Params pk) {
    extern __shared__ __attribute__((aligned(16))) unsigned char smem[];
    LAS unsigned char* lds = (LAS unsigned char*)smem;
    cg::grid_group grid = cg::this_grid();
    PPtr pc = (PPtr)__builtin_amdgcn_kernarg_segment_ptr();
    const int GB = pc->GB, MG = pc->MG, NGRP = pc->NGRP, LATR = GB * 2048;
    ph_prologue(pc, lds);
    grid.sync();
    XB_SETUP();
    for (int l = 0; l < DEPTH; ++l) {
        const int Mr = (l < DEPTH - 1) ? MG : LATR;
        for (int g = 0; g < NGRP; ++g) {
            if ((l == 0 && g == 0) || NGRP == 1) { ph_rowpass(pc, l, g, 1, MG, -1, lds); GSYNC(); }
            ph_inproj(pc, lds);
            GSYNC();
            ph_mixer(pc, l, g, lds);
            GSYNC();
            ph_post(pc, l, Mr);
            GSYNC();
            ph_branch(pc, Mr, lds);
            GSYNC();
            ph_gemm_f32(pc, 0, Mr, lds);
            GSYNC();
            ph_rowpass(pc, l, g, 2, Mr, -1, lds);
            GSYNC();
            ph_ffn1(pc, Mr, lds);
            GSYNC();
            ph_gemm_f32(pc, 1, Mr, lds);
            GSYNC();
            {
                const bool lastg = (g == NGRP - 1);
                const int nl = (NGRP == 1) ? -1 : (lastg ? (l + 1 < DEPTH ? l + 1 : -1) : l), ng = lastg ? 0 : g + 1;
                ph_rowpass_tail(pc, l, g, Mr, (lastg && l + 1 < DEPTH) ? l + 1 : -1, nl, ng, MG, lds);
            }
            if (!(l == DEPTH - 1 && g == NGRP - 1)) GSYNC();
        }
    }
}

#endif
extern "C" void kernel_launch(void* const* d_in, const int* in_sizes, int n_in, void* d_out, int out_size, void* d_ws, size_t ws_size, hipStream_t stream) {
    static int grid_blocks = 0;
    if (grid_blocks == 0) {
        int dev = 0, cus = 0, per_cu = 0;
        hipGetDevice(&dev);
        hipDeviceGetAttribute(&cus, hipDeviceAttributeMultiprocessorCount, dev);
        if (hipFuncSetAttribute((const void*)hybrid_fwd, hipFuncAttributeMaxDynamicSharedMemorySize, LDS_BYTES) != hipSuccess) fprintf(stderr, "hipFuncSetAttribute failed\n");
        if (hipOccupancyMaxActiveBlocksPerMultiprocessor(&per_cu, (const void*)hybrid_fwd, 512, LDS_BYTES) != hipSuccess || per_cu < 1) { fprintf(stderr, "occupancy query: %d\n", per_cu); per_cu = 1; }
        (void)hipGetLastError();
        grid_blocks = cus * 1;
        if (grid_blocks <= 0) grid_blocks = 256;
    }
    Params p{};
    const float* const* in = (const float* const*)d_in;
    p.x = in[0]; p.c = in[1]; p.ctx = in[2]; p.c_ctx = in[3]; p.w_mod = in[4]; p.b_mod = in[5]; p.norm_gains = in[6]; p.w_in = in[7]; p.a_sink = in[8]; p.b_rel_bias = in[9];
    p.c_lb = in[10]; p.c_norm = in[11]; p.d_gate_up = in[12]; p.d_gate_bias = in[13]; p.d_norm = in[14]; p.w_branch = in[15]; p.w_out = in[16]; p.w_ff1 = in[17]; p.w_ff2 = in[18];
    p.out = (float*)d_out; p.ws = (unsigned char*)d_ws;
    auto al = [](unsigned long long v) { return (v + 255ull) & ~255ull; };
    unsigned long long off = 32768;
    p.o_mod = off; off = al(off + 4ull * 17 * 6144 * 4);
    p.o_lb = off; off = al(off + 4ull * 512 * 4);
    p.o_rope = off; off = al(off + 2048ull * 4);
    p.o_xc = off; off = al(off + 4096ull * 1024 * 4);
    p.o_win = off; off = al(off + (unsigned long long)ZW * 1024 * 2);
    p.o_wb = off; off = al(off + 4096ull * 512 * 2);
    p.o_wo = off; off = al(off + 1024ull * 1024 * 2);
    p.o_w1 = off; off = al(off + 4096ull * 1024 * 2);
    p.o_w2 = off; off = al(off + 1024ull * 4096 * 2);
    p.o_wo4 = off; off = al(off + 1024ull * 4096 * 2);
    const unsigned long long fixed = off;
    int GB = 16;
    for (; GB > 1; GB >>= 1) {
        const unsigned long long MGt = (unsigned long long)GB * 2304;
        const unsigned long long need = fixed + MGt * (2048ull + (unsigned long long)ZW * 2 + 4096ull + 2048ull) + (unsigned long long)GB * 10 * 64 * VTS * 2 + 8 * 256;
        if (need <= (unsigned long long)ws_size) break;
    }
    p.GB = GB; p.NGRP = 16 / GB; p.MG = GB * 2304;
    const unsigned long long MGu = (unsigned long long)p.MG;
    p.o_h = off; off = al(off + MGu * 1024 * 2);
    p.o_z = off; off = al(off + MGu * ZW * 2);
    p.o_y4 = off; off = al(off + MGu * 2048 * 2);
    p.o_ob = off; off = al(off + MGu * 1024 * 2);
    p.o_vta = off; off = al(off + (unsigned long long)GB * 2 * 64 * VTS * 2);
    p.o_vtb = off; off = al(off + (unsigned long long)GB * 8 * 64 * VTS * 2);
    hipMemsetAsync(d_ws, 0, 32768, stream);
    void* args[] = {&p};
    hipError_t e = hipLaunchCooperativeKernel((const void*)hybrid_fwd, dim3(grid_blocks), dim3(512), args, LDS_BYTES, stream);
    if (e != hipSuccess) fprintf(stderr, "cooperative launch failed: %s (grid %d)\n", hipGetErrorString(e), grid_blocks);
}
```

```cpp
#include <hip/hip_runtime.h>
#include <hip/hip_cooperative_groups.h>
#include <cstdio>
namespace cg = cooperative_groups;
__device__ __forceinline__ int ltid() { int t = (int)threadIdx.x; asm volatile("" : "+v"(t)); return t; }
#define LAS __attribute__((address_space(3)))
namespace pg8 {
#define PG8_LAS __attribute__((address_space(3)))
typedef unsigned short bf16_t;
typedef short bf16x8 __attribute__((ext_vector_type(8)));
typedef float f32x4 __attribute__((ext_vector_type(4)));
typedef unsigned u32x4 __attribute__((ext_vector_type(4)));
constexpr int BM = 256, BK = 64, HALF = 128, HTB = HALF * BK * 2  , STAGE_BYTES = 8 * HTB, NXCD = 8, WGM = 8;

__host__ __device__ __forceinline__ int lds_byte(int r, int c) { const int st = (r >> 4) * 2 + (c >> 5), rr = r & 15, cc = c & 31, ob = rr * 64 + cc * 2; return st * 1024 + (ob ^ (((ob >> 9) & 1) << 5)); }
__host__ __device__ __forceinline__ void stage_rc(int b, int& R, int& C) { const int st = b / 1024, sb = b % 1024, swz = sb ^ (((sb >> 9) & 1) << 5); R = (st >> 1) * 16 + swz / 64; C = (st & 1) * 32 + (swz % 64) / 2; }
__host__ __device__ __forceinline__ int perm32(int rho) { const int n = rho >> 4, i = rho & 15; return 8 * (i >> 2) + 4 * n + (i & 3); }

struct Unit { int pm, pn, ko; };
struct Gemm { const bf16_t* A; const bf16_t* Bt; int M, N, K, Kl; };

struct StaticOrder {
    int nM, nN, nwg, G, c;
    __host__ __device__ void init(int M, int N, int G_, int c_) { nM = M / BM; nN = N / BM; nwg = nM * nN; G = G_; c = c_; }
    __host__ __device__ bool next(int i, Unit& u) const {
        const long L = (long)i * G + c; if (L >= nwg) return false;
        int wgid = (int)L; { const int q = nwg / NXCD, r = nwg % NXCD, xcd = wgid % NXCD, off = wgid / NXCD; wgid = (xcd < r ? xcd * (q + 1) : r * (q + 1) + (xcd - r) * q) + off; }
        const int nig = WGM * nN, gid = wgid / nig, fm = gid * WGM, gsz = (nM - fm) < WGM ? (nM - fm) : WGM;
        u.pm = fm + ((wgid % nig) % gsz); u.pn = (wgid % nig) / gsz; u.ko = 0; return true;
    }
    __device__ __forceinline__ void a_ready(const Unit&) const {}
    __device__ __forceinline__ void done(const Unit&) const {}
};
__device__ __forceinline__ unsigned cvt_pk_bf16(float lo, float hi) { unsigned r; asm volatile("v_cvt_pk_bf16_f32 %0, %1, %2" : "=v"(r) : "v"(lo), "v"(hi)); return r; }
struct EpiF32 {
    static constexpr bool PERM = false, AFTER_DRAIN = false;
    float* C; int ldc; const float* bias;
    __device__ __forceinline__ void operator()(const f32x4 (&acc)[2][2][4][2], const Unit& u, int wr, int wc, int fr, int fq) const {
        const int row0 = u.pm * BM + wr * 64 + fr, col0 = u.pn * BM + wc * 32 + 4 * fq;
        f32x4 bv[2][2];
#pragma unroll
        for (int bj = 0; bj < 2; ++bj)
#pragma unroll
            for (int n = 0; n < 2; ++n) bv[bj][n] = bias ? *(const f32x4*)(bias + col0 + bj * HALF + n * 16) : (f32x4){0.f, 0.f, 0.f, 0.f};
#pragma unroll
        for (int ai = 0; ai < 2; ++ai)
#pragma unroll
            for (int m = 0; m < 4; ++m) { float* rowp = C + (size_t)(row0 + ai * HALF + m * 16) * ldc + col0;
#pragma unroll
                for (int bj = 0; bj < 2; ++bj)
#pragma unroll
                    for (int n = 0; n < 2; ++n) *(f32x4*)(rowp + bj * HALF + n * 16) = acc[ai][bj][m][n] + bv[bj][n]; }
    }
};
template <class Epi, class Sched, bool STAMP = false>
__device__ __forceinline__ void gemm_phase(PG8_LAS unsigned char* lds, const Gemm g, const Sched& S, const Epi& E, unsigned long long* stamps) {
    const int tid = ltid(), wid = __builtin_amdgcn_readfirstlane(tid >> 6), lane = tid & 63, wr = wid >> 2, wc = wid & 3, fr = lane & 15, fq = lane >> 4;
    const int K = g.K, nt = g.Kl / BK;
    int ts_lo = 0, ts_hi = 0, nts = 0; const unsigned long long rt_entry = STAMP ? (unsigned long long)wall_clock64() : 0ull;
#define PG8_STAMP() do { if (STAMP && wid == 0 && nts < 64) { const unsigned long long _c = (unsigned long long)clock64(); \
        ts_lo = (lane == nts) ? (int)(unsigned)_c : ts_lo; ts_hi = (lane == nts) ? (int)(unsigned)(_c >> 32) : ts_hi; ++nts; } } while (0)
    PG8_STAMP();
    unsigned voffA[2], voffB[2];
#pragma unroll
    for (int i = 0; i < 2; ++i) { int R, C; stage_rc(tid * 16 + i * 8192, R, C); const int Rb = Epi::PERM ? ((R & ~31) + perm32(R & 31)) : R;
        voffA[i] = (unsigned)(R * K + C) * 2u; voffB[i] = (unsigned)(Rb * K + C) * 2u; }
    const size_t kstep = (size_t)(BK * 2);
    const size_t hstep = (size_t)HALF * K * 2;
    const size_t tstep = 2 * hstep;
    const unsigned ldsw = (unsigned)wid * 1024u;
    const int aoff = lds_byte(wr * 64 + fr, fq * 8), boff = lds_byte(wc * 32 + fr, fq * 8);
#define PG8_SA(b, h) (((b) * 2 + (h)) * HTB)
#define PG8_SB(b, h) ((4 + (b) * 2 + (h)) * HTB)
#define PG8_STAGE(bufoff, gbase, voff) do { _Pragma("unroll") for (int _i = 0; _i < 2; ++_i) \
        __builtin_amdgcn_global_load_lds((const unsigned*)((const char*)(gbase) + (voff)[_i]), (PG8_LAS unsigned*)(lds + (bufoff) + ldsw + _i * 8192), 16, 0, 0); } while (0)
#define PG8_LDA(dst, b, h) do { _Pragma("unroll") for (int m = 0; m < 4; ++m) _Pragma("unroll") for (int k = 0; k < 2; ++k) dst[m][k] = *(const PG8_LAS bf16x8*)(lds + PG8_SA(b, h) + aoff + m * 2048 + k * 1024); } while (0)
#define PG8_LDB(dst, b, h) do { _Pragma("unroll") for (int n = 0; n < 2; ++n) _Pragma("unroll") for (int k = 0; k < 2; ++k) dst[n][k] = *(const PG8_LAS bf16x8*)(lds + PG8_SB(b, h) + boff + n * 2048 + k * 1024); } while (0)
#define PG8_MMA(ai, bj, At, Bt) do { __builtin_amdgcn_s_setprio(1); _Pragma("unroll") for (int m = 0; m < 4; ++m) _Pragma("unroll") for (int n = 0; n < 2; ++n) _Pragma("unroll") for (int k = 0; k < 2; ++k) \
        acc[ai][bj][m][n] = __builtin_amdgcn_mfma_f32_16x16x32_bf16(Bt[n][k], At[m][k], acc[ai][bj][m][n], 0, 0, 0); __builtin_amdgcn_s_setprio(0); } while (0)
#define PG8_WAIT_V(n) asm volatile("s_waitcnt vmcnt(" #n ")" ::: "memory")
#define PG8_WAIT_L(n) asm volatile("s_waitcnt lgkmcnt(" #n ")" ::: "memory")
#define PG8_BAR __builtin_amdgcn_s_barrier()
#define PG8_SCHED __builtin_amdgcn_sched_barrier(0)
    Unit cur, nxt; int ui = 0;
    if (!S.next(0, cur)) return;
    f32x4 acc[2][2][4][2];
#pragma unroll
    for (int a = 0; a < 2; ++a)
#pragma unroll
        for (int b = 0; b < 2; ++b)
#pragma unroll
            for (int m = 0; m < 4; ++m)
#pragma unroll
                for (int n = 0; n < 2; ++n) acc[a][b][m][n] = (f32x4){0.f, 0.f, 0.f, 0.f};
    bf16x8 At[4][2], B0[2][2], B1[2][2];
    const char* cA = (const char*)g.A + (size_t)cur.pm * tstep + (size_t)cur.ko * 2; const char* cB = (const char*)g.Bt + (size_t)cur.pn * tstep + (size_t)cur.ko * 2;
    S.a_ready(cur);
    PG8_STAGE(PG8_SB(0, 0), cB, voffB); PG8_STAGE(PG8_SA(0, 0), cA, voffA); PG8_STAGE(PG8_SB(0, 1), cB + hstep, voffB); PG8_STAGE(PG8_SA(0, 1), cA + hstep, voffA);
    if (wr == 1) PG8_BAR;
    PG8_WAIT_V(4); PG8_BAR;
    PG8_STAGE(PG8_SB(1, 0), cB + kstep, voffB); PG8_STAGE(PG8_SA(1, 0), cA + kstep, voffA); PG8_STAGE(PG8_SB(1, 1), cB + hstep + kstep, voffB);
    PG8_WAIT_V(6); PG8_BAR;
    PG8_STAMP();
    for (;;) {
        const bool has_next = S.next(ui + 1, nxt);
        const char* nA = has_next ? (const char*)g.A + (size_t)nxt.pm * tstep + (size_t)nxt.ko * 2 : cA; const char* nB = has_next ? (const char*)g.Bt + (size_t)nxt.pn * tstep + (size_t)nxt.ko * 2 : cB;
        for (int t = 0; t < nt; t += 2) {
            const bool last = (t == nt - 2);
            const char* a1 = cA + (size_t)(t + 1) * kstep;
            const char* a2 = last ? nA : cA + (size_t)(t + 2) * kstep; const char* b2 = last ? nB : cB + (size_t)(t + 2) * kstep;
            const char* a3 = a2 + kstep; const char* b3 = b2 + kstep;
            if (last && has_next) S.a_ready(nxt);
            PG8_LDB(B0, 0, 0); PG8_SCHED; PG8_LDA(At, 0, 0); PG8_STAGE(PG8_SA(1, 1), a1 + hstep, voffA);
            PG8_WAIT_L(8); PG8_BAR; PG8_WAIT_L(0); PG8_MMA(0, 0, At, B0); PG8_BAR; PG8_SCHED;
            PG8_LDB(B1, 0, 1); PG8_STAGE(PG8_SB(0, 0), b2, voffB);
            PG8_BAR; PG8_WAIT_L(0); PG8_MMA(0, 1, At, B1); PG8_BAR;
            PG8_LDA(At, 0, 1); PG8_STAGE(PG8_SA(0, 0), a2, voffA);
            PG8_BAR; PG8_WAIT_L(0); PG8_MMA(1, 0, At, B0); PG8_BAR; PG8_SCHED;
            PG8_STAGE(PG8_SB(0, 1), b2 + hstep, voffB);
            PG8_WAIT_V(6); PG8_BAR; PG8_MMA(1, 1, At, B1); PG8_BAR;
            PG8_LDB(B0, 1, 0); PG8_SCHED; PG8_LDA(At, 1, 0); PG8_STAGE(PG8_SA(0, 1), a2 + hstep, voffA);
            PG8_WAIT_L(8); PG8_BAR; PG8_WAIT_L(0); PG8_MMA(0, 0, At, B0); PG8_BAR; PG8_SCHED;
            PG8_LDB(B1, 1, 1); PG8_STAGE(PG8_SB(1, 0), b3, voffB);
            PG8_BAR; PG8_WAIT_L(0); PG8_MMA(0, 1, At, B1); PG8_BAR;
            PG8_LDA(At, 1, 1); PG8_STAGE(PG8_SA(1, 0), a3, voffA);
            PG8_BAR; PG8_WAIT_L(0); PG8_MMA(1, 0, At, B0); PG8_BAR; PG8_SCHED;
            PG8_STAGE(PG8_SB(1, 1), b3 + hstep, voffB);
            PG8_WAIT_V(6); PG8_BAR; PG8_MMA(1, 1, At, B1); PG8_BAR;
        }
        PG8_STAMP();
        if constexpr (!Epi::AFTER_DRAIN) { E(acc, cur, wr, wc, fr, fq); S.done(cur); }
        PG8_STAMP();
        if (!has_next) break;
#pragma unroll
        for (int a = 0; a < 2; ++a)
#pragma unroll
            for (int b = 0; b < 2; ++b)
#pragma unroll
                for (int m = 0; m < 4; ++m)
#pragma unroll
                    for (int n = 0; n < 2; ++n) acc[a][b][m][n] = (f32x4){0.f, 0.f, 0.f, 0.f};
        cur = nxt; cA = nA; cB = nB; ++ui;
    }
    PG8_WAIT_V(0);
    if (wr == 0) PG8_BAR;
    PG8_BAR;
    if constexpr (Epi::AFTER_DRAIN) { E.fused(acc, cur, wr, wc, fr, fq, lds, wid, lane); S.done(cur); }
    PG8_STAMP();
    if (STAMP && wid == 0) { stamps[lane] = lane < nts ? (((unsigned long long)(unsigned)ts_hi << 32) | (unsigned)ts_lo) : 0ull;
        if (lane == 62) stamps[62] = rt_entry; if (lane == 63) stamps[63] = (unsigned long long)wall_clock64(); }
#undef PG8_STAMP
#undef PG8_SA
#undef PG8_SB
#undef PG8_STAGE
#undef PG8_LDA
#undef PG8_LDB
#undef PG8_MMA
#undef PG8_WAIT_V
#undef PG8_WAIT_L
#undef PG8_BAR
#undef PG8_SCHED
}
}
#define XB_TMO      128
#define XB_XCNT(j)  (256  + 64 * (j))
#define XB_XSUB(j)  (1280 + 64 * (j))
#define XB_XGEN(j)  (2304 + 64 * (j))
#define XB_TOP      3328
#define XB_TOPGEN   3392
#define XCD_BAR_WORDS 3456
#define XB_SPIN_CAP (1u << 18)

__device__ __forceinline__ unsigned xb_ld(unsigned* p)              { return __hip_atomic_load(p, __ATOMIC_RELAXED, __HIP_MEMORY_SCOPE_AGENT); }
__device__ __forceinline__ unsigned xb_add(unsigned* p, unsigned v) { return __hip_atomic_fetch_add(p, v, __ATOMIC_RELAXED, __HIP_MEMORY_SCOPE_AGENT); }
__device__ __forceinline__ unsigned xb_xcc_id() { return (unsigned)__builtin_amdgcn_s_getreg((3 << 11) | 20) & 0xFu; }
#define XB_SPIN(cond, bar) do { unsigned _sp = 0; while (cond) { __builtin_amdgcn_s_sleep(1); \
    if ((++_sp & 255u) == 0u) { if (xb_ld(&(bar)[XB_TMO])) break; if (_sp > XB_SPIN_CAP) { atomicAdd(&(bar)[XB_TMO], 1u); break; } } } } while (0)

struct XcdBarrier {
    unsigned* bar; unsigned x;
    volatile LAS unsigned* st;
};

__device__ __forceinline__ XcdBarrier xcd_barrier_post(unsigned* bar, volatile LAS unsigned* st) {
    XcdBarrier b; b.bar = bar; b.x = xb_xcc_id(); b.st = st;
    if (threadIdx.x == 0) (void)xb_add(&bar[XB_XCNT(b.x)], 1u);
    return b;
}
__device__ __forceinline__ void xcd_barrier_complete(unsigned* bar, unsigned x, unsigned& nloc, unsigned& nx) {
    const unsigned G = gridDim.x * gridDim.y * gridDim.z;
    unsigned sum, cnt, mine, sp = 0u;
    for (;;) {
        sum = 0u; cnt = 0u; mine = 0u;
#pragma unroll
        for (unsigned j = 0; j < 16; ++j) { const unsigned c = xb_ld(&bar[XB_XCNT(j)]); sum += c; cnt += (c > 0u) ? 1u : 0u; mine = (j == x) ? c : mine; }
        if (sum == G) break;
        __builtin_amdgcn_s_sleep(1);
        if ((++sp & 255u) == 0u) { if (xb_ld(&bar[XB_TMO])) break; if (sp > XB_SPIN_CAP) { atomicAdd(&bar[XB_TMO], 1u); break; } }
    }
    nloc = mine > 0u ? mine : 1u; nx = cnt > 0u ? cnt : 1u;
}

__device__ __forceinline__ void xcd_barrier(const XcdBarrier& b) {
    asm volatile("s_waitcnt vmcnt(0)" ::: "memory");
    __syncthreads();
    if (threadIdx.x == 0) {
        unsigned* bar = b.bar;
        __builtin_amdgcn_s_waitcnt(0);
        unsigned nloc = b.st[0], nx = b.st[1];
        if (nloc == 0u) { xcd_barrier_complete(bar, b.x, nloc, nx); b.st[0] = nloc; b.st[1] = nx; }
        const unsigned old = xb_add(&bar[XB_XSUB(b.x)], 1u);
        const unsigned gen = old / nloc;
        if (old + 1u == (gen + 1u) * nloc) {
            __builtin_amdgcn_fence(__ATOMIC_RELEASE, "agent");
            asm volatile("s_waitcnt vmcnt(0)" ::: "memory");
            const unsigned og = xb_add(&bar[XB_TOP], 1u);
            const unsigned tg = og / nx;
            if (og + 1u == (tg + 1u) * nx) xb_add(&bar[XB_TOPGEN], 1u);
            else XB_SPIN(xb_ld(&bar[XB_TOPGEN]) == tg, bar);
            __builtin_amdgcn_fence(__ATOMIC_ACQUIRE, "agent");
            xb_add(&bar[XB_XGEN(b.x)], 1u);
            asm volatile("s_waitcnt vmcnt(0)" ::: "memory");
        } else {
            XB_SPIN(xb_ld(&bar[XB_XGEN(b.x)]) == gen, bar);
            __builtin_amdgcn_fence(__ATOMIC_ACQUIRE, "agent");
            asm volatile("s_waitcnt vmcnt(0)" ::: "memory");
        }
    }
    __syncthreads();
}

typedef unsigned short bf16_t;
typedef pg8::bf16x8 bf16x8;
typedef pg8::f32x4 f32x4;
typedef pg8::u32x4 u32x4;
typedef unsigned u32x2 __attribute__((ext_vector_type(2)));

constexpr int DM = 1024, NB = 16, SEQ = 2048, DEPTH = 4, CTXL = 256, DFF = 4096;
constexpr int ZW = 10752;
constexpr int INW = 10528;
constexpr int ZA_Q = 0, ZA_K = 512, ZA_V = 640, ZB_Q = 768, ZB_K = 1280, ZB_V = 1792, ZC_Q = 2304, ZC_FF = 2816, ZC_FB = 3328, ZC_I = 3840, ZC_G = 4352,
              ZD_Q = 4864, ZD_K = 5120, ZD_V = 5376, ZD_GK = 5888, ZD_G = 6016, ZMERGE = 6656;
constexpr int VTS = 2304;
constexpr int LDS_BYTES = 144 * 1024;
constexpr int CTRL_OFF = LDS_BYTES - 256;
constexpr float EPS = 1e-6f;
constexpr float LOG2E = 1.4426950408889634f;
constexpr float QSCALE2 = 0.125f * LOG2E;

struct Params {
    const float *x, *c, *ctx, *c_ctx, *w_mod, *b_mod, *norm_gains, *w_in, *a_sink, *b_rel_bias, *c_lb, *c_norm, *d_gate_up, *d_gate_bias, *d_norm, *w_branch, *w_out, *w_ff1, *w_ff2;
    float* out;
    unsigned char* ws;
    unsigned long long o_mod, o_lb, o_rope, o_xc, o_win, o_wb, o_wo, o_w1, o_w2, o_h, o_z, o_y4, o_ob, o_vta, o_vtb, o_wo4;
    int GB, NGRP, MG, pad0;
};
typedef const Params __attribute__((address_space(4)))* PPtr;

__device__ __forceinline__ float bf2f(unsigned v) { return __uint_as_float(v << 16); }
__device__ __forceinline__ bf16_t f2bf(float f) { unsigned u = __float_as_uint(f); u += 0x7FFFu + ((u >> 16) & 1u); return (bf16_t)(u >> 16); }
typedef __bf16 bf16v2_t __attribute__((ext_vector_type(2)));
typedef float f32v2_t __attribute__((ext_vector_type(2)));
__device__ __forceinline__ unsigned pk2(float lo, float hi) { const f32v2_t v = {lo, hi}; const bf16v2_t b = __builtin_convertvector(v, bf16v2_t); return __builtin_bit_cast(unsigned, b); }
template <int CTRL> __device__ __forceinline__ float dpp(float x) { return __builtin_bit_cast(float, __builtin_amdgcn_mov_dpp(__builtin_bit_cast(int, x), CTRL, 0xf, 0xf, true)); }
constexpr int XOR1 = 0xB1, XOR2 = 0x4E, XOR7 = 0x141, XOR8 = 0x128;
__device__ __forceinline__ float xrow16_max(float x) {
    auto s = __builtin_amdgcn_permlane16_swap(__float_as_uint(x), __float_as_uint(x), false, false);
    x = fmaxf(__uint_as_float(s[0]), __uint_as_float(s[1]));
    auto t = __builtin_amdgcn_permlane32_swap(__float_as_uint(x), __float_as_uint(x), false, false);
    return fmaxf(__uint_as_float(t[0]), __uint_as_float(t[1]));
}
__device__ __forceinline__ float xrow16_sum(float x) {
    auto s = __builtin_amdgcn_permlane16_swap(__float_as_uint(x), __float_as_uint(x), false, false);
    x = __uint_as_float(s[0]) + __uint_as_float(s[1]);
    auto t = __builtin_amdgcn_permlane32_swap(__float_as_uint(x), __float_as_uint(x), false, false);
    return __uint_as_float(t[0]) + __uint_as_float(t[1]);
}
__device__ __forceinline__ float row16_sum(float v) {
    v += dpp<XOR1>(v); v += dpp<XOR2>(v); v += dpp<XOR7>(v); v += dpp<XOR8>(v);
    return v;
}
__device__ __forceinline__ float wave_sum(float v) { return xrow16_sum(row16_sum(v)); }
__device__ __forceinline__ float lo16(unsigned w) { return __uint_as_float(w << 16); }
__device__ __forceinline__ float hi16(unsigned w) { return __uint_as_float(w & 0xffff0000u); }
__device__ __forceinline__ float sigm(float x) { return __builtin_amdgcn_rcpf(1.0f + __builtin_amdgcn_exp2f(-LOG2E * x)); }
__device__ __forceinline__ float fexp(float x) { return __builtin_amdgcn_exp2f(x * LOG2E); }
__device__ __forceinline__ float flog(float x) { return __builtin_amdgcn_logf(x) * 0.6931471805599453f; }
__device__ __forceinline__ bf16_t f2bf1(float x) { return (bf16_t)pk2(x, 0.f); }

__device__ __forceinline__ int src_col(int n) {
    if (n < 640) {
        const int p = n & 63, base = n - p, pp = p >> 1, wh = p & 1;
        const int dim = (pp < 16) ? (wh ? 16 + pp : pp) : (wh ? 48 + (pp - 16) : 32 + (pp - 16));
        return base + dim;
    }
    if (n < 5920) return n;
    if (n < 6016) return -1;
    if (n < 6528) return n - 96;
    if (n < 6656) return -1;
    return 6432 + (n - 6656);
}

__device__ __forceinline__ void conv_tile(const float* src, int Nsrc, int k0, int n0, bool inmap, bf16_t* dst, int Kd, LAS float* t) {
    const int tid = ltid(), nl = tid & 63, ks = tid >> 6;
    const int sc = inmap ? src_col(n0 + nl) : (n0 + nl);
#pragma unroll
    for (int i = 0; i < 8; ++i) { const int kk = ks + 8 * i; t[nl * 65 + kk] = (sc >= 0) ? src[(size_t)(k0 + kk) * Nsrc + sc] : 0.f; }
    __syncthreads();
    const int kl = (tid & 31) * 2, ns = tid >> 5;
#pragma unroll
    for (int i = 0; i < 4; ++i) { const int n = ns + 16 * i; *(unsigned*)(dst + (size_t)(n0 + n) * Kd + k0 + kl) = pk2(t[n * 65 + kl], t[n * 65 + kl + 1]); }
    __syncthreads();
}
__device__ __forceinline__ void convert_weights(PPtr p, int l, LAS unsigned char* lds) {
    LAS float* t = (LAS float*)lds;
    bf16_t* WinT = (bf16_t*)(p->ws + p->o_win); bf16_t* WbT = (bf16_t*)(p->ws + p->o_wb); bf16_t* WoT = (bf16_t*)(p->ws + p->o_wo);
    bf16_t* W1T = (bf16_t*)(p->ws + p->o_w1); bf16_t* W2T = (bf16_t*)(p->ws + p->o_w2);
    constexpr int T_IN = 16 * 168, T_BR = 4 * 8 * 16, T_O = 16 * 16, T_1 = 16 * 64, T_2 = 64 * 16, T_ALL = T_IN + T_BR + T_O + T_1 + T_2;
    for (int it = blockIdx.x; it < T_ALL; it += gridDim.x) {
        int r = it;
        if (r < T_IN) { const int kb = r / 168, nb = r % 168; conv_tile(p->w_in + (size_t)l * 1024 * INW, INW, kb * 64, nb * 64, true, WinT, 1024, t); continue; } r -= T_IN;
        if (r < T_BR) { const int j = r / 128, q = r % 128, kb = q / 16, nb = q % 16; conv_tile(p->w_branch + (size_t)(l * 4 + j) * 512 * 1024, 1024, kb * 64, nb * 64, false, WbT + (size_t)j * 1024 * 512, 512, t); continue; } r -= T_BR;
        if (r < T_O) { const int kb = r / 16, nb = r % 16; conv_tile(p->w_out + (size_t)l * 1024 * 1024, 1024, kb * 64, nb * 64, false, WoT, 1024, t);
#pragma unroll 1
            for (int cpy = 0; cpy < 4; ++cpy) conv_tile(p->w_out + (size_t)l * 1024 * 1024, 1024, kb * 64, nb * 64, false, (bf16_t*)(p->ws + p->o_wo4) + cpy * 1024, 4096, t);
            continue; } r -= T_O;
        if (r < T_1) { const int kb = r / 64, nb = r % 64; conv_tile(p->w_ff1 + (size_t)l * 1024 * 4096, 4096, kb * 64, nb * 64, false, W1T, 1024, t); continue; } r -= T_1;
        { const int kb = r / 16, nb = r % 16; conv_tile(p->w_ff2 + (size_t)l * 4096 * 1024, 1024, kb * 64, nb * 64, false, W2T, 4096, t); }
    }
}

__device__ __forceinline__ void prologue(PPtr p, LAS unsigned char* lds) {
    const int tid = ltid();
    if (blockIdx.x == 0) {
        if (tid < 64) atomicExch((unsigned*)p->ws + tid, 0u);
        for (int i = tid; i < XCD_BAR_WORDS; i += 512) __hip_atomic_store((unsigned*)(p->ws + 4096) + i, 0u, __ATOMIC_RELAXED, __HIP_MEMORY_SCOPE_AGENT);
    }
    if (tid < 4) *((LAS unsigned*)(lds + CTRL_OFF + 64) + tid) = 0u;
    float* modb = (float*)(p->ws + p->o_mod);
    LAS float* sl = (LAS float*)lds;
    LAS float* red = sl + 17 * 1024;
    bool loaded = false;
    for (int task = blockIdx.x; task < 192; task += gridDim.x) {
        if (!loaded) {
            for (int i = tid; i < 17 * 1024; i += 512) { const int b = i >> 10, k = i & 1023; const float v = (b < 16) ? p->c[b * 1024 + k] : p->c_ctx[k]; sl[i] = v * sigm(v); }
            loaded = true;
        }
        __syncthreads();
        const int l = task / 48, nc = task % 48, nn = tid & 127, n = nc * 128 + nn, kq = tid >> 7;
        float acc[17];
#pragma unroll
        for (int b = 0; b < 17; ++b) acc[b] = 0.f;
        const float* w = p->w_mod + ((size_t)l * 1024 + kq * 256) * 6144 + n;
#pragma unroll 1
        for (int k = 0; k < 256; k += 4) {
            const float w0 = w[(size_t)k * 6144], w1 = w[(size_t)(k + 1) * 6144], w2 = w[(size_t)(k + 2) * 6144], w3 = w[(size_t)(k + 3) * 6144];
#pragma unroll
            for (int b = 0; b < 17; ++b) { const f32x4 sv = *(const LAS f32x4*)(sl + b * 1024 + kq * 256 + k); acc[b] += (sv.x * w0 + sv.y * w1) + (sv.z * w2 + sv.w * w3); }
        }
#pragma unroll
        for (int b = 0; b < 17; ++b) red[(kq * 17 + b) * 128 + nn] = acc[b];
        __syncthreads();
        if (kq == 0) {
            const float bm = p->b_mod[l * 6144 + n];
#pragma unroll
            for (int b = 0; b < 17; ++b) modb[((size_t)l * 17 + b) * 6144 + n] = red[b * 128 + nn] + red[(17 + b) * 128 + nn] + red[(34 + b) * 128 + nn] + red[(51 + b) * 128 + nn] + bm;
        }
        __syncthreads();
    }
    if (blockIdx.x == gridDim.x - 1) {
        float* lb = (float*)(p->ws + p->o_lb);
        {
            const int ch = tid;
            float v[4], mx = -1e30f;
#pragma unroll
            for (int l = 0; l < 4; ++l) { v[l] = p->c_lb[l * 512 + ch]; mx = fmaxf(mx, v[l]); }
            float s = 0.f;
#pragma unroll
            for (int l = 0; l < 4; ++l) { v[l] = __expf(v[l] - mx); s += v[l]; }
            const float inv = 1.0f / s, s0 = v[0] * inv; float cum = 0.f;
#pragma unroll
            for (int l = 0; l < 4; ++l) { cum += v[l] * inv; lb[l * 512 + ch] = cum - s0; }
        }
        float* rt = (float*)(p->ws + p->o_rope);
        for (int i = tid; i < 1024; i += 512) {
            const int n = i >> 4, f = i & 15;
            const float inv = __expf(-((float)(2 * f) / 32.0f) * 9.210340371976184f);
            const float a = (float)n * inv;
            const float kf = rintf(a * 0.15915494309189535f);
            const float rr = fmaf(-kf, 6.2831854820251465f, a) + kf * 1.7484556e-7f;
            rt[i] = __cosf(rr); rt[1024 + i] = __sinf(rr);
        }
    }
    __syncthreads();
    convert_weights(p, 0, lds);
}

__device__ __forceinline__ void rowpass(PPtr p, int l, int g, int mode, int nrows) {
    const int lane = ltid() & 63, gw = blockIdx.x * 8 + (ltid() >> 6), NGW = gridDim.x * 8;
    const int LATR = p->GB * 2048, GB = p->GB;
    const float* ng = p->norm_gains + (size_t)l * 4 * 1024;
    const float* modb = (const float*)(p->ws + p->o_mod) + (size_t)l * 17 * 6144;
    bf16_t* hb = (bf16_t*)(p->ws + p->o_h);
    const float* yf = (const float*)(p->ws + p->o_z);
    float* xcb = (float*)(p->ws + p->o_xc);
    const bool first = (l == 0 && mode <= 2);
    const float* xlat = first ? p->x : (const float*)p->out;
    const float* xctx = first ? p->ctx : (const float*)xcb;
    auto xsrc = [&](int row) -> const float* {
        if (row < LATR) return xlat + ((size_t)(g * GB + (row >> 11)) * 2048 + (row & 2047)) * 1024;
        const int r2 = row - LATR; return xctx + ((size_t)(g * GB + (r2 >> 8)) * 256 + (r2 & 255)) * 1024;
    };
    const bf16_t* slab = (const bf16_t*)(p->ws + p->o_z + (size_t)p->MG * 12288);
    const size_t slab_stride = (size_t)(p->MG - LATR) * 1024;
    auto yload = [&](int row, f32x4 (&yv)[4]) {
        if (row < LATR) {
            const bf16_t* yb = (const bf16_t*)yf + (size_t)row * 1024 + lane * 4;
#pragma unroll
            for (int j = 0; j < 4; ++j) { const u32x2 w = *(const u32x2*)(yb + 256 * j); yv[j] = (f32x4){lo16(w.x), hi16(w.x), lo16(w.y), hi16(w.y)}; }
        } else {
            const bf16_t* s0 = slab + (size_t)(row - LATR) * 1024 + lane * 4;
#pragma unroll
            for (int j = 0; j < 4; ++j) { const u32x2 w = *(const u32x2*)(s0 + 256 * j); yv[j] = (f32x4){lo16(w.x), hi16(w.x), lo16(w.y), hi16(w.y)}; }
#pragma unroll
            for (int ks = 1; ks < 8; ++ks)
#pragma unroll
                for (int j = 0; j < 4; ++j) { const u32x2 w = *(const u32x2*)(s0 + ks * slab_stride + 256 * j); yv[j] = yv[j] + (f32x4){lo16(w.x), hi16(w.x), lo16(w.y), hi16(w.y)}; }
        }
    };
    f32x4 xv[4], yv[4];
    int row = gw;
    if (row < nrows) {
        const float* xs = xsrc(row);
#pragma unroll
        for (int j = 0; j < 4; ++j) xv[j] = *(const f32x4*)(xs + lane * 4 + 256 * j);
        if (mode >= 2) yload(row, yv);
    }
    while (row < nrows) {
        const int nrow = row + NGW;
        f32x4 xn[4], yn[4];
        if (nrow < nrows) {
            const float* xs = xsrc(nrow);
#pragma unroll
            for (int j = 0; j < 4; ++j) xn[j] = *(const f32x4*)(xs + lane * 4 + 256 * j);
            if (mode >= 2) yload(nrow, yn);
        }
        const bool lat = row < LATR;
        int b; size_t xrow;
        if (lat) { b = g * GB + (row >> 11); xrow = (size_t)b * 2048 + (row & 2047); }
        else { const int r2 = row - LATR; b = g * GB + (r2 >> 8); xrow = (size_t)b * 256 + (r2 & 255); }
        float* xd = (lat ? p->out : xcb) + xrow * 1024;
        const float* m = modb + (size_t)(lat ? b : 16) * 6144;
        f32x4 tgv[4], tnv[4], tsh[4], tsc[4], tn2[4];
        {
            const float* gate = m + (mode == 2 ? 2048 : 5120); const float* gn = ng + (mode == 2 ? 1024 : 3072);
            const float* sh = m + (mode == 1 ? 0 : 3072); const float* sc = m + (mode == 1 ? 1024 : 4096); const float* gn2 = ng + (mode == 1 ? 0 : 2048);
#pragma unroll
            for (int j = 0; j < 4; ++j) {
                const int c = lane * 4 + 256 * j;
                if (mode >= 2) { tgv[j] = *(const f32x4*)(gate + c); tnv[j] = *(const f32x4*)(gn + c); }
                if (mode <= 2) { tsh[j] = *(const f32x4*)(sh + c); tsc[j] = *(const f32x4*)(sc + c); tn2[j] = *(const f32x4*)(gn2 + c); }
            }
        }
        if (mode >= 2) {
            float ss = 0.f;
#pragma unroll
            for (int j = 0; j < 4; ++j) ss += yv[j].x * yv[j].x + yv[j].y * yv[j].y + yv[j].z * yv[j].z + yv[j].w * yv[j].w;
            ss = wave_sum(ss);
            const float rs = rsqrtf(ss * (1.0f / 1024.0f) + EPS);
#pragma unroll
            for (int j = 0; j < 4; ++j) {
                const int c = lane * 4 + 256 * j;
                const f32x4 gv = tgv[j], nv = tnv[j];
                xv[j] = xv[j] + gv * (yv[j] * rs * nv);
                *(f32x4*)(xd + c) = xv[j];
            }
        }
        if (mode <= 2) {
            float ss = 0.f;
#pragma unroll
            for (int j = 0; j < 4; ++j) ss += xv[j].x * xv[j].x + xv[j].y * xv[j].y + xv[j].z * xv[j].z + xv[j].w * xv[j].w;
            ss = wave_sum(ss);
            const float rs = rsqrtf(ss * (1.0f / 1024.0f) + EPS);
#pragma unroll
            for (int j = 0; j < 4; ++j) {
                const int c = lane * 4 + 256 * j;
                const f32x4 shv = tsh[j], scv = tsc[j], nv = tn2[j];
                const f32x4 hv = (xv[j] * rs * nv) * (scv + 1.0f) + shv;
                u32x2 o; o.x = pk2(hv.x, hv.y); o.y = pk2(hv.z, hv.w);
                *(u32x2*)(hb + (size_t)row * 1024 + c) = o;
            }
        }
#pragma unroll
        for (int j = 0; j < 4; ++j) { xv[j] = xn[j]; yv[j] = yn[j]; }
        row = nrow;
    }
}

struct EpiInproj {
    static constexpr bool PERM = true, AFTER_DRAIN = false;
    bf16_t* Z; bf16_t* vta; bf16_t* vtb; const float* rope; int GB;
    __device__ __forceinline__ void operator()(const f32x4 (&acc)[2][2][4][2], const pg8::Unit& u, int wr, int wc, int fr, int fq) const {
        const int row0 = u.pm * 256 + wr * 64 + fr, LATR = GB * 2048;
#pragma unroll
        for (int bj = 0; bj < 2; ++bj) {
            const int seg = u.pn * 2 + bj, c0 = u.pn * 256 + bj * 128 + wc * 32 + 8 * fq;
            const int type = (seg <= 4) ? 1 : (seg == 5 ? 2 : ((seg >= 14 && seg <= 17) ? 3 : 0));
            const int xf = (seg <= 3 || (seg >= 6 && seg <= 9)) ? 1 : ((seg >= 18 && seg <= 21) ? 2 : ((seg >= 22 && seg <= 29) ? 3 : ((seg == 38 || seg == 39) ? 4 : 0)));
#pragma unroll
            for (int ai = 0; ai < 2; ++ai)
#pragma unroll
                for (int m = 0; m < 4; ++m) {
                    const int row = row0 + ai * 128 + m * 16;
                    f32x4 v0 = acc[ai][bj][m][0], v1 = acc[ai][bj][m][1];
                    if (type <= 1) {
                        if (type == 1 && row < LATR) {
                            const int t = row & 2047, pp0 = (c0 & 63) >> 1;
                            const int n = (pp0 < 16) ? (t >> 6) : (t & 63);
                            const float* cs = rope + n * 16 + (pp0 & 15);
                            const f32x4 cv = *(const f32x4*)cs, sv = *(const f32x4*)(cs + 1024);
                            f32x4 r0, r1;
                            r0.x = v0.x * cv.x - v0.y * sv.x; r0.y = v0.y * cv.x + v0.x * sv.x;
                            r0.z = v0.z * cv.y - v0.w * sv.y; r0.w = v0.w * cv.y + v0.z * sv.y;
                            r1.x = v1.x * cv.z - v1.y * sv.z; r1.y = v1.y * cv.z + v1.x * sv.z;
                            r1.z = v1.z * cv.w - v1.w * sv.w; r1.w = v1.w * cv.w + v1.z * sv.w;
                            v0 = r0; v1 = r1;
                        }
                        if (xf == 1) { v0 = v0 * QSCALE2; v1 = v1 * QSCALE2; }
                        else if (xf == 4) { v0 = v0 * 0.125f; v1 = v1 * 0.125f; }
                        else if (xf == 2) {
#pragma unroll
                            for (int e = 0; e < 4; ++e) { v0[e] = v0[e] * sigm(v0[e]); v1[e] = v1[e] * sigm(v1[e]); }
                        } else if (xf == 3) {
#pragma unroll
                            for (int e = 0; e < 4; ++e) { v0[e] = sigm(v0[e]); v1[e] = sigm(v1[e]); }
                        }
                        u32x4 w; w.x = pk2(v0.x, v0.y); w.y = pk2(v0.z, v0.w); w.z = pk2(v1.x, v1.y); w.w = pk2(v1.z, v1.w);
                        *(u32x4*)(Z + (size_t)row * ZW + c0) = w;
                    } else {
                        int bl, tok;
                        if (row < LATR) { bl = row >> 11; tok = row & 2047; } else { const int r2 = row - LATR; bl = r2 >> 8; tok = 2048 + (r2 & 255); }
                        const int cc = c0 - (type == 2 ? ZA_V : ZB_V), head = cc >> 6, dim0 = cc & 63, H = (type == 2) ? 2 : 8;
                        bf16_t* base = (type == 2 ? vta : vtb) + ((size_t)(bl * H + head) * 64 + dim0) * VTS + tok;
                        base[0 * VTS] = f2bf(v0.x); base[1 * VTS] = f2bf(v0.y); base[2 * VTS] = f2bf(v0.z); base[3 * VTS] = f2bf(v0.w);
                        base[4 * VTS] = f2bf(v1.x); base[5 * VTS] = f2bf(v1.y); base[6 * VTS] = f2bf(v1.z); base[7 * VTS] = f2bf(v1.w);
                    }
                }
        }
    }
};
struct EpiBranch {
    static constexpr bool PERM = true, AFTER_DRAIN = false;
    const bf16_t* Z; bf16_t* macc; int nMfull;
    __device__ __forceinline__ void operator()(const f32x4 (&acc)[2][2][4][2], const pg8::Unit& u, int wr, int wc, int fr, int fq) const {
        const int j = u.pm / nMfull, pm = u.pm - j * nMfull, pn = u.pn & 3;
        const int row0 = pm * 256 + wr * 64 + fr, col0 = pn * 256 + wc * 32 + 8 * fq;
        const bf16_t* gbase = Z + (size_t)row0 * ZW + ZMERGE + j * 1024 + col0;
        bf16_t* mbase = macc + (size_t)row0 * 1024 + col0;
#pragma unroll
        for (int ai = 0; ai < 2; ++ai) {
            u32x4 gw[4][2], pv[4][2];
#pragma unroll
            for (int m = 0; m < 4; ++m)
#pragma unroll
                for (int bj = 0; bj < 2; ++bj) {
                    const size_t ro = (size_t)(ai * 128 + m * 16);
                    gw[m][bj] = *(const u32x4*)(gbase + ro * ZW + bj * 128);
                    pv[m][bj] = (j > 0) ? *(const u32x4*)(mbase + ro * 1024 + bj * 128) : (u32x4){0u, 0u, 0u, 0u};
                }
#pragma unroll
            for (int m = 0; m < 4; ++m)
#pragma unroll
                for (int bj = 0; bj < 2; ++bj) {
                    const u32x4 g = gw[m][bj], q = pv[m][bj];
                    const f32x4 v0 = acc[ai][bj][m][0], v1 = acc[ai][bj][m][1];
                    const float t0 = v0.x * sigm(lo16(g.x)) + lo16(q.x), t1 = v0.y * sigm(hi16(g.x)) + hi16(q.x), t2 = v0.z * sigm(lo16(g.y)) + lo16(q.y), t3 = v0.w * sigm(hi16(g.y)) + hi16(q.y);
                    const float t4 = v1.x * sigm(lo16(g.z)) + lo16(q.z), t5 = v1.y * sigm(hi16(g.z)) + hi16(q.z), t6 = v1.z * sigm(lo16(g.w)) + lo16(q.w), t7 = v1.w * sigm(hi16(g.w)) + hi16(q.w);
                    u32x4 w; w.x = pk2(t0, t1); w.y = pk2(t2, t3); w.z = pk2(t4, t5); w.w = pk2(t6, t7);
                    *(u32x4*)(mbase + (size_t)(ai * 128 + m * 16) * 1024 + bj * 128) = w;
                }
        }
    }
};
struct BranchOrder {
    int nM, nMfull, G, c;
    __device__ __forceinline__ bool next(int i, pg8::Unit& u) const {
        const int j = i & 3; const int v = (c & 7) * (G >> 3) + (c >> 3);
        const long T = (long)(i >> 2) * G + v;
        if (T >= (long)nM * 4) return false;
        u.pm = j * nMfull + (int)(T >> 2); u.pn = j * 4 + (int)(T & 3); u.ko = 0; return true;
    }
    __device__ __forceinline__ void a_ready(const pg8::Unit&) const {}
    __device__ __forceinline__ void done(const pg8::Unit&) const {}
};
struct EpiBf16Y {
    static constexpr bool PERM = true, AFTER_DRAIN = false;
    bf16_t* O; int ldc;
    __device__ __forceinline__ void operator()(const f32x4 (&acc)[2][2][4][2], const pg8::Unit& u, int wr, int wc, int fr, int fq) const {
        const int row0 = u.pm * 256 + wr * 64 + fr, col0 = u.pn * 256 + wc * 32 + 8 * fq;
#pragma unroll
        for (int ai = 0; ai < 2; ++ai)
#pragma unroll
            for (int m = 0; m < 4; ++m) {
                bf16_t* rowp = O + (size_t)(row0 + ai * 128 + m * 16) * ldc + col0;
#pragma unroll
                for (int bj = 0; bj < 2; ++bj) {
                    const f32x4 v0 = acc[ai][bj][m][0], v1 = acc[ai][bj][m][1];
                    u32x4 w; w.x = pk2(v0.x, v0.y); w.y = pk2(v0.z, v0.w); w.z = pk2(v1.x, v1.y); w.w = pk2(v1.z, v1.w);
                    *(u32x4*)(rowp + bj * 128) = w;
                }
            }
    }
};
struct EpiRelu2 {
    static constexpr bool PERM = true, AFTER_DRAIN = false;
    bf16_t* O; int ldc;
    __device__ __forceinline__ void operator()(const f32x4 (&acc)[2][2][4][2], const pg8::Unit& u, int wr, int wc, int fr, int fq) const {
        const int row0 = u.pm * 256 + wr * 64 + fr, col0 = u.pn * 256 + wc * 32 + 8 * fq;
#pragma unroll
        for (int ai = 0; ai < 2; ++ai)
#pragma unroll
            for (int m = 0; m < 4; ++m) {
                bf16_t* rowp = O + (size_t)(row0 + ai * 128 + m * 16) * ldc + col0;
#pragma unroll
                for (int bj = 0; bj < 2; ++bj) {
                    f32x4 v0 = acc[ai][bj][m][0], v1 = acc[ai][bj][m][1];
#pragma unroll
                    for (int e = 0; e < 4; ++e) { const float a = fmaxf(v0[e], 0.f), b = fmaxf(v1[e], 0.f); v0[e] = a * a; v1[e] = b * b; }
                    u32x4 w; w.x = pk2(v0.x, v0.y); w.y = pk2(v0.z, v0.w); w.z = pk2(v1.x, v1.y); w.w = pk2(v1.z, v1.w);
                    *(u32x4*)(rowp + bj * 128) = w;
                }
            }
    }
};

struct CtxBranchOrder {
    int nMfull, pm0, nT, G, c;
    __device__ __forceinline__ bool next(int i, pg8::Unit& u) const {
        const long L = (long)i * G + c; if (L >= (long)nT * 4) return false;
        const int j = (int)(L & 3), t = (int)(L >> 2);
        u.pm = j * nMfull + pm0 + (t >> 2); u.pn = j * 4 + (t & 3); u.ko = 0; return true;
    }
    __device__ __forceinline__ void a_ready(const pg8::Unit&) const {}
    __device__ __forceinline__ void done(const pg8::Unit&) const {}
};
struct EpiBranchCtx {
    static constexpr bool PERM = true, AFTER_DRAIN = false;
    const bf16_t* Z; bf16_t* P; int nMfull, pm0;
    __device__ __forceinline__ void operator()(const f32x4 (&acc)[2][2][4][2], const pg8::Unit& u, int wr, int wc, int fr, int fq) const {
        const int j = u.pm / nMfull, pm = u.pm - j * nMfull, pn = u.pn & 3;
        const int row0 = pm * 256 + wr * 64 + fr, col0 = pn * 256 + wc * 32 + 8 * fq;
        const bf16_t* gbase = Z + (size_t)row0 * ZW + ZMERGE + j * 1024 + col0;
        bf16_t* pbase = P + (size_t)(row0 - pm0 * 256) * 4096 + j * 1024 + col0;
#pragma unroll
        for (int ai = 0; ai < 2; ++ai) {
            u32x4 gw[4][2];
#pragma unroll
            for (int m = 0; m < 4; ++m)
#pragma unroll
                for (int bj = 0; bj < 2; ++bj) gw[m][bj] = *(const u32x4*)(gbase + (size_t)(ai * 128 + m * 16) * ZW + bj * 128);
#pragma unroll
            for (int m = 0; m < 4; ++m)
#pragma unroll
                for (int bj = 0; bj < 2; ++bj) {
                    const u32x4 g = gw[m][bj];
                    const f32x4 v0 = acc[ai][bj][m][0], v1 = acc[ai][bj][m][1];
                    u32x4 w; w.x = pk2(v0.x * sigm(lo16(g.x)), v0.y * sigm(hi16(g.x))); w.y = pk2(v0.z * sigm(lo16(g.y)), v0.w * sigm(hi16(g.y)));
                    w.z = pk2(v1.x * sigm(lo16(g.z)), v1.y * sigm(hi16(g.z))); w.w = pk2(v1.z * sigm(lo16(g.w)), v1.w * sigm(hi16(g.w)));
                    *(u32x4*)(pbase + (size_t)(ai * 128 + m * 16) * 4096 + bj * 128) = w;
                }
        }
    }
};
struct SplitOrder {
    int pm0, nT, SPLIT, Kl, G, c;
    __device__ __forceinline__ bool next(int i, pg8::Unit& u) const {
        const long L = (long)i * G + c; if (L >= (long)nT * 4 * SPLIT) return false;
        const int ks = (int)(L % SPLIT), t = (int)(L / SPLIT);
        u.pm = pm0 + (t >> 2); u.pn = t & 3; u.ko = ks * Kl; return true;
    }
    __device__ __forceinline__ void a_ready(const pg8::Unit&) const {}
    __device__ __forceinline__ void done(const pg8::Unit&) const {}
};
struct EpiSlab {
    static constexpr bool PERM = true, AFTER_DRAIN = false;
    bf16_t* S; int pm0, nrows, Kl;
    __device__ __forceinline__ void operator()(const f32x4 (&acc)[2][2][4][2], const pg8::Unit& u, int wr, int wc, int fr, int fq) const {
        const int ks = u.ko / Kl;
        const int row0 = (u.pm - pm0) * 256 + wr * 64 + fr, col0 = u.pn * 256 + wc * 32 + 8 * fq;
        bf16_t* base = S + (size_t)ks * nrows * 1024;
#pragma unroll
        for (int ai = 0; ai < 2; ++ai)
#pragma unroll
            for (int m = 0; m < 4; ++m) { bf16_t* rowp = base + (size_t)(row0 + ai * 128 + m * 16) * 1024 + col0;
#pragma unroll
                for (int bj = 0; bj < 2; ++bj) {
                    const f32x4 v0 = acc[ai][bj][m][0], v1 = acc[ai][bj][m][1];
                    u32x4 w; w.x = pk2(v0.x, v0.y); w.y = pk2(v0.z, v0.w); w.z = pk2(v1.x, v1.y); w.w = pk2(v1.z, v1.w);
                    *(u32x4*)(rowp + bj * 128) = w;
                } }
    }
};

#define MFMA16(a, b, c) __builtin_amdgcn_mfma_f32_16x16x32_bf16((a), (b), (c), 0, 0, 0)
__device__ __forceinline__ void attn_wave(PPtr p, int l, int kind, int idx, int lane, const LAS float* biasL) {
    const int fr = lane & 15, fq = lane >> 4;
    const int LATR = p->GB * 2048, MG = p->MG;
    const bf16_t* Z = (const bf16_t*)(p->ws + p->o_z);
    const bool isA = (kind == 1 || kind == 2);
    int bl, hk, qrow0, r = 0, q0 = 0;
    if (kind == 0) { bl = idx >> 8; hk = (idx >> 5) & 7; r = idx & 31; qrow0 = bl * 2048 + r * 64; }
    else if (kind == 1) { bl = idx >> 8; hk = (idx >> 7) & 1; q0 = (idx & 127) * 16; qrow0 = bl * 2048 + q0; }
    else if (kind == 2) { bl = idx >> 5; hk = (idx >> 4) & 1; qrow0 = LATR + bl * 256 + (idx & 15) * 16; }
    else { bl = idx >> 5; hk = (idx >> 2) & 7; qrow0 = LATR + bl * 256 + (idx & 3) * 64; }
    const int qrstep = isA ? 0 : 16, qcstep = isA ? 64 : 0;
    const int qcol0 = isA ? (ZA_Q + hk * 4 * 64) : (ZB_Q + hk * 64);
    const int kcol = isA ? (ZA_K + hk * 64) : (ZB_K + hk * 64);
    const bf16_t* vt = isA ? ((const bf16_t*)(p->ws + p->o_vta) + (size_t)(bl * 2 + hk) * 64 * VTS) : ((const bf16_t*)(p->ws + p->o_vtb) + (size_t)(bl * 8 + hk) * 64 * VTS);
    bf16_t* yo = (bf16_t*)(p->ws + p->o_y4) + (isA ? (size_t)0 : (size_t)MG * 512);
    const int ocol0 = isA ? hk * 4 * 64 : hk * 64;
    const int krow_ctx0 = LATR + bl * 256, krow_lat0 = bl * 2048;

    bf16x8 Q[4][2];
#pragma unroll
    for (int s = 0; s < 4; ++s)
#pragma unroll
        for (int ks = 0; ks < 2; ++ks) Q[s][ks] = *(const bf16x8*)(Z + (size_t)(qrow0 + s * qrstep + fr) * ZW + qcol0 + s * qcstep + ks * 32 + fq * 8);
    f32x4 O[4][4]; float mrun[4], lrun[4];
#pragma unroll
    for (int s = 0; s < 4; ++s) { mrun[s] = -1e30f; lrun[s] = 0.f;
#pragma unroll
        for (int dt = 0; dt < 4; ++dt) O[s][dt] = (f32x4){0.f, 0.f, 0.f, 0.f}; }

    auto do_block = [&](int krow, int vtoff, int mode, int a0, int a1) {
        bf16x8 Kf[2][2];
#pragma unroll
        for (int kt = 0; kt < 2; ++kt)
#pragma unroll
            for (int ks = 0; ks < 2; ++ks) Kf[kt][ks] = *(const bf16x8*)(Z + (size_t)(krow + kt * 16 + fr) * ZW + kcol + ks * 32 + fq * 8);
        bf16x8 Vf[4];
#pragma unroll
        for (int dt = 0; dt < 4; ++dt) {
            const bf16_t* vp = vt + (size_t)(dt * 16 + fr) * VTS + vtoff + fq * 4;
            const u32x2 lo = *(const u32x2*)vp, hi = *(const u32x2*)(vp + 16);
            u32x4 w; w.x = lo.x; w.y = lo.y; w.z = hi.x; w.w = hi.y;
            Vf[dt] = __builtin_bit_cast(bf16x8, w);
        }
#pragma unroll
        for (int s = 0; s < 4; ++s) {
            const bool active = (mode != 2) || !((s == 0 && a1 == 1) || (s == 3 && a1 == 0));
            if (active) {
                f32x4 S0 = (f32x4){0.f, 0.f, 0.f, 0.f}, S1 = (f32x4){0.f, 0.f, 0.f, 0.f};
                S0 = MFMA16(Kf[0][0], Q[s][0], S0); S0 = MFMA16(Kf[0][1], Q[s][1], S0);
                S1 = MFMA16(Kf[1][0], Q[s][0], S1); S1 = MFMA16(Kf[1][1], Q[s][1], S1);
                float sc[8];
#pragma unroll
                for (int j = 0; j < 4; ++j) { sc[j] = S0[j]; sc[4 + j] = S1[j]; }
                if (mode == 1) {
                    if (a0 < q0 + 15 - 128 || a0 + 31 > q0 + 128) {
                        const int d0 = a0 + fq * 4 - (q0 + fr) + 128;
#pragma unroll
                        for (int e = 0; e < 8; ++e) { const unsigned d = (unsigned)(d0 + (e >> 2) * 16 + (e & 3)); if (d > 256u) sc[e] = -1e30f; }
                    }
                } else if (mode == 2) {
                    const int qc = 16 * s + fr; const int cs = min(max(qc - 8, 0), 48);
                    const int kc0 = a1 * 32 + fq * 4;
                    const LAS float* bp = biasL + hk * 465 + a0 * 31 + (kc0 - qc + 15);
                    const unsigned rel0 = (unsigned)(kc0 - cs);
#pragma unroll
                    for (int e = 0; e < 8; ++e) {
                        const int off = (e >> 2) * 16 + (e & 3);
                        const float bv = bp[off];
                        sc[e] = (rel0 + (unsigned)off < 16u) ? (sc[e] + bv) : -1e30f;
                    }
                }
                float ml = fmaxf(fmaxf(fmaxf(sc[0], sc[1]), fmaxf(sc[2], sc[3])), fmaxf(fmaxf(sc[4], sc[5]), fmaxf(sc[6], sc[7])));
                ml = xrow16_max(ml);
                const float mold = mrun[s], mn = fmaxf(mold, ml), alpha = __builtin_amdgcn_exp2f(mold - mn);
                mrun[s] = mn;
                float pv[8], ls = 0.f;
#pragma unroll
                for (int e = 0; e < 8; ++e) { pv[e] = __builtin_amdgcn_exp2f(sc[e] - mn); ls += pv[e]; }
                ls = xrow16_sum(ls);
                lrun[s] = lrun[s] * alpha + ls;
                u32x4 pw; pw.x = pk2(pv[0], pv[1]); pw.y = pk2(pv[2], pv[3]); pw.z = pk2(pv[4], pv[5]); pw.w = pk2(pv[6], pv[7]);
                const bf16x8 P = __builtin_bit_cast(bf16x8, pw);
                if (__builtin_amdgcn_ballot_w64(mn > mold) != 0ull) {
#pragma unroll
                    for (int dt = 0; dt < 4; ++dt) O[s][dt] = O[s][dt] * alpha;
                }
#pragma unroll
                for (int dt = 0; dt < 4; ++dt) O[s][dt] = MFMA16(Vf[dt], P, O[s][dt]);
            }
            __builtin_amdgcn_sched_barrier(0);
        }
    };
    int nloc = 0, lo = 0, r0 = 0;
    if (kind == 1) { lo = max(0, q0 - 128) & ~31; const int hi = min(2048, (q0 + 16 + 128 + 31) & ~31); nloc = (hi - lo) >> 5; }
    else if (kind == 0) { r0 = min(max(r - 4, 0), 24); nloc = 16; }
#pragma unroll 1
    for (int i = 0; i < 8 + nloc; ++i) {
        int krow, vtoff, mode, a0, a1;
        if (i < 8) { krow = krow_ctx0 + 32 * i; vtoff = 2048 + 32 * i; mode = 0; a0 = 0; a1 = 0; }
        else if (kind == 1) { const int kb = lo + 32 * (i - 8); krow = krow_lat0 + kb; vtoff = kb; mode = 1; a0 = kb; a1 = 0; }
        else { const int jj = i - 8, kr = r0 + (jj >> 1), hb = jj & 1; krow = krow_lat0 + kr * 64 + hb * 32; vtoff = kr * 64 + hb * 32; mode = 2; a0 = kr - r + 7; a1 = hb; }
        do_block(krow, vtoff, mode, a0, a1);
    }
#pragma unroll
    for (int s = 0; s < 4; ++s) {
        float fac;
        if (isA) { const float sk = p->a_sink[l * 8 + hk * 4 + s] * LOG2E; const float M = fmaxf(mrun[s], sk); const float e1 = __builtin_amdgcn_exp2f(mrun[s] - M); fac = e1 / (lrun[s] * e1 + __builtin_amdgcn_exp2f(sk - M)); }
        else fac = 1.0f / lrun[s];
        bf16_t* op = yo + (size_t)(qrow0 + s * qrstep + fr) * 512 + ocol0 + s * qcstep + fq * 4;
#pragma unroll
        for (int dt = 0; dt < 4; ++dt) { const f32x4 o = O[s][dt] * fac; u32x2 w; w.x = pk2(o.x, o.y); w.y = pk2(o.z, o.w); *(u32x2*)(op + dt * 16) = w; }
    }
}

constexpr int SCAN_BUF = 41472;
constexpr int BIAS_OFF = 3 * SCAN_BUF;
template <int DK, bool ISC>
__device__ __forceinline__ void scan_task(PPtr p, int l, int bl, int h, int dir, LAS unsigned char* lds) {
    constexpr int KPW = DK / 8, NTG = 64 / KPW, TPG = 32 / NTG, QS = (DK + 8) * 2, NKT = DK / 16;
    const int tid = ltid(), w = tid >> 6, lane = tid & 63, fr = lane & 15, fq = lane >> 4;
    const int kl = lane % KPW, tg = lane / KPW, kch = w * KPW + kl;
    const int vcol = tid & 127, vg = tid >> 7;
    LAS unsigned char* qt = lds; LAS unsigned char* kt_ = qt + 32 * QS; LAS unsigned char* khT = kt_ + 32 * QS; LAS unsigned char* vT = khT + DK * 80;
    LAS unsigned char* att = vT + 128 * 80; LAS float* dvec = (LAS float*)(att + 32 * 80); LAS float* evec = dvec + DK;
    const bf16_t* Z = (const bf16_t*)(p->ws + p->o_z);
    const int LATR = p->GB * 2048, MG = p->MG;
    const int qc = ISC ? (ZC_Q + h * 128 + kch) : (ZD_Q + h * 64 + kch);
    const int kc = ISC ? ((dir ? ZC_FB : ZC_FF) + h * 128 + kch) : (ZD_K + h * 64 + kch);
    const int vc = (ISC ? ZC_I : ZD_V) + h * 128 + vcol;
    const int gcol = ZD_GK + dir * 16;
    float lbv = 0.f, oml = 1.f, up[16], gb = 0.f;
#pragma unroll
    for (int r = 0; r < 16; ++r) up[r] = 0.f;
    if (ISC) { lbv = ((const float*)(p->ws + p->o_lb))[l * 512 + h * 128 + kch]; oml = 1.0f - lbv; }
    else {
#pragma unroll
        for (int r = 0; r < 16; ++r) up[r] = p->d_gate_up[((size_t)(l * 2 + dir) * 16 + r) * 256 + h * 64 + kch];
        gb = p->d_gate_bias[(l * 2 + dir) * 256 + h * 64 + kch];
    }
    bf16_t* odst = (dir == 0) ? ((bf16_t*)(p->ws + p->o_y4) + (size_t)(ISC ? 2 : 3) * MG * 512) : ((bf16_t*)(p->ws + p->o_ob) + (size_t)(ISC ? 0 : 1) * MG * 512);
    f32x4 S[NKT];
#pragma unroll
    for (int i = 0; i < NKT; ++i) S[i] = (f32x4){0.f, 0.f, 0.f, 0.f};
    const int sgn = dir ? -1 : 1;
    const long zstep = (long)sgn * ZW, ostep = (long)sgn * 512;
    auto row0of = [&](int cc) -> int {
        const bool isctx = cc < 8; const int L = isctx ? 256 : 2048, base = isctx ? (LATR + bl * 256) : (bl * 2048), c = isctx ? cc : cc - 8;
        return base + (dir ? (L - 1 - c * 32) : c * 32);
    };
    bf16_t rq[TPG], rk[TPG], rv[8]; u32x4 rz[TPG][2];
    auto load_raw = [&](int cc) {
        const int r0 = row0of(cc);
        const bf16_t* zq = Z + (size_t)(r0 + tg * TPG * sgn) * ZW;
#pragma unroll
        for (int e = 0; e < TPG; ++e) {
            const bf16_t* zr = zq + e * zstep;
            rq[e] = zr[qc]; rk[e] = zr[kc];
            if (!ISC) { rz[e][0] = *(const u32x4*)(zr + gcol); rz[e][1] = *(const u32x4*)(zr + gcol + 8); }
        }
        const bf16_t* zv = Z + (size_t)(r0 + vg * 8 * sgn) * ZW + vc;
#pragma unroll
        for (int e = 0; e < 8; ++e) rv[e] = zv[e * zstep];
    };
    load_raw(0);
    for (int cc = 0; cc < 72; ++cc) {
        __syncthreads();
        {
            float gq[TPG], gk[TPG], cum[TPG]; float run = 0.f;
#pragma unroll
            for (int e = 0; e < TPG; ++e) {
                const float zq = bf2f(rq[e]), zk = bf2f(rk[e]); float g, key, q;
                if (ISC) { const float sg = zk; g = flog(lbv + oml * sg); key = oml * (1.0f - sg); q = zq; }
                else {
                    float a = gb;
                    const u32x4 z0 = rz[e][0], z1 = rz[e][1];
                    a += lo16(z0.x) * up[0] + hi16(z0.x) * up[1] + lo16(z0.y) * up[2] + hi16(z0.y) * up[3] + lo16(z0.z) * up[4] + hi16(z0.z) * up[5] + lo16(z0.w) * up[6] + hi16(z0.w) * up[7];
                    a += lo16(z1.x) * up[8] + hi16(z1.x) * up[9] + lo16(z1.y) * up[10] + hi16(z1.y) * up[11] + lo16(z1.z) * up[12] + hi16(z1.z) * up[13] + lo16(z1.w) * up[14] + hi16(z1.w) * up[15];
                    g = (fminf(a, 0.f) - flog(1.0f + fexp(-fabsf(a)))) * (1.0f / 16.0f); key = zk; q = zq;
                }
                run += g; cum[e] = run; gq[e] = q; gk[e] = key;
            }
            float pre = 0.f, total = 0.f, cref = 0.f;
#pragma unroll
            for (int t = 0; t < NTG; ++t) { const float tt = __shfl(run, kl + KPW * t); if (t < tg) pre += tt; if (t < NTG / 2) cref += tt; total += tt; }
            float khv[TPG]; const float etc = fexp(total - cref);
#pragma unroll
            for (int e = 0; e < TPG; ++e) {
                const float c = cum[e] + pre; const int i = tg * TPG + e;
                const float E = fexp(c - cref), kE = gk[e] * __builtin_amdgcn_rcpf(E);
                *(LAS bf16_t*)(qt + i * QS + kch * 2) = f2bf1(gq[e] * E);
                *(LAS bf16_t*)(kt_ + i * QS + kch * 2) = f2bf1(kE);
                khv[e] = kE * etc;
            }
            if constexpr (TPG == 8) { u32x4 o; o.x = pk2(khv[0], khv[1]); o.y = pk2(khv[2], khv[3]); o.z = pk2(khv[4], khv[5]); o.w = pk2(khv[6], khv[7]); *(LAS u32x4*)(khT + kch * 80 + tg * 16) = o; }
            else { u32x2 o; o.x = pk2(khv[0], khv[1]); o.y = pk2(khv[2], khv[3]); *(LAS u32x2*)(khT + kch * 80 + tg * 8) = o; }
            if (tg == 0) { dvec[kch] = fexp(total); evec[kch] = fexp(cref); }
            u32x4 vo; vo.x = (unsigned)rv[0] | ((unsigned)rv[1] << 16); vo.y = (unsigned)rv[2] | ((unsigned)rv[3] << 16); vo.z = (unsigned)rv[4] | ((unsigned)rv[5] << 16); vo.w = (unsigned)rv[6] | ((unsigned)rv[7] << 16);
            *(LAS u32x4*)(vT + vcol * 80 + vg * 16) = vo;
        }
        if (cc + 1 < 72) load_raw(cc + 1);
        __syncthreads();
        if (w < 3) {
            const int tt = (w == 0) ? 0 : 1, st = (w == 2) ? 1 : 0;
            f32x4 a = (f32x4){0.f, 0.f, 0.f, 0.f};
#pragma unroll
            for (int ks = 0; ks < DK / 32; ++ks) {
                const bf16x8 A = *(const LAS bf16x8*)(qt + (tt * 16 + fr) * QS + (ks * 32 + fq * 8) * 2);
                const bf16x8 B = *(const LAS bf16x8*)(kt_ + (st * 16 + fr) * QS + (ks * 32 + fq * 8) * 2);
                a = MFMA16(A, B, a);
            }
#pragma unroll
            for (int j = 0; j < 4; ++j) { const int t = tt * 16 + fq * 4 + j, s = st * 16 + fr; *(LAS bf16_t*)(att + t * 80 + s * 2) = f2bf1(s <= t ? a[j] : 0.f); }
        } else if (w == 3) {
#pragma unroll
            for (int j = 0; j < 4; ++j) { const int t = fq * 4 + j, s = 16 + fr; *(LAS bf16_t*)(att + t * 80 + s * 2) = (bf16_t)0; }
        }
        __syncthreads();
        {
            const int vs = w * 16;
            bf16_t* ob0 = odst + (size_t)(row0of(cc) + fq * 4 * sgn) * 512 + h * 128 + vs + fr;
            const bf16x8 Bv = *(const LAS bf16x8*)(vT + (vs + fr) * 80 + fq * 16);
            f32x4 ev[NKT]; u32x4 qa[2][NKT / 2]; bf16x8 A2[2], A3[NKT]; f32x4 dv[NKT];
#pragma unroll
            for (int k2 = 0; k2 < NKT; ++k2) ev[k2] = *(const LAS f32x4*)(evec + k2 * 16 + fq * 4);
#pragma unroll
            for (int tt = 0; tt < 2; ++tt) {
#pragma unroll
                for (int kp = 0; kp < NKT / 2; ++kp) {
                    const u32x2 lo = *(const LAS u32x2*)(qt + (tt * 16 + fr) * QS + ((2 * kp) * 16 + fq * 4) * 2);
                    const u32x2 hi = *(const LAS u32x2*)(qt + (tt * 16 + fr) * QS + ((2 * kp + 1) * 16 + fq * 4) * 2);
                    qa[tt][kp].x = lo.x; qa[tt][kp].y = lo.y; qa[tt][kp].z = hi.x; qa[tt][kp].w = hi.y;
                }
                A2[tt] = *(const LAS bf16x8*)(att + (tt * 16 + fr) * 80 + fq * 16);
            }
#pragma unroll
            for (int k2 = 0; k2 < NKT; ++k2) { dv[k2] = *(const LAS f32x4*)(dvec + k2 * 16 + fq * 4); A3[k2] = *(const LAS bf16x8*)(khT + (k2 * 16 + fr) * 80 + fq * 16); }
            __builtin_amdgcn_sched_barrier(0);
            bf16x8 Sb[NKT / 2];
#pragma unroll
            for (int kp = 0; kp < NKT / 2; ++kp) {
                const f32x4 s0 = S[2 * kp] * ev[2 * kp], s1 = S[2 * kp + 1] * ev[2 * kp + 1];
                u32x4 sw; sw.x = pk2(s0.x, s0.y); sw.y = pk2(s0.z, s0.w); sw.z = pk2(s1.x, s1.y); sw.w = pk2(s1.z, s1.w);
                Sb[kp] = __builtin_bit_cast(bf16x8, sw);
            }
#pragma unroll
            for (int tt = 0; tt < 2; ++tt) {
                f32x4 o = (f32x4){0.f, 0.f, 0.f, 0.f};
#pragma unroll
                for (int kp = 0; kp < NKT / 2; ++kp) o = MFMA16(__builtin_bit_cast(bf16x8, qa[tt][kp]), Sb[kp], o);
                o = MFMA16(A2[tt], Bv, o);
#pragma unroll
                for (int j = 0; j < 4; ++j) ob0[(tt * 16 + j) * ostep] = f2bf1(o[j]);
            }
            __builtin_amdgcn_sched_barrier(0);
#pragma unroll
            for (int k2 = 0; k2 < NKT; ++k2) { S[k2] = S[k2] * dv[k2]; S[k2] = MFMA16(A3[k2], Bv, S[k2]); }
        }
    }
    __syncthreads();
}

__device__ __forceinline__ void mixer(PPtr p, int l, int g, LAS unsigned char* lds, unsigned long long* tscan = nullptr) {
    const int tid = ltid(), w = tid >> 6, lane = tid & 63;
    LAS float* biasL = (LAS float*)(lds + BIAS_OFF);
    for (int i = tid; i < 8 * 465; i += 512) biasL[i] = p->b_rel_bias[(size_t)l * 8 * 465 + i] * LOG2E;
    __syncthreads();
    const int GB = p->GB, NSC = GB * 8, NS = GB * 16;
    const unsigned long long ts0 = tscan ? __builtin_amdgcn_s_memrealtime() : 0ull;
    for (int st = blockIdx.x; st < NS; st += gridDim.x) {
        if (st < NSC) { scan_task<128, true>(p, l, st >> 3, (st >> 1) & 3, st & 1, lds); }
        else { const int s2 = st - NSC; scan_task<64, false>(p, l, s2 >> 3, (s2 >> 1) & 3, s2 & 1, lds); }
    }
    if (tscan) *tscan += __builtin_amdgcn_s_memrealtime() - ts0;
    unsigned* ctr = (unsigned*)p->ws + (l * 16 + g);
    const int NB0 = GB * 32, NB1 = GB * 32, NB2 = (l < DEPTH - 1) ? GB * 4 : 0, NB3 = NB2, NBT = NB0 + NB1 + NB2 + NB3;
    LAS int* tw = (LAS int*)(lds + CTRL_OFF);
    for (;;) {
        if (tid == 0) *tw = (int)atomicAdd(ctr, 1u);
        __syncthreads();
        const int bt = *tw;
        __syncthreads();
        if (bt >= NBT) break;
        int kind, idx;
        if (bt < NB0) { kind = 0; idx = bt * 8 + w; }
        else if (bt < NB0 + NB1) { kind = 1; idx = (bt - NB0) * 8 + w; }
        else if (bt < NB0 + NB1 + NB2) { kind = 2; idx = (bt - NB0 - NB1) * 8 + w; }
        else { kind = 3; idx = (bt - NB0 - NB1 - NB2) * 8 + w; }
        attn_wave(p, l, kind, idx, lane, biasL);
    }
}

__device__ __forceinline__ void postpass(PPtr p, int l, int nrows) {
    const int lane = ltid() & 63, gw = blockIdx.x * 8 + (ltid() >> 6), NGW = gridDim.x * 8, MG = p->MG;
    const bf16_t* Z = (const bf16_t*)(p->ws + p->o_z);
    for (int it = gw; it < nrows * 2; it += NGW) {
        const int row = it >> 1, br = it & 1;
        bf16_t* yf = (bf16_t*)(p->ws + p->o_y4) + (size_t)(2 + br) * MG * 512 + (size_t)row * 512 + lane * 8;
        const bf16_t* yb = (const bf16_t*)(p->ws + p->o_ob) + (size_t)br * MG * 512 + (size_t)row * 512 + lane * 8;
        const u32x4 a = *(const u32x4*)yf, b = *(const u32x4*)yb;
        const u32x4 gt = *(const u32x4*)(Z + (size_t)row * ZW + (br ? ZD_G : ZC_G) + lane * 8);
        const float* gain = (br ? p->d_norm : p->c_norm) + l * 128 + (lane & 15) * 8;
        float o[8], gv[8];
        o[0] = lo16(a.x) + lo16(b.x); o[1] = hi16(a.x) + hi16(b.x); o[2] = lo16(a.y) + lo16(b.y); o[3] = hi16(a.y) + hi16(b.y);
        o[4] = lo16(a.z) + lo16(b.z); o[5] = hi16(a.z) + hi16(b.z); o[6] = lo16(a.w) + lo16(b.w); o[7] = hi16(a.w) + hi16(b.w);
        gv[0] = lo16(gt.x); gv[1] = hi16(gt.x); gv[2] = lo16(gt.y); gv[3] = hi16(gt.y); gv[4] = lo16(gt.z); gv[5] = hi16(gt.z); gv[6] = lo16(gt.w); gv[7] = hi16(gt.w);
        float ss = 0.f;
#pragma unroll
        for (int e = 0; e < 8; ++e) ss += o[e] * o[e];
        ss = row16_sum(ss);
        const float rs = rsqrtf(ss * (1.0f / 128.0f) + EPS);
        const f32x4 g0 = *(const f32x4*)gain, g1 = *(const f32x4*)(gain + 4);
        float y[8];
#pragma unroll
        for (int e = 0; e < 8; ++e) { const float gn = (e < 4) ? g0[e & 3] : g1[e & 3]; y[e] = o[e] * rs * gn * (gv[e] * sigm(gv[e])); }
        u32x4 wv; wv.x = pk2(y[0], y[1]); wv.y = pk2(y[2], y[3]); wv.z = pk2(y[4], y[5]); wv.w = pk2(y[6], y[7]);
        *(u32x4*)yf = wv;
    }
}

#define NOINL __device__ __forceinline__
NOINL void ph_prologue(PPtr pc, LAS unsigned char* lds) { PPtr p = pc; asm volatile("" : "+s"(p)); prologue(p, lds); }
NOINL void ph_rowpass(PPtr pc, int l, int g, int mode, int nrows, int conv_l, LAS unsigned char* lds) { PPtr p = pc; asm volatile("" : "+s"(p)); rowpass(p, l, g, mode, nrows); if (conv_l >= 0) convert_weights(p, conv_l, lds); }
NOINL void ph_rowpass_tail(PPtr pc, int l, int g, int nrows, int conv_l, int nl, int ng, int nrows_next, LAS unsigned char* lds) {
    PPtr p = pc; asm volatile("" : "+s"(p));
    rowpass(p, l, g, 3, nrows);
    if (nl >= 0) rowpass(p, nl, ng, 1, nrows_next);
    if (conv_l >= 0) convert_weights(p, conv_l, lds);
}
NOINL void ph_inproj(PPtr pc, LAS unsigned char* lds) {
    PPtr p = pc; asm volatile("" : "+s"(p)); const int G = (int)gridDim.x, c = (int)blockIdx.x;
    pg8::Gemm gm{(const bf16_t*)(p->ws + p->o_h), (const bf16_t*)(p->ws + p->o_win), p->MG, ZW, 1024, 1024}; pg8::StaticOrder S; S.init(p->MG, ZW, G, c);
    EpiInproj E{(bf16_t*)(p->ws + p->o_z), (bf16_t*)(p->ws + p->o_vta), (bf16_t*)(p->ws + p->o_vtb), (const float*)(p->ws + p->o_rope), p->GB};
    pg8::gemm_phase<EpiInproj, pg8::StaticOrder>(lds, gm, S, E, nullptr);
}
NOINL void ph_mixer(PPtr pc, int l, int g, LAS unsigned char* lds, unsigned long long* tscan = nullptr) { PPtr p = pc; asm volatile("" : "+s"(p)); mixer(p, l, g, lds, tscan); }
NOINL void ph_post(PPtr pc, int l, int nrows) { PPtr p = pc; asm volatile("" : "+s"(p)); postpass(p, l, nrows); }
NOINL void ph_branch(PPtr pc, int Mr, LAS unsigned char* lds) {
    PPtr p = pc; asm volatile("" : "+s"(p)); const int G = (int)gridDim.x, c = (int)blockIdx.x;
    const int LATR = p->GB * 2048, nMfull = p->MG / 256;
    pg8::Gemm gm{(const bf16_t*)(p->ws + p->o_y4), (const bf16_t*)(p->ws + p->o_wb), Mr, 1024, 512, 512};
    { BranchOrder S{LATR / 256, nMfull, G, c};
      EpiBranch E{(const bf16_t*)(p->ws + p->o_z), (bf16_t*)(p->ws + p->o_h), nMfull};
      pg8::gemm_phase<EpiBranch, BranchOrder>(lds, gm, S, E, nullptr); }
    if (Mr > LATR) {
        CtxBranchOrder S{nMfull, LATR / 256, (Mr - LATR) / 256 * 4, G, c};
        EpiBranchCtx E{(const bf16_t*)(p->ws + p->o_z), (bf16_t*)(p->ws + p->o_ob), nMfull, LATR / 256};
        pg8::gemm_phase<EpiBranchCtx, CtxBranchOrder>(lds, gm, S, E, nullptr);
    }
}
NOINL void ph_gemm_f32(PPtr pc, int which, int Mr, LAS unsigned char* lds) {
    PPtr p = pc; asm volatile("" : "+s"(p)); const int G = (int)gridDim.x, c = (int)blockIdx.x;
    const int LATR = p->GB * 2048;
    const bf16_t* hid = (const bf16_t*)(p->ws + p->o_z + (size_t)p->MG * 1024 * 4);
    { const bf16_t* A = which ? hid : (const bf16_t*)(p->ws + p->o_h);
      const bf16_t* Bt = which ? (const bf16_t*)(p->ws + p->o_w2) : (const bf16_t*)(p->ws + p->o_wo);
      const int K = which ? 4096 : 1024;
      pg8::Gemm gm{A, Bt, LATR, 1024, K, K}; pg8::StaticOrder S; S.init(LATR, 1024, G, c);
      EpiBf16Y E{(bf16_t*)(p->ws + p->o_z), 1024};
      pg8::gemm_phase<EpiBf16Y, pg8::StaticOrder>(lds, gm, S, E, nullptr); }
    if (Mr > LATR) {
        const bf16_t* A = which ? hid : ((const bf16_t*)(p->ws + p->o_ob) - (size_t)LATR * 4096);
        const bf16_t* Bt = which ? (const bf16_t*)(p->ws + p->o_w2) : (const bf16_t*)(p->ws + p->o_wo4);
        pg8::Gemm gm{A, Bt, Mr, 1024, 4096, 512};
        SplitOrder S{LATR / 256, (Mr - LATR) / 256, 8, 512, G, c};
        EpiSlab E{(bf16_t*)(p->ws + p->o_z + (size_t)p->MG * 12288), LATR / 256, Mr - LATR, 512};
        pg8::gemm_phase<EpiSlab, SplitOrder>(lds, gm, S, E, nullptr);
    }
}
NOINL void ph_ffn1(PPtr pc, int Mr, LAS unsigned char* lds) {
    PPtr p = pc; asm volatile("" : "+s"(p)); const int G = (int)gridDim.x, c = (int)blockIdx.x;
    pg8::Gemm gm{(const bf16_t*)(p->ws + p->o_h), (const bf16_t*)(p->ws + p->o_w1), Mr, 4096, 1024, 1024}; pg8::StaticOrder S; S.init(Mr, 4096, G, c);
    EpiRelu2 E{(bf16_t*)(p->ws + p->o_z + (size_t)p->MG * 1024 * 4), 4096};
    pg8::gemm_phase<EpiRelu2, pg8::StaticOrder>(lds, gm, S, E, nullptr);
}

#define XB_SETUP() volatile LAS unsigned* xb_st = (volatile LAS unsigned*)(lds + CTRL_OFF + 64); unsigned* xb_bar = (unsigned*)(pc->ws + 4096); { XcdBarrier xb0 = xcd_barrier_post(xb_bar, xb_st); (void)xb0; }
#define GSYNC() { XcdBarrier xb_; xb_.bar = (unsigned*)(pc->ws + 4096); xb_.x = xb_xcc_id(); xb_.st = (volatile LAS unsigned*)(lds + CTRL_OFF + 64); xcd_barrier(xb_); }
#ifdef PROBE_MASK
__global__ void __launch_bounds__(512) hybrid_fwd(Params pk) {
    extern __shared__ __attribute__((aligned(16))) unsigned char smem[];
    LAS unsigned char* lds = (LAS unsigned char*)smem;
    cg::grid_group grid = cg::this_grid();
    PPtr pc = (PPtr)__builtin_amdgcn_kernarg_segment_ptr();
    const int GB = pc->GB, MG = pc->MG, NGRP = pc->NGRP, LATR = GB * 2048;
    unsigned long long tacc = 0, t0_ = __builtin_amdgcn_s_memrealtime();
#define PT(kind) { const unsigned long long t1_ = __builtin_amdgcn_s_memrealtime(); if ((PROBE_MASK >> (kind)) & 1) tacc += t1_ - t0_; t0_ = t1_; }
    ph_prologue(pc, lds);
    grid.sync();
    XB_SETUP(); PT(0)
    for (int l = 0; l < DEPTH; ++l) {
        const int Mr = (l < DEPTH - 1) ? MG : LATR;
        for (int g = 0; g < NGRP; ++g) {
            ph_rowpass(pc, l, g, 1, MG, -1, lds);
            GSYNC(); PT(1)
            ph_inproj(pc, lds);
            GSYNC(); PT(2)
            { unsigned long long tsc = 0; ph_mixer(pc, l, g, lds, &tsc); if ((PROBE_MASK >> 11) & 1) tacc += tsc; }
            GSYNC(); PT(3)
            ph_post(pc, l, Mr);
            GSYNC(); PT(4)
            ph_branch(pc, Mr, lds);
            GSYNC(); PT(5)
            ph_gemm_f32(pc, 0, Mr, lds);
            GSYNC(); PT(6)
            ph_rowpass(pc, l, g, 2, Mr, -1, lds);
            GSYNC(); PT(7)
            ph_ffn1(pc, Mr, lds);
            GSYNC(); PT(8)
            ph_gemm_f32(pc, 1, Mr, lds);
            GSYNC(); PT(9)
            ph_rowpass(pc, l, g, 3, Mr, (g == NGRP - 1 && l + 1 < DEPTH) ? l + 1 : -1, lds);
            GSYNC(); PT(10)
        }
    }
    if (blockIdx.x == 0) { const unsigned M = (unsigned)(tacc / 100ull); float* o = pc->out; for (unsigned i2 = threadIdx.x; i2 < M; i2 += 512) o[i2] += 0.125f; }
}

#else
__global__ void __launch_bounds__(512) hybrid_fwd(Params pk) {
    extern __shared__ __attribute__((aligned(16))) unsigned char smem[];
    LAS unsigned char* lds = (LAS unsigned char*)smem;
    cg::grid_group grid = cg::this_grid();
    PPtr pc = (PPtr)__builtin_amdgcn_kernarg_segment_ptr();
    const int GB = pc->GB, MG = pc->MG, NGRP = pc->NGRP, LATR = GB * 2048;
    ph_prologue(pc, lds);
    grid.sync();
    XB_SETUP();
    for (int l = 0; l < DEPTH; ++l) {
        const int Mr = (l < DEPTH - 1) ? MG : LATR;
        for (int g = 0; g < NGRP; ++g) {
            if ((l == 0 && g == 0) || NGRP == 1) { ph_rowpass(pc, l, g, 1, MG, -1, lds); GSYNC(); }
            ph_inproj(pc, lds);
            GSYNC();
            ph_mixer(pc, l, g, lds);
            GSYNC();
            ph_post(pc, l, Mr);
            GSYNC();
            ph_branch(pc, Mr, lds);
            GSYNC();
            ph_gemm_f32(pc, 0, Mr, lds);
            GSYNC();
            ph_rowpass(pc, l, g, 2, Mr, -1, lds);
            GSYNC();
            ph_ffn1(pc, Mr, lds);
            GSYNC();
            ph_gemm_f32(pc, 1, Mr, lds);
            GSYNC();
            {
                const bool lastg = (g == NGRP - 1);
                const int nl = (NGRP == 1) ? -1 : (lastg ? (l + 1 < DEPTH ? l + 1 : -1) : l), ng = lastg ? 0 : g + 1;
                ph_rowpass_tail(pc, l, g, Mr, (lastg && l + 1 < DEPTH) ? l + 1 : -1, nl, ng, MG, lds);
            }
            if (!(l == DEPTH - 1 && g == NGRP - 1)) GSYNC();
        }
    }
}

#endif
extern "C" void kernel_launch(void* const* d_in, const int* in_sizes, int n_in, void* d_out, int out_size, void* d_ws, size_t ws_size, hipStream_t stream) {
    static int grid_blocks = 0;
    if (grid_blocks == 0) {
        int dev = 0, cus = 0, per_cu = 0;
        hipGetDevice(&dev);
        hipDeviceGetAttribute(&cus, hipDeviceAttributeMultiprocessorCount, dev);
        if (hipFuncSetAttribute((const void*)hybrid_fwd, hipFuncAttributeMaxDynamicSharedMemorySize, LDS_BYTES) != hipSuccess) fprintf(stderr, "hipFuncSetAttribute failed\n");
        if (hipOccupancyMaxActiveBlocksPerMultiprocessor(&per_cu, (const void*)hybrid_fwd, 512, LDS_BYTES) != hipSuccess || per_cu < 1) { fprintf(stderr, "occupancy query: %d\n", per_cu); per_cu = 1; }
        (void)hipGetLastError();
        grid_blocks = cus * 1;
        if (grid_blocks <= 0) grid_blocks = 256;
    }
    Params p{};
    const float* const* in = (const float* const*)d_in;
    p.x = in[0]; p.c = in[1]; p.ctx = in[2]; p.c_ctx = in[3]; p.w_mod = in[4]; p.b_mod = in[5]; p.norm_gains = in[6]; p.w_in = in[7]; p.a_sink = in[8]; p.b_rel_bias = in[9];
    p.c_lb = in[10]; p.c_norm = in[11]; p.d_gate_up = in[12]; p.d_gate_bias = in[13]; p.d_norm = in[14]; p.w_branch = in[15]; p.w_out = in[16]; p.w_ff1 = in[17]; p.w_ff2 = in[18];
    p.out = (float*)d_out; p.ws = (unsigned char*)d_ws;
    auto al = [](unsigned long long v) { return (v + 255ull) & ~255ull; };
    unsigned long long off = 32768;
    p.o_mod = off; off = al(off + 4ull * 17 * 6144 * 4);
    p.o_lb = off; off = al(off + 4ull * 512 * 4);
    p.o_rope = off; off = al(off + 2048ull * 4);
    p.o_xc = off; off = al(off + 4096ull * 1024 * 4);
    p.o_win = off; off = al(off + (unsigned long long)ZW * 1024 * 2);
    p.o_wb = off; off = al(off + 4096ull * 512 * 2);
    p.o_wo = off; off = al(off + 1024ull * 1024 * 2);
    p.o_w1 = off; off = al(off + 4096ull * 1024 * 2);
    p.o_w2 = off; off = al(off + 1024ull * 4096 * 2);
    p.o_wo4 = off; off = al(off + 1024ull * 4096 * 2);
    const unsigned long long fixed = off;
    int GB = 8;
    for (; GB > 1; GB >>= 1) {
        const unsigned long long MGt = (unsigned long long)GB * 2304;
        const unsigned long long need = fixed + MGt * (2048ull + (unsigned long long)ZW * 2 + 4096ull + 2048ull) + (unsigned long long)GB * 10 * 64 * VTS * 2 + 8 * 256;
        if (need <= (unsigned long long)ws_size) break;
    }
    p.GB = GB; p.NGRP = 16 / GB; p.MG = GB * 2304;
    const unsigned long long MGu = (unsigned long long)p.MG;
    p.o_h = off; off = al(off + MGu * 1024 * 2);
    p.o_z = off; off = al(off + MGu * ZW * 2);
    p.o_y4 = off; off = al(off + MGu * 2048 * 2);
    p.o_ob = off; off = al(off + MGu * 1024 * 2);
    p.o_vta = off; off = al(off + (unsigned long long)GB * 2 * 64 * VTS * 2);
    p.o_vtb = off; off = al(off + (unsigned long long)GB * 8 * 64 * VTS * 2);
    hipMemsetAsync(d_ws, 0, 32768, stream);
    void* args[] = {&p};
    hipError_t e = hipLaunchCooperativeKernel((const void*)hybrid_fwd, dim3(grid_blocks), dim3(512), args, LDS_BYTES, stream);
    if (e != hipSuccess) fprintf(stderr, "cooperative launch failed: %s (grid %d)\n", hipGetErrorString(e), grid_blocks);
}
```

```cpp
#include <hip/hip_runtime.h>
#include <hip/hip_cooperative_groups.h>
#include <cstdio>
namespace cg = cooperative_groups;
__device__ __forceinline__ int ltid() { int t = (int)threadIdx.x; asm volatile("" : "+v"(t)); return t; }
#define LAS __attribute__((address_space(3)))
namespace pg8 {
#define PG8_LAS __attribute__((address_space(3)))
typedef unsigned short bf16_t;
typedef short bf16x8 __attribute__((ext_vector_type(8)));
typedef float f32x4 __attribute__((ext_vector_type(4)));
typedef unsigned u32x4 __attribute__((ext_vector_type(4)));
constexpr int BM = 256, BK = 64, HALF = 128, HTB = HALF * BK * 2  , STAGE_BYTES = 8 * HTB, NXCD = 8, WGM = 8;

__host__ __device__ __forceinline__ int lds_byte(int r, int c) { const int st = (r >> 4) * 2 + (c >> 5), rr = r & 15, cc = c & 31, ob = rr * 64 + cc * 2; return st * 1024 + (ob ^ (((ob >> 9) & 1) << 5)); }
__host__ __device__ __forceinline__ void stage_rc(int b, int& R, int& C) { const int st = b / 1024, sb = b % 1024, swz = sb ^ (((sb >> 9) & 1) << 5); R = (st >> 1) * 16 + swz / 64; C = (st & 1) * 32 + (swz % 64) / 2; }
__host__ __device__ __forceinline__ int perm32(int rho) { const int n = rho >> 4, i = rho & 15; return 8 * (i >> 2) + 4 * n + (i & 3); }

struct Unit { int pm, pn, ko; };
struct Gemm { const bf16_t* A; const bf16_t* Bt; int M, N, K, Kl; };

struct StaticOrder {
    int nM, nN, nwg, G, c;
    __host__ __device__ void init(int M, int N, int G_, int c_) { nM = M / BM; nN = N / BM; nwg = nM * nN; G = G_; c = c_; }
    __host__ __device__ bool next(int i, Unit& u) const {
        const long L = (long)i * G + c; if (L >= nwg) return false;
        int wgid = (int)L; { const int q = nwg / NXCD, r = nwg % NXCD, xcd = wgid % NXCD, off = wgid / NXCD; wgid = (xcd < r ? xcd * (q + 1) : r * (q + 1) + (xcd - r) * q) + off; }
        const int nig = WGM * nN, gid = wgid / nig, fm = gid * WGM, gsz = (nM - fm) < WGM ? (nM - fm) : WGM;
        u.pm = fm + ((wgid % nig) % gsz); u.pn = (wgid % nig) / gsz; u.ko = 0; return true;
    }
    __device__ __forceinline__ void a_ready(const Unit&) const {}
    __device__ __forceinline__ void done(const Unit&) const {}
};
__device__ __forceinline__ unsigned cvt_pk_bf16(float lo, float hi) { unsigned r; asm volatile("v_cvt_pk_bf16_f32 %0, %1, %2" : "=v"(r) : "v"(lo), "v"(hi)); return r; }
struct EpiF32 {
    static constexpr bool PERM = false, AFTER_DRAIN = false;
    float* C; int ldc; const float* bias;
    __device__ __forceinline__ void operator()(const f32x4 (&acc)[2][2][4][2], const Unit& u, int wr, int wc, int fr, int fq) const {
        const int row0 = u.pm * BM + wr * 64 + fr, col0 = u.pn * BM + wc * 32 + 4 * fq;
        f32x4 bv[2][2];
#pragma unroll
        for (int bj = 0; bj < 2; ++bj)
#pragma unroll
            for (int n = 0; n < 2; ++n) bv[bj][n] = bias ? *(const f32x4*)(bias + col0 + bj * HALF + n * 16) : (f32x4){0.f, 0.f, 0.f, 0.f};
#pragma unroll
        for (int ai = 0; ai < 2; ++ai)
#pragma unroll
            for (int m = 0; m < 4; ++m) { float* rowp = C + (size_t)(row0 + ai * HALF + m * 16) * ldc + col0;
#pragma unroll
                for (int bj = 0; bj < 2; ++bj)
#pragma unroll
                    for (int n = 0; n < 2; ++n) *(f32x4*)(rowp + bj * HALF + n * 16) = acc[ai][bj][m][n] + bv[bj][n]; }
    }
};
template <class Epi, class Sched, bool STAMP = false>
__device__ __forceinline__ void gemm_phase(PG8_LAS unsigned char* lds, const Gemm g, const Sched& S, const Epi& E, unsigned long long* stamps) {
    const int tid = ltid(), wid = __builtin_amdgcn_readfirstlane(tid >> 6), lane = tid & 63, wr = wid >> 2, wc = wid & 3, fr = lane & 15, fq = lane >> 4;
    const int K = g.K, nt = g.Kl / BK;
    int ts_lo = 0, ts_hi = 0, nts = 0; const unsigned long long rt_entry = STAMP ? (unsigned long long)wall_clock64() : 0ull;
#define PG8_STAMP() do { if (STAMP && wid == 0 && nts < 64) { const unsigned long long _c = (unsigned long long)clock64(); \
        ts_lo = (lane == nts) ? (int)(unsigned)_c : ts_lo; ts_hi = (lane == nts) ? (int)(unsigned)(_c >> 32) : ts_hi; ++nts; } } while (0)
    PG8_STAMP();
    unsigned voffA[2], voffB[2];
#pragma unroll
    for (int i = 0; i < 2; ++i) { int R, C; stage_rc(tid * 16 + i * 8192, R, C); const int Rb = Epi::PERM ? ((R & ~31) + perm32(R & 31)) : R;
        voffA[i] = (unsigned)(R * K + C) * 2u; voffB[i] = (unsigned)(Rb * K + C) * 2u; }
    const size_t kstep = (size_t)(BK * 2);
    const size_t hstep = (size_t)HALF * K * 2;
    const size_t tstep = 2 * hstep;
    const unsigned ldsw = (unsigned)wid * 1024u;
    const int aoff = lds_byte(wr * 64 + fr, fq * 8), boff = lds_byte(wc * 32 + fr, fq * 8);
#define PG8_SA(b, h) (((b) * 2 + (h)) * HTB)
#define PG8_SB(b, h) ((4 + (b) * 2 + (h)) * HTB)
#define PG8_STAGE(bufoff, gbase, voff) do { _Pragma("unroll") for (int _i = 0; _i < 2; ++_i) \
        __builtin_amdgcn_global_load_lds((const unsigned*)((const char*)(gbase) + (voff)[_i]), (PG8_LAS unsigned*)(lds + (bufoff) + ldsw + _i * 8192), 16, 0, 0); } while (0)
#define PG8_LDA(dst, b, h) do { _Pragma("unroll") for (int m = 0; m < 4; ++m) _Pragma("unroll") for (int k = 0; k < 2; ++k) dst[m][k] = *(const PG8_LAS bf16x8*)(lds + PG8_SA(b, h) + aoff + m * 2048 + k * 1024); } while (0)
#define PG8_LDB(dst, b, h) do { _Pragma("unroll") for (int n = 0; n < 2; ++n) _Pragma("unroll") for (int k = 0; k < 2; ++k) dst[n][k] = *(const PG8_LAS bf16x8*)(lds + PG8_SB(b, h) + boff + n * 2048 + k * 1024); } while (0)
#define PG8_MMA(ai, bj, At, Bt) do { __builtin_amdgcn_s_setprio(1); _Pragma("unroll") for (int m = 0; m < 4; ++m) _Pragma("unroll") for (int n = 0; n < 2; ++n) _Pragma("unroll") for (int k = 0; k < 2; ++k) \
        acc[ai][bj][m][n] = __builtin_amdgcn_mfma_f32_16x16x32_bf16(Bt[n][k], At[m][k], acc[ai][bj][m][n], 0, 0, 0); __builtin_amdgcn_s_setprio(0); } while (0)
#define PG8_WAIT_V(n) asm volatile("s_waitcnt vmcnt(" #n ")" ::: "memory")
#define PG8_WAIT_L(n) asm volatile("s_waitcnt lgkmcnt(" #n ")" ::: "memory")
#define PG8_BAR __builtin_amdgcn_s_barrier()
#define PG8_SCHED __builtin_amdgcn_sched_barrier(0)
    Unit cur, nxt; int ui = 0;
    if (!S.next(0, cur)) return;
    f32x4 acc[2][2][4][2];
#pragma unroll
    for (int a = 0; a < 2; ++a)
#pragma unroll
        for (int b = 0; b < 2; ++b)
#pragma unroll
            for (int m = 0; m < 4; ++m)
#pragma unroll
                for (int n = 0; n < 2; ++n) acc[a][b][m][n] = (f32x4){0.f, 0.f, 0.f, 0.f};
    bf16x8 At[4][2], B0[2][2], B1[2][2];
    const char* cA = (const char*)g.A + (size_t)cur.pm * tstep + (size_t)cur.ko * 2; const char* cB = (const char*)g.Bt + (size_t)cur.pn * tstep + (size_t)cur.ko * 2;
    S.a_ready(cur);
    PG8_STAGE(PG8_SB(0, 0), cB, voffB); PG8_STAGE(PG8_SA(0, 0), cA, voffA); PG8_STAGE(PG8_SB(0, 1), cB + hstep, voffB); PG8_STAGE(PG8_SA(0, 1), cA + hstep, voffA);
    if (wr == 1) PG8_BAR;
    PG8_WAIT_V(4); PG8_BAR;
    PG8_STAGE(PG8_SB(1, 0), cB + kstep, voffB); PG8_STAGE(PG8_SA(1, 0), cA + kstep, voffA); PG8_STAGE(PG8_SB(1, 1), cB + hstep + kstep, voffB);
    PG8_WAIT_V(6); PG8_BAR;
    PG8_STAMP();
    for (;;) {
        const bool has_next = S.next(ui + 1, nxt);
        const char* nA = has_next ? (const char*)g.A + (size_t)nxt.pm * tstep + (size_t)nxt.ko * 2 : cA; const char* nB = has_next ? (const char*)g.Bt + (size_t)nxt.pn * tstep + (size_t)nxt.ko * 2 : cB;
        for (int t = 0; t < nt; t += 2) {
            const bool last = (t == nt - 2);
            const char* a1 = cA + (size_t)(t + 1) * kstep;
            const char* a2 = last ? nA : cA + (size_t)(t + 2) * kstep; const char* b2 = last ? nB : cB + (size_t)(t + 2) * kstep;
            const char* a3 = a2 + kstep; const char* b3 = b2 + kstep;
            if (last && has_next) S.a_ready(nxt);
            PG8_LDB(B0, 0, 0); PG8_SCHED; PG8_LDA(At, 0, 0); PG8_STAGE(PG8_SA(1, 1), a1 + hstep, voffA);
            PG8_WAIT_L(8); PG8_BAR; PG8_WAIT_L(0); PG8_MMA(0, 0, At, B0); PG8_BAR; PG8_SCHED;
            PG8_LDB(B1, 0, 1); PG8_STAGE(PG8_SB(0, 0), b2, voffB);
            PG8_BAR; PG8_WAIT_L(0); PG8_MMA(0, 1, At, B1); PG8_BAR;
            PG8_LDA(At, 0, 1); PG8_STAGE(PG8_SA(0, 0), a2, voffA);
            PG8_BAR; PG8_WAIT_L(0); PG8_MMA(1, 0, At, B0); PG8_BAR; PG8_SCHED;
            PG8_STAGE(PG8_SB(0, 1), b2 + hstep, voffB);
            PG8_WAIT_V(6); PG8_BAR; PG8_MMA(1, 1, At, B1); PG8_BAR;
            PG8_LDB(B0, 1, 0); PG8_SCHED; PG8_LDA(At, 1, 0); PG8_STAGE(PG8_SA(0, 1), a2 + hstep, voffA);
            PG8_WAIT_L(8); PG8_BAR; PG8_WAIT_L(0); PG8_MMA(0, 0, At, B0); PG8_BAR; PG8_SCHED;
            PG8_LDB(B1, 1, 1); PG8_STAGE(PG8_SB(1, 0), b3, voffB);
            PG8_BAR; PG8_WAIT_L(0); PG8_MMA(0, 1, At, B1); PG8_BAR;
            PG8_LDA(At, 1, 1); PG8_STAGE(PG8_SA(1, 0), a3, voffA);
            PG8_BAR; PG8_WAIT_L(0); PG8_MMA(1, 0, At, B0); PG8_BAR; PG8_SCHED;
            PG8_STAGE(PG8_SB(1, 1), b3 + hstep, voffB);
            PG8_WAIT_V(6); PG8_BAR; PG8_MMA(1, 1, At, B1); PG8_BAR;
        }
        PG8_STAMP();
        if constexpr (!Epi::AFTER_DRAIN) { E(acc, cur, wr, wc, fr, fq); S.done(cur); }
        PG8_STAMP();
        if (!has_next) break;
#pragma unroll
        for (int a = 0; a < 2; ++a)
#pragma unroll
            for (int b = 0; b < 2; ++b)
#pragma unroll
                for (int m = 0; m < 4; ++m)
#pragma unroll
                    for (int n = 0; n < 2; ++n) acc[a][b][m][n] = (f32x4){0.f, 0.f, 0.f, 0.f};
        cur = nxt; cA = nA; cB = nB; ++ui;
    }
    PG8_WAIT_V(0);
    if (wr == 0) PG8_BAR;
    PG8_BAR;
    if constexpr (Epi::AFTER_DRAIN) { E.fused(acc, cur, wr, wc, fr, fq, lds, wid, lane); S.done(cur); }
    PG8_STAMP();
    if (STAMP && wid == 0) { stamps[lane] = lane < nts ? (((unsigned long long)(unsigned)ts_hi << 32) | (unsigned)ts_lo) : 0ull;
        if (lane == 62) stamps[62] = rt_entry; if (lane == 63) stamps[63] = (unsigned long long)wall_clock64(); }
#undef PG8_STAMP
#undef PG8_SA
#undef PG8_SB
#undef PG8_STAGE
#undef PG8_LDA
#undef PG8_LDB
#undef PG8_MMA
#undef PG8_WAIT_V
#undef PG8_WAIT_L
#undef PG8_BAR
#undef PG8_SCHED
}
}
#define XB_TMO      128
#define XB_XCNT(j)  (256  + 64 * (j))
#define XB_XSUB(j)  (1280 + 64 * (j))
#define XB_XGEN(j)  (2304 + 64 * (j))
#define XB_TOP      3328
#define XB_TOPGEN   3392
#define XCD_BAR_WORDS 3456
#define XB_SPIN_CAP (1u << 18)

__device__ __forceinline__ unsigned xb_ld(unsigned* p)              { return __hip_atomic_load(p, __ATOMIC_RELAXED, __HIP_MEMORY_SCOPE_AGENT); }
__device__ __forceinline__ unsigned xb_add(unsigned* p, unsigned v) { return __hip_atomic_fetch_add(p, v, __ATOMIC_RELAXED, __HIP_MEMORY_SCOPE_AGENT); }
__device__ __forceinline__ unsigned xb_xcc_id() { return (unsigned)__builtin_amdgcn_s_getreg((3 << 11) | 20) & 0xFu; }
#define XB_SPIN(cond, bar) do { unsigned _sp = 0; while (cond) { __builtin_amdgcn_s_sleep(1); \
    if ((++_sp & 255u) == 0u) { if (xb_ld(&(bar)[XB_TMO])) break; if (_sp > XB_SPIN_CAP) { atomicAdd(&(bar)[XB_TMO], 1u); break; } } } } while (0)

struct XcdBarrier {
    unsigned* bar; unsigned x;
    volatile LAS unsigned* st;
};

__device__ __forceinline__ XcdBarrier xcd_barrier_post(unsigned* bar, volatile LAS unsigned* st) {
    XcdBarrier b; b.bar = bar; b.x = xb_xcc_id(); b.st = st;
    if (threadIdx.x == 0) (void)xb_add(&bar[XB_XCNT(b.x)], 1u);
    return b;
}
__device__ __forceinline__ void xcd_barrier_complete(unsigned* bar, unsigned x, unsigned& nloc, unsigned& nx) {
    const unsigned G = gridDim.x * gridDim.y * gridDim.z;
    unsigned sum, cnt, mine, sp = 0u;
    for (;;) {
        sum = 0u; cnt = 0u; mine = 0u;
#pragma unroll
        for (unsigned j = 0; j < 16; ++j) { const unsigned c = xb_ld(&bar[XB_XCNT(j)]); sum += c; cnt += (c > 0u) ? 1u : 0u; mine = (j == x) ? c : mine; }
        if (sum == G) break;
        __builtin_amdgcn_s_sleep(1);
        if ((++sp & 255u) == 0u) { if (xb_ld(&bar[XB_TMO])) break; if (sp > XB_SPIN_CAP) { atomicAdd(&bar[XB_TMO], 1u); break; } }
    }
    nloc = mine > 0u ? mine : 1u; nx = cnt > 0u ? cnt : 1u;
}

__device__ __forceinline__ void xcd_barrier(const XcdBarrier& b) {
    asm volatile("s_waitcnt vmcnt(0)" ::: "memory");
    __syncthreads();
    if (threadIdx.x == 0) {
        unsigned* bar = b.bar;
        __builtin_amdgcn_s_waitcnt(0);
        unsigned nloc = b.st[0], nx = b.st[1];
        if (nloc == 0u) { xcd_barrier_complete(bar, b.x, nloc, nx); b.st[0] = nloc; b.st[1] = nx; }
        const unsigned old = xb_add(&bar[XB_XSUB(b.x)], 1u);
        const unsigned gen = old / nloc;
        if (old + 1u == (gen + 1u) * nloc) {
            __builtin_amdgcn_fence(__ATOMIC_RELEASE, "agent");
            asm volatile("s_waitcnt vmcnt(0)" ::: "memory");
            const unsigned og = xb_add(&bar[XB_TOP], 1u);
            const unsigned tg = og / nx;
            if (og + 1u == (tg + 1u) * nx) xb_add(&bar[XB_TOPGEN], 1u);
            else XB_SPIN(xb_ld(&bar[XB_TOPGEN]) == tg, bar);
            __builtin_amdgcn_fence(__ATOMIC_ACQUIRE, "agent");
            xb_add(&bar[XB_XGEN(b.x)], 1u);
            asm volatile("s_waitcnt vmcnt(0)" ::: "memory");
        } else {
            XB_SPIN(xb_ld(&bar[XB_XGEN(b.x)]) == gen, bar);
            __builtin_amdgcn_fence(__ATOMIC_ACQUIRE, "agent");
            asm volatile("s_waitcnt vmcnt(0)" ::: "memory");
        }
    }
    __syncthreads();
}

typedef unsigned short bf16_t;
typedef pg8::bf16x8 bf16x8;
typedef pg8::f32x4 f32x4;
typedef pg8::u32x4 u32x4;
typedef unsigned u32x2 __attribute__((ext_vector_type(2)));

constexpr int DM = 1024, NB = 16, SEQ = 2048, DEPTH = 4, CTXL = 256, DFF = 4096;
constexpr int ZW = 10752;
constexpr int INW = 10528;
constexpr int ZA_Q = 0, ZA_K = 512, ZA_V = 640, ZB_Q = 768, ZB_K = 1280, ZB_V = 1792, ZC_Q = 2304, ZC_FF = 2816, ZC_FB = 3328, ZC_I = 3840, ZC_G = 4352,
              ZD_Q = 4864, ZD_K = 5120, ZD_V = 5376, ZD_GK = 5888, ZD_G = 6016, ZMERGE = 6656;
constexpr int VTS = 2304;
constexpr int LDS_BYTES = 144 * 1024;
constexpr int CTRL_OFF = LDS_BYTES - 256;
constexpr float EPS = 1e-6f;
constexpr float LOG2E = 1.4426950408889634f;
constexpr float QSCALE2 = 0.125f * LOG2E;

struct Params {
    const float *x, *c, *ctx, *c_ctx, *w_mod, *b_mod, *norm_gains, *w_in, *a_sink, *b_rel_bias, *c_lb, *c_norm, *d_gate_up, *d_gate_bias, *d_norm, *w_branch, *w_out, *w_ff1, *w_ff2;
    float* out;
    unsigned char* ws;
    unsigned long long o_mod, o_lb, o_rope, o_xc, o_win, o_wb, o_wo, o_w1, o_w2, o_h, o_z, o_y4, o_ob, o_vta, o_vtb, o_wo4;
    int GB, NGRP, MG, pad0;
};
typedef const Params __attribute__((address_space(4)))* PPtr;

__device__ __forceinline__ float bf2f(unsigned v) { return __uint_as_float(v << 16); }
__device__ __forceinline__ bf16_t f2bf(float f) { unsigned u = __float_as_uint(f); u += 0x7FFFu + ((u >> 16) & 1u); return (bf16_t)(u >> 16); }
typedef __bf16 bf16v2_t __attribute__((ext_vector_type(2)));
typedef float f32v2_t __attribute__((ext_vector_type(2)));
__device__ __forceinline__ unsigned pk2(float lo, float hi) { const f32v2_t v = {lo, hi}; const bf16v2_t b = __builtin_convertvector(v, bf16v2_t); return __builtin_bit_cast(unsigned, b); }
template <int CTRL> __device__ __forceinline__ float dpp(float x) { return __builtin_bit_cast(float, __builtin_amdgcn_mov_dpp(__builtin_bit_cast(int, x), CTRL, 0xf, 0xf, true)); }
constexpr int XOR1 = 0xB1, XOR2 = 0x4E, XOR7 = 0x141, XOR8 = 0x128;
__device__ __forceinline__ float xrow16_max(float x) {
    auto s = __builtin_amdgcn_permlane16_swap(__float_as_uint(x), __float_as_uint(x), false, false);
    x = fmaxf(__uint_as_float(s[0]), __uint_as_float(s[1]));
    auto t = __builtin_amdgcn_permlane32_swap(__float_as_uint(x), __float_as_uint(x), false, false);
    return fmaxf(__uint_as_float(t[0]), __uint_as_float(t[1]));
}
__device__ __forceinline__ float xrow16_sum(float x) {
    auto s = __builtin_amdgcn_permlane16_swap(__float_as_uint(x), __float_as_uint(x), false, false);
    x = __uint_as_float(s[0]) + __uint_as_float(s[1]);
    auto t = __builtin_amdgcn_permlane32_swap(__float_as_uint(x), __float_as_uint(x), false, false);
    return __uint_as_float(t[0]) + __uint_as_float(t[1]);
}
__device__ __forceinline__ float row16_sum(float v) {
    v += dpp<XOR1>(v); v += dpp<XOR2>(v); v += dpp<XOR7>(v); v += dpp<XOR8>(v);
    return v;
}
__device__ __forceinline__ float wave_sum(float v) { return xrow16_sum(row16_sum(v)); }
__device__ __forceinline__ float lo16(unsigned w) { return __uint_as_float(w << 16); }
__device__ __forceinline__ float hi16(unsigned w) { return __uint_as_float(w & 0xffff0000u); }
__device__ __forceinline__ float sigm(float x) { return __builtin_amdgcn_rcpf(1.0f + __builtin_amdgcn_exp2f(-LOG2E * x)); }
__device__ __forceinline__ float fexp(float x) { return __builtin_amdgcn_exp2f(x * LOG2E); }
__device__ __forceinline__ float flog(float x) { return __builtin_amdgcn_logf(x) * 0.6931471805599453f; }
__device__ __forceinline__ bf16_t f2bf1(float x) { return (bf16_t)pk2(x, 0.f); }

__device__ __forceinline__ int src_col(int n) {
    if (n < 640) {
        const int p = n & 63, base = n - p, pp = p >> 1, wh = p & 1;
        const int dim = (pp < 16) ? (wh ? 16 + pp : pp) : (wh ? 48 + (pp - 16) : 32 + (pp - 16));
        return base + dim;
    }
    if (n < 5920) return n;
    if (n < 6016) return -1;
    if (n < 6528) return n - 96;
    if (n < 6656) return -1;
    return 6432 + (n - 6656);
}

__device__ __forceinline__ void conv_tile(const float* src, int Nsrc, int k0, int n0, bool inmap, bf16_t* dst, int Kd, LAS float* t) {
    const int tid = ltid(), nl = tid & 63, ks = tid >> 6;
    const int sc = inmap ? src_col(n0 + nl) : (n0 + nl);
#pragma unroll
    for (int i = 0; i < 8; ++i) { const int kk = ks + 8 * i; t[nl * 65 + kk] = (sc >= 0) ? src[(size_t)(k0 + kk) * Nsrc + sc] : 0.f; }
    __syncthreads();
    const int kl = (tid & 31) * 2, ns = tid >> 5;
#pragma unroll
    for (int i = 0; i < 4; ++i) { const int n = ns + 16 * i; *(unsigned*)(dst + (size_t)(n0 + n) * Kd + k0 + kl) = pk2(t[n * 65 + kl], t[n * 65 + kl + 1]); }
    __syncthreads();
}
__device__ __forceinline__ void convert_weights(PPtr p, int l, LAS unsigned char* lds) {
    LAS float* t = (LAS float*)lds;
    bf16_t* WinT = (bf16_t*)(p->ws + p->o_win); bf16_t* WbT = (bf16_t*)(p->ws + p->o_wb); bf16_t* WoT = (bf16_t*)(p->ws + p->o_wo);
    bf16_t* W1T = (bf16_t*)(p->ws + p->o_w1); bf16_t* W2T = (bf16_t*)(p->ws + p->o_w2);
    constexpr int T_IN = 16 * 168, T_BR = 4 * 8 * 16, T_O = 16 * 16, T_1 = 16 * 64, T_2 = 64 * 16, T_ALL = T_IN + T_BR + T_O + T_1 + T_2;
    for (int it = blockIdx.x; it < T_ALL; it += gridDim.x) {
        int r = it;
        if (r < T_IN) { const int kb = r / 168, nb = r % 168; conv_tile(p->w_in + (size_t)l * 1024 * INW, INW, kb * 64, nb * 64, true, WinT, 1024, t); continue; } r -= T_IN;
        if (r < T_BR) { const int j = r / 128, q = r % 128, kb = q / 16, nb = q % 16; conv_tile(p->w_branch + (size_t)(l * 4 + j) * 512 * 1024, 1024, kb * 64, nb * 64, false, WbT + (size_t)j * 1024 * 512, 512, t); continue; } r -= T_BR;
        if (r < T_O) { const int kb = r / 16, nb = r % 16; conv_tile(p->w_out + (size_t)l * 1024 * 1024, 1024, kb * 64, nb * 64, false, WoT, 1024, t);
#pragma unroll 1
            for (int cpy = 0; cpy < 4; ++cpy) conv_tile(p->w_out + (size_t)l * 1024 * 1024, 1024, kb * 64, nb * 64, false, (bf16_t*)(p->ws + p->o_wo4) + cpy * 1024, 4096, t);
            continue; } r -= T_O;
        if (r < T_1) { const int kb = r / 64, nb = r % 64; conv_tile(p->w_ff1 + (size_t)l * 1024 * 4096, 4096, kb * 64, nb * 64, false, W1T, 1024, t); continue; } r -= T_1;
        { const int kb = r / 16, nb = r % 16; conv_tile(p->w_ff2 + (size_t)l * 4096 * 1024, 1024, kb * 64, nb * 64, false, W2T, 4096, t); }
    }
}

__device__ __forceinline__ void prologue(PPtr p, LAS unsigned char* lds) {
    const int tid = ltid();
    if (blockIdx.x == 0) {
        if (tid < 64) atomicExch((unsigned*)p->ws + tid, 0u);
        for (int i = tid; i < XCD_BAR_WORDS; i += 512) __hip_atomic_store((unsigned*)(p->ws + 4096) + i, 0u, __ATOMIC_RELAXED, __HIP_MEMORY_SCOPE_AGENT);
    }
    if (tid < 4) *((LAS unsigned*)(lds + CTRL_OFF + 64) + tid) = 0u;
    float* modb = (float*)(p->ws + p->o_mod);
    LAS float* sl = (LAS float*)lds;
    LAS float* red = sl + 17 * 1024;
    bool loaded = false;
    for (int task = blockIdx.x; task < 192; task += gridDim.x) {
        if (!loaded) {
            for (int i = tid; i < 17 * 1024; i += 512) { const int b = i >> 10, k = i & 1023; const float v = (b < 16) ? p->c[b * 1024 + k] : p->c_ctx[k]; sl[i] = v * sigm(v); }
            loaded = true;
        }
        __syncthreads();
        const int l = task / 48, nc = task % 48, nn = tid & 127, n = nc * 128 + nn, kq = tid >> 7;
        float acc[17];
#pragma unroll
        for (int b = 0; b < 17; ++b) acc[b] = 0.f;
        const float* w = p->w_mod + ((size_t)l * 1024 + kq * 256) * 6144 + n;
#pragma unroll 1
        for (int k = 0; k < 256; k += 4) {
            const float w0 = w[(size_t)k * 6144], w1 = w[(size_t)(k + 1) * 6144], w2 = w[(size_t)(k + 2) * 6144], w3 = w[(size_t)(k + 3) * 6144];
#pragma unroll
            for (int b = 0; b < 17; ++b) { const f32x4 sv = *(const LAS f32x4*)(sl + b * 1024 + kq * 256 + k); acc[b] += (sv.x * w0 + sv.y * w1) + (sv.z * w2 + sv.w * w3); }
        }
#pragma unroll
        for (int b = 0; b < 17; ++b) red[(kq * 17 + b) * 128 + nn] = acc[b];
        __syncthreads();
        if (kq == 0) {
            const float bm = p->b_mod[l * 6144 + n];
#pragma unroll
            for (int b = 0; b < 17; ++b) modb[((size_t)l * 17 + b) * 6144 + n] = red[b * 128 + nn] + red[(17 + b) * 128 + nn] + red[(34 + b) * 128 + nn] + red[(51 + b) * 128 + nn] + bm;
        }
        __syncthreads();
    }
    if (blockIdx.x == gridDim.x - 1) {
        float* lb = (float*)(p->ws + p->o_lb);
        {
            const int ch = tid;
            float v[4], mx = -1e30f;
#pragma unroll
            for (int l = 0; l < 4; ++l) { v[l] = p->c_lb[l * 512 + ch]; mx = fmaxf(mx, v[l]); }
            float s = 0.f;
#pragma unroll
            for (int l = 0; l < 4; ++l) { v[l] = __expf(v[l] - mx); s += v[l]; }
            const float inv = 1.0f / s, s0 = v[0] * inv; float cum = 0.f;
#pragma unroll
            for (int l = 0; l < 4; ++l) { cum += v[l] * inv; lb[l * 512 + ch] = cum - s0; }
        }
        float* rt = (float*)(p->ws + p->o_rope);
        for (int i = tid; i < 1024; i += 512) {
            const int n = i >> 4, f = i & 15;
            const float inv = __expf(-((float)(2 * f) / 32.0f) * 9.210340371976184f);
            const float a = (float)n * inv;
            const float kf = rintf(a * 0.15915494309189535f);
            const float rr = fmaf(-kf, 6.2831854820251465f, a) + kf * 1.7484556e-7f;
            rt[i] = __cosf(rr); rt[1024 + i] = __sinf(rr);
        }
    }
    __syncthreads();
    convert_weights(p, 0, lds);
}

__device__ __forceinline__ void rowpass(PPtr p, int l, int g, int mode, int nrows) {
    const int lane = ltid() & 63, gw = blockIdx.x * 8 + (ltid() >> 6), NGW = gridDim.x * 8;
    const int LATR = p->GB * 2048, GB = p->GB;
    const float* ng = p->norm_gains + (size_t)l * 4 * 1024;
    const float* modb = (const float*)(p->ws + p->o_mod) + (size_t)l * 17 * 6144;
    bf16_t* hb = (bf16_t*)(p->ws + p->o_h);
    const float* yf = (const float*)(p->ws + p->o_z);
    float* xcb = (float*)(p->ws + p->o_xc);
    const bool first = (l == 0 && mode <= 2);
    const float* xlat = first ? p->x : (const float*)p->out;
    const float* xctx = first ? p->ctx : (const float*)xcb;
    auto xsrc = [&](int row) -> const float* {
        if (row < LATR) return xlat + ((size_t)(g * GB + (row >> 11)) * 2048 + (row & 2047)) * 1024;
        const int r2 = row - LATR; return xctx + ((size_t)(g * GB + (r2 >> 8)) * 256 + (r2 & 255)) * 1024;
    };
    const bf16_t* slab = (const bf16_t*)(p->ws + p->o_z + (size_t)p->MG * 12288);
    const size_t slab_stride = (size_t)(p->MG - LATR) * 1024;
    auto yload = [&](int row, f32x4 (&yv)[4]) {
        if (row < LATR) {
            const bf16_t* yb = (const bf16_t*)yf + (size_t)row * 1024 + lane * 4;
#pragma unroll
            for (int j = 0; j < 4; ++j) { const u32x2 w = *(const u32x2*)(yb + 256 * j); yv[j] = (f32x4){lo16(w.x), hi16(w.x), lo16(w.y), hi16(w.y)}; }
        } else {
            const bf16_t* s0 = slab + (size_t)(row - LATR) * 1024 + lane * 4;
#pragma unroll
            for (int j = 0; j < 4; ++j) { const u32x2 w = *(const u32x2*)(s0 + 256 * j); yv[j] = (f32x4){lo16(w.x), hi16(w.x), lo16(w.y), hi16(w.y)}; }
#pragma unroll
            for (int ks = 1; ks < 8; ++ks)
#pragma unroll
                for (int j = 0; j < 4; ++j) { const u32x2 w = *(const u32x2*)(s0 + ks * slab_stride + 256 * j); yv[j] = yv[j] + (f32x4){lo16(w.x), hi16(w.x), lo16(w.y), hi16(w.y)}; }
        }
    };
    f32x4 xv[4], yv[4];
    int row = gw;
    if (row < nrows) {
        const float* xs = xsrc(row);
#pragma unroll
        for (int j = 0; j < 4; ++j) xv[j] = *(const f32x4*)(xs + lane * 4 + 256 * j);
        if (mode >= 2) yload(row, yv);
    }
    while (row < nrows) {
        const int nrow = row + NGW;
        f32x4 xn[4], yn[4];
        if (nrow < nrows) {
            const float* xs = xsrc(nrow);
#pragma unroll
            for (int j = 0; j < 4; ++j) xn[j] = *(const f32x4*)(xs + lane * 4 + 256 * j);
            if (mode >= 2) yload(nrow, yn);
        }
        const bool lat = row < LATR;
        int b; size_t xrow;
        if (lat) { b = g * GB + (row >> 11); xrow = (size_t)b * 2048 + (row & 2047); }
        else { const int r2 = row - LATR; b = g * GB + (r2 >> 8); xrow = (size_t)b * 256 + (r2 & 255); }
        float* xd = (lat ? p->out : xcb) + xrow * 1024;
        const float* m = modb + (size_t)(lat ? b : 16) * 6144;
        f32x4 tgv[4], tnv[4], tsh[4], tsc[4], tn2[4];
        {
            const float* gate = m + (mode == 2 ? 2048 : 5120); const float* gn = ng + (mode == 2 ? 1024 : 3072);
            const float* sh = m + (mode == 1 ? 0 : 3072); const float* sc = m + (mode == 1 ? 1024 : 4096); const float* gn2 = ng + (mode == 1 ? 0 : 2048);
#pragma unroll
            for (int j = 0; j < 4; ++j) {
                const int c = lane * 4 + 256 * j;
                if (mode >= 2) { tgv[j] = *(const f32x4*)(gate + c); tnv[j] = *(const f32x4*)(gn + c); }
                if (mode <= 2) { tsh[j] = *(const f32x4*)(sh + c); tsc[j] = *(const f32x4*)(sc + c); tn2[j] = *(const f32x4*)(gn2 + c); }
            }
        }
        if (mode >= 2) {
            float ss = 0.f;
#pragma unroll
            for (int j = 0; j < 4; ++j) ss += yv[j].x * yv[j].x + yv[j].y * yv[j].y + yv[j].z * yv[j].z + yv[j].w * yv[j].w;
            ss = wave_sum(ss);
            const float rs = rsqrtf(ss * (1.0f / 1024.0f) + EPS);
#pragma unroll
            for (int j = 0; j < 4; ++j) {
                const int c = lane * 4 + 256 * j;
                const f32x4 gv = tgv[j], nv = tnv[j];
                xv[j] = xv[j] + gv * (yv[j] * rs * nv);
                *(f32x4*)(xd + c) = xv[j];
            }
        }
        if (mode <= 2) {
            float ss = 0.f;
#pragma unroll
            for (int j = 0; j < 4; ++j) ss += xv[j].x * xv[j].x + xv[j].y * xv[j].y + xv[j].z * xv[j].z + xv[j].w * xv[j].w;
            ss = wave_sum(ss);
            const float rs = rsqrtf(ss * (1.0f / 1024.0f) + EPS);
#pragma unroll
            for (int j = 0; j < 4; ++j) {
                const int c = lane * 4 + 256 * j;
                const f32x4 shv = tsh[j], scv = tsc[j], nv = tn2[j];
                const f32x4 hv = (xv[j] * rs * nv) * (scv + 1.0f) + shv;
                u32x2 o; o.x = pk2(hv.x, hv.y); o.y = pk2(hv.z, hv.w);
                *(u32x2*)(hb + (size_t)row * 1024 + c) = o;
            }
        }
#pragma unroll
        for (int j = 0; j < 4; ++j) { xv[j] = xn[j]; yv[j] = yn[j]; }
        row = nrow;
    }
}

struct EpiInproj {
    static constexpr bool PERM = true, AFTER_DRAIN = false;
    bf16_t* Z; bf16_t* vta; bf16_t* vtb; const float* rope; int GB;
    __device__ __forceinline__ void operator()(const f32x4 (&acc)[2][2][4][2], const pg8::Unit& u, int wr, int wc, int fr, int fq) const {
        const int row0 = u.pm * 256 + wr * 64 + fr, LATR = GB * 2048;
#pragma unroll
        for (int bj = 0; bj < 2; ++bj) {
            const int seg = u.pn * 2 + bj, c0 = u.pn * 256 + bj * 128 + wc * 32 + 8 * fq;
            const int type = (seg <= 4) ? 1 : (seg == 5 ? 2 : ((seg >= 14 && seg <= 17) ? 3 : 0));
            const int xf = (seg <= 3 || (seg >= 6 && seg <= 9)) ? 1 : ((seg >= 18 && seg <= 21) ? 2 : ((seg >= 22 && seg <= 29) ? 3 : ((seg == 38 || seg == 39) ? 4 : 0)));
#pragma unroll
            for (int ai = 0; ai < 2; ++ai)
#pragma unroll
                for (int m = 0; m < 4; ++m) {
                    const int row = row0 + ai * 128 + m * 16;
                    f32x4 v0 = acc[ai][bj][m][0], v1 = acc[ai][bj][m][1];
                    if (type <= 1) {
                        if (type == 1 && row < LATR) {
                            const int t = row & 2047, pp0 = (c0 & 63) >> 1;
                            const int n = (pp0 < 16) ? (t >> 6) : (t & 63);
                            const float* cs = rope + n * 16 + (pp0 & 15);
                            const f32x4 cv = *(const f32x4*)cs, sv = *(const f32x4*)(cs + 1024);
                            f32x4 r0, r1;
                            r0.x = v0.x * cv.x - v0.y * sv.x; r0.y = v0.y * cv.x + v0.x * sv.x;
                            r0.z = v0.z * cv.y - v0.w * sv.y; r0.w = v0.w * cv.y + v0.z * sv.y;
                            r1.x = v1.x * cv.z - v1.y * sv.z; r1.y = v1.y * cv.z + v1.x * sv.z;
                            r1.z = v1.z * cv.w - v1.w * sv.w; r1.w = v1.w * cv.w + v1.z * sv.w;
                            v0 = r0; v1 = r1;
                        }
                        if (xf == 1) { v0 = v0 * QSCALE2; v1 = v1 * QSCALE2; }
                        else if (xf == 4) { v0 = v0 * 0.125f; v1 = v1 * 0.125f; }
                        else if (xf == 2) {
#pragma unroll
                            for (int e = 0; e < 4; ++e) { v0[e] = v0[e] * sigm(v0[e]); v1[e] = v1[e] * sigm(v1[e]); }
                        } else if (xf == 3) {
#pragma unroll
                            for (int e = 0; e < 4; ++e) { v0[e] = sigm(v0[e]); v1[e] = sigm(v1[e]); }
                        }
                        u32x4 w; w.x = pk2(v0.x, v0.y); w.y = pk2(v0.z, v0.w); w.z = pk2(v1.x, v1.y); w.w = pk2(v1.z, v1.w);
                        *(u32x4*)(Z + (size_t)row * ZW + c0) = w;
                    } else {
                        int bl, tok;
                        if (row < LATR) { bl = row >> 11; tok = row & 2047; } else { const int r2 = row - LATR; bl = r2 >> 8; tok = 2048 + (r2 & 255); }
                        const int cc = c0 - (type == 2 ? ZA_V : ZB_V), head = cc >> 6, dim0 = cc & 63, H = (type == 2) ? 2 : 8;
                        bf16_t* base = (type == 2 ? vta : vtb) + ((size_t)(bl * H + head) * 64 + dim0) * VTS + tok;
                        base[0 * VTS] = f2bf(v0.x); base[1 * VTS] = f2bf(v0.y); base[2 * VTS] = f2bf(v0.z); base[3 * VTS] = f2bf(v0.w);
                        base[4 * VTS] = f2bf(v1.x); base[5 * VTS] = f2bf(v1.y); base[6 * VTS] = f2bf(v1.z); base[7 * VTS] = f2bf(v1.w);
                    }
                }
        }
    }
};
struct EpiBranch {
    static constexpr bool PERM = true, AFTER_DRAIN = false;
    const bf16_t* Z; bf16_t* macc; int nMfull;
    __device__ __forceinline__ void operator()(const f32x4 (&acc)[2][2][4][2], const pg8::Unit& u, int wr, int wc, int fr, int fq) const {
        const int j = u.pm / nMfull, pm = u.pm - j * nMfull, pn = u.pn & 3;
        const int row0 = pm * 256 + wr * 64 + fr, col0 = pn * 256 + wc * 32 + 8 * fq;
        const bf16_t* gbase = Z + (size_t)row0 * ZW + ZMERGE + j * 1024 + col0;
        bf16_t* mbase = macc + (size_t)row0 * 1024 + col0;
#pragma unroll
        for (int ai = 0; ai < 2; ++ai) {
            u32x4 gw[4][2], pv[4][2];
#pragma unroll
            for (int m = 0; m < 4; ++m)
#pragma unroll
                for (int bj = 0; bj < 2; ++bj) {
                    const size_t ro = (size_t)(ai * 128 + m * 16);
                    gw[m][bj] = *(const u32x4*)(gbase + ro * ZW + bj * 128);
                    pv[m][bj] = (j > 0) ? *(const u32x4*)(mbase + ro * 1024 + bj * 128) : (u32x4){0u, 0u, 0u, 0u};
                }
#pragma unroll
            for (int m = 0; m < 4; ++m)
#pragma unroll
                for (int bj = 0; bj < 2; ++bj) {
                    const u32x4 g = gw[m][bj], q = pv[m][bj];
                    const f32x4 v0 = acc[ai][bj][m][0], v1 = acc[ai][bj][m][1];
                    const float t0 = v0.x * sigm(lo16(g.x)) + lo16(q.x), t1 = v0.y * sigm(hi16(g.x)) + hi16(q.x), t2 = v0.z * sigm(lo16(g.y)) + lo16(q.y), t3 = v0.w * sigm(hi16(g.y)) + hi16(q.y);
                    const float t4 = v1.x * sigm(lo16(g.z)) + lo16(q.z), t5 = v1.y * sigm(hi16(g.z)) + hi16(q.z), t6 = v1.z * sigm(lo16(g.w)) + lo16(q.w), t7 = v1.w * sigm(hi16(g.w)) + hi16(q.w);
                    u32x4 w; w.x = pk2(t0, t1); w.y = pk2(t2, t3); w.z = pk2(t4, t5); w.w = pk2(t6, t7);
                    *(u32x4*)(mbase + (size_t)(ai * 128 + m * 16) * 1024 + bj * 128) = w;
                }
        }
    }
};
struct BranchOrder {
    int nM, nMfull, G, c;
    __device__ __forceinline__ bool next(int i, pg8::Unit& u) const {
        const int j = i & 3; const int v = (c & 7) * (G >> 3) + (c >> 3);
        const long T = (long)(i >> 2) * G + v;
        if (T >= (long)nM * 4) return false;
        u.pm = j * nMfull + (int)(T >> 2); u.pn = j * 4 + (int)(T & 3); u.ko = 0; return true;
    }
    __device__ __forceinline__ void a_ready(const pg8::Unit&) const {}
    __device__ __forceinline__ void done(const pg8::Unit&) const {}
};
struct EpiBf16Y {
    static constexpr bool PERM = true, AFTER_DRAIN = false;
    bf16_t* O; int ldc;
    __device__ __forceinline__ void operator()(const f32x4 (&acc)[2][2][4][2], const pg8::Unit& u, int wr, int wc, int fr, int fq) const {
        const int row0 = u.pm * 256 + wr * 64 + fr, col0 = u.pn * 256 + wc * 32 + 8 * fq;
#pragma unroll
        for (int ai = 0; ai < 2; ++ai)
#pragma unroll
            for (int m = 0; m < 4; ++m) {
                bf16_t* rowp = O + (size_t)(row0 + ai * 128 + m * 16) * ldc + col0;
#pragma unroll
                for (int bj = 0; bj < 2; ++bj) {
                    const f32x4 v0 = acc[ai][bj][m][0], v1 = acc[ai][bj][m][1];
                    u32x4 w; w.x = pk2(v0.x, v0.y); w.y = pk2(v0.z, v0.w); w.z = pk2(v1.x, v1.y); w.w = pk2(v1.z, v1.w);
                    *(u32x4*)(rowp + bj * 128) = w;
                }
            }
    }
};
struct EpiRelu2 {
    static constexpr bool PERM = true, AFTER_DRAIN = false;
    bf16_t* O; int ldc;
    __device__ __forceinline__ void operator()(const f32x4 (&acc)[2][2][4][2], const pg8::Unit& u, int wr, int wc, int fr, int fq) const {
        const int row0 = u.pm * 256 + wr * 64 + fr, col0 = u.pn * 256 + wc * 32 + 8 * fq;
#pragma unroll
        for (int ai = 0; ai < 2; ++ai)
#pragma unroll
            for (int m = 0; m < 4; ++m) {
                bf16_t* rowp = O + (size_t)(row0 + ai * 128 + m * 16) * ldc + col0;
#pragma unroll
                for (int bj = 0; bj < 2; ++bj) {
                    f32x4 v0 = acc[ai][bj][m][0], v1 = acc[ai][bj][m][1];
#pragma unroll
                    for (int e = 0; e < 4; ++e) { const float a = fmaxf(v0[e], 0.f), b = fmaxf(v1[e], 0.f); v0[e] = a * a; v1[e] = b * b; }
                    u32x4 w; w.x = pk2(v0.x, v0.y); w.y = pk2(v0.z, v0.w); w.z = pk2(v1.x, v1.y); w.w = pk2(v1.z, v1.w);
                    *(u32x4*)(rowp + bj * 128) = w;
                }
            }
    }
};

struct CtxBranchOrder {
    int nMfull, pm0, nT, G, c;
    __device__ __forceinline__ bool next(int i, pg8::Unit& u) const {
        const long L = (long)i * G + c; if (L >= (long)nT * 4) return false;
        const int j = (int)(L & 3), t = (int)(L >> 2);
        u.pm = j * nMfull + pm0 + (t >> 2); u.pn = j * 4 + (t & 3); u.ko = 0; return true;
    }
    __device__ __forceinline__ void a_ready(const pg8::Unit&) const {}
    __device__ __forceinline__ void done(const pg8::Unit&) const {}
};
struct EpiBranchCtx {
    static constexpr bool PERM = true, AFTER_DRAIN = false;
    const bf16_t* Z; bf16_t* P; int nMfull, pm0;
    __device__ __forceinline__ void operator()(const f32x4 (&acc)[2][2][4][2], const pg8::Unit& u, int wr, int wc, int fr, int fq) const {
        const int j = u.pm / nMfull, pm = u.pm - j * nMfull, pn = u.pn & 3;
        const int row0 = pm * 256 + wr * 64 + fr, col0 = pn * 256 + wc * 32 + 8 * fq;
        const bf16_t* gbase = Z + (size_t)row0 * ZW + ZMERGE + j * 1024 + col0;
        bf16_t* pbase = P + (size_t)(row0 - pm0 * 256) * 4096 + j * 1024 + col0;
#pragma unroll
        for (int ai = 0; ai < 2; ++ai) {
            u32x4 gw[4][2];
#pragma unroll
            for (int m = 0; m < 4; ++m)
#pragma unroll
                for (int bj = 0; bj < 2; ++bj) gw[m][bj] = *(const u32x4*)(gbase + (size_t)(ai * 128 + m * 16) * ZW + bj * 128);
#pragma unroll
            for (int m = 0; m < 4; ++m)
#pragma unroll
                for (int bj = 0; bj < 2; ++bj) {
                    const u32x4 g = gw[m][bj];
                    const f32x4 v0 = acc[ai][bj][m][0], v1 = acc[ai][bj][m][1];
                    u32x4 w; w.x = pk2(v0.x * sigm(lo16(g.x)), v0.y * sigm(hi16(g.x))); w.y = pk2(v0.z * sigm(lo16(g.y)), v0.w * sigm(hi16(g.y)));
                    w.z = pk2(v1.x * sigm(lo16(g.z)), v1.y * sigm(hi16(g.z))); w.w = pk2(v1.z * sigm(lo16(g.w)), v1.w * sigm(hi16(g.w)));
                    *(u32x4*)(pbase + (size_t)(ai * 128 + m * 16) * 4096 + bj * 128) = w;
                }
        }
    }
};
struct SplitOrder {
    int pm0, nT, SPLIT, Kl, G, c;
    __device__ __forceinline__ bool next(int i, pg8::Unit& u) const {
        const long L = (long)i * G + c; if (L >= (long)nT * 4 * SPLIT) return false;
        const int ks = (int)(L % SPLIT), t = (int)(L / SPLIT);
        u.pm = pm0 + (t >> 2); u.pn = t & 3; u.ko = ks * Kl; return true;
    }
    __device__ __forceinline__ void a_ready(const pg8::Unit&) const {}
    __device__ __forceinline__ void done(const pg8::Unit&) const {}
};
struct EpiSlab {
    static constexpr bool PERM = true, AFTER_DRAIN = false;
    bf16_t* S; int pm0, nrows, Kl;
    __device__ __forceinline__ void operator()(const f32x4 (&acc)[2][2][4][2], const pg8::Unit& u, int wr, int wc, int fr, int fq) const {
        const int ks = u.ko / Kl;
        const int row0 = (u.pm - pm0) * 256 + wr * 64 + fr, col0 = u.pn * 256 + wc * 32 + 8 * fq;
        bf16_t* base = S + (size_t)ks * nrows * 1024;
#pragma unroll
        for (int ai = 0; ai < 2; ++ai)
#pragma unroll
            for (int m = 0; m < 4; ++m) { bf16_t* rowp = base + (size_t)(row0 + ai * 128 + m * 16) * 1024 + col0;
#pragma unroll
                for (int bj = 0; bj < 2; ++bj) {
                    const f32x4 v0 = acc[ai][bj][m][0], v1 = acc[ai][bj][m][1];
                    u32x4 w; w.x = pk2(v0.x, v0.y); w.y = pk2(v0.z, v0.w); w.z = pk2(v1.x, v1.y); w.w = pk2(v1.z, v1.w);
                    *(u32x4*)(rowp + bj * 128) = w;
                } }
    }
};

#define MFMA16(a, b, c) __builtin_amdgcn_mfma_f32_16x16x32_bf16((a), (b), (c), 0, 0, 0)
__device__ __forceinline__ void attn_wave(PPtr p, int l, int kind, int idx, int lane, const LAS float* biasL) {
    const int fr = lane & 15, fq = lane >> 4;
    const int LATR = p->GB * 2048, MG = p->MG;
    const bf16_t* Z = (const bf16_t*)(p->ws + p->o_z);
    const bool isA = (kind == 1 || kind == 2);
    int bl, hk, qrow0, r = 0, q0 = 0;
    if (kind == 0) { bl = idx >> 8; hk = (idx >> 5) & 7; r = idx & 31; qrow0 = bl * 2048 + r * 64; }
    else if (kind == 1) { bl = idx >> 8; hk = (idx >> 7) & 1; q0 = (idx & 127) * 16; qrow0 = bl * 2048 + q0; }
    else if (kind == 2) { bl = idx >> 5; hk = (idx >> 4) & 1; qrow0 = LATR + bl * 256 + (idx & 15) * 16; }
    else { bl = idx >> 5; hk = (idx >> 2) & 7; qrow0 = LATR + bl * 256 + (idx & 3) * 64; }
    const int qrstep = isA ? 0 : 16, qcstep = isA ? 64 : 0;
    const int qcol0 = isA ? (ZA_Q + hk * 4 * 64) : (ZB_Q + hk * 64);
    const int kcol = isA ? (ZA_K + hk * 64) : (ZB_K + hk * 64);
    const bf16_t* vt = isA ? ((const bf16_t*)(p->ws + p->o_vta) + (size_t)(bl * 2 + hk) * 64 * VTS) : ((const bf16_t*)(p->ws + p->o_vtb) + (size_t)(bl * 8 + hk) * 64 * VTS);
    bf16_t* yo = (bf16_t*)(p->ws + p->o_y4) + (isA ? (size_t)0 : (size_t)MG * 512);
    const int ocol0 = isA ? hk * 4 * 64 : hk * 64;
    const int krow_ctx0 = LATR + bl * 256, krow_lat0 = bl * 2048;

    bf16x8 Q[4][2];
#pragma unroll
    for (int s = 0; s < 4; ++s)
#pragma unroll
        for (int ks = 0; ks < 2; ++ks) Q[s][ks] = *(const bf16x8*)(Z + (size_t)(qrow0 + s * qrstep + fr) * ZW + qcol0 + s * qcstep + ks * 32 + fq * 8);
    f32x4 O[4][4]; float mrun[4], lrun[4];
#pragma unroll
    for (int s = 0; s < 4; ++s) { mrun[s] = -1e30f; lrun[s] = 0.f;
#pragma unroll
        for (int dt = 0; dt < 4; ++dt) O[s][dt] = (f32x4){0.f, 0.f, 0.f, 0.f}; }

    auto do_block = [&](int krow, int vtoff, int mode, int a0, int a1, bool first) {
        bf16x8 Kf[2][2];
#pragma unroll
        for (int kt = 0; kt < 2; ++kt)
#pragma unroll
            for (int ks = 0; ks < 2; ++ks) Kf[kt][ks] = *(const bf16x8*)(Z + (size_t)(krow + kt * 16 + fr) * ZW + kcol + ks * 32 + fq * 8);
        bf16x8 Vf[4];
#pragma unroll
        for (int dt = 0; dt < 4; ++dt) {
            const bf16_t* vp = vt + (size_t)(dt * 16 + fr) * VTS + vtoff + fq * 4;
            const u32x2 lo = *(const u32x2*)vp, hi = *(const u32x2*)(vp + 16);
            u32x4 w; w.x = lo.x; w.y = lo.y; w.z = hi.x; w.w = hi.y;
            Vf[dt] = __builtin_bit_cast(bf16x8, w);
        }
#pragma unroll
        for (int s = 0; s < 4; ++s) {
            const bool active = (mode != 2) || !((s == 0 && a1 == 1) || (s == 3 && a1 == 0));
            if (active) {
                f32x4 S0 = (f32x4){0.f, 0.f, 0.f, 0.f}, S1 = (f32x4){0.f, 0.f, 0.f, 0.f};
                S0 = MFMA16(Kf[0][0], Q[s][0], S0); S0 = MFMA16(Kf[0][1], Q[s][1], S0);
                S1 = MFMA16(Kf[1][0], Q[s][0], S1); S1 = MFMA16(Kf[1][1], Q[s][1], S1);
                float sc[8];
#pragma unroll
                for (int j = 0; j < 4; ++j) { sc[j] = S0[j]; sc[4 + j] = S1[j]; }
                if (mode == 1) {
                    if (a0 < q0 + 15 - 128 || a0 + 31 > q0 + 128) {
                        const int d0 = a0 + fq * 4 - (q0 + fr) + 128;
#pragma unroll
                        for (int e = 0; e < 8; ++e) { const unsigned d = (unsigned)(d0 + (e >> 2) * 16 + (e & 3)); if (d > 256u) sc[e] = -1e30f; }
                    }
                } else if (mode == 2) {
                    const int qc = 16 * s + fr; const int cs = min(max(qc - 8, 0), 48);
                    const int kc0 = a1 * 32 + fq * 4;
                    const LAS float* bp = biasL + hk * 465 + a0 * 31 + (kc0 - qc + 15);
                    const unsigned rel0 = (unsigned)(kc0 - cs);
#pragma unroll
                    for (int e = 0; e < 8; ++e) {
                        const int off = (e >> 2) * 16 + (e & 3);
                        const float bv = bp[off];
                        sc[e] = (rel0 + (unsigned)off < 16u) ? (sc[e] + bv) : -1e30f;
                    }
                }
                if (first) {
                    float ml = fmaxf(fmaxf(fmaxf(sc[0], sc[1]), fmaxf(sc[2], sc[3])), fmaxf(fmaxf(sc[4], sc[5]), fmaxf(sc[6], sc[7])));
                    mrun[s] = xrow16_max(ml);
                }
                const float mn = mrun[s];
                float pv[8], ls = 0.f;
#pragma unroll
                for (int e = 0; e < 8; ++e) { pv[e] = __builtin_amdgcn_exp2f(sc[e] - mn); ls += pv[e]; }
                ls = xrow16_sum(ls);
                lrun[s] += ls;
                u32x4 pw; pw.x = pk2(pv[0], pv[1]); pw.y = pk2(pv[2], pv[3]); pw.z = pk2(pv[4], pv[5]); pw.w = pk2(pv[6], pv[7]);
                const bf16x8 P = __builtin_bit_cast(bf16x8, pw);
#pragma unroll
                for (int dt = 0; dt < 4; ++dt) O[s][dt] = MFMA16(Vf[dt], P, O[s][dt]);
            }
            __builtin_amdgcn_sched_barrier(0);
        }
    };
    int nloc = 0, lo = 0, r0 = 0;
    if (kind == 1) { lo = max(0, q0 - 128) & ~31; const int hi = min(2048, (q0 + 16 + 128 + 31) & ~31); nloc = (hi - lo) >> 5; }
    else if (kind == 0) { r0 = min(max(r - 4, 0), 24); nloc = 16; }
#pragma unroll 1
    for (int i = 0; i < 8 + nloc; ++i) {
        int krow, vtoff, mode, a0, a1;
        if (i < 8) { krow = krow_ctx0 + 32 * i; vtoff = 2048 + 32 * i; mode = 0; a0 = 0; a1 = 0; }
        else if (kind == 1) { const int kb = lo + 32 * (i - 8); krow = krow_lat0 + kb; vtoff = kb; mode = 1; a0 = kb; a1 = 0; }
        else { const int jj = i - 8, kr = r0 + (jj >> 1), hb = jj & 1; krow = krow_lat0 + kr * 64 + hb * 32; vtoff = kr * 64 + hb * 32; mode = 2; a0 = kr - r + 7; a1 = hb; }
        do_block(krow, vtoff, mode, a0, a1, i == 0);
    }
#pragma unroll
    for (int s = 0; s < 4; ++s) {
        float fac;
        if (isA) { const float sk = p->a_sink[l * 8 + hk * 4 + s] * LOG2E; const float M = fmaxf(mrun[s], sk); const float e1 = __builtin_amdgcn_exp2f(mrun[s] - M); fac = e1 / (lrun[s] * e1 + __builtin_amdgcn_exp2f(sk - M)); }
        else fac = 1.0f / lrun[s];
        bf16_t* op = yo + (size_t)(qrow0 + s * qrstep + fr) * 512 + ocol0 + s * qcstep + fq * 4;
#pragma unroll
        for (int dt = 0; dt < 4; ++dt) { const f32x4 o = O[s][dt] * fac; u32x2 w; w.x = pk2(o.x, o.y); w.y = pk2(o.z, o.w); *(u32x2*)(op + dt * 16) = w; }
    }
}

constexpr int SCAN_BUF = 41472;
constexpr int BIAS_OFF = 3 * SCAN_BUF;
template <int DK, bool ISC>
__device__ __forceinline__ void scan_task(PPtr p, int l, int bl, int h, int dir, LAS unsigned char* lds) {
    constexpr int KPW = DK / 8, NTG = 64 / KPW, TPG = 32 / NTG, QS = (DK + 8) * 2, NKT = DK / 16;
    const int tid = ltid(), w = tid >> 6, lane = tid & 63, fr = lane & 15, fq = lane >> 4;
    const int kl = lane % KPW, tg = lane / KPW, kch = w * KPW + kl;
    const int vcol = tid & 127, vg = tid >> 7;
    LAS unsigned char* qt = lds; LAS unsigned char* kt_ = qt + 32 * QS; LAS unsigned char* khT = kt_ + 32 * QS; LAS unsigned char* vT = khT + DK * 80;
    LAS unsigned char* att = vT + 128 * 80; LAS float* dvec = (LAS float*)(att + 32 * 80); LAS float* evec = dvec + DK;
    const bf16_t* Z = (const bf16_t*)(p->ws + p->o_z);
    const int LATR = p->GB * 2048, MG = p->MG;
    const int qc = ISC ? (ZC_Q + h * 128 + kch) : (ZD_Q + h * 64 + kch);
    const int kc = ISC ? ((dir ? ZC_FB : ZC_FF) + h * 128 + kch) : (ZD_K + h * 64 + kch);
    const int vc = (ISC ? ZC_I : ZD_V) + h * 128 + vcol;
    const int gcol = ZD_GK + dir * 16;
    float lbv = 0.f, oml = 1.f, up[16], gb = 0.f;
#pragma unroll
    for (int r = 0; r < 16; ++r) up[r] = 0.f;
    if (ISC) { lbv = ((const float*)(p->ws + p->o_lb))[l * 512 + h * 128 + kch]; oml = 1.0f - lbv; }
    else {
#pragma unroll
        for (int r = 0; r < 16; ++r) up[r] = p->d_gate_up[((size_t)(l * 2 + dir) * 16 + r) * 256 + h * 64 + kch];
        gb = p->d_gate_bias[(l * 2 + dir) * 256 + h * 64 + kch];
    }
    bf16_t* odst = (dir == 0) ? ((bf16_t*)(p->ws + p->o_y4) + (size_t)(ISC ? 2 : 3) * MG * 512) : ((bf16_t*)(p->ws + p->o_ob) + (size_t)(ISC ? 0 : 1) * MG * 512);
    f32x4 S[NKT];
#pragma unroll
    for (int i = 0; i < NKT; ++i) S[i] = (f32x4){0.f, 0.f, 0.f, 0.f};
    const int sgn = dir ? -1 : 1;
    const long zstep = (long)sgn * ZW, ostep = (long)sgn * 512;
    auto row0of = [&](int cc) -> int {
        const bool isctx = cc < 8; const int L = isctx ? 256 : 2048, base = isctx ? (LATR + bl * 256) : (bl * 2048), c = isctx ? cc : cc - 8;
        return base + (dir ? (L - 1 - c * 32) : c * 32);
    };
    bf16_t rq[TPG], rk[TPG], rv[8]; u32x4 rz[TPG][2];
    auto load_raw = [&](int cc) {
        const int r0 = row0of(cc);
        const bf16_t* zq = Z + (size_t)(r0 + tg * TPG * sgn) * ZW;
#pragma unroll
        for (int e = 0; e < TPG; ++e) {
            const bf16_t* zr = zq + e * zstep;
            rq[e] = zr[qc]; rk[e] = zr[kc];
            if (!ISC) { rz[e][0] = *(const u32x4*)(zr + gcol); rz[e][1] = *(const u32x4*)(zr + gcol + 8); }
        }
        const bf16_t* zv = Z + (size_t)(r0 + vg * 8 * sgn) * ZW + vc;
#pragma unroll
        for (int e = 0; e < 8; ++e) rv[e] = zv[e * zstep];
    };
    load_raw(0);
    for (int cc = 0; cc < 72; ++cc) {
        __syncthreads();
        {
            float gq[TPG], gk[TPG], cum[TPG]; float run = 0.f;
#pragma unroll
            for (int e = 0; e < TPG; ++e) {
                const float zq = bf2f(rq[e]), zk = bf2f(rk[e]); float g, key, q;
                if (ISC) { const float sg = zk; g = flog(lbv + oml * sg); key = oml * (1.0f - sg); q = zq; }
                else {
                    float a = gb;
                    const u32x4 z0 = rz[e][0], z1 = rz[e][1];
                    a += lo16(z0.x) * up[0] + hi16(z0.x) * up[1] + lo16(z0.y) * up[2] + hi16(z0.y) * up[3] + lo16(z0.z) * up[4] + hi16(z0.z) * up[5] + lo16(z0.w) * up[6] + hi16(z0.w) * up[7];
                    a += lo16(z1.x) * up[8] + hi16(z1.x) * up[9] + lo16(z1.y) * up[10] + hi16(z1.y) * up[11] + lo16(z1.z) * up[12] + hi16(z1.z) * up[13] + lo16(z1.w) * up[14] + hi16(z1.w) * up[15];
                    g = (fminf(a, 0.f) - flog(1.0f + fexp(-fabsf(a)))) * (1.0f / 16.0f); key = zk; q = zq;
                }
                run += g; cum[e] = run; gq[e] = q; gk[e] = key;
            }
            float pre = 0.f, total = 0.f, cref = 0.f;
#pragma unroll
            for (int t = 0; t < NTG; ++t) { const float tt = __shfl(run, kl + KPW * t); if (t < tg) pre += tt; if (t < NTG / 2) cref += tt; total += tt; }
            float khv[TPG]; const float etc = fexp(total - cref);
#pragma unroll
            for (int e = 0; e < TPG; ++e) {
                const float c = cum[e] + pre; const int i = tg * TPG + e;
                const float E = fexp(c - cref), kE = gk[e] * __builtin_amdgcn_rcpf(E);
                *(LAS bf16_t*)(qt + i * QS + kch * 2) = f2bf1(gq[e] * E);
                *(LAS bf16_t*)(kt_ + i * QS + kch * 2) = f2bf1(kE);
                khv[e] = kE * etc;
            }
            if constexpr (TPG == 8) { u32x4 o; o.x = pk2(khv[0], khv[1]); o.y = pk2(khv[2], khv[3]); o.z = pk2(khv[4], khv[5]); o.w = pk2(khv[6], khv[7]); *(LAS u32x4*)(khT + kch * 80 + tg * 16) = o; }
            else { u32x2 o; o.x = pk2(khv[0], khv[1]); o.y = pk2(khv[2], khv[3]); *(LAS u32x2*)(khT + kch * 80 + tg * 8) = o; }
            if (tg == 0) { dvec[kch] = fexp(total); evec[kch] = fexp(cref); }
            u32x4 vo; vo.x = (unsigned)rv[0] | ((unsigned)rv[1] << 16); vo.y = (unsigned)rv[2] | ((unsigned)rv[3] << 16); vo.z = (unsigned)rv[4] | ((unsigned)rv[5] << 16); vo.w = (unsigned)rv[6] | ((unsigned)rv[7] << 16);
            *(LAS u32x4*)(vT + vcol * 80 + vg * 16) = vo;
        }
        if (cc + 1 < 72) load_raw(cc + 1);
        __syncthreads();
        if (w < 3) {
            const int tt = (w == 0) ? 0 : 1, st = (w == 2) ? 1 : 0;
            f32x4 a = (f32x4){0.f, 0.f, 0.f, 0.f};
#pragma unroll
            for (int ks = 0; ks < DK / 32; ++ks) {
                const bf16x8 A = *(const LAS bf16x8*)(qt + (tt * 16 + fr) * QS + (ks * 32 + fq * 8) * 2);
                const bf16x8 B = *(const LAS bf16x8*)(kt_ + (st * 16 + fr) * QS + (ks * 32 + fq * 8) * 2);
                a = MFMA16(A, B, a);
            }
#pragma unroll
            for (int j = 0; j < 4; ++j) { const int t = tt * 16 + fq * 4 + j, s = st * 16 + fr; *(LAS bf16_t*)(att + t * 80 + s * 2) = f2bf1(s <= t ? a[j] : 0.f); }
        } else if (w == 3) {
#pragma unroll
            for (int j = 0; j < 4; ++j) { const int t = fq * 4 + j, s = 16 + fr; *(LAS bf16_t*)(att + t * 80 + s * 2) = (bf16_t)0; }
        }
        __syncthreads();
        {
            const int vs = w * 16;
            bf16_t* ob0 = odst + (size_t)(row0of(cc) + fq * 4 * sgn) * 512 + h * 128 + vs + fr;
            const bf16x8 Bv = *(const LAS bf16x8*)(vT + (vs + fr) * 80 + fq * 16);
            f32x4 ev[NKT]; u32x4 qa[2][NKT / 2]; bf16x8 A2[2], A3[NKT]; f32x4 dv[NKT];
#pragma unroll
            for (int k2 = 0; k2 < NKT; ++k2) ev[k2] = *(const LAS f32x4*)(evec + k2 * 16 + fq * 4);
#pragma unroll
            for (int tt = 0; tt < 2; ++tt) {
#pragma unroll
                for (int kp = 0; kp < NKT / 2; ++kp) {
                    const u32x2 lo = *(const LAS u32x2*)(qt + (tt * 16 + fr) * QS + ((2 * kp) * 16 + fq * 4) * 2);
                    const u32x2 hi = *(const LAS u32x2*)(qt + (tt * 16 + fr) * QS + ((2 * kp + 1) * 16 + fq * 4) * 2);
                    qa[tt][kp].x = lo.x; qa[tt][kp].y = lo.y; qa[tt][kp].z = hi.x; qa[tt][kp].w = hi.y;
                }
                A2[tt] = *(const LAS bf16x8*)(att + (tt * 16 + fr) * 80 + fq * 16);
            }
#pragma unroll
            for (int k2 = 0; k2 < NKT; ++k2) { dv[k2] = *(const LAS f32x4*)(dvec + k2 * 16 + fq * 4); A3[k2] = *(const LAS bf16x8*)(khT + (k2 * 16 + fr) * 80 + fq * 16); }
            __builtin_amdgcn_sched_barrier(0);
            bf16x8 Sb[NKT / 2];
#pragma unroll
            for (int kp = 0; kp < NKT / 2; ++kp) {
                const f32x4 s0 = S[2 * kp] * ev[2 * kp], s1 = S[2 * kp + 1] * ev[2 * kp + 1];
                u32x4 sw; sw.x = pk2(s0.x, s0.y); sw.y = pk2(s0.z, s0.w); sw.z = pk2(s1.x, s1.y); sw.w = pk2(s1.z, s1.w);
                Sb[kp] = __builtin_bit_cast(bf16x8, sw);
            }
#pragma unroll
            for (int tt = 0; tt < 2; ++tt) {
                f32x4 o = (f32x4){0.f, 0.f, 0.f, 0.f};
#pragma unroll
                for (int kp = 0; kp < NKT / 2; ++kp) o = MFMA16(__builtin_bit_cast(bf16x8, qa[tt][kp]), Sb[kp], o);
                o = MFMA16(A2[tt], Bv, o);
#pragma unroll
                for (int j = 0; j < 4; ++j) ob0[(tt * 16 + j) * ostep] = f2bf1(o[j]);
            }
            __builtin_amdgcn_sched_barrier(0);
#pragma unroll
            for (int k2 = 0; k2 < NKT; ++k2) { S[k2] = S[k2] * dv[k2]; S[k2] = MFMA16(A3[k2], Bv, S[k2]); }
        }
    }
    __syncthreads();
}

__device__ __forceinline__ void mixer(PPtr p, int l, int g, LAS unsigned char* lds, unsigned long long* tscan = nullptr) {
    const int tid = ltid(), w = tid >> 6, lane = tid & 63;
    LAS float* biasL = (LAS float*)(lds + BIAS_OFF);
    for (int i = tid; i < 8 * 465; i += 512) biasL[i] = p->b_rel_bias[(size_t)l * 8 * 465 + i] * LOG2E;
    __syncthreads();
    const int GB = p->GB, NSC = GB * 8, NS = GB * 16;
    const unsigned long long ts0 = tscan ? __builtin_amdgcn_s_memrealtime() : 0ull;
    for (int st = blockIdx.x; st < NS; st += gridDim.x) {
        if (st < NSC) { scan_task<128, true>(p, l, st >> 3, (st >> 1) & 3, st & 1, lds); }
        else { const int s2 = st - NSC; scan_task<64, false>(p, l, s2 >> 3, (s2 >> 1) & 3, s2 & 1, lds); }
    }
    if (tscan) *tscan += __builtin_amdgcn_s_memrealtime() - ts0;
    unsigned* ctr = (unsigned*)p->ws + (l * 16 + g);
    const int NB0 = GB * 32, NB1 = GB * 32, NB2 = (l < DEPTH - 1) ? GB * 4 : 0, NB3 = NB2, NBT = NB0 + NB1 + NB2 + NB3;
    LAS int* tw = (LAS int*)(lds + CTRL_OFF);
    for (;;) {
        if (tid == 0) *tw = (int)atomicAdd(ctr, 1u);
        __syncthreads();
        const int bt = *tw;
        __syncthreads();
        if (bt >= NBT) break;
        int kind, idx;
        if (bt < NB0) { kind = 0; idx = bt * 8 + w; }
        else if (bt < NB0 + NB1) { kind = 1; idx = (bt - NB0) * 8 + w; }
        else if (bt < NB0 + NB1 + NB2) { kind = 2; idx = (bt - NB0 - NB1) * 8 + w; }
        else { kind = 3; idx = (bt - NB0 - NB1 - NB2) * 8 + w; }
        attn_wave(p, l, kind, idx, lane, biasL);
    }
}

__device__ __forceinline__ void postpass(PPtr p, int l, int nrows) {
    const int lane = ltid() & 63, gw = blockIdx.x * 8 + (ltid() >> 6), NGW = gridDim.x * 8, MG = p->MG;
    const bf16_t* Z = (const bf16_t*)(p->ws + p->o_z);
    for (int it = gw; it < nrows * 2; it += NGW) {
        const int row = it >> 1, br = it & 1;
        bf16_t* yf = (bf16_t*)(p->ws + p->o_y4) + (size_t)(2 + br) * MG * 512 + (size_t)row * 512 + lane * 8;
        const bf16_t* yb = (const bf16_t*)(p->ws + p->o_ob) + (size_t)br * MG * 512 + (size_t)row * 512 + lane * 8;
        const u32x4 a = *(const u32x4*)yf, b = *(const u32x4*)yb;
        const u32x4 gt = *(const u32x4*)(Z + (size_t)row * ZW + (br ? ZD_G : ZC_G) + lane * 8);
        const float* gain = (br ? p->d_norm : p->c_norm) + l * 128 + (lane & 15) * 8;
        float o[8], gv[8];
        o[0] = lo16(a.x) + lo16(b.x); o[1] = hi16(a.x) + hi16(b.x); o[2] = lo16(a.y) + lo16(b.y); o[3] = hi16(a.y) + hi16(b.y);
        o[4] = lo16(a.z) + lo16(b.z); o[5] = hi16(a.z) + hi16(b.z); o[6] = lo16(a.w) + lo16(b.w); o[7] = hi16(a.w) + hi16(b.w);
        gv[0] = lo16(gt.x); gv[1] = hi16(gt.x); gv[2] = lo16(gt.y); gv[3] = hi16(gt.y); gv[4] = lo16(gt.z); gv[5] = hi16(gt.z); gv[6] = lo16(gt.w); gv[7] = hi16(gt.w);
        float ss = 0.f;
#pragma unroll
        for (int e = 0; e < 8; ++e) ss += o[e] * o[e];
        ss = row16_sum(ss);
        const float rs = rsqrtf(ss * (1.0f / 128.0f) + EPS);
        const f32x4 g0 = *(const f32x4*)gain, g1 = *(const f32x4*)(gain + 4);
        float y[8];
#pragma unroll
        for (int e = 0; e < 8; ++e) { const float gn = (e < 4) ? g0[e & 3] : g1[e & 3]; y[e] = o[e] * rs * gn * (gv[e] * sigm(gv[e])); }
        u32x4 wv; wv.x = pk2(y[0], y[1]); wv.y = pk2(y[2], y[3]); wv.z = pk2(y[4], y[5]); wv.w = pk2(y[6], y[7]);
        *(u32x4*)yf = wv;
    }
}

#define NOINL __device__ __forceinline__
NOINL void ph_prologue(PPtr pc, LAS unsigned char* lds) { PPtr p = pc; asm volatile("" : "+s"(p)); prologue(p, lds); }
NOINL void ph_rowpass(PPtr pc, int l, int g, int mode, int nrows, int conv_l, LAS unsigned char* lds) { PPtr p = pc; asm volatile("" : "+s"(p)); rowpass(p, l, g, mode, nrows); if (conv_l >= 0) convert_weights(p, conv_l, lds); }
NOINL void ph_rowpass_tail(PPtr pc, int l, int g, int nrows, int conv_l, int nl, int ng, int nrows_next, LAS unsigned char* lds) {
    PPtr p = pc; asm volatile("" : "+s"(p));
    rowpass(p, l, g, 3, nrows);
    if (nl >= 0) rowpass(p, nl, ng, 1, nrows_next);
    if (conv_l >= 0) convert_weights(p, conv_l, lds);
}
NOINL void ph_inproj(PPtr pc, LAS unsigned char* lds) {
    PPtr p = pc; asm volatile("" : "+s"(p)); const int G = (int)gridDim.x, c = (int)blockIdx.x;
    pg8::Gemm gm{(const bf16_t*)(p->ws + p->o_h), (const bf16_t*)(p->ws + p->o_win), p->MG, ZW, 1024, 1024}; pg8::StaticOrder S; S.init(p->MG, ZW, G, c);
    EpiInproj E{(bf16_t*)(p->ws + p->o_z), (bf16_t*)(p->ws + p->o_vta), (bf16_t*)(p->ws + p->o_vtb), (const float*)(p->ws + p->o_rope), p->GB};
    pg8::gemm_phase<EpiInproj, pg8::StaticOrder>(lds, gm, S, E, nullptr);
}
NOINL void ph_mixer(PPtr pc, int l, int g, LAS unsigned char* lds, unsigned long long* tscan = nullptr) { PPtr p = pc; asm volatile("" : "+s"(p)); mixer(p, l, g, lds, tscan); }
NOINL void ph_post(PPtr pc, int l, int nrows) { PPtr p = pc; asm volatile("" : "+s"(p)); postpass(p, l, nrows); }
NOINL void ph_branch(PPtr pc, int Mr, LAS unsigned char* lds) {
    PPtr p = pc; asm volatile("" : "+s"(p)); const int G = (int)gridDim.x, c = (int)blockIdx.x;
    const int LATR = p->GB * 2048, nMfull = p->MG / 256;
    pg8::Gemm gm{(const bf16_t*)(p->ws + p->o_y4), (const bf16_t*)(p->ws + p->o_wb), Mr, 1024, 512, 512};
    { BranchOrder S{LATR / 256, nMfull, G, c};
      EpiBranch E{(const bf16_t*)(p->ws + p->o_z), (bf16_t*)(p->ws + p->o_h), nMfull};
      pg8::gemm_phase<EpiBranch, BranchOrder>(lds, gm, S, E, nullptr); }
    if (Mr > LATR) {
        CtxBranchOrder S{nMfull, LATR / 256, (Mr - LATR) / 256 * 4, G, c};
        EpiBranchCtx E{(const bf16_t*)(p->ws + p->o_z), (bf16_t*)(p->ws + p->o_ob), nMfull, LATR / 256};
        pg8::gemm_phase<EpiBranchCtx, CtxBranchOrder>(lds, gm, S, E, nullptr);
    }
}
NOINL void ph_gemm_f32(PPtr pc, int which, int Mr, LAS unsigned char* lds) {
    PPtr p = pc; asm volatile("" : "+s"(p)); const int G = (int)gridDim.x, c = (int)blockIdx.x;
    const int LATR = p->GB * 2048;
    const bf16_t* hid = (const bf16_t*)(p->ws + p->o_z + (size_t)p->MG * 1024 * 4);
    { const bf16_t* A = which ? hid : (const bf16_t*)(p->ws + p->o_h);
      const bf16_t* Bt = which ? (const bf16_t*)(p->ws + p->o_w2) : (const bf16_t*)(p->ws + p->o_wo);
      const int K = which ? 4096 : 1024;
      pg8::Gemm gm{A, Bt, LATR, 1024, K, K}; pg8::StaticOrder S; S.init(LATR, 1024, G, c);
      EpiBf16Y E{(bf16_t*)(p->ws + p->o_z), 1024};
      pg8::gemm_phase<EpiBf16Y, pg8::StaticOrder>(lds, gm, S, E, nullptr); }
    if (Mr > LATR) {
        const bf16_t* A = which ? hid : ((const bf16_t*)(p->ws + p->o_ob) - (size_t)LATR * 4096);
        const bf16_t* Bt = which ? (const bf16_t*)(p->ws + p->o_w2) : (const bf16_t*)(p->ws + p->o_wo4);
        pg8::Gemm gm{A, Bt, Mr, 1024, 4096, 512};
        SplitOrder S{LATR / 256, (Mr - LATR) / 256, 8, 512, G, c};
        EpiSlab E{(bf16_t*)(p->ws + p->o_z + (size_t)p->MG * 12288), LATR / 256, Mr - LATR, 512};
        pg8::gemm_phase<EpiSlab, SplitOrder>(lds, gm, S, E, nullptr);
    }
}
NOINL void ph_ffn1(PPtr pc, int Mr, LAS unsigned char* lds) {
    PPtr p = pc; asm volatile("" : "+s"(p)); const int G = (int)gridDim.x, c = (int)blockIdx.x;
    pg8::Gemm gm{(const bf16_t*)(p->ws + p->o_h), (const bf16_t*)(p->ws + p->o_w1), Mr, 4096, 1024, 1024}; pg8::StaticOrder S; S.init(Mr, 4096, G, c);
    EpiRelu2 E{(bf16_t*)(p->ws + p->o_z + (size_t)p->MG * 1024 * 4), 4096};
    pg8::gemm_phase<EpiRelu2, pg8::StaticOrder>(lds, gm, S, E, nullptr);
}

#define XB_SETUP() volatile LAS unsigned* xb_st = (volatile LAS unsigned*)(lds + CTRL_OFF + 64); unsigned* xb_bar = (unsigned*)(pc->ws + 4096); { XcdBarrier xb0 = xcd_barrier_post(xb_bar, xb_st); (void)xb0; }
#define GSYNC() { XcdBarrier xb_; xb_.bar = (unsigned*)(pc->ws + 4096); xb_.x = xb_xcc_id(); xb_.st = (volatile LAS unsigned*)(lds + CTRL_OFF + 64); xcd_barrier(xb_); }
#ifdef PROBE_MASK
__global__ void __launch_bounds__(512) hybrid_fwd(Params pk) {
    extern __shared__ __attribute__((aligned(16))) unsigned char smem[];
    LAS unsigned char* lds = (LAS unsigned char*)smem;
    cg::grid_group grid = cg::this_grid();
    PPtr pc = (PPtr)__builtin_amdgcn_kernarg_segment_ptr();
    const int GB = pc->GB, MG = pc->MG, NGRP = pc->NGRP, LATR = GB * 2048;
    unsigned long long tacc = 0, t0_ = __builtin_amdgcn_s_memrealtime();
#define PT(kind) { const unsigned long long t1_ = __builtin_amdgcn_s_memrealtime(); if ((PROBE_MASK >> (kind)) & 1) tacc += t1_ - t0_; t0_ = t1_; }
    ph_prologue(pc, lds);
    grid.sync();
    XB_SETUP(); PT(0)
    for (int l = 0; l < DEPTH; ++l) {
        const int Mr = (l < DEPTH - 1) ? MG : LATR;
        for (int g = 0; g < NGRP; ++g) {
            ph_rowpass(pc, l, g, 1, MG, -1, lds);
            GSYNC(); PT(1)
            ph_inproj(pc, lds);
            GSYNC(); PT(2)
            { unsigned long long tsc = 0; ph_mixer(pc, l, g, lds, &tsc); if ((PROBE_MASK >> 11) & 1) tacc += tsc; }
            GSYNC(); PT(3)
            ph_post(pc, l, Mr);
            GSYNC(); PT(4)
            ph_branch(pc, Mr, lds);
            GSYNC(); PT(5)
            ph_gemm_f32(pc, 0, Mr, lds);
            GSYNC(); PT(6)
            ph_rowpass(pc, l, g, 2, Mr, -1, lds);
            GSYNC(); PT(7)
            ph_ffn1(pc, Mr, lds);
            GSYNC(); PT(8)
            ph_gemm_f32(pc, 1, Mr, lds);
            GSYNC(); PT(9)
            ph_rowpass(pc, l, g, 3, Mr, (g == NGRP - 1 && l + 1 < DEPTH) ? l + 1 : -1, lds);
            GSYNC(); PT(10)
        }
    }
    if (blockIdx.x == 0) { const unsigned M = (unsigned)(tacc / 100ull); float* o = pc->out; for (unsigned i2 = threadIdx.x; i2 < M; i2 += 512) o[i2] += 0.125f; }
}

#else
__global__ void __launch_bounds__(512) hybrid_fwd(Params pk) {
    extern __shared__ __attribute__((aligned(16))) unsigned char smem[];
    LAS unsigned char* lds = (LAS unsigned char*)smem;
    cg::grid_group grid = cg::this_grid();
    PPtr pc = (PPtr)__builtin_amdgcn_kernarg_segment_ptr();
    const int GB = pc->GB, MG = pc->MG, NGRP = pc->NGRP, LATR = GB * 2048;
    ph_prologue(pc, lds);
    grid.sync();
    XB_SETUP();
    for (int l = 0; l < DEPTH; ++l) {
        const int Mr = (l < DEPTH - 1) ? MG : LATR;
        for (int g = 0; g < NGRP; ++g) {
            if ((l == 0 && g == 0) || NGRP == 1) { ph_rowpass(pc, l, g, 1, MG, -1, lds); GSYNC(); }
            ph_inproj(pc, lds);
            GSYNC();
            ph_mixer(pc, l, g, lds);
            GSYNC();
            ph_post(pc, l, Mr);
            GSYNC();
            ph_branch(pc, Mr, lds);
            GSYNC();
            ph_gemm_f32(pc, 0, Mr, lds);
            GSYNC();
            ph_rowpass(pc, l, g, 2, Mr, -1, lds);
            GSYNC();
            ph_ffn1(pc, Mr, lds);
            GSYNC();
            ph_gemm_f32(pc, 1, Mr, lds);
            GSYNC();
            {
                const bool lastg = (g == NGRP - 1);
                const int nl = (NGRP == 1) ? -1 : (lastg ? (l + 1 < DEPTH ? l + 1 : -1) : l), ng = lastg ? 0 : g + 1;
                ph_rowpass_tail(pc, l, g, Mr, (lastg && l + 1 < DEPTH) ? l + 1 : -1, nl, ng, MG, lds);
            }
            if (!(l == DEPTH - 1 && g == NGRP - 1)) GSYNC();
        }
    }
}

#endif
extern "C" void kernel_launch(void* const* d_in, const int* in_sizes, int n_in, void* d_out, int out_size, void* d_ws, size_t ws_size, hipStream_t stream) {
    static int grid_blocks = 0;
    if (grid_blocks == 0) {
        int dev = 0, cus = 0, per_cu = 0;
        hipGetDevice(&dev);
        hipDeviceGetAttribute(&cus, hipDeviceAttributeMultiprocessorCount, dev);
        if (hipFuncSetAttribute((const void*)hybrid_fwd, hipFuncAttributeMaxDynamicSharedMemorySize, LDS_BYTES) != hipSuccess) fprintf(stderr, "hipFuncSetAttribute failed\n");
        if (hipOccupancyMaxActiveBlocksPerMultiprocessor(&per_cu, (const void*)hybrid_fwd, 512, LDS_BYTES) != hipSuccess || per_cu < 1) { fprintf(stderr, "occupancy query: %d\n", per_cu); per_cu = 1; }
        (void)hipGetLastError();
        grid_blocks = cus * 1;
        if (grid_blocks <= 0) grid_blocks = 256;
    }
    Params p{};
    const float* const* in = (const float* const*)d_in;
    p.x = in[0]; p.c = in[1]; p.ctx = in[2]; p.c_ctx = in[3]; p.w_mod = in[4]; p.b_mod = in[5]; p.norm_gains = in[6]; p.w_in = in[7]; p.a_sink = in[8]; p.b_rel_bias = in[9];
    p.c_lb = in[10]; p.c_norm = in[11]; p.d_gate_up = in[12]; p.d_gate_bias = in[13]; p.d_norm = in[14]; p.w_branch = in[15]; p.w_out = in[16]; p.w_ff1 = in[17]; p.w_ff2 = in[18];
    p.out = (float*)d_out; p.ws = (unsigned char*)d_ws;
    auto al = [](unsigned long long v) { return (v + 255ull) & ~255ull; };
    unsigned long long off = 32768;
    p.o_mod = off; off = al(off + 4ull * 17 * 6144 * 4);
    p.o_lb = off; off = al(off + 4ull * 512 * 4);
    p.o_rope = off; off = al(off + 2048ull * 4);
    p.o_xc = off; off = al(off + 4096ull * 1024 * 4);
    p.o_win = off; off = al(off + (unsigned long long)ZW * 1024 * 2);
    p.o_wb = off; off = al(off + 4096ull * 512 * 2);
    p.o_wo = off; off = al(off + 1024ull * 1024 * 2);
    p.o_w1 = off; off = al(off + 4096ull * 1024 * 2);
    p.o_w2 = off; off = al(off + 1024ull * 4096 * 2);
    p.o_wo4 = off; off = al(off + 1024ull * 4096 * 2);
    const unsigned long long fixed = off;
    int GB = 8;
    for (; GB > 1; GB >>= 1) {
        const unsigned long long MGt = (unsigned long long)GB * 2304;
        const unsigned long long need = fixed + MGt * (2048ull + (unsigned long long)ZW * 2 + 4096ull + 2048ull) + (unsigned long long)GB * 10 * 64 * VTS * 2 + 8 * 256;
        if (need <= (unsigned long long)ws_size) break;
    }
    p.GB = GB; p.NGRP = 16 / GB; p.MG = GB * 2304;
    const unsigned long long MGu = (unsigned long long)p.MG;
    p.o_h = off; off = al(off + MGu * 1024 * 2);
    p.o_z = off; off = al(off + MGu * ZW * 2);
    p.o_y4 = off; off = al(off + MGu * 2048 * 2);
    p.o_ob = off; off = al(off + MGu * 1024 * 2);
    p.o_vta = off; off = al(off + (unsigned long long)GB * 2 * 64 * VTS * 2);
    p.o_vtb = off; off = al(off + (unsigned long long)GB * 8 * 64 * VTS * 2);
    hipMemsetAsync(d_ws, 0, 32768, stream);
    void* args[] = {&p};
    hipError_t e = hipLaunchCooperativeKernel((const void*)hybrid_fwd, dim3(grid_blocks), dim3(512), args, LDS_BYTES, stream);
    if (e != hipSuccess) fprintf(stderr, "cooperative launch failed: %s (grid %d)\n", hipGetErrorString(e), grid_blocks);
}
```

```cpp
#include <hip/hip_runtime.h>
#include <hip/hip_cooperative_groups.h>
#include <cstdio>
namespace cg = cooperative_groups;
__device__ __forceinline__ int ltid() { int t = (int)threadIdx.x; asm volatile("" : "+v"(t)); return t; }
#define LAS __attribute__((address_space(3)))
namespace pg8 {
#define PG8_LAS __attribute__((address_space(3)))
typedef unsigned short bf16_t;
typedef short bf16x8 __attribute__((ext_vector_type(8)));
typedef float f32x4 __attribute__((ext_vector_type(4)));
typedef unsigned u32x4 __attribute__((ext_vector_type(4)));
constexpr int BM = 256, BK = 64, HALF = 128, HTB = HALF * BK * 2  , STAGE_BYTES = 8 * HTB, NXCD = 8, WGM = 8;

__host__ __device__ __forceinline__ int lds_byte(int r, int c) { const int st = (r >> 4) * 2 + (c >> 5), rr = r & 15, cc = c & 31, ob = rr * 64 + cc * 2; return st * 1024 + (ob ^ (((ob >> 9) & 1) << 5)); }
__host__ __device__ __forceinline__ void stage_rc(int b, int& R, int& C) { const int st = b / 1024, sb = b % 1024, swz = sb ^ (((sb >> 9) & 1) << 5); R = (st >> 1) * 16 + swz / 64; C = (st & 1) * 32 + (swz % 64) / 2; }
__host__ __device__ __forceinline__ int perm32(int rho) { const int n = rho >> 4, i = rho & 15; return 8 * (i >> 2) + 4 * n + (i & 3); }

struct Unit { int pm, pn, ko; };
struct Gemm { const bf16_t* A; const bf16_t* Bt; int M, N, K, Kl; };

struct StaticOrder {
    int nM, nN, nwg, G, c;
    __host__ __device__ void init(int M, int N, int G_, int c_) { nM = M / BM; nN = N / BM; nwg = nM * nN; G = G_; c = c_; }
    __host__ __device__ bool next(int i, Unit& u) const {
        const long L = (long)i * G + c; if (L >= nwg) return false;
        int wgid = (int)L; { const int q = nwg / NXCD, r = nwg % NXCD, xcd = wgid % NXCD, off = wgid / NXCD; wgid = (xcd < r ? xcd * (q + 1) : r * (q + 1) + (xcd - r) * q) + off; }
        const int nig = WGM * nN, gid = wgid / nig, fm = gid * WGM, gsz = (nM - fm) < WGM ? (nM - fm) : WGM;
        u.pm = fm + ((wgid % nig) % gsz); u.pn = (wgid % nig) / gsz; u.ko = 0; return true;
    }
    __device__ __forceinline__ void a_ready(const Unit&) const {}
    __device__ __forceinline__ void done(const Unit&) const {}
};
__device__ __forceinline__ unsigned cvt_pk_bf16(float lo, float hi) { unsigned r; asm volatile("v_cvt_pk_bf16_f32 %0, %1, %2" : "=v"(r) : "v"(lo), "v"(hi)); return r; }
struct EpiF32 {
    static constexpr bool PERM = false, AFTER_DRAIN = false;
    float* C; int ldc; const float* bias;
    __device__ __forceinline__ void operator()(const f32x4 (&acc)[2][2][4][2], const Unit& u, int wr, int wc, int fr, int fq) const {
        const int row0 = u.pm * BM + wr * 64 + fr, col0 = u.pn * BM + wc * 32 + 4 * fq;
        f32x4 bv[2][2];
#pragma unroll
        for (int bj = 0; bj < 2; ++bj)
#pragma unroll
            for (int n = 0; n < 2; ++n) bv[bj][n] = bias ? *(const f32x4*)(bias + col0 + bj * HALF + n * 16) : (f32x4){0.f, 0.f, 0.f, 0.f};
#pragma unroll
        for (int ai = 0; ai < 2; ++ai)
#pragma unroll
            for (int m = 0; m < 4; ++m) { float* rowp = C + (size_t)(row0 + ai * HALF + m * 16) * ldc + col0;
#pragma unroll
                for (int bj = 0; bj < 2; ++bj)
#pragma unroll
                    for (int n = 0; n < 2; ++n) *(f32x4*)(rowp + bj * HALF + n * 16) = acc[ai][bj][m][n] + bv[bj][n]; }
    }
};
template <class Epi, class Sched, bool STAMP = false>
__device__ __forceinline__ void gemm_phase(PG8_LAS unsigned char* lds, const Gemm g, const Sched& S, const Epi& E, unsigned long long* stamps) {
    const int tid = ltid(), wid = __builtin_amdgcn_readfirstlane(tid >> 6), lane = tid & 63, wr = wid >> 2, wc = wid & 3, fr = lane & 15, fq = lane >> 4;
    const int K = g.K, nt = g.Kl / BK;
    int ts_lo = 0, ts_hi = 0, nts = 0; const unsigned long long rt_entry = STAMP ? (unsigned long long)wall_clock64() : 0ull;
#define PG8_STAMP() do { if (STAMP && wid == 0 && nts < 64) { const unsigned long long _c = (unsigned long long)clock64(); \
        ts_lo = (lane == nts) ? (int)(unsigned)_c : ts_lo; ts_hi = (lane == nts) ? (int)(unsigned)(_c >> 32) : ts_hi; ++nts; } } while (0)
    PG8_STAMP();
    unsigned voffA[2], voffB[2];
#pragma unroll
    for (int i = 0; i < 2; ++i) { int R, C; stage_rc(tid * 16 + i * 8192, R, C); const int Rb = Epi::PERM ? ((R & ~31) + perm32(R & 31)) : R;
        voffA[i] = (unsigned)(R * K + C) * 2u; voffB[i] = (unsigned)(Rb * K + C) * 2u; }
    const size_t kstep = (size_t)(BK * 2);
    const size_t hstep = (size_t)HALF * K * 2;
    const size_t tstep = 2 * hstep;
    const unsigned ldsw = (unsigned)wid * 1024u;
    const int aoff = lds_byte(wr * 64 + fr, fq * 8), boff = lds_byte(wc * 32 + fr, fq * 8);
#define PG8_SA(b, h) (((b) * 2 + (h)) * HTB)
#define PG8_SB(b, h) ((4 + (b) * 2 + (h)) * HTB)
#define PG8_STAGE(bufoff, gbase, voff) do { _Pragma("unroll") for (int _i = 0; _i < 2; ++_i) \
        __builtin_amdgcn_global_load_lds((const unsigned*)((const char*)(gbase) + (voff)[_i]), (PG8_LAS unsigned*)(lds + (bufoff) + ldsw + _i * 8192), 16, 0, 0); } while (0)
#define PG8_LDA(dst, b, h) do { _Pragma("unroll") for (int m = 0; m < 4; ++m) _Pragma("unroll") for (int k = 0; k < 2; ++k) dst[m][k] = *(const PG8_LAS bf16x8*)(lds + PG8_SA(b, h) + aoff + m * 2048 + k * 1024); } while (0)
#define PG8_LDB(dst, b, h) do { _Pragma("unroll") for (int n = 0; n < 2; ++n) _Pragma("unroll") for (int k = 0; k < 2; ++k) dst[n][k] = *(const PG8_LAS bf16x8*)(lds + PG8_SB(b, h) + boff + n * 2048 + k * 1024); } while (0)
#define PG8_MMA(ai, bj, At, Bt) do { __builtin_amdgcn_s_setprio(1); _Pragma("unroll") for (int m = 0; m < 4; ++m) _Pragma("unroll") for (int n = 0; n < 2; ++n) _Pragma("unroll") for (int k = 0; k < 2; ++k) \
        acc[ai][bj][m][n] = __builtin_amdgcn_mfma_f32_16x16x32_bf16(Bt[n][k], At[m][k], acc[ai][bj][m][n], 0, 0, 0); __builtin_amdgcn_s_setprio(0); } while (0)
#define PG8_WAIT_V(n) asm volatile("s_waitcnt vmcnt(" #n ")" ::: "memory")
#define PG8_WAIT_L(n) asm volatile("s_waitcnt lgkmcnt(" #n ")" ::: "memory")
#define PG8_BAR __builtin_amdgcn_s_barrier()
#define PG8_SCHED __builtin_amdgcn_sched_barrier(0)
    Unit cur, nxt; int ui = 0;
    if (!S.next(0, cur)) return;
    f32x4 acc[2][2][4][2];
#pragma unroll
    for (int a = 0; a < 2; ++a)
#pragma unroll
        for (int b = 0; b < 2; ++b)
#pragma unroll
            for (int m = 0; m < 4; ++m)
#pragma unroll
                for (int n = 0; n < 2; ++n) acc[a][b][m][n] = (f32x4){0.f, 0.f, 0.f, 0.f};
    bf16x8 At[4][2], B0[2][2], B1[2][2];
    const char* cA = (const char*)g.A + (size_t)cur.pm * tstep + (size_t)cur.ko * 2; const char* cB = (const char*)g.Bt + (size_t)cur.pn * tstep + (size_t)cur.ko * 2;
    S.a_ready(cur);
    PG8_STAGE(PG8_SB(0, 0), cB, voffB); PG8_STAGE(PG8_SA(0, 0), cA, voffA); PG8_STAGE(PG8_SB(0, 1), cB + hstep, voffB); PG8_STAGE(PG8_SA(0, 1), cA + hstep, voffA);
    if (wr == 1) PG8_BAR;
    PG8_WAIT_V(4); PG8_BAR;
    PG8_STAGE(PG8_SB(1, 0), cB + kstep, voffB); PG8_STAGE(PG8_SA(1, 0), cA + kstep, voffA); PG8_STAGE(PG8_SB(1, 1), cB + hstep + kstep, voffB);
    PG8_WAIT_V(6); PG8_BAR;
    PG8_STAMP();
    for (;;) {
        const bool has_next = S.next(ui + 1, nxt);
        const char* nA = has_next ? (const char*)g.A + (size_t)nxt.pm * tstep + (size_t)nxt.ko * 2 : cA; const char* nB = has_next ? (const char*)g.Bt + (size_t)nxt.pn * tstep + (size_t)nxt.ko * 2 : cB;
        for (int t = 0; t < nt; t += 2) {
            const bool last = (t == nt - 2);
            const char* a1 = cA + (size_t)(t + 1) * kstep;
            const char* a2 = last ? nA : cA + (size_t)(t + 2) * kstep; const char* b2 = last ? nB : cB + (size_t)(t + 2) * kstep;
            const char* a3 = a2 + kstep; const char* b3 = b2 + kstep;
            if (last && has_next) S.a_ready(nxt);
            PG8_LDB(B0, 0, 0); PG8_SCHED; PG8_LDA(At, 0, 0); PG8_STAGE(PG8_SA(1, 1), a1 + hstep, voffA);
            PG8_WAIT_L(8); PG8_BAR; PG8_WAIT_L(0); PG8_MMA(0, 0, At, B0); PG8_BAR; PG8_SCHED;
            PG8_LDB(B1, 0, 1); PG8_STAGE(PG8_SB(0, 0), b2, voffB);
            PG8_BAR; PG8_WAIT_L(0); PG8_MMA(0, 1, At, B1); PG8_BAR;
            PG8_LDA(At, 0, 1); PG8_STAGE(PG8_SA(0, 0), a2, voffA);
            PG8_BAR; PG8_WAIT_L(0); PG8_MMA(1, 0, At, B0); PG8_BAR; PG8_SCHED;
            PG8_STAGE(PG8_SB(0, 1), b2 + hstep, voffB);
            PG8_WAIT_V(6); PG8_BAR; PG8_MMA(1, 1, At, B1); PG8_BAR;
            PG8_LDB(B0, 1, 0); PG8_SCHED; PG8_LDA(At, 1, 0); PG8_STAGE(PG8_SA(0, 1), a2 + hstep, voffA);
            PG8_WAIT_L(8); PG8_BAR; PG8_WAIT_L(0); PG8_MMA(0, 0, At, B0); PG8_BAR; PG8_SCHED;
            PG8_LDB(B1, 1, 1); PG8_STAGE(PG8_SB(1, 0), b3, voffB);
            PG8_BAR; PG8_WAIT_L(0); PG8_MMA(0, 1, At, B1); PG8_BAR;
            PG8_LDA(At, 1, 1); PG8_STAGE(PG8_SA(1, 0), a3, voffA);
            PG8_BAR; PG8_WAIT_L(0); PG8_MMA(1, 0, At, B0); PG8_BAR; PG8_SCHED;
            PG8_STAGE(PG8_SB(1, 1), b3 + hstep, voffB);
            PG8_WAIT_V(6); PG8_BAR; PG8_MMA(1, 1, At, B1); PG8_BAR;
        }
        PG8_STAMP();
        if constexpr (!Epi::AFTER_DRAIN) { E(acc, cur, wr, wc, fr, fq); S.done(cur); }
        PG8_STAMP();
        if (!has_next) break;
#pragma unroll
        for (int a = 0; a < 2; ++a)
#pragma unroll
            for (int b = 0; b < 2; ++b)
#pragma unroll
                for (int m = 0; m < 4; ++m)
#pragma unroll
                    for (int n = 0; n < 2; ++n) acc[a][b][m][n] = (f32x4){0.f, 0.f, 0.f, 0.f};
        cur = nxt; cA = nA; cB = nB; ++ui;
    }
    PG8_WAIT_V(0);
    if (wr == 0) PG8_BAR;
    PG8_BAR;
    if constexpr (Epi::AFTER_DRAIN) { E.fused(acc, cur, wr, wc, fr, fq, lds, wid, lane); S.done(cur); }
    PG8_STAMP();
    if (STAMP && wid == 0) { stamps[lane] = lane < nts ? (((unsigned long long)(unsigned)ts_hi << 32) | (unsigned)ts_lo) : 0ull;
        if (lane == 62) stamps[62] = rt_entry; if (lane == 63) stamps[63] = (unsigned long long)wall_clock64(); }
#undef PG8_STAMP
#undef PG8_SA
#undef PG8_SB
#undef PG8_STAGE
#undef PG8_LDA
#undef PG8_LDB
#undef PG8_MMA
#undef PG8_WAIT_V
#undef PG8_WAIT_L
#undef PG8_BAR
#undef PG8_SCHED
}
}
#define XB_TMO      128
#define XB_XCNT(j)  (256  + 64 * (j))
#define XB_XSUB(j)  (1280 + 64 * (j))
#define XB_XGEN(j)  (2304 + 64 * (j))
#define XB_TOP      3328
#define XB_TOPGEN   3392
#define XCD_BAR_WORDS 3456
#define XB_SPIN_CAP (1u << 18)

__device__ __forceinline__ unsigned xb_ld(unsigned* p)              { return __hip_atomic_load(p, __ATOMIC_RELAXED, __HIP_MEMORY_SCOPE_AGENT); }
__device__ __forceinline__ unsigned xb_add(unsigned* p, unsigned v) { return __hip_atomic_fetch_add(p, v, __ATOMIC_RELAXED, __HIP_MEMORY_SCOPE_AGENT); }
__device__ __forceinline__ unsigned xb_xcc_id() { return (unsigned)__builtin_amdgcn_s_getreg((3 << 11) | 20) & 0xFu; }
#define XB_SPIN(cond, bar) do { unsigned _sp = 0; while (cond) { __builtin_amdgcn_s_sleep(1); \
    if ((++_sp & 255u) == 0u) { if (xb_ld(&(bar)[XB_TMO])) break; if (_sp > XB_SPIN_CAP) { atomicAdd(&(bar)[XB_TMO], 1u); break; } } } } while (0)

struct XcdBarrier {
    unsigned* bar; unsigned x;
    volatile LAS unsigned* st;
};

__device__ __forceinline__ XcdBarrier xcd_barrier_post(unsigned* bar, volatile LAS unsigned* st) {
    XcdBarrier b; b.bar = bar; b.x = xb_xcc_id(); b.st = st;
    if (threadIdx.x == 0) (void)xb_add(&bar[XB_XCNT(b.x)], 1u);
    return b;
}
__device__ __forceinline__ void xcd_barrier_complete(unsigned* bar, unsigned x, unsigned& nloc, unsigned& nx) {
    const unsigned G = gridDim.x * gridDim.y * gridDim.z;
    unsigned sum, cnt, mine, sp = 0u;
    for (;;) {
        sum = 0u; cnt = 0u; mine = 0u;
#pragma unroll
        for (unsigned j = 0; j < 16; ++j) { const unsigned c = xb_ld(&bar[XB_XCNT(j)]); sum += c; cnt += (c > 0u) ? 1u : 0u; mine = (j == x) ? c : mine; }
        if (sum == G) break;
        __builtin_amdgcn_s_sleep(1);
        if ((++sp & 255u) == 0u) { if (xb_ld(&bar[XB_TMO])) break; if (sp > XB_SPIN_CAP) { atomicAdd(&bar[XB_TMO], 1u); break; } }
    }
    nloc = mine > 0u ? mine : 1u; nx = cnt > 0u ? cnt : 1u;
}

__device__ __forceinline__ void xcd_barrier(const XcdBarrier& b) {
    asm volatile("s_waitcnt vmcnt(0)" ::: "memory");
    __syncthreads();
    if (threadIdx.x == 0) {
        unsigned* bar = b.bar;
        __builtin_amdgcn_s_waitcnt(0);
        unsigned nloc = b.st[0], nx = b.st[1];
        if (nloc == 0u) { xcd_barrier_complete(bar, b.x, nloc, nx); b.st[0] = nloc; b.st[1] = nx; }
        const unsigned old = xb_add(&bar[XB_XSUB(b.x)], 1u);
        const unsigned gen = old / nloc;
        if (old + 1u == (gen + 1u) * nloc) {
            __builtin_amdgcn_fence(__ATOMIC_RELEASE, "agent");
            asm volatile("s_waitcnt vmcnt(0)" ::: "memory");
            const unsigned og = xb_add(&bar[XB_TOP], 1u);
            const unsigned tg = og / nx;
            if (og + 1u == (tg + 1u) * nx) xb_add(&bar[XB_TOPGEN], 1u);
            else XB_SPIN(xb_ld(&bar[XB_TOPGEN]) == tg, bar);
            __builtin_amdgcn_fence(__ATOMIC_ACQUIRE, "agent");
            xb_add(&bar[XB_XGEN(b.x)], 1u);
            asm volatile("s_waitcnt vmcnt(0)" ::: "memory");
        } else {
            XB_SPIN(xb_ld(&bar[XB_XGEN(b.x)]) == gen, bar);
            __builtin_amdgcn_fence(__ATOMIC_ACQUIRE, "agent");
            asm volatile("s_waitcnt vmcnt(0)" ::: "memory");
        }
    }
    __syncthreads();
}

typedef unsigned short bf16_t;
typedef pg8::bf16x8 bf16x8;
typedef pg8::f32x4 f32x4;
typedef pg8::u32x4 u32x4;
typedef unsigned u32x2 __attribute__((ext_vector_type(2)));

constexpr int DM = 1024, NB = 16, SEQ = 2048, DEPTH = 4, CTXL = 256, DFF = 4096;
constexpr int ZW = 10752;
constexpr int INW = 10528;
constexpr int ZA_Q = 0, ZA_K = 512, ZA_V = 640, ZB_Q = 768, ZB_K = 1280, ZB_V = 1792, ZC_Q = 2304, ZC_FF = 2816, ZC_FB = 3328, ZC_I = 3840, ZC_G = 4352,
              ZD_Q = 4864, ZD_K = 5120, ZD_V = 5376, ZD_GK = 5888, ZD_G = 6016, ZMERGE = 6656;
constexpr int VTS = 2304;
constexpr int LDS_BYTES = 144 * 1024;
constexpr int CTRL_OFF = LDS_BYTES - 256;
constexpr float EPS = 1e-6f;
constexpr float LOG2E = 1.4426950408889634f;
constexpr float QSCALE2 = 0.125f * LOG2E;

struct Params {
    const float *x, *c, *ctx, *c_ctx, *w_mod, *b_mod, *norm_gains, *w_in, *a_sink, *b_rel_bias, *c_lb, *c_norm, *d_gate_up, *d_gate_bias, *d_norm, *w_branch, *w_out, *w_ff1, *w_ff2;
    float* out;
    unsigned char* ws;
    unsigned long long o_mod, o_lb, o_rope, o_xc, o_win, o_wb, o_wo, o_w1, o_w2, o_h, o_z, o_y4, o_ob, o_vta, o_vtb, o_wo4;
    int GB, NGRP, MG, pad0;
};
typedef const Params __attribute__((address_space(4)))* PPtr;

__device__ __forceinline__ float bf2f(unsigned v) { return __uint_as_float(v << 16); }
__device__ __forceinline__ bf16_t f2bf(float f) { unsigned u = __float_as_uint(f); u += 0x7FFFu + ((u >> 16) & 1u); return (bf16_t)(u >> 16); }
typedef __bf16 bf16v2_t __attribute__((ext_vector_type(2)));
typedef float f32v2_t __attribute__((ext_vector_type(2)));
__device__ __forceinline__ unsigned pk2(float lo, float hi) { const f32v2_t v = {lo, hi}; const bf16v2_t b = __builtin_convertvector(v, bf16v2_t); return __builtin_bit_cast(unsigned, b); }
template <int CTRL> __device__ __forceinline__ float dpp(float x) { return __builtin_bit_cast(float, __builtin_amdgcn_mov_dpp(__builtin_bit_cast(int, x), CTRL, 0xf, 0xf, true)); }
constexpr int XOR1 = 0xB1, XOR2 = 0x4E, XOR7 = 0x141, XOR8 = 0x128;
__device__ __forceinline__ float xrow16_max(float x) {
    auto s = __builtin_amdgcn_permlane16_swap(__float_as_uint(x), __float_as_uint(x), false, false);
    x = fmaxf(__uint_as_float(s[0]), __uint_as_float(s[1]));
    auto t = __builtin_amdgcn_permlane32_swap(__float_as_uint(x), __float_as_uint(x), false, false);
    return fmaxf(__uint_as_float(t[0]), __uint_as_float(t[1]));
}
__device__ __forceinline__ float xrow16_sum(float x) {
    auto s = __builtin_amdgcn_permlane16_swap(__float_as_uint(x), __float_as_uint(x), false, false);
    x = __uint_as_float(s[0]) + __uint_as_float(s[1]);
    auto t = __builtin_amdgcn_permlane32_swap(__float_as_uint(x), __float_as_uint(x), false, false);
    return __uint_as_float(t[0]) + __uint_as_float(t[1]);
}
__device__ __forceinline__ float row16_sum(float v) {
    v += dpp<XOR1>(v); v += dpp<XOR2>(v); v += dpp<XOR7>(v); v += dpp<XOR8>(v);
    return v;
}
__device__ __forceinline__ float wave_sum(float v) { return xrow16_sum(row16_sum(v)); }
__device__ __forceinline__ float lo16(unsigned w) { return __uint_as_float(w << 16); }
__device__ __forceinline__ float hi16(unsigned w) { return __uint_as_float(w & 0xffff0000u); }
__device__ __forceinline__ float sigm(float x) { return __builtin_amdgcn_rcpf(1.0f + __builtin_amdgcn_exp2f(-LOG2E * x)); }
__device__ __forceinline__ float fexp(float x) { return __builtin_amdgcn_exp2f(x * LOG2E); }
__device__ __forceinline__ float flog(float x) { return __builtin_amdgcn_logf(x) * 0.6931471805599453f; }
__device__ __forceinline__ bf16_t f2bf1(float x) { return (bf16_t)pk2(x, 0.f); }

__device__ __forceinline__ int src_col(int n) {
    if (n < 640) {
        const int p = n & 63, base = n - p, pp = p >> 1, wh = p & 1;
        const int dim = (pp < 16) ? (wh ? 16 + pp : pp) : (wh ? 48 + (pp - 16) : 32 + (pp - 16));
        return base + dim;
    }
    if (n < 5920) return n;
    if (n < 6016) return -1;
    if (n < 6528) return n - 96;
    if (n < 6656) return -1;
    return 6432 + (n - 6656);
}

__device__ __forceinline__ void conv_tile(const float* src, int Nsrc, int k0, int n0, bool inmap, bf16_t* dst, int Kd, LAS float* t) {
    const int tid = ltid(), nl = tid & 63, ks = tid >> 6;
    const int sc = inmap ? src_col(n0 + nl) : (n0 + nl);
#pragma unroll
    for (int i = 0; i < 8; ++i) { const int kk = ks + 8 * i; t[nl * 65 + kk] = (sc >= 0) ? src[(size_t)(k0 + kk) * Nsrc + sc] : 0.f; }
    __syncthreads();
    const int kl = (tid & 31) * 2, ns = tid >> 5;
#pragma unroll
    for (int i = 0; i < 4; ++i) { const int n = ns + 16 * i; *(unsigned*)(dst + (size_t)(n0 + n) * Kd + k0 + kl) = pk2(t[n * 65 + kl], t[n * 65 + kl + 1]); }
    __syncthreads();
}
__device__ __forceinline__ void convert_weights(PPtr p, int l, LAS unsigned char* lds) {
    LAS float* t = (LAS float*)lds;
    bf16_t* WinT = (bf16_t*)(p->ws + p->o_win); bf16_t* WbT = (bf16_t*)(p->ws + p->o_wb); bf16_t* WoT = (bf16_t*)(p->ws + p->o_wo);
    bf16_t* W1T = (bf16_t*)(p->ws + p->o_w1); bf16_t* W2T = (bf16_t*)(p->ws + p->o_w2);
    constexpr int T_IN = 16 * 168, T_BR = 4 * 8 * 16, T_O = 16 * 16, T_1 = 16 * 64, T_2 = 64 * 16, T_ALL = T_IN + T_BR + T_O + T_1 + T_2;
    for (int it = blockIdx.x; it < T_ALL; it += gridDim.x) {
        int r = it;
        if (r < T_IN) { const int kb = r / 168, nb = r % 168; conv_tile(p->w_in + (size_t)l * 1024 * INW, INW, kb * 64, nb * 64, true, WinT, 1024, t); continue; } r -= T_IN;
        if (r < T_BR) { const int j = r / 128, q = r % 128, kb = q / 16, nb = q % 16; conv_tile(p->w_branch + (size_t)(l * 4 + j) * 512 * 1024, 1024, kb * 64, nb * 64, false, WbT + (size_t)j * 1024 * 512, 512, t); continue; } r -= T_BR;
        if (r < T_O) { const int kb = r / 16, nb = r % 16; conv_tile(p->w_out + (size_t)l * 1024 * 1024, 1024, kb * 64, nb * 64, false, WoT, 1024, t);
#pragma unroll 1
            for (int cpy = 0; cpy < 4; ++cpy) conv_tile(p->w_out + (size_t)l * 1024 * 1024, 1024, kb * 64, nb * 64, false, (bf16_t*)(p->ws + p->o_wo4) + cpy * 1024, 4096, t);
            continue; } r -= T_O;
        if (r < T_1) { const int kb = r / 64, nb = r % 64; conv_tile(p->w_ff1 + (size_t)l * 1024 * 4096, 4096, kb * 64, nb * 64, false, W1T, 1024, t); continue; } r -= T_1;
        { const int kb = r / 16, nb = r % 16; conv_tile(p->w_ff2 + (size_t)l * 4096 * 1024, 1024, kb * 64, nb * 64, false, W2T, 4096, t); }
    }
}

__device__ __forceinline__ void prologue(PPtr p, LAS unsigned char* lds) {
    const int tid = ltid();
    if (blockIdx.x == 0) {
        if (tid < 64) atomicExch((unsigned*)p->ws + tid, 0u);
        for (int i = tid; i < XCD_BAR_WORDS; i += 512) __hip_atomic_store((unsigned*)(p->ws + 4096) + i, 0u, __ATOMIC_RELAXED, __HIP_MEMORY_SCOPE_AGENT);
    }
    if (tid < 4) *((LAS unsigned*)(lds + CTRL_OFF + 64) + tid) = 0u;
    float* modb = (float*)(p->ws + p->o_mod);
    LAS float* sl = (LAS float*)lds;
    LAS float* red = sl + 17 * 1024;
    bool loaded = false;
    for (int task = blockIdx.x; task < 192; task += gridDim.x) {
        if (!loaded) {
            for (int i = tid; i < 17 * 1024; i += 512) { const int b = i >> 10, k = i & 1023; const float v = (b < 16) ? p->c[b * 1024 + k] : p->c_ctx[k]; sl[i] = v * sigm(v); }
            loaded = true;
        }
        __syncthreads();
        const int l = task / 48, nc = task % 48, nn = tid & 127, n = nc * 128 + nn, kq = tid >> 7;
        float acc[17];
#pragma unroll
        for (int b = 0; b < 17; ++b) acc[b] = 0.f;
        const float* w = p->w_mod + ((size_t)l * 1024 + kq * 256) * 6144 + n;
#pragma unroll 1
        for (int k = 0; k < 256; k += 4) {
            const float w0 = w[(size_t)k * 6144], w1 = w[(size_t)(k + 1) * 6144], w2 = w[(size_t)(k + 2) * 6144], w3 = w[(size_t)(k + 3) * 6144];
#pragma unroll
            for (int b = 0; b < 17; ++b) { const f32x4 sv = *(const LAS f32x4*)(sl + b * 1024 + kq * 256 + k); acc[b] += (sv.x * w0 + sv.y * w1) + (sv.z * w2 + sv.w * w3); }
        }
#pragma unroll
        for (int b = 0; b < 17; ++b) red[(kq * 17 + b) * 128 + nn] = acc[b];
        __syncthreads();
        if (kq == 0) {
            const float bm = p->b_mod[l * 6144 + n];
#pragma unroll
            for (int b = 0; b < 17; ++b) modb[((size_t)l * 17 + b) * 6144 + n] = red[b * 128 + nn] + red[(17 + b) * 128 + nn] + red[(34 + b) * 128 + nn] + red[(51 + b) * 128 + nn] + bm;
        }
        __syncthreads();
    }
    if (blockIdx.x == gridDim.x - 1) {
        float* lb = (float*)(p->ws + p->o_lb);
        {
            const int ch = tid;
            float v[4], mx = -1e30f;
#pragma unroll
            for (int l = 0; l < 4; ++l) { v[l] = p->c_lb[l * 512 + ch]; mx = fmaxf(mx, v[l]); }
            float s = 0.f;
#pragma unroll
            for (int l = 0; l < 4; ++l) { v[l] = __expf(v[l] - mx); s += v[l]; }
            const float inv = 1.0f / s, s0 = v[0] * inv; float cum = 0.f;
#pragma unroll
            for (int l = 0; l < 4; ++l) { cum += v[l] * inv; lb[l * 512 + ch] = cum - s0; }
        }
        float* rt = (float*)(p->ws + p->o_rope);
        for (int i = tid; i < 1024; i += 512) {
            const int n = i >> 4, f = i & 15;
            const float inv = __expf(-((float)(2 * f) / 32.0f) * 9.210340371976184f);
            const float a = (float)n * inv;
            const float kf = rintf(a * 0.15915494309189535f);
            const float rr = fmaf(-kf, 6.2831854820251465f, a) + kf * 1.7484556e-7f;
            rt[i] = __cosf(rr); rt[1024 + i] = __sinf(rr);
        }
    }
    __syncthreads();
    convert_weights(p, 0, lds);
}

__device__ __forceinline__ void rowpass(PPtr p, int l, int g, int mode, int nrows) {
    const int lane = ltid() & 63, gw = blockIdx.x * 8 + (ltid() >> 6), NGW = gridDim.x * 8;
    const int LATR = p->GB * 2048, GB = p->GB;
    const float* ng = p->norm_gains + (size_t)l * 4 * 1024;
    const float* modb = (const float*)(p->ws + p->o_mod) + (size_t)l * 17 * 6144;
    bf16_t* hb = (bf16_t*)(p->ws + p->o_h);
    const float* yf = (const float*)(p->ws + p->o_z);
    float* xcb = (float*)(p->ws + p->o_xc);
    const bool first = (l == 0 && mode <= 2);
    const float* xlat = first ? p->x : (const float*)p->out;
    const float* xctx = first ? p->ctx : (const float*)xcb;
    auto xsrc = [&](int row) -> const float* {
        if (row < LATR) return xlat + ((size_t)(g * GB + (row >> 11)) * 2048 + (row & 2047)) * 1024;
        const int r2 = row - LATR; return xctx + ((size_t)(g * GB + (r2 >> 8)) * 256 + (r2 & 255)) * 1024;
    };
    const bf16_t* slab = (const bf16_t*)(p->ws + p->o_z + (size_t)p->MG * 12288);
    const size_t slab_stride = (size_t)(p->MG - LATR) * 1024;
    auto yload = [&](int row, f32x4 (&yv)[4]) {
        if (row < LATR) {
            const bf16_t* yb = (const bf16_t*)yf + (size_t)row * 1024 + lane * 4;
#pragma unroll
            for (int j = 0; j < 4; ++j) { const u32x2 w = __builtin_nontemporal_load((const u32x2*)(yb + 256 * j)); yv[j] = (f32x4){lo16(w.x), hi16(w.x), lo16(w.y), hi16(w.y)}; }
        } else {
            const bf16_t* s0 = slab + (size_t)(row - LATR) * 1024 + lane * 4;
#pragma unroll
            for (int j = 0; j < 4; ++j) { const u32x2 w = *(const u32x2*)(s0 + 256 * j); yv[j] = (f32x4){lo16(w.x), hi16(w.x), lo16(w.y), hi16(w.y)}; }
#pragma unroll
            for (int ks = 1; ks < 8; ++ks)
#pragma unroll
                for (int j = 0; j < 4; ++j) { const u32x2 w = *(const u32x2*)(s0 + ks * slab_stride + 256 * j); yv[j] = yv[j] + (f32x4){lo16(w.x), hi16(w.x), lo16(w.y), hi16(w.y)}; }
        }
    };
    f32x4 xv[4], yv[4];
    int row = gw;
    if (row < nrows) {
        const float* xs = xsrc(row);
#pragma unroll
        for (int j = 0; j < 4; ++j) xv[j] = __builtin_nontemporal_load((const f32x4*)(xs + lane * 4 + 256 * j));
        if (mode >= 2) yload(row, yv);
    }
    while (row < nrows) {
        const int nrow = row + NGW;
        f32x4 xn[4], yn[4];
        if (nrow < nrows) {
            const float* xs = xsrc(nrow);
#pragma unroll
            for (int j = 0; j < 4; ++j) xn[j] = __builtin_nontemporal_load((const f32x4*)(xs + lane * 4 + 256 * j));
            if (mode >= 2) yload(nrow, yn);
        }
        const bool lat = row < LATR;
        int b; size_t xrow;
        if (lat) { b = g * GB + (row >> 11); xrow = (size_t)b * 2048 + (row & 2047); }
        else { const int r2 = row - LATR; b = g * GB + (r2 >> 8); xrow = (size_t)b * 256 + (r2 & 255); }
        float* xd = (lat ? p->out : xcb) + xrow * 1024;
        const float* m = modb + (size_t)(lat ? b : 16) * 6144;
        f32x4 tgv[4], tnv[4], tsh[4], tsc[4], tn2[4];
        {
            const float* gate = m + (mode == 2 ? 2048 : 5120); const float* gn = ng + (mode == 2 ? 1024 : 3072);
            const float* sh = m + (mode == 1 ? 0 : 3072); const float* sc = m + (mode == 1 ? 1024 : 4096); const float* gn2 = ng + (mode == 1 ? 0 : 2048);
#pragma unroll
            for (int j = 0; j < 4; ++j) {
                const int c = lane * 4 + 256 * j;
                if (mode >= 2) { tgv[j] = *(const f32x4*)(gate + c); tnv[j] = *(const f32x4*)(gn + c); }
                if (mode <= 2) { tsh[j] = *(const f32x4*)(sh + c); tsc[j] = *(const f32x4*)(sc + c); tn2[j] = *(const f32x4*)(gn2 + c); }
            }
        }
        if (mode >= 2) {
            float ss = 0.f;
#pragma unroll
            for (int j = 0; j < 4; ++j) ss += yv[j].x * yv[j].x + yv[j].y * yv[j].y + yv[j].z * yv[j].z + yv[j].w * yv[j].w;
            ss = wave_sum(ss);
            const float rs = rsqrtf(ss * (1.0f / 1024.0f) + EPS);
#pragma unroll
            for (int j = 0; j < 4; ++j) {
                const int c = lane * 4 + 256 * j;
                const f32x4 gv = tgv[j], nv = tnv[j];
                xv[j] = xv[j] + gv * (yv[j] * rs * nv);
                __builtin_nontemporal_store(xv[j], (f32x4*)(xd + c));
            }
        }
        if (mode <= 2) {
            float ss = 0.f;
#pragma unroll
            for (int j = 0; j < 4; ++j) ss += xv[j].x * xv[j].x + xv[j].y * xv[j].y + xv[j].z * xv[j].z + xv[j].w * xv[j].w;
            ss = wave_sum(ss);
            const float rs = rsqrtf(ss * (1.0f / 1024.0f) + EPS);
#pragma unroll
            for (int j = 0; j < 4; ++j) {
                const int c = lane * 4 + 256 * j;
                const f32x4 shv = tsh[j], scv = tsc[j], nv = tn2[j];
                const f32x4 hv = (xv[j] * rs * nv) * (scv + 1.0f) + shv;
                u32x2 o; o.x = pk2(hv.x, hv.y); o.y = pk2(hv.z, hv.w);
                *(u32x2*)(hb + (size_t)row * 1024 + c) = o;
            }
        }
#pragma unroll
        for (int j = 0; j < 4; ++j) { xv[j] = xn[j]; yv[j] = yn[j]; }
        row = nrow;
    }
}

struct EpiInproj {
    static constexpr bool PERM = true, AFTER_DRAIN = false;
    bf16_t* Z; bf16_t* vta; bf16_t* vtb; const float* rope; int GB;
    __device__ __forceinline__ void operator()(const f32x4 (&acc)[2][2][4][2], const pg8::Unit& u, int wr, int wc, int fr, int fq) const {
        const int row0 = u.pm * 256 + wr * 64 + fr, LATR = GB * 2048;
#pragma unroll
        for (int bj = 0; bj < 2; ++bj) {
            const int seg = u.pn * 2 + bj, c0 = u.pn * 256 + bj * 128 + wc * 32 + 8 * fq;
            const int type = (seg <= 4) ? 1 : (seg == 5 ? 2 : ((seg >= 14 && seg <= 17) ? 3 : 0));
            const int xf = (seg <= 3 || (seg >= 6 && seg <= 9)) ? 1 : ((seg >= 18 && seg <= 21) ? 2 : ((seg >= 22 && seg <= 29) ? 3 : ((seg == 38 || seg == 39) ? 4 : 0)));
#pragma unroll
            for (int ai = 0; ai < 2; ++ai)
#pragma unroll
                for (int m = 0; m < 4; ++m) {
                    const int row = row0 + ai * 128 + m * 16;
                    f32x4 v0 = acc[ai][bj][m][0], v1 = acc[ai][bj][m][1];
                    if (type <= 1) {
                        if (type == 1 && row < LATR) {
                            const int t = row & 2047, pp0 = (c0 & 63) >> 1;
                            const int n = (pp0 < 16) ? (t >> 6) : (t & 63);
                            const float* cs = rope + n * 16 + (pp0 & 15);
                            const f32x4 cv = *(const f32x4*)cs, sv = *(const f32x4*)(cs + 1024);
                            f32x4 r0, r1;
                            r0.x = v0.x * cv.x - v0.y * sv.x; r0.y = v0.y * cv.x + v0.x * sv.x;
                            r0.z = v0.z * cv.y - v0.w * sv.y; r0.w = v0.w * cv.y + v0.z * sv.y;
                            r1.x = v1.x * cv.z - v1.y * sv.z; r1.y = v1.y * cv.z + v1.x * sv.z;
                            r1.z = v1.z * cv.w - v1.w * sv.w; r1.w = v1.w * cv.w + v1.z * sv.w;
                            v0 = r0; v1 = r1;
                        }
                        if (xf == 1) { v0 = v0 * QSCALE2; v1 = v1 * QSCALE2; }
                        else if (xf == 4) { v0 = v0 * 0.125f; v1 = v1 * 0.125f; }
                        else if (xf == 2) {
#pragma unroll
                            for (int e = 0; e < 4; ++e) { v0[e] = v0[e] * sigm(v0[e]); v1[e] = v1[e] * sigm(v1[e]); }
                        } else if (xf == 3) {
#pragma unroll
                            for (int e = 0; e < 4; ++e) { v0[e] = sigm(v0[e]); v1[e] = sigm(v1[e]); }
                        }
                        u32x4 w; w.x = pk2(v0.x, v0.y); w.y = pk2(v0.z, v0.w); w.z = pk2(v1.x, v1.y); w.w = pk2(v1.z, v1.w);
                        *(u32x4*)(Z + (size_t)row * ZW + c0) = w;
                    } else {
                        int bl, tok;
                        if (row < LATR) { bl = row >> 11; tok = row & 2047; } else { const int r2 = row - LATR; bl = r2 >> 8; tok = 2048 + (r2 & 255); }
                        const int cc = c0 - (type == 2 ? ZA_V : ZB_V), head = cc >> 6, dim0 = cc & 63, H = (type == 2) ? 2 : 8;
                        bf16_t* base = (type == 2 ? vta : vtb) + ((size_t)(bl * H + head) * 64 + dim0) * VTS + tok;
                        base[0 * VTS] = f2bf(v0.x); base[1 * VTS] = f2bf(v0.y); base[2 * VTS] = f2bf(v0.z); base[3 * VTS] = f2bf(v0.w);
                        base[4 * VTS] = f2bf(v1.x); base[5 * VTS] = f2bf(v1.y); base[6 * VTS] = f2bf(v1.z); base[7 * VTS] = f2bf(v1.w);
                    }
                }
        }
    }
};
struct EpiBranch {
    static constexpr bool PERM = true, AFTER_DRAIN = false;
    const bf16_t* Z; bf16_t* macc; int nMfull;
    __device__ __forceinline__ void operator()(const f32x4 (&acc)[2][2][4][2], const pg8::Unit& u, int wr, int wc, int fr, int fq) const {
        const int j = u.pm / nMfull, pm = u.pm - j * nMfull, pn = u.pn & 3;
        const int row0 = pm * 256 + wr * 64 + fr, col0 = pn * 256 + wc * 32 + 8 * fq;
        const bf16_t* gbase = Z + (size_t)row0 * ZW + ZMERGE + j * 1024 + col0;
        bf16_t* mbase = macc + (size_t)row0 * 1024 + col0;
#pragma unroll
        for (int ai = 0; ai < 2; ++ai) {
            u32x4 gw[4][2], pv[4][2];
#pragma unroll
            for (int m = 0; m < 4; ++m)
#pragma unroll
                for (int bj = 0; bj < 2; ++bj) {
                    const size_t ro = (size_t)(ai * 128 + m * 16);
                    gw[m][bj] = *(const u32x4*)(gbase + ro * ZW + bj * 128);
                    pv[m][bj] = (j > 0) ? *(const u32x4*)(mbase + ro * 1024 + bj * 128) : (u32x4){0u, 0u, 0u, 0u};
                }
#pragma unroll
            for (int m = 0; m < 4; ++m)
#pragma unroll
                for (int bj = 0; bj < 2; ++bj) {
                    const u32x4 g = gw[m][bj], q = pv[m][bj];
                    const f32x4 v0 = acc[ai][bj][m][0], v1 = acc[ai][bj][m][1];
                    const float t0 = v0.x * sigm(lo16(g.x)) + lo16(q.x), t1 = v0.y * sigm(hi16(g.x)) + hi16(q.x), t2 = v0.z * sigm(lo16(g.y)) + lo16(q.y), t3 = v0.w * sigm(hi16(g.y)) + hi16(q.y);
                    const float t4 = v1.x * sigm(lo16(g.z)) + lo16(q.z), t5 = v1.y * sigm(hi16(g.z)) + hi16(q.z), t6 = v1.z * sigm(lo16(g.w)) + lo16(q.w), t7 = v1.w * sigm(hi16(g.w)) + hi16(q.w);
                    u32x4 w; w.x = pk2(t0, t1); w.y = pk2(t2, t3); w.z = pk2(t4, t5); w.w = pk2(t6, t7);
                    *(u32x4*)(mbase + (size_t)(ai * 128 + m * 16) * 1024 + bj * 128) = w;
                }
        }
    }
};
struct BranchOrder {
    int nM, nMfull, G, c;
    __device__ __forceinline__ bool next(int i, pg8::Unit& u) const {
        const int j = i & 3; const int v = (c & 7) * (G >> 3) + (c >> 3);
        const long T = (long)(i >> 2) * G + v;
        if (T >= (long)nM * 4) return false;
        u.pm = j * nMfull + (int)(T >> 2); u.pn = j * 4 + (int)(T & 3); u.ko = 0; return true;
    }
    __device__ __forceinline__ void a_ready(const pg8::Unit&) const {}
    __device__ __forceinline__ void done(const pg8::Unit&) const {}
};
struct EpiBf16Y {
    static constexpr bool PERM = true, AFTER_DRAIN = false;
    bf16_t* O; int ldc;
    __device__ __forceinline__ void operator()(const f32x4 (&acc)[2][2][4][2], const pg8::Unit& u, int wr, int wc, int fr, int fq) const {
        const int row0 = u.pm * 256 + wr * 64 + fr, col0 = u.pn * 256 + wc * 32 + 8 * fq;
#pragma unroll
        for (int ai = 0; ai < 2; ++ai)
#pragma unroll
            for (int m = 0; m < 4; ++m) {
                bf16_t* rowp = O + (size_t)(row0 + ai * 128 + m * 16) * ldc + col0;
#pragma unroll
                for (int bj = 0; bj < 2; ++bj) {
                    const f32x4 v0 = acc[ai][bj][m][0], v1 = acc[ai][bj][m][1];
                    u32x4 w; w.x = pk2(v0.x, v0.y); w.y = pk2(v0.z, v0.w); w.z = pk2(v1.x, v1.y); w.w = pk2(v1.z, v1.w);
                    *(u32x4*)(rowp + bj * 128) = w;
                }
            }
    }
};
struct EpiRelu2 {
    static constexpr bool PERM = true, AFTER_DRAIN = false;
    bf16_t* O; int ldc;
    __device__ __forceinline__ void operator()(const f32x4 (&acc)[2][2][4][2], const pg8::Unit& u, int wr, int wc, int fr, int fq) const {
        const int row0 = u.pm * 256 + wr * 64 + fr, col0 = u.pn * 256 + wc * 32 + 8 * fq;
#pragma unroll
        for (int ai = 0; ai < 2; ++ai)
#pragma unroll
            for (int m = 0; m < 4; ++m) {
                bf16_t* rowp = O + (size_t)(row0 + ai * 128 + m * 16) * ldc + col0;
#pragma unroll
                for (int bj = 0; bj < 2; ++bj) {
                    f32x4 v0 = acc[ai][bj][m][0], v1 = acc[ai][bj][m][1];
#pragma unroll
                    for (int e = 0; e < 4; ++e) { const float a = fmaxf(v0[e], 0.f), b = fmaxf(v1[e], 0.f); v0[e] = a * a; v1[e] = b * b; }
                    u32x4 w; w.x = pk2(v0.x, v0.y); w.y = pk2(v0.z, v0.w); w.z = pk2(v1.x, v1.y); w.w = pk2(v1.z, v1.w);
                    *(u32x4*)(rowp + bj * 128) = w;
                }
            }
    }
};

struct CtxBranchOrder {
    int nMfull, pm0, nT, G, c;
    __device__ __forceinline__ bool next(int i, pg8::Unit& u) const {
        const long L = (long)i * G + c; if (L >= (long)nT * 4) return false;
        const int j = (int)(L & 3), t = (int)(L >> 2);
        u.pm = j * nMfull + pm0 + (t >> 2); u.pn = j * 4 + (t & 3); u.ko = 0; return true;
    }
    __device__ __forceinline__ void a_ready(const pg8::Unit&) const {}
    __device__ __forceinline__ void done(const pg8::Unit&) const {}
};
struct EpiBranchCtx {
    static constexpr bool PERM = true, AFTER_DRAIN = false;
    const bf16_t* Z; bf16_t* P; int nMfull, pm0;
    __device__ __forceinline__ void operator()(const f32x4 (&acc)[2][2][4][2], const pg8::Unit& u, int wr, int wc, int fr, int fq) const {
        const int j = u.pm / nMfull, pm = u.pm - j * nMfull, pn = u.pn & 3;
        const int row0 = pm * 256 + wr * 64 + fr, col0 = pn * 256 + wc * 32 + 8 * fq;
        const bf16_t* gbase = Z + (size_t)row0 * ZW + ZMERGE + j * 1024 + col0;
        bf16_t* pbase = P + (size_t)(row0 - pm0 * 256) * 4096 + j * 1024 + col0;
#pragma unroll
        for (int ai = 0; ai < 2; ++ai) {
            u32x4 gw[4][2];
#pragma unroll
            for (int m = 0; m < 4; ++m)
#pragma unroll
                for (int bj = 0; bj < 2; ++bj) gw[m][bj] = *(const u32x4*)(gbase + (size_t)(ai * 128 + m * 16) * ZW + bj * 128);
#pragma unroll
            for (int m = 0; m < 4; ++m)
#pragma unroll
                for (int bj = 0; bj < 2; ++bj) {
                    const u32x4 g = gw[m][bj];
                    const f32x4 v0 = acc[ai][bj][m][0], v1 = acc[ai][bj][m][1];
                    u32x4 w; w.x = pk2(v0.x * sigm(lo16(g.x)), v0.y * sigm(hi16(g.x))); w.y = pk2(v0.z * sigm(lo16(g.y)), v0.w * sigm(hi16(g.y)));
                    w.z = pk2(v1.x * sigm(lo16(g.z)), v1.y * sigm(hi16(g.z))); w.w = pk2(v1.z * sigm(lo16(g.w)), v1.w * sigm(hi16(g.w)));
                    *(u32x4*)(pbase + (size_t)(ai * 128 + m * 16) * 4096 + bj * 128) = w;
                }
        }
    }
};
struct SplitOrder {
    int pm0, nT, SPLIT, Kl, G, c;
    __device__ __forceinline__ bool next(int i, pg8::Unit& u) const {
        const long L = (long)i * G + c; if (L >= (long)nT * 4 * SPLIT) return false;
        const int ks = (int)(L % SPLIT), t = (int)(L / SPLIT);
        u.pm = pm0 + (t >> 2); u.pn = t & 3; u.ko = ks * Kl; return true;
    }
    __device__ __forceinline__ void a_ready(const pg8::Unit&) const {}
    __device__ __forceinline__ void done(const pg8::Unit&) const {}
};
struct EpiSlab {
    static constexpr bool PERM = true, AFTER_DRAIN = false;
    bf16_t* S; int pm0, nrows, Kl;
    __device__ __forceinline__ void operator()(const f32x4 (&acc)[2][2][4][2], const pg8::Unit& u, int wr, int wc, int fr, int fq) const {
        const int ks = u.ko / Kl;
        const int row0 = (u.pm - pm0) * 256 + wr * 64 + fr, col0 = u.pn * 256 + wc * 32 + 8 * fq;
        bf16_t* base = S + (size_t)ks * nrows * 1024;
#pragma unroll
        for (int ai = 0; ai < 2; ++ai)
#pragma unroll
            for (int m = 0; m < 4; ++m) { bf16_t* rowp = base + (size_t)(row0 + ai * 128 + m * 16) * 1024 + col0;
#pragma unroll
                for (int bj = 0; bj < 2; ++bj) {
                    const f32x4 v0 = acc[ai][bj][m][0], v1 = acc[ai][bj][m][1];
                    u32x4 w; w.x = pk2(v0.x, v0.y); w.y = pk2(v0.z, v0.w); w.z = pk2(v1.x, v1.y); w.w = pk2(v1.z, v1.w);
                    *(u32x4*)(rowp + bj * 128) = w;
                } }
    }
};

#define MFMA16(a, b, c) __builtin_amdgcn_mfma_f32_16x16x32_bf16((a), (b), (c), 0, 0, 0)
__device__ __forceinline__ void attn_wave(PPtr p, int l, int kind, int idx, int lane, const LAS float* biasL) {
    const int fr = lane & 15, fq = lane >> 4;
    const int LATR = p->GB * 2048, MG = p->MG;
    const bf16_t* Z = (const bf16_t*)(p->ws + p->o_z);
    const bool isA = (kind == 1 || kind == 2);
    int bl, hk, qrow0, r = 0, q0 = 0;
    if (kind == 0) { bl = idx >> 8; hk = (idx >> 5) & 7; r = idx & 31; qrow0 = bl * 2048 + r * 64; }
    else if (kind == 1) { bl = idx >> 8; hk = (idx >> 7) & 1; q0 = (idx & 127) * 16; qrow0 = bl * 2048 + q0; }
    else if (kind == 2) { bl = idx >> 5; hk = (idx >> 4) & 1; qrow0 = LATR + bl * 256 + (idx & 15) * 16; }
    else { bl = idx >> 5; hk = (idx >> 2) & 7; qrow0 = LATR + bl * 256 + (idx & 3) * 64; }
    const int qrstep = isA ? 0 : 16, qcstep = isA ? 64 : 0;
    const int qcol0 = isA ? (ZA_Q + hk * 4 * 64) : (ZB_Q + hk * 64);
    const int kcol = isA ? (ZA_K + hk * 64) : (ZB_K + hk * 64);
    const bf16_t* vt = isA ? ((const bf16_t*)(p->ws + p->o_vta) + (size_t)(bl * 2 + hk) * 64 * VTS) : ((const bf16_t*)(p->ws + p->o_vtb) + (size_t)(bl * 8 + hk) * 64 * VTS);
    bf16_t* yo = (bf16_t*)(p->ws + p->o_y4) + (isA ? (size_t)0 : (size_t)MG * 512);
    const int ocol0 = isA ? hk * 4 * 64 : hk * 64;
    const int krow_ctx0 = LATR + bl * 256, krow_lat0 = bl * 2048;

    bf16x8 Q[4][2];
#pragma unroll
    for (int s = 0; s < 4; ++s)
#pragma unroll
        for (int ks = 0; ks < 2; ++ks) Q[s][ks] = *(const bf16x8*)(Z + (size_t)(qrow0 + s * qrstep + fr) * ZW + qcol0 + s * qcstep + ks * 32 + fq * 8);
    f32x4 O[4][4]; float mrun[4], lrun[4];
#pragma unroll
    for (int s = 0; s < 4; ++s) { mrun[s] = -1e30f; lrun[s] = 0.f;
#pragma unroll
        for (int dt = 0; dt < 4; ++dt) O[s][dt] = (f32x4){0.f, 0.f, 0.f, 0.f}; }

    auto do_block = [&](int krow, int vtoff, int mode, int a0, int a1, bool first) {
        bf16x8 Kf[2][2];
#pragma unroll
        for (int kt = 0; kt < 2; ++kt)
#pragma unroll
            for (int ks = 0; ks < 2; ++ks) Kf[kt][ks] = *(const bf16x8*)(Z + (size_t)(krow + kt * 16 + fr) * ZW + kcol + ks * 32 + fq * 8);
        bf16x8 Vf[4];
#pragma unroll
        for (int dt = 0; dt < 4; ++dt) {
            const bf16_t* vp = vt + (size_t)(dt * 16 + fr) * VTS + vtoff + fq * 4;
            const u32x2 lo = *(const u32x2*)vp, hi = *(const u32x2*)(vp + 16);
            u32x4 w; w.x = lo.x; w.y = lo.y; w.z = hi.x; w.w = hi.y;
            Vf[dt] = __builtin_bit_cast(bf16x8, w);
        }
#pragma unroll
        for (int s = 0; s < 4; ++s) {
            const bool active = (mode != 2) || !((s == 0 && a1 == 1) || (s == 3 && a1 == 0));
            if (active) {
                f32x4 S0 = (f32x4){0.f, 0.f, 0.f, 0.f}, S1 = (f32x4){0.f, 0.f, 0.f, 0.f};
                S0 = MFMA16(Kf[0][0], Q[s][0], S0); S0 = MFMA16(Kf[0][1], Q[s][1], S0);
                S1 = MFMA16(Kf[1][0], Q[s][0], S1); S1 = MFMA16(Kf[1][1], Q[s][1], S1);
                float sc[8];
#pragma unroll
                for (int j = 0; j < 4; ++j) { sc[j] = S0[j]; sc[4 + j] = S1[j]; }
                if (mode == 1) {
                    if (a0 < q0 + 15 - 128 || a0 + 31 > q0 + 128) {
                        const int d0 = a0 + fq * 4 - (q0 + fr) + 128;
#pragma unroll
                        for (int e = 0; e < 8; ++e) { const unsigned d = (unsigned)(d0 + (e >> 2) * 16 + (e & 3)); if (d > 256u) sc[e] = -1e30f; }
                    }
                } else if (mode == 2) {
                    const int qc = 16 * s + fr; const int cs = min(max(qc - 8, 0), 48);
                    const int kc0 = a1 * 32 + fq * 4;
                    const LAS float* bp = biasL + hk * 465 + a0 * 31 + (kc0 - qc + 15);
                    const unsigned rel0 = (unsigned)(kc0 - cs);
#pragma unroll
                    for (int e = 0; e < 8; ++e) {
                        const int off = (e >> 2) * 16 + (e & 3);
                        const float bv = bp[off];
                        sc[e] = (rel0 + (unsigned)off < 16u) ? (sc[e] + bv) : -1e30f;
                    }
                }
                if (first) {
                    float ml = fmaxf(fmaxf(fmaxf(sc[0], sc[1]), fmaxf(sc[2], sc[3])), fmaxf(fmaxf(sc[4], sc[5]), fmaxf(sc[6], sc[7])));
                    mrun[s] = xrow16_max(ml);
                }
                const float mn = mrun[s];
                float pv[8], ls = 0.f;
#pragma unroll
                for (int e = 0; e < 8; ++e) { pv[e] = __builtin_amdgcn_exp2f(sc[e] - mn); ls += pv[e]; }
                ls = xrow16_sum(ls);
                lrun[s] += ls;
                u32x4 pw; pw.x = pk2(pv[0], pv[1]); pw.y = pk2(pv[2], pv[3]); pw.z = pk2(pv[4], pv[5]); pw.w = pk2(pv[6], pv[7]);
                const bf16x8 P = __builtin_bit_cast(bf16x8, pw);
#pragma unroll
                for (int dt = 0; dt < 4; ++dt) O[s][dt] = MFMA16(Vf[dt], P, O[s][dt]);
            }
            __builtin_amdgcn_sched_barrier(0);
        }
    };
    int nloc = 0, lo = 0, r0 = 0;
    if (kind == 1) { lo = max(0, q0 - 128) & ~31; const int hi = min(2048, (q0 + 16 + 128 + 31) & ~31); nloc = (hi - lo) >> 5; }
    else if (kind == 0) { r0 = min(max(r - 4, 0), 24); nloc = 16; }
#pragma unroll 1
    for (int i = 0; i < 8 + nloc; ++i) {
        int krow, vtoff, mode, a0, a1;
        if (i < 8) { krow = krow_ctx0 + 32 * i; vtoff = 2048 + 32 * i; mode = 0; a0 = 0; a1 = 0; }
        else if (kind == 1) { const int kb = lo + 32 * (i - 8); krow = krow_lat0 + kb; vtoff = kb; mode = 1; a0 = kb; a1 = 0; }
        else { const int jj = i - 8, kr = r0 + (jj >> 1), hb = jj & 1; krow = krow_lat0 + kr * 64 + hb * 32; vtoff = kr * 64 + hb * 32; mode = 2; a0 = kr - r + 7; a1 = hb; }
        do_block(krow, vtoff, mode, a0, a1, i == 0);
    }
#pragma unroll
    for (int s = 0; s < 4; ++s) {
        float fac;
        if (isA) { const float sk = p->a_sink[l * 8 + hk * 4 + s] * LOG2E; const float M = fmaxf(mrun[s], sk); const float e1 = __builtin_amdgcn_exp2f(mrun[s] - M); fac = e1 / (lrun[s] * e1 + __builtin_amdgcn_exp2f(sk - M)); }
        else fac = 1.0f / lrun[s];
        bf16_t* op = yo + (size_t)(qrow0 + s * qrstep + fr) * 512 + ocol0 + s * qcstep + fq * 4;
#pragma unroll
        for (int dt = 0; dt < 4; ++dt) { const f32x4 o = O[s][dt] * fac; u32x2 w; w.x = pk2(o.x, o.y); w.y = pk2(o.z, o.w); *(u32x2*)(op + dt * 16) = w; }
    }
}

constexpr int SCAN_BUF = 41472;
constexpr int BIAS_OFF = 3 * SCAN_BUF;
template <int DK, bool ISC>
__device__ __forceinline__ void scan_task(PPtr p, int l, int bl, int h, int dir, LAS unsigned char* lds) {
    constexpr int KPW = DK / 8, NTG = 64 / KPW, TPG = 32 / NTG, QS = (DK + 8) * 2, NKT = DK / 16;
    const int tid = ltid(), w = tid >> 6, lane = tid & 63, fr = lane & 15, fq = lane >> 4;
    const int kl = lane % KPW, tg = lane / KPW, kch = w * KPW + kl;
    const int vcol = tid & 127, vg = tid >> 7;
    LAS unsigned char* qt = lds; LAS unsigned char* kt_ = qt + 32 * QS; LAS unsigned char* khT = kt_ + 32 * QS; LAS unsigned char* vT = khT + DK * 80;
    LAS unsigned char* att = vT + 128 * 80; LAS float* dvec = (LAS float*)(att + 32 * 80); LAS float* evec = dvec + DK;
    const bf16_t* Z = (const bf16_t*)(p->ws + p->o_z);
    const int LATR = p->GB * 2048, MG = p->MG;
    const int qc = ISC ? (ZC_Q + h * 128 + kch) : (ZD_Q + h * 64 + kch);
    const int kc = ISC ? ((dir ? ZC_FB : ZC_FF) + h * 128 + kch) : (ZD_K + h * 64 + kch);
    const int vc = (ISC ? ZC_I : ZD_V) + h * 128 + vcol;
    const int gcol = ZD_GK + dir * 16;
    float lbv = 0.f, oml = 1.f, up[16], gb = 0.f;
#pragma unroll
    for (int r = 0; r < 16; ++r) up[r] = 0.f;
    if (ISC) { lbv = ((const float*)(p->ws + p->o_lb))[l * 512 + h * 128 + kch]; oml = 1.0f - lbv; }
    else {
#pragma unroll
        for (int r = 0; r < 16; ++r) up[r] = p->d_gate_up[((size_t)(l * 2 + dir) * 16 + r) * 256 + h * 64 + kch];
        gb = p->d_gate_bias[(l * 2 + dir) * 256 + h * 64 + kch];
    }
    bf16_t* odst = (dir == 0) ? ((bf16_t*)(p->ws + p->o_y4) + (size_t)(ISC ? 2 : 3) * MG * 512) : ((bf16_t*)(p->ws + p->o_ob) + (size_t)(ISC ? 0 : 1) * MG * 512);
    f32x4 S[NKT];
#pragma unroll
    for (int i = 0; i < NKT; ++i) S[i] = (f32x4){0.f, 0.f, 0.f, 0.f};
    const int sgn = dir ? -1 : 1;
    const long zstep = (long)sgn * ZW, ostep = (long)sgn * 512;
    auto row0of = [&](int cc) -> int {
        const bool isctx = cc < 8; const int L = isctx ? 256 : 2048, base = isctx ? (LATR + bl * 256) : (bl * 2048), c = isctx ? cc : cc - 8;
        return base + (dir ? (L - 1 - c * 32) : c * 32);
    };
    bf16_t rq[TPG], rk[TPG], rv[8]; u32x4 rz[TPG][2];
    auto load_raw = [&](int cc) {
        const int r0 = row0of(cc);
        const bf16_t* zq = Z + (size_t)(r0 + tg * TPG * sgn) * ZW;
#pragma unroll
        for (int e = 0; e < TPG; ++e) {
            const bf16_t* zr = zq + e * zstep;
            rq[e] = zr[qc]; rk[e] = zr[kc];
            if (!ISC) { rz[e][0] = *(const u32x4*)(zr + gcol); rz[e][1] = *(const u32x4*)(zr + gcol + 8); }
        }
        const bf16_t* zv = Z + (size_t)(r0 + vg * 8 * sgn) * ZW + vc;
#pragma unroll
        for (int e = 0; e < 8; ++e) rv[e] = zv[e * zstep];
    };
    load_raw(0);
    for (int cc = 0; cc < 72; ++cc) {
        __syncthreads();
        {
            float gq[TPG], gk[TPG], cum[TPG]; float run = 0.f;
#pragma unroll
            for (int e = 0; e < TPG; ++e) {
                const float zq = bf2f(rq[e]), zk = bf2f(rk[e]); float g, key, q;
                if (ISC) { const float sg = zk; g = flog(lbv + oml * sg); key = oml * (1.0f - sg); q = zq; }
                else {
                    float a = gb;
                    const u32x4 z0 = rz[e][0], z1 = rz[e][1];
                    a += lo16(z0.x) * up[0] + hi16(z0.x) * up[1] + lo16(z0.y) * up[2] + hi16(z0.y) * up[3] + lo16(z0.z) * up[4] + hi16(z0.z) * up[5] + lo16(z0.w) * up[6] + hi16(z0.w) * up[7];
                    a += lo16(z1.x) * up[8] + hi16(z1.x) * up[9] + lo16(z1.y) * up[10] + hi16(z1.y) * up[11] + lo16(z1.z) * up[12] + hi16(z1.z) * up[13] + lo16(z1.w) * up[14] + hi16(z1.w) * up[15];
                    g = (fminf(a, 0.f) - flog(1.0f + fexp(-fabsf(a)))) * (1.0f / 16.0f); key = zk; q = zq;
                }
                run += g; cum[e] = run; gq[e] = q; gk[e] = key;
            }
            float pre = 0.f, total = 0.f, cref = 0.f;
#pragma unroll
            for (int t = 0; t < NTG; ++t) { const float tt = __shfl(run, kl + KPW * t); if (t < tg) pre += tt; if (t < NTG / 2) cref += tt; total += tt; }
            float khv[TPG]; const float etc = fexp(total - cref);
#pragma unroll
            for (int e = 0; e < TPG; ++e) {
                const float c = cum[e] + pre; const int i = tg * TPG + e;
                const float E = fexp(c - cref), kE = gk[e] * __builtin_amdgcn_rcpf(E);
                *(LAS bf16_t*)(qt + i * QS + kch * 2) = f2bf1(gq[e] * E);
                *(LAS bf16_t*)(kt_ + i * QS + kch * 2) = f2bf1(kE);
                khv[e] = kE * etc;
            }
            if constexpr (TPG == 8) { u32x4 o; o.x = pk2(khv[0], khv[1]); o.y = pk2(khv[2], khv[3]); o.z = pk2(khv[4], khv[5]); o.w = pk2(khv[6], khv[7]); *(LAS u32x4*)(khT + kch * 80 + tg * 16) = o; }
            else { u32x2 o; o.x = pk2(khv[0], khv[1]); o.y = pk2(khv[2], khv[3]); *(LAS u32x2*)(khT + kch * 80 + tg * 8) = o; }
            if (tg == 0) { dvec[kch] = fexp(total); evec[kch] = fexp(cref); }
            u32x4 vo; vo.x = (unsigned)rv[0] | ((unsigned)rv[1] << 16); vo.y = (unsigned)rv[2] | ((unsigned)rv[3] << 16); vo.z = (unsigned)rv[4] | ((unsigned)rv[5] << 16); vo.w = (unsigned)rv[6] | ((unsigned)rv[7] << 16);
            *(LAS u32x4*)(vT + vcol * 80 + vg * 16) = vo;
        }
        if (cc + 1 < 72) load_raw(cc + 1);
        __syncthreads();
        if (w < 3) {
            const int tt = (w == 0) ? 0 : 1, st = (w == 2) ? 1 : 0;
            f32x4 a = (f32x4){0.f, 0.f, 0.f, 0.f};
#pragma unroll
            for (int ks = 0; ks < DK / 32; ++ks) {
                const bf16x8 A = *(const LAS bf16x8*)(qt + (tt * 16 + fr) * QS + (ks * 32 + fq * 8) * 2);
                const bf16x8 B = *(const LAS bf16x8*)(kt_ + (st * 16 + fr) * QS + (ks * 32 + fq * 8) * 2);
                a = MFMA16(A, B, a);
            }
#pragma unroll
            for (int j = 0; j < 4; ++j) { const int t = tt * 16 + fq * 4 + j, s = st * 16 + fr; *(LAS bf16_t*)(att + t * 80 + s * 2) = f2bf1(s <= t ? a[j] : 0.f); }
        } else if (w == 3) {
#pragma unroll
            for (int j = 0; j < 4; ++j) { const int t = fq * 4 + j, s = 16 + fr; *(LAS bf16_t*)(att + t * 80 + s * 2) = (bf16_t)0; }
        }
        __syncthreads();
        {
            const int vs = w * 16;
            bf16_t* ob0 = odst + (size_t)(row0of(cc) + fq * 4 * sgn) * 512 + h * 128 + vs + fr;
            const bf16x8 Bv = *(const LAS bf16x8*)(vT + (vs + fr) * 80 + fq * 16);
            f32x4 ev[NKT]; u32x4 qa[2][NKT / 2]; bf16x8 A2[2], A3[NKT]; f32x4 dv[NKT];
#pragma unroll
            for (int k2 = 0; k2 < NKT; ++k2) ev[k2] = *(const LAS f32x4*)(evec + k2 * 16 + fq * 4);
#pragma unroll
            for (int tt = 0; tt < 2; ++tt) {
#pragma unroll
                for (int kp = 0; kp < NKT / 2; ++kp) {
                    const u32x2 lo = *(const LAS u32x2*)(qt + (tt * 16 + fr) * QS + ((2 * kp) * 16 + fq * 4) * 2);
                    const u32x2 hi = *(const LAS u32x2*)(qt + (tt * 16 + fr) * QS + ((2 * kp + 1) * 16 + fq * 4) * 2);
                    qa[tt][kp].x = lo.x; qa[tt][kp].y = lo.y; qa[tt][kp].z = hi.x; qa[tt][kp].w = hi.y;
                }
                A2[tt] = *(const LAS bf16x8*)(att + (tt * 16 + fr) * 80 + fq * 16);
            }
#pragma unroll
            for (int k2 = 0; k2 < NKT; ++k2) { dv[k2] = *(const LAS f32x4*)(dvec + k2 * 16 + fq * 4); A3[k2] = *(const LAS bf16x8*)(khT + (k2 * 16 + fr) * 80 + fq * 16); }
            __builtin_amdgcn_sched_barrier(0);
            bf16x8 Sb[NKT / 2];
#pragma unroll
            for (int kp = 0; kp < NKT / 2; ++kp) {
                const f32x4 s0 = S[2 * kp] * ev[2 * kp], s1 = S[2 * kp + 1] * ev[2 * kp + 1];
                u32x4 sw; sw.x = pk2(s0.x, s0.y); sw.y = pk2(s0.z, s0.w); sw.z = pk2(s1.x, s1.y); sw.w = pk2(s1.z, s1.w);
                Sb[kp] = __builtin_bit_cast(bf16x8, sw);
            }
#pragma unroll
            for (int tt = 0; tt < 2; ++tt) {
                f32x4 o = (f32x4){0.f, 0.f, 0.f, 0.f};
#pragma unroll
                for (int kp = 0; kp < NKT / 2; ++kp) o = MFMA16(__builtin_bit_cast(bf16x8, qa[tt][kp]), Sb[kp], o);
                o = MFMA16(A2[tt], Bv, o);
#pragma unroll
                for (int j = 0; j < 4; ++j) ob0[(tt * 16 + j) * ostep] = f2bf1(o[j]);
            }
            __builtin_amdgcn_sched_barrier(0);
#pragma unroll
            for (int k2 = 0; k2 < NKT; ++k2) { S[k2] = S[k2] * dv[k2]; S[k2] = MFMA16(A3[k2], Bv, S[k2]); }
        }
    }
    __syncthreads();
}

__device__ __forceinline__ void mixer(PPtr p, int l, int g, LAS unsigned char* lds, unsigned long long* tscan = nullptr) {
    const int tid = ltid(), w = tid >> 6, lane = tid & 63;
    LAS float* biasL = (LAS float*)(lds + BIAS_OFF);
    for (int i = tid; i < 8 * 465; i += 512) biasL[i] = p->b_rel_bias[(size_t)l * 8 * 465 + i] * LOG2E;
    __syncthreads();
    const int GB = p->GB, NSC = GB * 8, NS = GB * 16;
    const unsigned long long ts0 = tscan ? __builtin_amdgcn_s_memrealtime() : 0ull;
    for (int st = blockIdx.x; st < NS; st += gridDim.x) {
        if (st < NSC) { scan_task<128, true>(p, l, st >> 3, (st >> 1) & 3, st & 1, lds); }
        else { const int s2 = st - NSC; scan_task<64, false>(p, l, s2 >> 3, (s2 >> 1) & 3, s2 & 1, lds); }
    }
    if (tscan) *tscan += __builtin_amdgcn_s_memrealtime() - ts0;
    unsigned* ctr = (unsigned*)p->ws + (l * 16 + g);
    const int NB0 = GB * 32, NB1 = GB * 32, NB2 = (l < DEPTH - 1) ? GB * 4 : 0, NB3 = NB2, NBT = NB0 + NB1 + NB2 + NB3;
    LAS int* tw = (LAS int*)(lds + CTRL_OFF);
    for (;;) {
        if (tid == 0) *tw = (int)atomicAdd(ctr, 1u);
        __syncthreads();
        const int bt = *tw;
        __syncthreads();
        if (bt >= NBT) break;
        int kind, idx;
        if (bt < NB0) { kind = 0; idx = bt * 8 + w; }
        else if (bt < NB0 + NB1) { kind = 1; idx = (bt - NB0) * 8 + w; }
        else if (bt < NB0 + NB1 + NB2) { kind = 2; idx = (bt - NB0 - NB1) * 8 + w; }
        else { kind = 3; idx = (bt - NB0 - NB1 - NB2) * 8 + w; }
        attn_wave(p, l, kind, idx, lane, biasL);
    }
}

__device__ __forceinline__ void postpass(PPtr p, int l, int nrows) {
    const int lane = ltid() & 63, gw = blockIdx.x * 8 + (ltid() >> 6), NGW = gridDim.x * 8, MG = p->MG;
    const bf16_t* Z = (const bf16_t*)(p->ws + p->o_z);
    for (int it = gw; it < nrows * 2; it += NGW) {
        const int row = it >> 1, br = it & 1;
        bf16_t* yf = (bf16_t*)(p->ws + p->o_y4) + (size_t)(2 + br) * MG * 512 + (size_t)row * 512 + lane * 8;
        const bf16_t* yb = (const bf16_t*)(p->ws + p->o_ob) + (size_t)br * MG * 512 + (size_t)row * 512 + lane * 8;
        const u32x4 a = *(const u32x4*)yf, b = *(const u32x4*)yb;
        const u32x4 gt = *(const u32x4*)(Z + (size_t)row * ZW + (br ? ZD_G : ZC_G) + lane * 8);
        const float* gain = (br ? p->d_norm : p->c_norm) + l * 128 + (lane & 15) * 8;
        float o[8], gv[8];
        o[0] = lo16(a.x) + lo16(b.x); o[1] = hi16(a.x) + hi16(b.x); o[2] = lo16(a.y) + lo16(b.y); o[3] = hi16(a.y) + hi16(b.y);
        o[4] = lo16(a.z) + lo16(b.z); o[5] = hi16(a.z) + hi16(b.z); o[6] = lo16(a.w) + lo16(b.w); o[7] = hi16(a.w) + hi16(b.w);
        gv[0] = lo16(gt.x); gv[1] = hi16(gt.x); gv[2] = lo16(gt.y); gv[3] = hi16(gt.y); gv[4] = lo16(gt.z); gv[5] = hi16(gt.z); gv[6] = lo16(gt.w); gv[7] = hi16(gt.w);
        float ss = 0.f;
#pragma unroll
        for (int e = 0; e < 8; ++e) ss += o[e] * o[e];
        ss = row16_sum(ss);
        const float rs = rsqrtf(ss * (1.0f / 128.0f) + EPS);
        const f32x4 g0 = *(const f32x4*)gain, g1 = *(const f32x4*)(gain + 4);
        float y[8];
#pragma unroll
        for (int e = 0; e < 8; ++e) { const float gn = (e < 4) ? g0[e & 3] : g1[e & 3]; y[e] = o[e] * rs * gn * (gv[e] * sigm(gv[e])); }
        u32x4 wv; wv.x = pk2(y[0], y[1]); wv.y = pk2(y[2], y[3]); wv.z = pk2(y[4], y[5]); wv.w = pk2(y[6], y[7]);
        *(u32x4*)yf = wv;
    }
}

#define NOINL __device__ __forceinline__
NOINL void ph_prologue(PPtr pc, LAS unsigned char* lds) { PPtr p = pc; asm volatile("" : "+s"(p)); prologue(p, lds); }
NOINL void ph_rowpass(PPtr pc, int l, int g, int mode, int nrows, int conv_l, LAS unsigned char* lds) { PPtr p = pc; asm volatile("" : "+s"(p)); rowpass(p, l, g, mode, nrows); if (conv_l >= 0) convert_weights(p, conv_l, lds); }
NOINL void ph_rowpass_tail(PPtr pc, int l, int g, int nrows, int conv_l, int nl, int ng, int nrows_next, LAS unsigned char* lds) {
    PPtr p = pc; asm volatile("" : "+s"(p));
    rowpass(p, l, g, 3, nrows);
    if (nl >= 0) rowpass(p, nl, ng, 1, nrows_next);
    if (conv_l >= 0) convert_weights(p, conv_l, lds);
}
NOINL void ph_inproj(PPtr pc, LAS unsigned char* lds) {
    PPtr p = pc; asm volatile("" : "+s"(p)); const int G = (int)gridDim.x, c = (int)blockIdx.x;
    pg8::Gemm gm{(const bf16_t*)(p->ws + p->o_h), (const bf16_t*)(p->ws + p->o_win), p->MG, ZW, 1024, 1024}; pg8::StaticOrder S; S.init(p->MG, ZW, G, c);
    EpiInproj E{(bf16_t*)(p->ws + p->o_z), (bf16_t*)(p->ws + p->o_vta), (bf16_t*)(p->ws + p->o_vtb), (const float*)(p->ws + p->o_rope), p->GB};
    pg8::gemm_phase<EpiInproj, pg8::StaticOrder>(lds, gm, S, E, nullptr);
}
NOINL void ph_mixer(PPtr pc, int l, int g, LAS unsigned char* lds, unsigned long long* tscan = nullptr) { PPtr p = pc; asm volatile("" : "+s"(p)); mixer(p, l, g, lds, tscan); }
NOINL void ph_post(PPtr pc, int l, int nrows) { PPtr p = pc; asm volatile("" : "+s"(p)); postpass(p, l, nrows); }
NOINL void ph_branch(PPtr pc, int Mr, LAS unsigned char* lds) {
    PPtr p = pc; asm volatile("" : "+s"(p)); const int G = (int)gridDim.x, c = (int)blockIdx.x;
    const int LATR = p->GB * 2048, nMfull = p->MG / 256;
    pg8::Gemm gm{(const bf16_t*)(p->ws + p->o_y4), (const bf16_t*)(p->ws + p->o_wb), Mr, 1024, 512, 512};
    { BranchOrder S{LATR / 256, nMfull, G, c};
      EpiBranch E{(const bf16_t*)(p->ws + p->o_z), (bf16_t*)(p->ws + p->o_h), nMfull};
      pg8::gemm_phase<EpiBranch, BranchOrder>(lds, gm, S, E, nullptr); }
    if (Mr > LATR) {
        CtxBranchOrder S{nMfull, LATR / 256, (Mr - LATR) / 256 * 4, G, c};
        EpiBranchCtx E{(const bf16_t*)(p->ws + p->o_z), (bf16_t*)(p->ws + p->o_ob), nMfull, LATR / 256};
        pg8::gemm_phase<EpiBranchCtx, CtxBranchOrder>(lds, gm, S, E, nullptr);
    }
}
NOINL void ph_gemm_f32(PPtr pc, int which, int Mr, LAS unsigned char* lds) {
    PPtr p = pc; asm volatile("" : "+s"(p)); const int G = (int)gridDim.x, c = (int)blockIdx.x;
    const int LATR = p->GB * 2048;
    const bf16_t* hid = (const bf16_t*)(p->ws + p->o_z + (size_t)p->MG * 1024 * 4);
    { const bf16_t* A = which ? hid : (const bf16_t*)(p->ws + p->o_h);
      const bf16_t* Bt = which ? (const bf16_t*)(p->ws + p->o_w2) : (const bf16_t*)(p->ws + p->o_wo);
      const int K = which ? 4096 : 1024;
      pg8::Gemm gm{A, Bt, LATR, 1024, K, K}; pg8::StaticOrder S; S.init(LATR, 1024, G, c);
      EpiBf16Y E{(bf16_t*)(p->ws + p->o_z), 1024};
      pg8::gemm_phase<EpiBf16Y, pg8::StaticOrder>(lds, gm, S, E, nullptr); }
    if (Mr > LATR) {
        const bf16_t* A = which ? hid : ((const bf16_t*)(p->ws + p->o_ob) - (size_t)LATR * 4096);
        const bf16_t* Bt = which ? (const bf16_t*)(p->ws + p->o_w2) : (const bf16_t*)(p->ws + p->o_wo4);
        pg8::Gemm gm{A, Bt, Mr, 1024, 4096, 512};
        SplitOrder S{LATR / 256, (Mr - LATR) / 256, 8, 512, G, c};
        EpiSlab E{(bf16_t*)(p->ws + p->o_z + (size_t)p->MG * 12288), LATR / 256, Mr - LATR, 512};
        pg8::gemm_phase<EpiSlab, SplitOrder>(lds, gm, S, E, nullptr);
    }
}
NOINL void ph_ffn1(PPtr pc, int Mr, LAS unsigned char* lds) {
    PPtr p = pc; asm volatile("" : "+s"(p)); const int G = (int)gridDim.x, c = (int)blockIdx.x;
    pg8::Gemm gm{(const bf16_t*)(p->ws + p->o_h), (const bf16_t*)(p->ws + p->o_w1), Mr, 4096, 1024, 1024}; pg8::StaticOrder S; S.init(Mr, 4096, G, c);
    EpiRelu2 E{(bf16_t*)(p->ws + p->o_z + (size_t)p->MG * 1024 * 4), 4096};
    pg8::gemm_phase<EpiRelu2, pg8::StaticOrder>(lds, gm, S, E, nullptr);
}

#define XB_SETUP() volatile LAS unsigned* xb_st = (volatile LAS unsigned*)(lds + CTRL_OFF + 64); unsigned* xb_bar = (unsigned*)(pc->ws + 4096); { XcdBarrier xb0 = xcd_barrier_post(xb_bar, xb_st); (void)xb0; }
#define GSYNC() { XcdBarrier xb_; xb_.bar = (unsigned*)(pc->ws + 4096); xb_.x = xb_xcc_id(); xb_.st = (volatile LAS unsigned*)(lds + CTRL_OFF + 64); xcd_barrier(xb_); }
#ifdef PROBE_MASK
__global__ void __launch_bounds__(512) hybrid_fwd(Params pk) {
    extern __shared__ __attribute__((aligned(16))) unsigned char smem[];
    LAS unsigned char* lds = (LAS unsigned char*)smem;
    cg::grid_group grid = cg::this_grid();
    PPtr pc = (PPtr)__builtin_amdgcn_kernarg_segment_ptr();
    const int GB = pc->GB, MG = pc->MG, NGRP = pc->NGRP, LATR = GB * 2048;
    unsigned long long tacc = 0, t0_ = __builtin_amdgcn_s_memrealtime();
#define PT(kind) { const unsigned long long t1_ = __builtin_amdgcn_s_memrealtime(); if ((PROBE_MASK >> (kind)) & 1) tacc += t1_ - t0_; t0_ = t1_; }
    ph_prologue(pc, lds);
    grid.sync();
    XB_SETUP(); PT(0)
    for (int l = 0; l < DEPTH; ++l) {
        const int Mr = (l < DEPTH - 1) ? MG : LATR;
        for (int g = 0; g < NGRP; ++g) {
            ph_rowpass(pc, l, g, 1, MG, -1, lds);
            GSYNC(); PT(1)
            ph_inproj(pc, lds);
            GSYNC(); PT(2)
            { unsigned long long tsc = 0; ph_mixer(pc, l, g, lds, &tsc); if ((PROBE_MASK >> 11) & 1) tacc += tsc; }
            GSYNC(); PT(3)
            ph_post(pc, l, Mr);
            GSYNC(); PT(4)
            ph_branch(pc, Mr, lds);
            GSYNC(); PT(5)
            ph_gemm_f32(pc, 0, Mr, lds);
            GSYNC(); PT(6)
            ph_rowpass(pc, l, g, 2, Mr, -1, lds);
            GSYNC(); PT(7)
            ph_ffn1(pc, Mr, lds);
            GSYNC(); PT(8)
            ph_gemm_f32(pc, 1, Mr, lds);
            GSYNC(); PT(9)
            ph_rowpass(pc, l, g, 3, Mr, (g == NGRP - 1 && l + 1 < DEPTH) ? l + 1 : -1, lds);
            GSYNC(); PT(10)
        }
    }
    if (blockIdx.x == 0) { const unsigned M = (unsigned)(tacc / 100ull); float* o = pc->out; for (unsigned i2 = threadIdx.x; i2 < M; i2 += 512) o[i2] += 0.125f; }
}

#else
__global__ void __launch_bounds__(512) hybrid_fwd(Params pk) {
    extern __shared__ __attribute__((aligned(16))) unsigned char smem[];
    LAS unsigned char* lds = (LAS unsigned char*)smem;
    cg::grid_group grid = cg::this_grid();
    PPtr pc = (PPtr)__builtin_amdgcn_kernarg_segment_ptr();
    const int GB = pc->GB, MG = pc->MG, NGRP = pc->NGRP, LATR = GB * 2048;
    ph_prologue(pc, lds);
    grid.sync();
    XB_SETUP();
    for (int l = 0; l < DEPTH; ++l) {
        const int Mr = (l < DEPTH - 1) ? MG : LATR;
        for (int g = 0; g < NGRP; ++g) {
            if ((l == 0 && g == 0) || NGRP == 1) { ph_rowpass(pc, l, g, 1, MG, -1, lds); GSYNC(); }
            ph_inproj(pc, lds);
            GSYNC();
            ph_mixer(pc, l, g, lds);
            GSYNC();
            ph_post(pc, l, Mr);
            GSYNC();
            ph_branch(pc, Mr, lds);
            GSYNC();
            ph_gemm_f32(pc, 0, Mr, lds);
            GSYNC();
            ph_rowpass(pc, l, g, 2, Mr, -1, lds);
            GSYNC();
            ph_ffn1(pc, Mr, lds);
            GSYNC();
            ph_gemm_f32(pc, 1, Mr, lds);
            GSYNC();
            {
                const bool lastg = (g == NGRP - 1);
                const int nl = (NGRP == 1) ? -1 : (lastg ? (l + 1 < DEPTH ? l + 1 : -1) : l), ng = lastg ? 0 : g + 1;
                ph_rowpass_tail(pc, l, g, Mr, (lastg && l + 1 < DEPTH) ? l + 1 : -1, nl, ng, MG, lds);
            }
            if (!(l == DEPTH - 1 && g == NGRP - 1)) GSYNC();
        }
    }
}

#endif
extern "C" void kernel_launch(void* const* d_in, const int* in_sizes, int n_in, void* d_out, int out_size, void* d_ws, size_t ws_size, hipStream_t stream) {
    static int grid_blocks = 0;
    if (grid_blocks == 0) {
        int dev = 0, cus = 0, per_cu = 0;
        hipGetDevice(&dev);
        hipDeviceGetAttribute(&cus, hipDeviceAttributeMultiprocessorCount, dev);
        if (hipFuncSetAttribute((const void*)hybrid_fwd, hipFuncAttributeMaxDynamicSharedMemorySize, LDS_BYTES) != hipSuccess) fprintf(stderr, "hipFuncSetAttribute failed\n");
        if (hipOccupancyMaxActiveBlocksPerMultiprocessor(&per_cu, (const void*)hybrid_fwd, 512, LDS_BYTES) != hipSuccess || per_cu < 1) { fprintf(stderr, "occupancy query: %d\n", per_cu); per_cu = 1; }
        (void)hipGetLastError();
        grid_blocks = cus * 1;
        if (grid_blocks <= 0) grid_blocks = 256;
    }
    Params p{};
    const float* const* in = (const float* const*)d_in;
    p.x = in[0]; p.c = in[1]; p.ctx = in[2]; p.c_ctx = in[3]; p.w_mod = in[4]; p.b_mod = in[5]; p.norm_gains = in[6]; p.w_in = in[7]; p.a_sink = in[8]; p.b_rel_bias = in[9];
    p.c_lb = in[10]; p.c_norm = in[11]; p.d_gate_up = in[12]; p.d_gate_bias = in[13]; p.d_norm = in[14]; p.w_branch = in[15]; p.w_out = in[16]; p.w_ff1 = in[17]; p.w_ff2 = in[18];
    p.out = (float*)d_out; p.ws = (unsigned char*)d_ws;
    auto al = [](unsigned long long v) { return (v + 255ull) & ~255ull; };
    unsigned long long off = 32768;
    p.o_mod = off; off = al(off + 4ull * 17 * 6144 * 4);
    p.o_lb = off; off = al(off + 4ull * 512 * 4);
    p.o_rope = off; off = al(off + 2048ull * 4);
    p.o_xc = off; off = al(off + 4096ull * 1024 * 4);
    p.o_win = off; off = al(off + (unsigned long long)ZW * 1024 * 2);
    p.o_wb = off; off = al(off + 4096ull * 512 * 2);
    p.o_wo = off; off = al(off + 1024ull * 1024 * 2);
    p.o_w1 = off; off = al(off + 4096ull * 1024 * 2);
    p.o_w2 = off; off = al(off + 1024ull * 4096 * 2);
    p.o_wo4 = off; off = al(off + 1024ull * 4096 * 2);
    const unsigned long long fixed = off;
    int GB = 8;
    for (; GB > 1; GB >>= 1) {
        const unsigned long long MGt = (unsigned long long)GB * 2304;
        const unsigned long long need = fixed + MGt * (2048ull + (unsigned long long)ZW * 2 + 4096ull + 2048ull) + (unsigned long long)GB * 10 * 64 * VTS * 2 + 8 * 256;
        if (need <= (unsigned long long)ws_size) break;
    }
    p.GB = GB; p.NGRP = 16 / GB; p.MG = GB * 2304;
    const unsigned long long MGu = (unsigned long long)p.MG;
    p.o_h = off; off = al(off + MGu * 1024 * 2);
    p.o_z = off; off = al(off + MGu * ZW * 2);
    p.o_y4 = off; off = al(off + MGu * 2048 * 2);
    p.o_ob = off; off = al(off + MGu * 1024 * 2);
    p.o_vta = off; off = al(off + (unsigned long long)GB * 2 * 64 * VTS * 2);
    p.o_vtb = off; off = al(off + (unsigned long long)GB * 8 * 64 * VTS * 2);
    hipMemsetAsync(d_ws, 0, 32768, stream);
    void* args[] = {&p};
    hipError_t e = hipLaunchCooperativeKernel((const void*)hybrid_fwd, dim3(grid_blocks), dim3(512), args, LDS_BYTES, stream);
    if (e != hipSuccess) fprintf(stderr, "cooperative launch failed: %s (grid %d)\n", hipGetErrorString(e), grid_blocks);
}
```

```cpp
#include <hip/hip_runtime.h>
#include <hip/hip_cooperative_groups.h>
#include <cstdio>
namespace cg = cooperative_groups;
__device__ __forceinline__ int ltid() { int t = (int)threadIdx.x; asm volatile("" : "+v"(t)); return t; }
#define LAS __attribute__((address_space(3)))
namespace pg8 {
#define PG8_LAS __attribute__((address_space(3)))
typedef unsigned short bf16_t;
typedef short bf16x8 __attribute__((ext_vector_type(8)));
typedef float f32x4 __attribute__((ext_vector_type(4)));
typedef unsigned u32x4 __attribute__((ext_vector_type(4)));
constexpr int BM = 256, BK = 64, HALF = 128, HTB = HALF * BK * 2  , STAGE_BYTES = 8 * HTB, NXCD = 8, WGM = 8;

__host__ __device__ __forceinline__ int lds_byte(int r, int c) { const int st = (r >> 4) * 2 + (c >> 5), rr = r & 15, cc = c & 31, ob = rr * 64 + cc * 2; return st * 1024 + (ob ^ (((ob >> 9) & 1) << 5)); }
__host__ __device__ __forceinline__ void stage_rc(int b, int& R, int& C) { const int st = b / 1024, sb = b % 1024, swz = sb ^ (((sb >> 9) & 1) << 5); R = (st >> 1) * 16 + swz / 64; C = (st & 1) * 32 + (swz % 64) / 2; }
__host__ __device__ __forceinline__ int perm32(int rho) { const int n = rho >> 4, i = rho & 15; return 8 * (i >> 2) + 4 * n + (i & 3); }

struct Unit { int pm, pn, ko; };
struct Gemm { const bf16_t* A; const bf16_t* Bt; int M, N, K, Kl; };

struct StaticOrder {
    int nM, nN, nwg, G, c;
    __host__ __device__ void init(int M, int N, int G_, int c_) { nM = M / BM; nN = N / BM; nwg = nM * nN; G = G_; c = c_; }
    __host__ __device__ bool next(int i, Unit& u) const {
        const long L = (long)i * G + c; if (L >= nwg) return false;
        int wgid = (int)L; { const int q = nwg / NXCD, r = nwg % NXCD, xcd = wgid % NXCD, off = wgid / NXCD; wgid = (xcd < r ? xcd * (q + 1) : r * (q + 1) + (xcd - r) * q) + off; }
        const int nig = WGM * nN, gid = wgid / nig, fm = gid * WGM, gsz = (nM - fm) < WGM ? (nM - fm) : WGM;
        u.pm = fm + ((wgid % nig) % gsz); u.pn = (wgid % nig) / gsz; u.ko = 0; return true;
    }
    __device__ __forceinline__ void a_ready(const Unit&) const {}
    __device__ __forceinline__ void done(const Unit&) const {}
};
__device__ __forceinline__ unsigned cvt_pk_bf16(float lo, float hi) { unsigned r; asm volatile("v_cvt_pk_bf16_f32 %0, %1, %2" : "=v"(r) : "v"(lo), "v"(hi)); return r; }
struct EpiF32 {
    static constexpr bool PERM = false, AFTER_DRAIN = false;
    float* C; int ldc; const float* bias;
    __device__ __forceinline__ void operator()(const f32x4 (&acc)[2][2][4][2], const Unit& u, int wr, int wc, int fr, int fq) const {
        const int row0 = u.pm * BM + wr * 64 + fr, col0 = u.pn * BM + wc * 32 + 4 * fq;
        f32x4 bv[2][2];
#pragma unroll
        for (int bj = 0; bj < 2; ++bj)
#pragma unroll
            for (int n = 0; n < 2; ++n) bv[bj][n] = bias ? *(const f32x4*)(bias + col0 + bj * HALF + n * 16) : (f32x4){0.f, 0.f, 0.f, 0.f};
#pragma unroll
        for (int ai = 0; ai < 2; ++ai)
#pragma unroll
            for (int m = 0; m < 4; ++m) { float* rowp = C + (size_t)(row0 + ai * HALF + m * 16) * ldc + col0;
#pragma unroll
                for (int bj = 0; bj < 2; ++bj)
#pragma unroll
                    for (int n = 0; n < 2; ++n) *(f32x4*)(rowp + bj * HALF + n * 16) = acc[ai][bj][m][n] + bv[bj][n]; }
    }
};
template <class Epi, class Sched, bool STAMP = false>
__device__ __forceinline__ void gemm_phase(PG8_LAS unsigned char* lds, const Gemm g, const Sched& S, const Epi& E, unsigned long long* stamps) {
    const int tid = ltid(), wid = __builtin_amdgcn_readfirstlane(tid >> 6), lane = tid & 63, wr = wid >> 2, wc = wid & 3, fr = lane & 15, fq = lane >> 4;
    const int K = g.K, nt = g.Kl / BK;
    int ts_lo = 0, ts_hi = 0, nts = 0; const unsigned long long rt_entry = STAMP ? (unsigned long long)wall_clock64() : 0ull;
#define PG8_STAMP() do { if (STAMP && wid == 0 && nts < 64) { const unsigned long long _c = (unsigned long long)clock64(); \
        ts_lo = (lane == nts) ? (int)(unsigned)_c : ts_lo; ts_hi = (lane == nts) ? (int)(unsigned)(_c >> 32) : ts_hi; ++nts; } } while (0)
    PG8_STAMP();
    unsigned voffA[2], voffB[2];
#pragma unroll
    for (int i = 0; i < 2; ++i) { int R, C; stage_rc(tid * 16 + i * 8192, R, C); const int Rb = Epi::PERM ? ((R & ~31) + perm32(R & 31)) : R;
        voffA[i] = (unsigned)(R * K + C) * 2u; voffB[i] = (unsigned)(Rb * K + C) * 2u; }
    const size_t kstep = (size_t)(BK * 2);
    const size_t hstep = (size_t)HALF * K * 2;
    const size_t tstep = 2 * hstep;
    const unsigned ldsw = (unsigned)wid * 1024u;
    const int aoff = lds_byte(wr * 64 + fr, fq * 8), boff = lds_byte(wc * 32 + fr, fq * 8);
#define PG8_SA(b, h) (((b) * 2 + (h)) * HTB)
#define PG8_SB(b, h) ((4 + (b) * 2 + (h)) * HTB)
#define PG8_STAGE(bufoff, gbase, voff) do { _Pragma("unroll") for (int _i = 0; _i < 2; ++_i) \
        __builtin_amdgcn_global_load_lds((const unsigned*)((const char*)(gbase) + (voff)[_i]), (PG8_LAS unsigned*)(lds + (bufoff) + ldsw + _i * 8192), 16, 0, 0); } while (0)
#define PG8_LDA(dst, b, h) do { _Pragma("unroll") for (int m = 0; m < 4; ++m) _Pragma("unroll") for (int k = 0; k < 2; ++k) dst[m][k] = *(const PG8_LAS bf16x8*)(lds + PG8_SA(b, h) + aoff + m * 2048 + k * 1024); } while (0)
#define PG8_LDB(dst, b, h) do { _Pragma("unroll") for (int n = 0; n < 2; ++n) _Pragma("unroll") for (int k = 0; k < 2; ++k) dst[n][k] = *(const PG8_LAS bf16x8*)(lds + PG8_SB(b, h) + boff + n * 2048 + k * 1024); } while (0)
#define PG8_MMA(ai, bj, At, Bt) do { __builtin_amdgcn_s_setprio(1); _Pragma("unroll") for (int m = 0; m < 4; ++m) _Pragma("unroll") for (int n = 0; n < 2; ++n) _Pragma("unroll") for (int k = 0; k < 2; ++k) \
        acc[ai][bj][m][n] = __builtin_amdgcn_mfma_f32_16x16x32_bf16(Bt[n][k], At[m][k], acc[ai][bj][m][n], 0, 0, 0); __builtin_amdgcn_s_setprio(0); } while (0)
#define PG8_WAIT_V(n) asm volatile("s_waitcnt vmcnt(" #n ")" ::: "memory")
#define PG8_WAIT_L(n) asm volatile("s_waitcnt lgkmcnt(" #n ")" ::: "memory")
#define PG8_BAR __builtin_amdgcn_s_barrier()
#define PG8_SCHED __builtin_amdgcn_sched_barrier(0)
    Unit cur, nxt; int ui = 0;
    if (!S.next(0, cur)) return;
    f32x4 acc[2][2][4][2];
#pragma unroll
    for (int a = 0; a < 2; ++a)
#pragma unroll
        for (int b = 0; b < 2; ++b)
#pragma unroll
            for (int m = 0; m < 4; ++m)
#pragma unroll
                for (int n = 0; n < 2; ++n) acc[a][b][m][n] = (f32x4){0.f, 0.f, 0.f, 0.f};
    bf16x8 At[4][2], B0[2][2], B1[2][2];
    const char* cA = (const char*)g.A + (size_t)cur.pm * tstep + (size_t)cur.ko * 2; const char* cB = (const char*)g.Bt + (size_t)cur.pn * tstep + (size_t)cur.ko * 2;
    S.a_ready(cur);
    PG8_STAGE(PG8_SB(0, 0), cB, voffB); PG8_STAGE(PG8_SA(0, 0), cA, voffA); PG8_STAGE(PG8_SB(0, 1), cB + hstep, voffB); PG8_STAGE(PG8_SA(0, 1), cA + hstep, voffA);
    if (wr == 1) PG8_BAR;
    PG8_WAIT_V(4); PG8_BAR;
    PG8_STAGE(PG8_SB(1, 0), cB + kstep, voffB); PG8_STAGE(PG8_SA(1, 0), cA + kstep, voffA); PG8_STAGE(PG8_SB(1, 1), cB + hstep + kstep, voffB);
    PG8_WAIT_V(6); PG8_BAR;
    PG8_STAMP();
    for (;;) {
        const bool has_next = S.next(ui + 1, nxt);
        const char* nA = has_next ? (const char*)g.A + (size_t)nxt.pm * tstep + (size_t)nxt.ko * 2 : cA; const char* nB = has_next ? (const char*)g.Bt + (size_t)nxt.pn * tstep + (size_t)nxt.ko * 2 : cB;
        for (int t = 0; t < nt; t += 2) {
            const bool last = (t == nt - 2);
            const char* a1 = cA + (size_t)(t + 1) * kstep;
            const char* a2 = last ? nA : cA + (size_t)(t + 2) * kstep; const char* b2 = last ? nB : cB + (size_t)(t + 2) * kstep;
            const char* a3 = a2 + kstep; const char* b3 = b2 + kstep;
            if (last && has_next) S.a_ready(nxt);
            PG8_LDB(B0, 0, 0); PG8_SCHED; PG8_LDA(At, 0, 0); PG8_STAGE(PG8_SA(1, 1), a1 + hstep, voffA);
            PG8_WAIT_L(8); PG8_BAR; PG8_WAIT_L(0); PG8_MMA(0, 0, At, B0); PG8_BAR; PG8_SCHED;
            PG8_LDB(B1, 0, 1); PG8_STAGE(PG8_SB(0, 0), b2, voffB);
            PG8_BAR; PG8_WAIT_L(0); PG8_MMA(0, 1, At, B1); PG8_BAR;
            PG8_LDA(At, 0, 1); PG8_STAGE(PG8_SA(0, 0), a2, voffA);
            PG8_BAR; PG8_WAIT_L(0); PG8_MMA(1, 0, At, B0); PG8_BAR; PG8_SCHED;
            PG8_STAGE(PG8_SB(0, 1), b2 + hstep, voffB);
            PG8_WAIT_V(6); PG8_BAR; PG8_MMA(1, 1, At, B1); PG8_BAR;
            PG8_LDB(B0, 1, 0); PG8_SCHED; PG8_LDA(At, 1, 0); PG8_STAGE(PG8_SA(0, 1), a2 + hstep, voffA);
            PG8_WAIT_L(8); PG8_BAR; PG8_WAIT_L(0); PG8_MMA(0, 0, At, B0); PG8_BAR; PG8_SCHED;
            PG8_LDB(B1, 1, 1); PG8_STAGE(PG8_SB(1, 0), b3, voffB);
            PG8_BAR; PG8_WAIT_L(0); PG8_MMA(0, 1, At, B1); PG8_BAR;
            PG8_LDA(At, 1, 1); PG8_STAGE(PG8_SA(1, 0), a3, voffA);
            PG8_BAR; PG8_WAIT_L(0); PG8_MMA(1, 0, At, B0); PG8_BAR; PG8_SCHED;
            PG8_STAGE(PG8_SB(1, 1), b3 + hstep, voffB);
            PG8_WAIT_V(6); PG8_BAR; PG8_MMA(1, 1, At, B1); PG8_BAR;
        }
        PG8_STAMP();
        if constexpr (!Epi::AFTER_DRAIN) { E(acc, cur, wr, wc, fr, fq); S.done(cur); }
        PG8_STAMP();
        if (!has_next) break;
#pragma unroll
        for (int a = 0; a < 2; ++a)
#pragma unroll
            for (int b = 0; b < 2; ++b)
#pragma unroll
                for (int m = 0; m < 4; ++m)
#pragma unroll
                    for (int n = 0; n < 2; ++n) acc[a][b][m][n] = (f32x4){0.f, 0.f, 0.f, 0.f};
        cur = nxt; cA = nA; cB = nB; ++ui;
    }
    PG8_WAIT_V(0);
    if (wr == 0) PG8_BAR;
    PG8_BAR;
    if constexpr (Epi::AFTER_DRAIN) { E.fused(acc, cur, wr, wc, fr, fq, lds, wid, lane); S.done(cur); }
    PG8_STAMP();
    if (STAMP && wid == 0) { stamps[lane] = lane < nts ? (((unsigned long long)(unsigned)ts_hi << 32) | (unsigned)ts_lo) : 0ull;
        if (lane == 62) stamps[62] = rt_entry; if (lane == 63) stamps[63] = (unsigned long long)wall_clock64(); }
#undef PG8_STAMP
#undef PG8_SA
#undef PG8_SB
#undef PG8_STAGE
#undef PG8_LDA
#undef PG8_LDB
#undef PG8_MMA
#undef PG8_WAIT_V
#undef PG8_WAIT_L
#undef PG8_BAR
#undef PG8_SCHED
}
}
#define XB_TMO      128
#define XB_XCNT(j)  (256  + 64 * (j))
#define XB_XSUB(j)  (1280 + 64 * (j))
#define XB_XGEN(j)  (2304 + 64 * (j))
#define XB_TOP      3328
#define XB_TOPGEN   3392
#define XCD_BAR_WORDS 3456
#define XB_SPIN_CAP (1u << 18)

__device__ __forceinline__ unsigned xb_ld(unsigned* p)              { return __hip_atomic_load(p, __ATOMIC_RELAXED, __HIP_MEMORY_SCOPE_AGENT); }
__device__ __forceinline__ unsigned xb_add(unsigned* p, unsigned v) { return __hip_atomic_fetch_add(p, v, __ATOMIC_RELAXED, __HIP_MEMORY_SCOPE_AGENT); }
__device__ __forceinline__ unsigned xb_xcc_id() { return (unsigned)__builtin_amdgcn_s_getreg((3 << 11) | 20) & 0xFu; }
#define XB_SPIN(cond, bar) do { unsigned _sp = 0; while (cond) { __builtin_amdgcn_s_sleep(1); \
    if ((++_sp & 255u) == 0u) { if (xb_ld(&(bar)[XB_TMO])) break; if (_sp > XB_SPIN_CAP) { atomicAdd(&(bar)[XB_TMO], 1u); break; } } } } while (0)

struct XcdBarrier {
    unsigned* bar; unsigned x;
    volatile LAS unsigned* st;
};

__device__ __forceinline__ XcdBarrier xcd_barrier_post(unsigned* bar, volatile LAS unsigned* st) {
    XcdBarrier b; b.bar = bar; b.x = xb_xcc_id(); b.st = st;
    if (threadIdx.x == 0) (void)xb_add(&bar[XB_XCNT(b.x)], 1u);
    return b;
}
__device__ __forceinline__ void xcd_barrier_complete(unsigned* bar, unsigned x, unsigned& nloc, unsigned& nx) {
    const unsigned G = gridDim.x * gridDim.y * gridDim.z;
    unsigned sum, cnt, mine, sp = 0u;
    for (;;) {
        sum = 0u; cnt = 0u; mine = 0u;
#pragma unroll
        for (unsigned j = 0; j < 16; ++j) { const unsigned c = xb_ld(&bar[XB_XCNT(j)]); sum += c; cnt += (c > 0u) ? 1u : 0u; mine = (j == x) ? c : mine; }
        if (sum == G) break;
        __builtin_amdgcn_s_sleep(1);
        if ((++sp & 255u) == 0u) { if (xb_ld(&bar[XB_TMO])) break; if (sp > XB_SPIN_CAP) { atomicAdd(&bar[XB_TMO], 1u); break; } }
    }
    nloc = mine > 0u ? mine : 1u; nx = cnt > 0u ? cnt : 1u;
}

__device__ __forceinline__ void xcd_barrier(const XcdBarrier& b) {
    asm volatile("s_waitcnt vmcnt(0)" ::: "memory");
    __syncthreads();
    if (threadIdx.x == 0) {
        unsigned* bar = b.bar;
        __builtin_amdgcn_s_waitcnt(0);
        unsigned nloc = b.st[0], nx = b.st[1];
        if (nloc == 0u) { xcd_barrier_complete(bar, b.x, nloc, nx); b.st[0] = nloc; b.st[1] = nx; }
        const unsigned old = xb_add(&bar[XB_XSUB(b.x)], 1u);
        const unsigned gen = old / nloc;
        if (old + 1u == (gen + 1u) * nloc) {
            __builtin_amdgcn_fence(__ATOMIC_RELEASE, "agent");
            asm volatile("s_waitcnt vmcnt(0)" ::: "memory");
            const unsigned og = xb_add(&bar[XB_TOP], 1u);
            const unsigned tg = og / nx;
            if (og + 1u == (tg + 1u) * nx) xb_add(&bar[XB_TOPGEN], 1u);
            else XB_SPIN(xb_ld(&bar[XB_TOPGEN]) == tg, bar);
            __builtin_amdgcn_fence(__ATOMIC_ACQUIRE, "agent");
            xb_add(&bar[XB_XGEN(b.x)], 1u);
            asm volatile("s_waitcnt vmcnt(0)" ::: "memory");
        } else {
            XB_SPIN(xb_ld(&bar[XB_XGEN(b.x)]) == gen, bar);
            __builtin_amdgcn_fence(__ATOMIC_ACQUIRE, "agent");
            asm volatile("s_waitcnt vmcnt(0)" ::: "memory");
        }
    }
    __syncthreads();
}

typedef unsigned short bf16_t;
typedef pg8::bf16x8 bf16x8;
typedef pg8::f32x4 f32x4;
typedef pg8::u32x4 u32x4;
typedef unsigned u32x2 __attribute__((ext_vector_type(2)));

constexpr int DM = 1024, NB = 16, SEQ = 2048, DEPTH = 4, CTXL = 256, DFF = 4096;
constexpr int ZW = 10752;
constexpr int INW = 10528;
constexpr int ZA_Q = 0, ZA_K = 512, ZA_V = 640, ZB_Q = 768, ZB_K = 1280, ZB_V = 1792, ZC_Q = 2304, ZC_FF = 2816, ZC_FB = 3328, ZC_I = 3840, ZC_G = 4352,
              ZD_Q = 4864, ZD_K = 5120, ZD_V = 5376, ZD_GK = 5888, ZD_G = 6016, ZMERGE = 6656;
constexpr int VTS = 2304;
constexpr int LDS_BYTES = 144 * 1024;
constexpr int CTRL_OFF = LDS_BYTES - 256;
constexpr float EPS = 1e-6f;
constexpr float LOG2E = 1.4426950408889634f;
constexpr float QSCALE2 = 0.125f * LOG2E;

struct Params {
    const float *x, *c, *ctx, *c_ctx, *w_mod, *b_mod, *norm_gains, *w_in, *a_sink, *b_rel_bias, *c_lb, *c_norm, *d_gate_up, *d_gate_bias, *d_norm, *w_branch, *w_out, *w_ff1, *w_ff2;
    float* out;
    unsigned char* ws;
    unsigned long long o_mod, o_lb, o_rope, o_xc, o_win, o_wb, o_wo, o_w1, o_w2, o_h, o_z, o_y4, o_ob, o_vta, o_vtb, o_wo4;
    int GB, NGRP, MG, pad0;
};
typedef const Params __attribute__((address_space(4)))* PPtr;

__device__ __forceinline__ float bf2f(unsigned v) { return __uint_as_float(v << 16); }
__device__ __forceinline__ bf16_t f2bf(float f) { unsigned u = __float_as_uint(f); u += 0x7FFFu + ((u >> 16) & 1u); return (bf16_t)(u >> 16); }
typedef __bf16 bf16v2_t __attribute__((ext_vector_type(2)));
typedef float f32v2_t __attribute__((ext_vector_type(2)));
__device__ __forceinline__ unsigned pk2(float lo, float hi) { const f32v2_t v = {lo, hi}; const bf16v2_t b = __builtin_convertvector(v, bf16v2_t); return __builtin_bit_cast(unsigned, b); }
template <int CTRL> __device__ __forceinline__ float dpp(float x) { return __builtin_bit_cast(float, __builtin_amdgcn_mov_dpp(__builtin_bit_cast(int, x), CTRL, 0xf, 0xf, true)); }
constexpr int XOR1 = 0xB1, XOR2 = 0x4E, XOR7 = 0x141, XOR8 = 0x128;
__device__ __forceinline__ float xrow16_max(float x) {
    auto s = __builtin_amdgcn_permlane16_swap(__float_as_uint(x), __float_as_uint(x), false, false);
    x = fmaxf(__uint_as_float(s[0]), __uint_as_float(s[1]));
    auto t = __builtin_amdgcn_permlane32_swap(__float_as_uint(x), __float_as_uint(x), false, false);
    return fmaxf(__uint_as_float(t[0]), __uint_as_float(t[1]));
}
__device__ __forceinline__ float xrow16_sum(float x) {
    auto s = __builtin_amdgcn_permlane16_swap(__float_as_uint(x), __float_as_uint(x), false, false);
    x = __uint_as_float(s[0]) + __uint_as_float(s[1]);
    auto t = __builtin_amdgcn_permlane32_swap(__float_as_uint(x), __float_as_uint(x), false, false);
    return __uint_as_float(t[0]) + __uint_as_float(t[1]);
}
__device__ __forceinline__ float row16_sum(float v) {
    v += dpp<XOR1>(v); v += dpp<XOR2>(v); v += dpp<XOR7>(v); v += dpp<XOR8>(v);
    return v;
}
__device__ __forceinline__ float wave_sum(float v) { return xrow16_sum(row16_sum(v)); }
__device__ __forceinline__ float lo16(unsigned w) { return __uint_as_float(w << 16); }
__device__ __forceinline__ float hi16(unsigned w) { return __uint_as_float(w & 0xffff0000u); }
__device__ __forceinline__ float sigm(float x) { return __builtin_amdgcn_rcpf(1.0f + __builtin_amdgcn_exp2f(-LOG2E * x)); }
__device__ __forceinline__ float fexp(float x) { return __builtin_amdgcn_exp2f(x * LOG2E); }
__device__ __forceinline__ float flog(float x) { return __builtin_amdgcn_logf(x) * 0.6931471805599453f; }
__device__ __forceinline__ bf16_t f2bf1(float x) { return (bf16_t)pk2(x, 0.f); }

__device__ __forceinline__ int src_col(int n) {
    if (n < 640) {
        const int p = n & 63, base = n - p, pp = p >> 1, wh = p & 1;
        const int dim = (pp < 16) ? (wh ? 16 + pp : pp) : (wh ? 48 + (pp - 16) : 32 + (pp - 16));
        return base + dim;
    }
    if (n < 5920) return n;
    if (n < 6016) return -1;
    if (n < 6528) return n - 96;
    if (n < 6656) return -1;
    return 6432 + (n - 6656);
}

__device__ __forceinline__ void conv_tile(const float* src, int Nsrc, int k0, int n0, bool inmap, bf16_t* dst, int Kd, LAS float* t) {
    const int tid = ltid(), nl = tid & 63, ks = tid >> 6;
    const int sc = inmap ? src_col(n0 + nl) : (n0 + nl);
#pragma unroll
    for (int i = 0; i < 8; ++i) { const int kk = ks + 8 * i; t[nl * 65 + kk] = (sc >= 0) ? src[(size_t)(k0 + kk) * Nsrc + sc] : 0.f; }
    __syncthreads();
    const int kl = (tid & 31) * 2, ns = tid >> 5;
#pragma unroll
    for (int i = 0; i < 4; ++i) { const int n = ns + 16 * i; *(unsigned*)(dst + (size_t)(n0 + n) * Kd + k0 + kl) = pk2(t[n * 65 + kl], t[n * 65 + kl + 1]); }
    __syncthreads();
}
__device__ __forceinline__ void convert_weights(PPtr p, int l, LAS unsigned char* lds) {
    LAS float* t = (LAS float*)lds;
    bf16_t* WinT = (bf16_t*)(p->ws + p->o_win); bf16_t* WbT = (bf16_t*)(p->ws + p->o_wb); bf16_t* WoT = (bf16_t*)(p->ws + p->o_wo);
    bf16_t* W1T = (bf16_t*)(p->ws + p->o_w1); bf16_t* W2T = (bf16_t*)(p->ws + p->o_w2);
    constexpr int T_IN = 16 * 168, T_BR = 4 * 8 * 16, T_O = 16 * 16, T_1 = 16 * 64, T_2 = 64 * 16, T_ALL = T_IN + T_BR + T_O + T_1 + T_2;
    for (int it = blockIdx.x; it < T_ALL; it += gridDim.x) {
        int r = it;
        if (r < T_IN) { const int kb = r / 168, nb = r % 168; conv_tile(p->w_in + (size_t)l * 1024 * INW, INW, kb * 64, nb * 64, true, WinT, 1024, t); continue; } r -= T_IN;
        if (r < T_BR) { const int j = r / 128, q = r % 128, kb = q / 16, nb = q % 16; conv_tile(p->w_branch + (size_t)(l * 4 + j) * 512 * 1024, 1024, kb * 64, nb * 64, false, WbT + (size_t)j * 1024 * 512, 512, t); continue; } r -= T_BR;
        if (r < T_O) { const int kb = r / 16, nb = r % 16; conv_tile(p->w_out + (size_t)l * 1024 * 1024, 1024, kb * 64, nb * 64, false, WoT, 1024, t);
#pragma unroll 1
            for (int cpy = 0; cpy < 4; ++cpy) conv_tile(p->w_out + (size_t)l * 1024 * 1024, 1024, kb * 64, nb * 64, false, (bf16_t*)(p->ws + p->o_wo4) + cpy * 1024, 4096, t);
            continue; } r -= T_O;
        if (r < T_1) { const int kb = r / 64, nb = r % 64; conv_tile(p->w_ff1 + (size_t)l * 1024 * 4096, 4096, kb * 64, nb * 64, false, W1T, 1024, t); continue; } r -= T_1;
        { const int kb = r / 16, nb = r % 16; conv_tile(p->w_ff2 + (size_t)l * 4096 * 1024, 1024, kb * 64, nb * 64, false, W2T, 4096, t); }
    }
}

__device__ __forceinline__ void prologue(PPtr p, LAS unsigned char* lds) {
    const int tid = ltid();
    if (blockIdx.x == 0) {
        atomicExch((unsigned*)p->ws + tid, 0u);
        for (int i = tid; i < XCD_BAR_WORDS; i += 512) __hip_atomic_store((unsigned*)(p->ws + 4096) + i, 0u, __ATOMIC_RELAXED, __HIP_MEMORY_SCOPE_AGENT);
    }
    if (tid < 4) *((LAS unsigned*)(lds + CTRL_OFF + 64) + tid) = 0u;
    float* modb = (float*)(p->ws + p->o_mod);
    LAS float* sl = (LAS float*)lds;
    LAS float* red = sl + 17 * 1024;
    bool loaded = false;
    for (int task = blockIdx.x; task < 192; task += gridDim.x) {
        if (!loaded) {
            for (int i = tid; i < 17 * 1024; i += 512) { const int b = i >> 10, k = i & 1023; const float v = (b < 16) ? p->c[b * 1024 + k] : p->c_ctx[k]; sl[i] = v * sigm(v); }
            loaded = true;
        }
        __syncthreads();
        const int l = task / 48, nc = task % 48, nn = tid & 127, n = nc * 128 + nn, kq = tid >> 7;
        float acc[17];
#pragma unroll
        for (int b = 0; b < 17; ++b) acc[b] = 0.f;
        const float* w = p->w_mod + ((size_t)l * 1024 + kq * 256) * 6144 + n;
#pragma unroll 1
        for (int k = 0; k < 256; k += 4) {
            const float w0 = w[(size_t)k * 6144], w1 = w[(size_t)(k + 1) * 6144], w2 = w[(size_t)(k + 2) * 6144], w3 = w[(size_t)(k + 3) * 6144];
#pragma unroll
            for (int b = 0; b < 17; ++b) { const f32x4 sv = *(const LAS f32x4*)(sl + b * 1024 + kq * 256 + k); acc[b] += (sv.x * w0 + sv.y * w1) + (sv.z * w2 + sv.w * w3); }
        }
#pragma unroll
        for (int b = 0; b < 17; ++b) red[(kq * 17 + b) * 128 + nn] = acc[b];
        __syncthreads();
        if (kq == 0) {
            const float bm = p->b_mod[l * 6144 + n];
#pragma unroll
            for (int b = 0; b < 17; ++b) modb[((size_t)l * 17 + b) * 6144 + n] = red[b * 128 + nn] + red[(17 + b) * 128 + nn] + red[(34 + b) * 128 + nn] + red[(51 + b) * 128 + nn] + bm;
        }
        __syncthreads();
    }
    if (blockIdx.x == gridDim.x - 1) {
        float* lb = (float*)(p->ws + p->o_lb);
        {
            const int ch = tid;
            float v[4], mx = -1e30f;
#pragma unroll
            for (int l = 0; l < 4; ++l) { v[l] = p->c_lb[l * 512 + ch]; mx = fmaxf(mx, v[l]); }
            float s = 0.f;
#pragma unroll
            for (int l = 0; l < 4; ++l) { v[l] = __expf(v[l] - mx); s += v[l]; }
            const float inv = 1.0f / s, s0 = v[0] * inv; float cum = 0.f;
#pragma unroll
            for (int l = 0; l < 4; ++l) { cum += v[l] * inv; lb[l * 512 + ch] = cum - s0; }
        }
        float* rt = (float*)(p->ws + p->o_rope);
        for (int i = tid; i < 1024; i += 512) {
            const int n = i >> 4, f = i & 15;
            const float inv = __expf(-((float)(2 * f) / 32.0f) * 9.210340371976184f);
            const float a = (float)n * inv;
            const float kf = rintf(a * 0.15915494309189535f);
            const float rr = fmaf(-kf, 6.2831854820251465f, a) + kf * 1.7484556e-7f;
            rt[i] = __cosf(rr); rt[1024 + i] = __sinf(rr);
        }
    }
    __syncthreads();
    convert_weights(p, 0, lds);
}

__device__ __forceinline__ void rowpass(PPtr p, int l, int g, int mode, int nrows) {
    const int lane = ltid() & 63, gw = blockIdx.x * 8 + (ltid() >> 6), NGW = gridDim.x * 8;
    const int LATR = p->GB * 2048, GB = p->GB;
    const float* ng = p->norm_gains + (size_t)l * 4 * 1024;
    const float* modb = (const float*)(p->ws + p->o_mod) + (size_t)l * 17 * 6144;
    bf16_t* hb = (bf16_t*)(p->ws + p->o_h);
    const float* yf = (const float*)(p->ws + p->o_z);
    float* xcb = (float*)(p->ws + p->o_xc);
    const bool first = (l == 0 && mode <= 2);
    const float* xlat = first ? p->x : (const float*)p->out;
    const float* xctx = first ? p->ctx : (const float*)xcb;
    auto xsrc = [&](int row) -> const float* {
        if (row < LATR) return xlat + ((size_t)(g * GB + (row >> 11)) * 2048 + (row & 2047)) * 1024;
        const int r2 = row - LATR; return xctx + ((size_t)(g * GB + (r2 >> 8)) * 256 + (r2 & 255)) * 1024;
    };
    const bf16_t* slab = (const bf16_t*)(p->ws + p->o_z + (size_t)p->MG * 12288);
    const size_t slab_stride = (size_t)(p->MG - LATR) * 1024;
    auto yload = [&](int row, f32x4 (&yv)[4]) {
        if (row < LATR) {
            const bf16_t* yb = (const bf16_t*)yf + (size_t)row * 1024 + lane * 4;
#pragma unroll
            for (int j = 0; j < 4; ++j) { const u32x2 w = __builtin_nontemporal_load((const u32x2*)(yb + 256 * j)); yv[j] = (f32x4){lo16(w.x), hi16(w.x), lo16(w.y), hi16(w.y)}; }
        } else {
            const bf16_t* s0 = slab + (size_t)(row - LATR) * 1024 + lane * 4;
#pragma unroll
            for (int j = 0; j < 4; ++j) { const u32x2 w = *(const u32x2*)(s0 + 256 * j); yv[j] = (f32x4){lo16(w.x), hi16(w.x), lo16(w.y), hi16(w.y)}; }
#pragma unroll
            for (int ks = 1; ks < 8; ++ks)
#pragma unroll
                for (int j = 0; j < 4; ++j) { const u32x2 w = *(const u32x2*)(s0 + ks * slab_stride + 256 * j); yv[j] = yv[j] + (f32x4){lo16(w.x), hi16(w.x), lo16(w.y), hi16(w.y)}; }
        }
    };
    f32x4 xv[4], yv[4];
    int row = gw;
    if (row < nrows) {
        const float* xs = xsrc(row);
#pragma unroll
        for (int j = 0; j < 4; ++j) xv[j] = __builtin_nontemporal_load((const f32x4*)(xs + lane * 4 + 256 * j));
        if (mode >= 2) yload(row, yv);
    }
    while (row < nrows) {
        const int nrow = row + NGW;
        f32x4 xn[4], yn[4];
        if (nrow < nrows) {
            const float* xs = xsrc(nrow);
#pragma unroll
            for (int j = 0; j < 4; ++j) xn[j] = __builtin_nontemporal_load((const f32x4*)(xs + lane * 4 + 256 * j));
            if (mode >= 2) yload(nrow, yn);
        }
        const bool lat = row < LATR;
        int b; size_t xrow;
        if (lat) { b = g * GB + (row >> 11); xrow = (size_t)b * 2048 + (row & 2047); }
        else { const int r2 = row - LATR; b = g * GB + (r2 >> 8); xrow = (size_t)b * 256 + (r2 & 255); }
        float* xd = (lat ? p->out : xcb) + xrow * 1024;
        const float* m = modb + (size_t)(lat ? b : 16) * 6144;
        f32x4 tgv[4], tnv[4], tsh[4], tsc[4], tn2[4];
        {
            const float* gate = m + (mode == 2 ? 2048 : 5120); const float* gn = ng + (mode == 2 ? 1024 : 3072);
            const float* sh = m + (mode == 1 ? 0 : 3072); const float* sc = m + (mode == 1 ? 1024 : 4096); const float* gn2 = ng + (mode == 1 ? 0 : 2048);
#pragma unroll
            for (int j = 0; j < 4; ++j) {
                const int c = lane * 4 + 256 * j;
                if (mode >= 2) { tgv[j] = *(const f32x4*)(gate + c); tnv[j] = *(const f32x4*)(gn + c); }
                if (mode <= 2) { tsh[j] = *(const f32x4*)(sh + c); tsc[j] = *(const f32x4*)(sc + c); tn2[j] = *(const f32x4*)(gn2 + c); }
            }
        }
        if (mode >= 2) {
            float ss = 0.f;
#pragma unroll
            for (int j = 0; j < 4; ++j) ss += yv[j].x * yv[j].x + yv[j].y * yv[j].y + yv[j].z * yv[j].z + yv[j].w * yv[j].w;
            ss = wave_sum(ss);
            const float rs = rsqrtf(ss * (1.0f / 1024.0f) + EPS);
#pragma unroll
            for (int j = 0; j < 4; ++j) {
                const int c = lane * 4 + 256 * j;
                const f32x4 gv = tgv[j], nv = tnv[j];
                xv[j] = xv[j] + gv * (yv[j] * rs * nv);
                __builtin_nontemporal_store(xv[j], (f32x4*)(xd + c));
            }
        }
        if (mode <= 2) {
            float ss = 0.f;
#pragma unroll
            for (int j = 0; j < 4; ++j) ss += xv[j].x * xv[j].x + xv[j].y * xv[j].y + xv[j].z * xv[j].z + xv[j].w * xv[j].w;
            ss = wave_sum(ss);
            const float rs = rsqrtf(ss * (1.0f / 1024.0f) + EPS);
#pragma unroll
            for (int j = 0; j < 4; ++j) {
                const int c = lane * 4 + 256 * j;
                const f32x4 shv = tsh[j], scv = tsc[j], nv = tn2[j];
                const f32x4 hv = (xv[j] * rs * nv) * (scv + 1.0f) + shv;
                u32x2 o; o.x = pk2(hv.x, hv.y); o.y = pk2(hv.z, hv.w);
                *(u32x2*)(hb + (size_t)row * 1024 + c) = o;
            }
        }
#pragma unroll
        for (int j = 0; j < 4; ++j) { xv[j] = xn[j]; yv[j] = yn[j]; }
        row = nrow;
    }
}

struct EpiInproj {
    static constexpr bool PERM = true, AFTER_DRAIN = false;
    bf16_t* Z; bf16_t* vta; bf16_t* vtb; const float* rope; int GB;
    __device__ __forceinline__ void operator()(const f32x4 (&acc)[2][2][4][2], const pg8::Unit& u, int wr, int wc, int fr, int fq) const {
        const int row0 = u.pm * 256 + wr * 64 + fr, LATR = GB * 2048;
#pragma unroll
        for (int bj = 0; bj < 2; ++bj) {
            const int seg = u.pn * 2 + bj, c0 = u.pn * 256 + bj * 128 + wc * 32 + 8 * fq;
            const int type = (seg <= 4) ? 1 : (seg == 5 ? 2 : ((seg >= 14 && seg <= 17) ? 3 : 0));
            const int xf = (seg <= 3 || (seg >= 6 && seg <= 9)) ? 1 : ((seg >= 18 && seg <= 21) ? 2 : ((seg >= 22 && seg <= 29) ? 3 : ((seg == 38 || seg == 39) ? 4 : 0)));
#pragma unroll
            for (int ai = 0; ai < 2; ++ai)
#pragma unroll
                for (int m = 0; m < 4; ++m) {
                    const int row = row0 + ai * 128 + m * 16;
                    f32x4 v0 = acc[ai][bj][m][0], v1 = acc[ai][bj][m][1];
                    if (type <= 1) {
                        if (type == 1 && row < LATR) {
                            const int t = row & 2047, pp0 = (c0 & 63) >> 1;
                            const int n = (pp0 < 16) ? (t >> 6) : (t & 63);
                            const float* cs = rope + n * 16 + (pp0 & 15);
                            const f32x4 cv = *(const f32x4*)cs, sv = *(const f32x4*)(cs + 1024);
                            f32x4 r0, r1;
                            r0.x = v0.x * cv.x - v0.y * sv.x; r0.y = v0.y * cv.x + v0.x * sv.x;
                            r0.z = v0.z * cv.y - v0.w * sv.y; r0.w = v0.w * cv.y + v0.z * sv.y;
                            r1.x = v1.x * cv.z - v1.y * sv.z; r1.y = v1.y * cv.z + v1.x * sv.z;
                            r1.z = v1.z * cv.w - v1.w * sv.w; r1.w = v1.w * cv.w + v1.z * sv.w;
                            v0 = r0; v1 = r1;
                        }
                        if (xf == 1) { v0 = v0 * QSCALE2; v1 = v1 * QSCALE2; }
                        else if (xf == 4) { v0 = v0 * 0.125f; v1 = v1 * 0.125f; }
                        else if (xf == 2) {
#pragma unroll
                            for (int e = 0; e < 4; ++e) { v0[e] = v0[e] * sigm(v0[e]); v1[e] = v1[e] * sigm(v1[e]); }
                        } else if (xf == 3) {
#pragma unroll
                            for (int e = 0; e < 4; ++e) { v0[e] = sigm(v0[e]); v1[e] = sigm(v1[e]); }
                        }
                        u32x4 w; w.x = pk2(v0.x, v0.y); w.y = pk2(v0.z, v0.w); w.z = pk2(v1.x, v1.y); w.w = pk2(v1.z, v1.w);
                        *(u32x4*)(Z + (size_t)row * ZW + c0) = w;
                    } else {
                        int bl, tok;
                        if (row < LATR) { bl = row >> 11; tok = row & 2047; } else { const int r2 = row - LATR; bl = r2 >> 8; tok = 2048 + (r2 & 255); }
                        const int cc = c0 - (type == 2 ? ZA_V : ZB_V), head = cc >> 6, dim0 = cc & 63, H = (type == 2) ? 2 : 8;
                        bf16_t* base = (type == 2 ? vta : vtb) + ((size_t)(bl * H + head) * 64 + dim0) * VTS + tok;
                        base[0 * VTS] = f2bf(v0.x); base[1 * VTS] = f2bf(v0.y); base[2 * VTS] = f2bf(v0.z); base[3 * VTS] = f2bf(v0.w);
                        base[4 * VTS] = f2bf(v1.x); base[5 * VTS] = f2bf(v1.y); base[6 * VTS] = f2bf(v1.z); base[7 * VTS] = f2bf(v1.w);
                    }
                }
        }
    }
};
struct EpiBranch {
    static constexpr bool PERM = true, AFTER_DRAIN = false;
    const bf16_t* Z; bf16_t* macc; int nMfull;
    __device__ __forceinline__ void operator()(const f32x4 (&acc)[2][2][4][2], const pg8::Unit& u, int wr, int wc, int fr, int fq) const {
        const int j = u.pm / nMfull, pm = u.pm - j * nMfull, pn = u.pn & 3;
        const int row0 = pm * 256 + wr * 64 + fr, col0 = pn * 256 + wc * 32 + 8 * fq;
        const bf16_t* gbase = Z + (size_t)row0 * ZW + ZMERGE + j * 1024 + col0;
        bf16_t* mbase = macc + (size_t)row0 * 1024 + col0;
#pragma unroll
        for (int ai = 0; ai < 2; ++ai) {
            u32x4 gw[4][2], pv[4][2];
#pragma unroll
            for (int m = 0; m < 4; ++m)
#pragma unroll
                for (int bj = 0; bj < 2; ++bj) {
                    const size_t ro = (size_t)(ai * 128 + m * 16);
                    gw[m][bj] = *(const u32x4*)(gbase + ro * ZW + bj * 128);
                    pv[m][bj] = (j > 0) ? *(const u32x4*)(mbase + ro * 1024 + bj * 128) : (u32x4){0u, 0u, 0u, 0u};
                }
#pragma unroll
            for (int m = 0; m < 4; ++m)
#pragma unroll
                for (int bj = 0; bj < 2; ++bj) {
                    const u32x4 g = gw[m][bj], q = pv[m][bj];
                    const f32x4 v0 = acc[ai][bj][m][0], v1 = acc[ai][bj][m][1];
                    const float t0 = v0.x * sigm(lo16(g.x)) + lo16(q.x), t1 = v0.y * sigm(hi16(g.x)) + hi16(q.x), t2 = v0.z * sigm(lo16(g.y)) + lo16(q.y), t3 = v0.w * sigm(hi16(g.y)) + hi16(q.y);
                    const float t4 = v1.x * sigm(lo16(g.z)) + lo16(q.z), t5 = v1.y * sigm(hi16(g.z)) + hi16(q.z), t6 = v1.z * sigm(lo16(g.w)) + lo16(q.w), t7 = v1.w * sigm(hi16(g.w)) + hi16(q.w);
                    u32x4 w; w.x = pk2(t0, t1); w.y = pk2(t2, t3); w.z = pk2(t4, t5); w.w = pk2(t6, t7);
                    *(u32x4*)(mbase + (size_t)(ai * 128 + m * 16) * 1024 + bj * 128) = w;
                }
        }
    }
};
struct BranchOrder {
    int nM, nMfull, G, c;
    __device__ __forceinline__ bool next(int i, pg8::Unit& u) const {
        const int j = i & 3; const int v = (c & 7) * (G >> 3) + (c >> 3);
        const long T = (long)(i >> 2) * G + v;
        if (T >= (long)nM * 4) return false;
        u.pm = j * nMfull + (int)(T >> 2); u.pn = j * 4 + (int)(T & 3); u.ko = 0; return true;
    }
    __device__ __forceinline__ void a_ready(const pg8::Unit&) const {}
    __device__ __forceinline__ void done(const pg8::Unit&) const {}
};
struct EpiBf16Y {
    static constexpr bool PERM = true, AFTER_DRAIN = false;
    bf16_t* O; int ldc;
    __device__ __forceinline__ void operator()(const f32x4 (&acc)[2][2][4][2], const pg8::Unit& u, int wr, int wc, int fr, int fq) const {
        const int row0 = u.pm * 256 + wr * 64 + fr, col0 = u.pn * 256 + wc * 32 + 8 * fq;
#pragma unroll
        for (int ai = 0; ai < 2; ++ai)
#pragma unroll
            for (int m = 0; m < 4; ++m) {
                bf16_t* rowp = O + (size_t)(row0 + ai * 128 + m * 16) * ldc + col0;
#pragma unroll
                for (int bj = 0; bj < 2; ++bj) {
                    const f32x4 v0 = acc[ai][bj][m][0], v1 = acc[ai][bj][m][1];
                    u32x4 w; w.x = pk2(v0.x, v0.y); w.y = pk2(v0.z, v0.w); w.z = pk2(v1.x, v1.y); w.w = pk2(v1.z, v1.w);
                    *(u32x4*)(rowp + bj * 128) = w;
                }
            }
    }
};
struct EpiRelu2 {
    static constexpr bool PERM = true, AFTER_DRAIN = false;
    bf16_t* O; int ldc;
    __device__ __forceinline__ void operator()(const f32x4 (&acc)[2][2][4][2], const pg8::Unit& u, int wr, int wc, int fr, int fq) const {
        const int row0 = u.pm * 256 + wr * 64 + fr, col0 = u.pn * 256 + wc * 32 + 8 * fq;
#pragma unroll
        for (int ai = 0; ai < 2; ++ai)
#pragma unroll
            for (int m = 0; m < 4; ++m) {
                bf16_t* rowp = O + (size_t)(row0 + ai * 128 + m * 16) * ldc + col0;
#pragma unroll
                for (int bj = 0; bj < 2; ++bj) {
                    f32x4 v0 = acc[ai][bj][m][0], v1 = acc[ai][bj][m][1];
#pragma unroll
                    for (int e = 0; e < 4; ++e) { const float a = fmaxf(v0[e], 0.f), b = fmaxf(v1[e], 0.f); v0[e] = a * a; v1[e] = b * b; }
                    u32x4 w; w.x = pk2(v0.x, v0.y); w.y = pk2(v0.z, v0.w); w.z = pk2(v1.x, v1.y); w.w = pk2(v1.z, v1.w);
                    *(u32x4*)(rowp + bj * 128) = w;
                }
            }
    }
};

struct CtxBranchOrder {
    int nMfull, pm0, nT, G, c;
    __device__ __forceinline__ bool next(int i, pg8::Unit& u) const {
        const long L = (long)i * G + c; if (L >= (long)nT * 4) return false;
        const int j = (int)(L & 3), t = (int)(L >> 2);
        u.pm = j * nMfull + pm0 + (t >> 2); u.pn = j * 4 + (t & 3); u.ko = 0; return true;
    }
    __device__ __forceinline__ void a_ready(const pg8::Unit&) const {}
    __device__ __forceinline__ void done(const pg8::Unit&) const {}
};
struct EpiBranchCtx {
    static constexpr bool PERM = true, AFTER_DRAIN = false;
    const bf16_t* Z; bf16_t* P; int nMfull, pm0;
    __device__ __forceinline__ void operator()(const f32x4 (&acc)[2][2][4][2], const pg8::Unit& u, int wr, int wc, int fr, int fq) const {
        const int j = u.pm / nMfull, pm = u.pm - j * nMfull, pn = u.pn & 3;
        const int row0 = pm * 256 + wr * 64 + fr, col0 = pn * 256 + wc * 32 + 8 * fq;
        const bf16_t* gbase = Z + (size_t)row0 * ZW + ZMERGE + j * 1024 + col0;
        bf16_t* pbase = P + (size_t)(row0 - pm0 * 256) * 4096 + j * 1024 + col0;
#pragma unroll
        for (int ai = 0; ai < 2; ++ai) {
            u32x4 gw[4][2];
#pragma unroll
            for (int m = 0; m < 4; ++m)
#pragma unroll
                for (int bj = 0; bj < 2; ++bj) gw[m][bj] = *(const u32x4*)(gbase + (size_t)(ai * 128 + m * 16) * ZW + bj * 128);
#pragma unroll
            for (int m = 0; m < 4; ++m)
#pragma unroll
                for (int bj = 0; bj < 2; ++bj) {
                    const u32x4 g = gw[m][bj];
                    const f32x4 v0 = acc[ai][bj][m][0], v1 = acc[ai][bj][m][1];
                    u32x4 w; w.x = pk2(v0.x * sigm(lo16(g.x)), v0.y * sigm(hi16(g.x))); w.y = pk2(v0.z * sigm(lo16(g.y)), v0.w * sigm(hi16(g.y)));
                    w.z = pk2(v1.x * sigm(lo16(g.z)), v1.y * sigm(hi16(g.z))); w.w = pk2(v1.z * sigm(lo16(g.w)), v1.w * sigm(hi16(g.w)));
                    *(u32x4*)(pbase + (size_t)(ai * 128 + m * 16) * 4096 + bj * 128) = w;
                }
        }
    }
};
struct SplitOrder {
    int pm0, nT, SPLIT, Kl, G, c;
    __device__ __forceinline__ bool next(int i, pg8::Unit& u) const {
        const long L = (long)i * G + c; if (L >= (long)nT * 4 * SPLIT) return false;
        const int ks = (int)(L % SPLIT), t = (int)(L / SPLIT);
        u.pm = pm0 + (t >> 2); u.pn = t & 3; u.ko = ks * Kl; return true;
    }
    __device__ __forceinline__ void a_ready(const pg8::Unit&) const {}
    __device__ __forceinline__ void done(const pg8::Unit&) const {}
};
struct EpiSlab {
    static constexpr bool PERM = true, AFTER_DRAIN = false;
    bf16_t* S; int pm0, nrows, Kl;
    __device__ __forceinline__ void operator()(const f32x4 (&acc)[2][2][4][2], const pg8::Unit& u, int wr, int wc, int fr, int fq) const {
        const int ks = u.ko / Kl;
        const int row0 = (u.pm - pm0) * 256 + wr * 64 + fr, col0 = u.pn * 256 + wc * 32 + 8 * fq;
        bf16_t* base = S + (size_t)ks * nrows * 1024;
#pragma unroll
        for (int ai = 0; ai < 2; ++ai)
#pragma unroll
            for (int m = 0; m < 4; ++m) { bf16_t* rowp = base + (size_t)(row0 + ai * 128 + m * 16) * 1024 + col0;
#pragma unroll
                for (int bj = 0; bj < 2; ++bj) {
                    const f32x4 v0 = acc[ai][bj][m][0], v1 = acc[ai][bj][m][1];
                    u32x4 w; w.x = pk2(v0.x, v0.y); w.y = pk2(v0.z, v0.w); w.z = pk2(v1.x, v1.y); w.w = pk2(v1.z, v1.w);
                    *(u32x4*)(rowp + bj * 128) = w;
                } }
    }
};

#define MFMA16(a, b, c) __builtin_amdgcn_mfma_f32_16x16x32_bf16((a), (b), (c), 0, 0, 0)
__device__ __forceinline__ void attn_wave(PPtr p, int l, int kind, int idx, int lane, const LAS float* biasL) {
    const int fr = lane & 15, fq = lane >> 4;
    const int LATR = p->GB * 2048, MG = p->MG;
    const bf16_t* Z = (const bf16_t*)(p->ws + p->o_z);
    const bool isA = (kind == 1 || kind == 2);
    int bl, hk, qrow0, r = 0, q0 = 0;
    if (kind == 0) { bl = idx >> 8; hk = (idx >> 5) & 7; r = idx & 31; qrow0 = bl * 2048 + r * 64; }
    else if (kind == 1) { bl = idx >> 8; hk = (idx >> 7) & 1; q0 = (idx & 127) * 16; qrow0 = bl * 2048 + q0; }
    else if (kind == 2) { bl = idx >> 5; hk = (idx >> 4) & 1; qrow0 = LATR + bl * 256 + (idx & 15) * 16; }
    else { bl = idx >> 5; hk = (idx >> 2) & 7; qrow0 = LATR + bl * 256 + (idx & 3) * 64; }
    const int qrstep = isA ? 0 : 16, qcstep = isA ? 64 : 0;
    const int qcol0 = isA ? (ZA_Q + hk * 4 * 64) : (ZB_Q + hk * 64);
    const int kcol = isA ? (ZA_K + hk * 64) : (ZB_K + hk * 64);
    const bf16_t* vt = isA ? ((const bf16_t*)(p->ws + p->o_vta) + (size_t)(bl * 2 + hk) * 64 * VTS) : ((const bf16_t*)(p->ws + p->o_vtb) + (size_t)(bl * 8 + hk) * 64 * VTS);
    bf16_t* yo = (bf16_t*)(p->ws + p->o_y4) + (isA ? (size_t)0 : (size_t)MG * 512);
    const int ocol0 = isA ? hk * 4 * 64 : hk * 64;
    const int krow_ctx0 = LATR + bl * 256, krow_lat0 = bl * 2048;

    bf16x8 Q[4][2];
#pragma unroll
    for (int s = 0; s < 4; ++s)
#pragma unroll
        for (int ks = 0; ks < 2; ++ks) Q[s][ks] = *(const bf16x8*)(Z + (size_t)(qrow0 + s * qrstep + fr) * ZW + qcol0 + s * qcstep + ks * 32 + fq * 8);
    f32x4 O[4][4]; float mrun[4], lrun[4];
#pragma unroll
    for (int s = 0; s < 4; ++s) { mrun[s] = -1e30f; lrun[s] = 0.f;
#pragma unroll
        for (int dt = 0; dt < 4; ++dt) O[s][dt] = (f32x4){0.f, 0.f, 0.f, 0.f}; }

    auto do_block = [&](int krow, int vtoff, int mode, int a0, int a1, bool first) {
        bf16x8 Kf[2][2];
#pragma unroll
        for (int kt = 0; kt < 2; ++kt)
#pragma unroll
            for (int ks = 0; ks < 2; ++ks) Kf[kt][ks] = *(const bf16x8*)(Z + (size_t)(krow + kt * 16 + fr) * ZW + kcol + ks * 32 + fq * 8);
        bf16x8 Vf[4];
#pragma unroll
        for (int dt = 0; dt < 4; ++dt) {
            const bf16_t* vp = vt + (size_t)(dt * 16 + fr) * VTS + vtoff + fq * 4;
            const u32x2 lo = *(const u32x2*)vp, hi = *(const u32x2*)(vp + 16);
            u32x4 w; w.x = lo.x; w.y = lo.y; w.z = hi.x; w.w = hi.y;
            Vf[dt] = __builtin_bit_cast(bf16x8, w);
        }
#pragma unroll
        for (int s = 0; s < 4; ++s) {
            const bool active = (mode != 2) || !((s == 0 && a1 == 1) || (s == 3 && a1 == 0));
            if (active) {
                f32x4 S0 = (f32x4){0.f, 0.f, 0.f, 0.f}, S1 = (f32x4){0.f, 0.f, 0.f, 0.f};
                S0 = MFMA16(Kf[0][0], Q[s][0], S0); S0 = MFMA16(Kf[0][1], Q[s][1], S0);
                S1 = MFMA16(Kf[1][0], Q[s][0], S1); S1 = MFMA16(Kf[1][1], Q[s][1], S1);
                float sc[8];
#pragma unroll
                for (int j = 0; j < 4; ++j) { sc[j] = S0[j]; sc[4 + j] = S1[j]; }
                if (mode == 1) {
                    if (a0 < q0 + 15 - 128 || a0 + 31 > q0 + 128) {
                        const int d0 = a0 + fq * 4 - (q0 + fr) + 128;
#pragma unroll
                        for (int e = 0; e < 8; ++e) { const unsigned d = (unsigned)(d0 + (e >> 2) * 16 + (e & 3)); if (d > 256u) sc[e] = -1e30f; }
                    }
                } else if (mode == 2) {
                    const int qc = 16 * s + fr; const int cs = min(max(qc - 8, 0), 48);
                    const int kc0 = a1 * 32 + fq * 4;
                    const LAS float* bp = biasL + hk * 465 + a0 * 31 + (kc0 - qc + 15);
                    const unsigned rel0 = (unsigned)(kc0 - cs);
#pragma unroll
                    for (int e = 0; e < 8; ++e) {
                        const int off = (e >> 2) * 16 + (e & 3);
                        const float bv = bp[off];
                        sc[e] = (rel0 + (unsigned)off < 16u) ? (sc[e] + bv) : -1e30f;
                    }
                }
                if (first) {
                    float ml = fmaxf(fmaxf(fmaxf(sc[0], sc[1]), fmaxf(sc[2], sc[3])), fmaxf(fmaxf(sc[4], sc[5]), fmaxf(sc[6], sc[7])));
                    mrun[s] = xrow16_max(ml);
                }
                const float mn = mrun[s];
                float pv[8], ls = 0.f;
#pragma unroll
                for (int e = 0; e < 8; ++e) { pv[e] = __builtin_amdgcn_exp2f(sc[e] - mn); ls += pv[e]; }
                ls = xrow16_sum(ls);
                lrun[s] += ls;
                u32x4 pw; pw.x = pk2(pv[0], pv[1]); pw.y = pk2(pv[2], pv[3]); pw.z = pk2(pv[4], pv[5]); pw.w = pk2(pv[6], pv[7]);
                const bf16x8 P = __builtin_bit_cast(bf16x8, pw);
#pragma unroll
                for (int dt = 0; dt < 4; ++dt) O[s][dt] = MFMA16(Vf[dt], P, O[s][dt]);
            }
            __builtin_amdgcn_sched_barrier(0);
        }
    };
    int nloc = 0, lo = 0, r0 = 0;
    if (kind == 1) { lo = max(0, q0 - 128) & ~31; const int hi = min(2048, (q0 + 16 + 128 + 31) & ~31); nloc = (hi - lo) >> 5; }
    else if (kind == 0) { r0 = min(max(r - 4, 0), 24); nloc = 16; }
#pragma unroll 1
    for (int i = 0; i < 8 + nloc; ++i) {
        int krow, vtoff, mode, a0, a1;
        if (i < 8) { krow = krow_ctx0 + 32 * i; vtoff = 2048 + 32 * i; mode = 0; a0 = 0; a1 = 0; }
        else if (kind == 1) { const int kb = lo + 32 * (i - 8); krow = krow_lat0 + kb; vtoff = kb; mode = 1; a0 = kb; a1 = 0; }
        else { const int jj = i - 8, kr = r0 + (jj >> 1), hb = jj & 1; krow = krow_lat0 + kr * 64 + hb * 32; vtoff = kr * 64 + hb * 32; mode = 2; a0 = kr - r + 7; a1 = hb; }
        do_block(krow, vtoff, mode, a0, a1, i == 0);
    }
#pragma unroll
    for (int s = 0; s < 4; ++s) {
        float fac;
        if (isA) { const float sk = p->a_sink[l * 8 + hk * 4 + s] * LOG2E; const float M = fmaxf(mrun[s], sk); const float e1 = __builtin_amdgcn_exp2f(mrun[s] - M); fac = e1 / (lrun[s] * e1 + __builtin_amdgcn_exp2f(sk - M)); }
        else fac = 1.0f / lrun[s];
        bf16_t* op = yo + (size_t)(qrow0 + s * qrstep + fr) * 512 + ocol0 + s * qcstep + fq * 4;
#pragma unroll
        for (int dt = 0; dt < 4; ++dt) { const f32x4 o = O[s][dt] * fac; u32x2 w; w.x = pk2(o.x, o.y); w.y = pk2(o.z, o.w); *(u32x2*)(op + dt * 16) = w; }
    }
}

constexpr int SCAN_BUF = 41472;
constexpr int BIAS_OFF = 3 * SCAN_BUF;
template <int DK, bool ISC>
__device__ __forceinline__ void scan_task(PPtr p, int l, int bl, int h, int dir, LAS unsigned char* lds) {
    constexpr int KPW = DK / 8, NTG = 64 / KPW, TPG = 32 / NTG, QS = (DK + 8) * 2, NKT = DK / 16;
    const int tid = ltid(), w = tid >> 6, lane = tid & 63, fr = lane & 15, fq = lane >> 4;
    const int kl = lane % KPW, tg = lane / KPW, kch = w * KPW + kl;
    const int vcol = tid & 127, vg = tid >> 7;
    LAS unsigned char* qt = lds; LAS unsigned char* kt_ = qt + 32 * QS; LAS unsigned char* khT = kt_ + 32 * QS; LAS unsigned char* vT = khT + DK * 80;
    LAS unsigned char* att = vT + 128 * 80; LAS float* dvec = (LAS float*)(att + 32 * 80); LAS float* evec = dvec + DK;
    const bf16_t* Z = (const bf16_t*)(p->ws + p->o_z);
    const int LATR = p->GB * 2048, MG = p->MG;
    const int qc = ISC ? (ZC_Q + h * 128 + kch) : (ZD_Q + h * 64 + kch);
    const int kc = ISC ? ((dir ? ZC_FB : ZC_FF) + h * 128 + kch) : (ZD_K + h * 64 + kch);
    const int vc = (ISC ? ZC_I : ZD_V) + h * 128 + vcol;
    const int gcol = ZD_GK + dir * 16;
    float lbv = 0.f, oml = 1.f, up[16], gb = 0.f;
#pragma unroll
    for (int r = 0; r < 16; ++r) up[r] = 0.f;
    if (ISC) { lbv = ((const float*)(p->ws + p->o_lb))[l * 512 + h * 128 + kch]; oml = 1.0f - lbv; }
    else {
#pragma unroll
        for (int r = 0; r < 16; ++r) up[r] = p->d_gate_up[((size_t)(l * 2 + dir) * 16 + r) * 256 + h * 64 + kch];
        gb = p->d_gate_bias[(l * 2 + dir) * 256 + h * 64 + kch];
    }
    bf16_t* odst = (dir == 0) ? ((bf16_t*)(p->ws + p->o_y4) + (size_t)(ISC ? 2 : 3) * MG * 512) : ((bf16_t*)(p->ws + p->o_ob) + (size_t)(ISC ? 0 : 1) * MG * 512);
    f32x4 S[NKT];
#pragma unroll
    for (int i = 0; i < NKT; ++i) S[i] = (f32x4){0.f, 0.f, 0.f, 0.f};
    const int sgn = dir ? -1 : 1;
    const long zstep = (long)sgn * ZW, ostep = (long)sgn * 512;
    auto row0of = [&](int cc) -> int {
        const bool isctx = cc < 8; const int L = isctx ? 256 : 2048, base = isctx ? (LATR + bl * 256) : (bl * 2048), c = isctx ? cc : cc - 8;
        return base + (dir ? (L - 1 - c * 32) : c * 32);
    };
    bf16_t rq[TPG], rk[TPG], rv[8]; u32x4 rz[TPG][2];
    auto load_raw = [&](int cc) {
        const int r0 = row0of(cc);
        const bf16_t* zq = Z + (size_t)(r0 + tg * TPG * sgn) * ZW;
#pragma unroll
        for (int e = 0; e < TPG; ++e) {
            const bf16_t* zr = zq + e * zstep;
            rq[e] = zr[qc]; rk[e] = zr[kc];
            if (!ISC) { rz[e][0] = *(const u32x4*)(zr + gcol); rz[e][1] = *(const u32x4*)(zr + gcol + 8); }
        }
        const bf16_t* zv = Z + (size_t)(r0 + vg * 8 * sgn) * ZW + vc;
#pragma unroll
        for (int e = 0; e < 8; ++e) rv[e] = zv[e * zstep];
    };
    load_raw(0);
    for (int cc = 0; cc < 72; ++cc) {
        __syncthreads();
        {
            float gq[TPG], gk[TPG], cum[TPG]; float run = 0.f;
#pragma unroll
            for (int e = 0; e < TPG; ++e) {
                const float zq = bf2f(rq[e]), zk = bf2f(rk[e]); float g, key, q;
                if (ISC) { const float sg = zk; g = flog(lbv + oml * sg); key = oml * (1.0f - sg); q = zq; }
                else {
                    float a = gb;
                    const u32x4 z0 = rz[e][0], z1 = rz[e][1];
                    a += lo16(z0.x) * up[0] + hi16(z0.x) * up[1] + lo16(z0.y) * up[2] + hi16(z0.y) * up[3] + lo16(z0.z) * up[4] + hi16(z0.z) * up[5] + lo16(z0.w) * up[6] + hi16(z0.w) * up[7];
                    a += lo16(z1.x) * up[8] + hi16(z1.x) * up[9] + lo16(z1.y) * up[10] + hi16(z1.y) * up[11] + lo16(z1.z) * up[12] + hi16(z1.z) * up[13] + lo16(z1.w) * up[14] + hi16(z1.w) * up[15];
                    g = (fminf(a, 0.f) - flog(1.0f + fexp(-fabsf(a)))) * (1.0f / 16.0f); key = zk; q = zq;
                }
                run += g; cum[e] = run; gq[e] = q; gk[e] = key;
            }
            float pre = 0.f, total = 0.f, cref = 0.f;
#pragma unroll
            for (int t = 0; t < NTG; ++t) { const float tt = __shfl(run, kl + KPW * t); if (t < tg) pre += tt; if (t < NTG / 2) cref += tt; total += tt; }
            float khv[TPG]; const float etc = fexp(total - cref);
#pragma unroll
            for (int e = 0; e < TPG; ++e) {
                const float c = cum[e] + pre; const int i = tg * TPG + e;
                const float E = fexp(c - cref), kE = gk[e] * __builtin_amdgcn_rcpf(E);
                *(LAS bf16_t*)(qt + i * QS + kch * 2) = f2bf1(gq[e] * E);
                *(LAS bf16_t*)(kt_ + i * QS + kch * 2) = f2bf1(kE);
                khv[e] = kE * etc;
            }
            if constexpr (TPG == 8) { u32x4 o; o.x = pk2(khv[0], khv[1]); o.y = pk2(khv[2], khv[3]); o.z = pk2(khv[4], khv[5]); o.w = pk2(khv[6], khv[7]); *(LAS u32x4*)(khT + kch * 80 + tg * 16) = o; }
            else { u32x2 o; o.x = pk2(khv[0], khv[1]); o.y = pk2(khv[2], khv[3]); *(LAS u32x2*)(khT + kch * 80 + tg * 8) = o; }
            if (tg == 0) { dvec[kch] = fexp(total); evec[kch] = fexp(cref); }
            u32x4 vo; vo.x = (unsigned)rv[0] | ((unsigned)rv[1] << 16); vo.y = (unsigned)rv[2] | ((unsigned)rv[3] << 16); vo.z = (unsigned)rv[4] | ((unsigned)rv[5] << 16); vo.w = (unsigned)rv[6] | ((unsigned)rv[7] << 16);
            *(LAS u32x4*)(vT + vcol * 80 + vg * 16) = vo;
        }
        if (cc + 1 < 72) load_raw(cc + 1);
        __syncthreads();
        if (w < 3) {
            const int tt = (w == 0) ? 0 : 1, st = (w == 2) ? 1 : 0;
            f32x4 a = (f32x4){0.f, 0.f, 0.f, 0.f};
#pragma unroll
            for (int ks = 0; ks < DK / 32; ++ks) {
                const bf16x8 A = *(const LAS bf16x8*)(qt + (tt * 16 + fr) * QS + (ks * 32 + fq * 8) * 2);
                const bf16x8 B = *(const LAS bf16x8*)(kt_ + (st * 16 + fr) * QS + (ks * 32 + fq * 8) * 2);
                a = MFMA16(A, B, a);
            }
#pragma unroll
            for (int j = 0; j < 4; ++j) { const int t = tt * 16 + fq * 4 + j, s = st * 16 + fr; *(LAS bf16_t*)(att + t * 80 + s * 2) = f2bf1(s <= t ? a[j] : 0.f); }
        } else if (w == 3) {
#pragma unroll
            for (int j = 0; j < 4; ++j) { const int t = fq * 4 + j, s = 16 + fr; *(LAS bf16_t*)(att + t * 80 + s * 2) = (bf16_t)0; }
        }
        __syncthreads();
        {
            const int vs = w * 16;
            bf16_t* ob0 = odst + (size_t)(row0of(cc) + fq * 4 * sgn) * 512 + h * 128 + vs + fr;
            const bf16x8 Bv = *(const LAS bf16x8*)(vT + (vs + fr) * 80 + fq * 16);
            f32x4 ev[NKT]; u32x4 qa[2][NKT / 2]; bf16x8 A2[2], A3[NKT]; f32x4 dv[NKT];
#pragma unroll
            for (int k2 = 0; k2 < NKT; ++k2) ev[k2] = *(const LAS f32x4*)(evec + k2 * 16 + fq * 4);
#pragma unroll
            for (int tt = 0; tt < 2; ++tt) {
#pragma unroll
                for (int kp = 0; kp < NKT / 2; ++kp) {
                    const u32x2 lo = *(const LAS u32x2*)(qt + (tt * 16 + fr) * QS + ((2 * kp) * 16 + fq * 4) * 2);
                    const u32x2 hi = *(const LAS u32x2*)(qt + (tt * 16 + fr) * QS + ((2 * kp + 1) * 16 + fq * 4) * 2);
                    qa[tt][kp].x = lo.x; qa[tt][kp].y = lo.y; qa[tt][kp].z = hi.x; qa[tt][kp].w = hi.y;
                }
                A2[tt] = *(const LAS bf16x8*)(att + (tt * 16 + fr) * 80 + fq * 16);
            }
#pragma unroll
            for (int k2 = 0; k2 < NKT; ++k2) { dv[k2] = *(const LAS f32x4*)(dvec + k2 * 16 + fq * 4); A3[k2] = *(const LAS bf16x8*)(khT + (k2 * 16 + fr) * 80 + fq * 16); }
            __builtin_amdgcn_sched_barrier(0);
            bf16x8 Sb[NKT / 2];
#pragma unroll
            for (int kp = 0; kp < NKT / 2; ++kp) {
                const f32x4 s0 = S[2 * kp] * ev[2 * kp], s1 = S[2 * kp + 1] * ev[2 * kp + 1];
                u32x4 sw; sw.x = pk2(s0.x, s0.y); sw.y = pk2(s0.z, s0.w); sw.z = pk2(s1.x, s1.y); sw.w = pk2(s1.z, s1.w);
                Sb[kp] = __builtin_bit_cast(bf16x8, sw);
            }
#pragma unroll
            for (int tt = 0; tt < 2; ++tt) {
                f32x4 o = (f32x4){0.f, 0.f, 0.f, 0.f};
#pragma unroll
                for (int kp = 0; kp < NKT / 2; ++kp) o = MFMA16(__builtin_bit_cast(bf16x8, qa[tt][kp]), Sb[kp], o);
                o = MFMA16(A2[tt], Bv, o);
#pragma unroll
                for (int j = 0; j < 4; ++j) ob0[(tt * 16 + j) * ostep] = f2bf1(o[j]);
            }
            __builtin_amdgcn_sched_barrier(0);
#pragma unroll
            for (int k2 = 0; k2 < NKT; ++k2) { S[k2] = S[k2] * dv[k2]; S[k2] = MFMA16(A3[k2], Bv, S[k2]); }
        }
    }
    __syncthreads();
}

__device__ __forceinline__ void mixer(PPtr p, int l, int g, LAS unsigned char* lds, unsigned long long* tscan = nullptr) {
    const int tid = ltid(), w = tid >> 6, lane = tid & 63;
    LAS float* biasL = (LAS float*)(lds + BIAS_OFF);
    for (int i = tid; i < 8 * 465; i += 512) biasL[i] = p->b_rel_bias[(size_t)l * 8 * 465 + i] * LOG2E;
    __syncthreads();
    const int GB = p->GB, NSC = GB * 8, NS = GB * 16;
    const unsigned long long ts0 = tscan ? __builtin_amdgcn_s_memrealtime() : 0ull;
    for (int st = blockIdx.x; st < NS; st += gridDim.x) {
        if (st < NSC) { scan_task<128, true>(p, l, st >> 3, (st >> 1) & 3, st & 1, lds); }
        else { const int s2 = st - NSC; scan_task<64, false>(p, l, s2 >> 3, (s2 >> 1) & 3, s2 & 1, lds); }
    }
    if (tscan) *tscan += __builtin_amdgcn_s_memrealtime() - ts0;
    unsigned* ctr8 = (unsigned*)p->ws + (l * 16 + g) * 8;
    const int NB0 = GB * 32, NB1 = GB * 32, NB2 = (l < DEPTH - 1) ? GB * 4 : 0, NB3 = NB2;
    const int S0 = NB0 >> 3, S1 = NB1 >> 3, S2 = NB2 >> 3, S3 = NB3 >> 3, LSH = S0 + S1 + S2 + S3;
    const int myx = (int)(xb_xcc_id() & 7u);
    int sh = 0;
    LAS int* tw = (LAS int*)(lds + CTRL_OFF);
    for (;;) {
        if (tid == 0) {
            int got = -1;
            while (sh < 8) {
                const int xx = (myx + sh) & 7; const unsigned q = atomicAdd(ctr8 + xx, 1u);
                if ((int)q < LSH) { got = xx * LSH + (int)q; break; }
                ++sh;
            }
            *tw = got;
        }
        __syncthreads();
        const int tk = *tw;
        __syncthreads();
        if (tk < 0) break;
        const int xx = tk / LSH, q = tk - xx * LSH;
        int kind, idx;
        if (q < S0) { kind = 0; idx = (xx * S0 + q) * 8 + w; }
        else if (q < S0 + S1) { kind = 1; idx = (xx * S1 + (q - S0)) * 8 + w; }
        else if (q < S0 + S1 + S2) { kind = 2; idx = (xx * S2 + (q - S0 - S1)) * 8 + w; }
        else { kind = 3; idx = (xx * S3 + (q - S0 - S1 - S2)) * 8 + w; }
        attn_wave(p, l, kind, idx, lane, biasL);
    }
}

__device__ __forceinline__ void postpass(PPtr p, int l, int nrows) {
    const int lane = ltid() & 63, gw = blockIdx.x * 8 + (ltid() >> 6), NGW = gridDim.x * 8, MG = p->MG;
    const bf16_t* Z = (const bf16_t*)(p->ws + p->o_z);
    for (int it = gw; it < nrows * 2; it += NGW) {
        const int row = it >> 1, br = it & 1;
        bf16_t* yf = (bf16_t*)(p->ws + p->o_y4) + (size_t)(2 + br) * MG * 512 + (size_t)row * 512 + lane * 8;
        const bf16_t* yb = (const bf16_t*)(p->ws + p->o_ob) + (size_t)br * MG * 512 + (size_t)row * 512 + lane * 8;
        const u32x4 a = *(const u32x4*)yf, b = *(const u32x4*)yb;
        const u32x4 gt = *(const u32x4*)(Z + (size_t)row * ZW + (br ? ZD_G : ZC_G) + lane * 8);
        const float* gain = (br ? p->d_norm : p->c_norm) + l * 128 + (lane & 15) * 8;
        float o[8], gv[8];
        o[0] = lo16(a.x) + lo16(b.x); o[1] = hi16(a.x) + hi16(b.x); o[2] = lo16(a.y) + lo16(b.y); o[3] = hi16(a.y) + hi16(b.y);
        o[4] = lo16(a.z) + lo16(b.z); o[5] = hi16(a.z) + hi16(b.z); o[6] = lo16(a.w) + lo16(b.w); o[7] = hi16(a.w) + hi16(b.w);
        gv[0] = lo16(gt.x); gv[1] = hi16(gt.x); gv[2] = lo16(gt.y); gv[3] = hi16(gt.y); gv[4] = lo16(gt.z); gv[5] = hi16(gt.z); gv[6] = lo16(gt.w); gv[7] = hi16(gt.w);
        float ss = 0.f;
#pragma unroll
        for (int e = 0; e < 8; ++e) ss += o[e] * o[e];
        ss = row16_sum(ss);
        const float rs = rsqrtf(ss * (1.0f / 128.0f) + EPS);
        const f32x4 g0 = *(const f32x4*)gain, g1 = *(const f32x4*)(gain + 4);
        float y[8];
#pragma unroll
        for (int e = 0; e < 8; ++e) { const float gn = (e < 4) ? g0[e & 3] : g1[e & 3]; y[e] = o[e] * rs * gn * (gv[e] * sigm(gv[e])); }
        u32x4 wv; wv.x = pk2(y[0], y[1]); wv.y = pk2(y[2], y[3]); wv.z = pk2(y[4], y[5]); wv.w = pk2(y[6], y[7]);
        *(u32x4*)yf = wv;
    }
}

#define NOINL __device__ __forceinline__
NOINL void ph_prologue(PPtr pc, LAS unsigned char* lds) { PPtr p = pc; asm volatile("" : "+s"(p)); prologue(p, lds); }
NOINL void ph_rowpass(PPtr pc, int l, int g, int mode, int nrows, int conv_l, LAS unsigned char* lds) { PPtr p = pc; asm volatile("" : "+s"(p)); rowpass(p, l, g, mode, nrows); if (conv_l >= 0) convert_weights(p, conv_l, lds); }
NOINL void ph_rowpass_tail(PPtr pc, int l, int g, int nrows, int conv_l, int nl, int ng, int nrows_next, LAS unsigned char* lds) {
    PPtr p = pc; asm volatile("" : "+s"(p));
    rowpass(p, l, g, 3, nrows);
    if (nl >= 0) rowpass(p, nl, ng, 1, nrows_next);
    if (conv_l >= 0) convert_weights(p, conv_l, lds);
}
NOINL void ph_inproj(PPtr pc, LAS unsigned char* lds) {
    PPtr p = pc; asm volatile("" : "+s"(p)); const int G = (int)gridDim.x, c = (int)blockIdx.x;
    pg8::Gemm gm{(const bf16_t*)(p->ws + p->o_h), (const bf16_t*)(p->ws + p->o_win), p->MG, ZW, 1024, 1024}; pg8::StaticOrder S; S.init(p->MG, ZW, G, c);
    EpiInproj E{(bf16_t*)(p->ws + p->o_z), (bf16_t*)(p->ws + p->o_vta), (bf16_t*)(p->ws + p->o_vtb), (const float*)(p->ws + p->o_rope), p->GB};
    pg8::gemm_phase<EpiInproj, pg8::StaticOrder>(lds, gm, S, E, nullptr);
}
NOINL void ph_mixer(PPtr pc, int l, int g, LAS unsigned char* lds, unsigned long long* tscan = nullptr) { PPtr p = pc; asm volatile("" : "+s"(p)); mixer(p, l, g, lds, tscan); }
NOINL void ph_post(PPtr pc, int l, int nrows) { PPtr p = pc; asm volatile("" : "+s"(p)); postpass(p, l, nrows); }
NOINL void ph_branch(PPtr pc, int Mr, LAS unsigned char* lds) {
    PPtr p = pc; asm volatile("" : "+s"(p)); const int G = (int)gridDim.x, c = (int)blockIdx.x;
    const int LATR = p->GB * 2048, nMfull = p->MG / 256;
    pg8::Gemm gm{(const bf16_t*)(p->ws + p->o_y4), (const bf16_t*)(p->ws + p->o_wb), Mr, 1024, 512, 512};
    { BranchOrder S{LATR / 256, nMfull, G, c};
      EpiBranch E{(const bf16_t*)(p->ws + p->o_z), (bf16_t*)(p->ws + p->o_h), nMfull};
      pg8::gemm_phase<EpiBranch, BranchOrder>(lds, gm, S, E, nullptr); }
    if (Mr > LATR) {
        CtxBranchOrder S{nMfull, LATR / 256, (Mr - LATR) / 256 * 4, G, c};
        EpiBranchCtx E{(const bf16_t*)(p->ws + p->o_z), (bf16_t*)(p->ws + p->o_ob), nMfull, LATR / 256};
        pg8::gemm_phase<EpiBranchCtx, CtxBranchOrder>(lds, gm, S, E, nullptr);
    }
}
NOINL void ph_gemm_f32(PPtr pc, int which, int Mr, LAS unsigned char* lds) {
    PPtr p = pc; asm volatile("" : "+s"(p)); const int G = (int)gridDim.x, c = (int)blockIdx.x;
    const int LATR = p->GB * 2048;
    const bf16_t* hid = (const bf16_t*)(p->ws + p->o_z + (size_t)p->MG * 1024 * 4);
    { const bf16_t* A = which ? hid : (const bf16_t*)(p->ws + p->o_h);
      const bf16_t* Bt = which ? (const bf16_t*)(p->ws + p->o_w2) : (const bf16_t*)(p->ws + p->o_wo);
      const int K = which ? 4096 : 1024;
      pg8::Gemm gm{A, Bt, LATR, 1024, K, K}; pg8::StaticOrder S; S.init(LATR, 1024, G, c);
      EpiBf16Y E{(bf16_t*)(p->ws + p->o_z), 1024};
      pg8::gemm_phase<EpiBf16Y, pg8::StaticOrder>(lds, gm, S, E, nullptr); }
    if (Mr > LATR) {
        const bf16_t* A = which ? hid : ((const bf16_t*)(p->ws + p->o_ob) - (size_t)LATR * 4096);
        const bf16_t* Bt = which ? (const bf16_t*)(p->ws + p->o_w2) : (const bf16_t*)(p->ws + p->o_wo4);
        pg8::Gemm gm{A, Bt, Mr, 1024, 4096, 512};
        SplitOrder S{LATR / 256, (Mr - LATR) / 256, 8, 512, G, c};
        EpiSlab E{(bf16_t*)(p->ws + p->o_z + (size_t)p->MG * 12288), LATR / 256, Mr - LATR, 512};
        pg8::gemm_phase<EpiSlab, SplitOrder>(lds, gm, S, E, nullptr);
    }
}
NOINL void ph_ffn1(PPtr pc, int Mr, LAS unsigned char* lds) {
    PPtr p = pc; asm volatile("" : "+s"(p)); const int G = (int)gridDim.x, c = (int)blockIdx.x;
    pg8::Gemm gm{(const bf16_t*)(p->ws + p->o_h), (const bf16_t*)(p->ws + p->o_w1), Mr, 4096, 1024, 1024}; pg8::StaticOrder S; S.init(Mr, 4096, G, c);
    EpiRelu2 E{(bf16_t*)(p->ws + p->o_z + (size_t)p->MG * 1024 * 4), 4096};
    pg8::gemm_phase<EpiRelu2, pg8::StaticOrder>(lds, gm, S, E, nullptr);
}

#define XB_SETUP() volatile LAS unsigned* xb_st = (volatile LAS unsigned*)(lds + CTRL_OFF + 64); unsigned* xb_bar = (unsigned*)(pc->ws + 4096); { XcdBarrier xb0 = xcd_barrier_post(xb_bar, xb_st); (void)xb0; }
#define GSYNC() { XcdBarrier xb_; xb_.bar = (unsigned*)(pc->ws + 4096); xb_.x = xb_xcc_id(); xb_.st = (volatile LAS unsigned*)(lds + CTRL_OFF + 64); xcd_barrier(xb_); }
#ifdef PROBE_MASK
__global__ void __launch_bounds__(512) hybrid_fwd(Params pk) {
    extern __shared__ __attribute__((aligned(16))) unsigned char smem[];
    LAS unsigned char* lds = (LAS unsigned char*)smem;
    cg::grid_group grid = cg::this_grid();
    PPtr pc = (PPtr)__builtin_amdgcn_kernarg_segment_ptr();
    const int GB = pc->GB, MG = pc->MG, NGRP = pc->NGRP, LATR = GB * 2048;
    unsigned long long tacc = 0, t0_ = __builtin_amdgcn_s_memrealtime();
#define PT(kind) { const unsigned long long t1_ = __builtin_amdgcn_s_memrealtime(); if ((PROBE_MASK >> (kind)) & 1) tacc += t1_ - t0_; t0_ = t1_; }
    ph_prologue(pc, lds);
    grid.sync();
    XB_SETUP(); PT(0)
    for (int l = 0; l < DEPTH; ++l) {
        const int Mr = (l < DEPTH - 1) ? MG : LATR;
        for (int g = 0; g < NGRP; ++g) {
            ph_rowpass(pc, l, g, 1, MG, -1, lds);
            GSYNC(); PT(1)
            ph_inproj(pc, lds);
            GSYNC(); PT(2)
            { unsigned long long tsc = 0; ph_mixer(pc, l, g, lds, &tsc); if ((PROBE_MASK >> 11) & 1) tacc += tsc; }
            GSYNC(); PT(3)
            ph_post(pc, l, Mr);
            GSYNC(); PT(4)
            ph_branch(pc, Mr, lds);
            GSYNC(); PT(5)
            ph_gemm_f32(pc, 0, Mr, lds);
            GSYNC(); PT(6)
            ph_rowpass(pc, l, g, 2, Mr, -1, lds);
            GSYNC(); PT(7)
            ph_ffn1(pc, Mr, lds);
            GSYNC(); PT(8)
            ph_gemm_f32(pc, 1, Mr, lds);
            GSYNC(); PT(9)
            ph_rowpass(pc, l, g, 3, Mr, (g == NGRP - 1 && l + 1 < DEPTH) ? l + 1 : -1, lds);
            GSYNC(); PT(10)
        }
    }
    if (blockIdx.x == 0) { const unsigned M = (unsigned)(tacc / 100ull); float* o = pc->out; for (unsigned i2 = threadIdx.x; i2 < M; i2 += 512) o[i2] += 0.125f; }
}

#else
__global__ void __launch_bounds__(512) hybrid_fwd(Params pk) {
    extern __shared__ __attribute__((aligned(16))) unsigned char smem[];
    LAS unsigned char* lds = (LAS unsigned char*)smem;
    cg::grid_group grid = cg::this_grid();
    PPtr pc = (PPtr)__builtin_amdgcn_kernarg_segment_ptr();
    const int GB = pc->GB, MG = pc->MG, NGRP = pc->NGRP, LATR = GB * 2048;
    ph_prologue(pc, lds);
    grid.sync();
    XB_SETUP();
    for (int l = 0; l < DEPTH; ++l) {
        const int Mr = (l < DEPTH - 1) ? MG : LATR;
        for (int g = 0; g < NGRP; ++g) {
            if ((l == 0 && g == 0) || NGRP == 1) { ph_rowpass(pc, l, g, 1, MG, -1, lds); GSYNC(); }
            ph_inproj(pc, lds);
            GSYNC();
            ph_mixer(pc, l, g, lds);
            GSYNC();
            ph_post(pc, l, Mr);
            GSYNC();
            ph_branch(pc, Mr, lds);
            GSYNC();
            ph_gemm_f32(pc, 0, Mr, lds);
            GSYNC();
            ph_rowpass(pc, l, g, 2, Mr, -1, lds);
            GSYNC();
            ph_ffn1(pc, Mr, lds);
            GSYNC();
            ph_gemm_f32(pc, 1, Mr, lds);
            GSYNC();
            {
                const bool lastg = (g == NGRP - 1);
                const int nl = (NGRP == 1) ? -1 : (lastg ? (l + 1 < DEPTH ? l + 1 : -1) : l), ng = lastg ? 0 : g + 1;
                ph_rowpass_tail(pc, l, g, Mr, (lastg && l + 1 < DEPTH) ? l + 1 : -1, nl, ng, MG, lds);
            }
            if (!(l == DEPTH - 1 && g == NGRP - 1)) GSYNC();
        }
    }
}

#endif
extern "C" void kernel_launch(void* const* d_in, const int* in_sizes, int n_in, void* d_out, int out_size, void* d_ws, size_t ws_size, hipStream_t stream) {
    static int grid_blocks = 0;
    if (grid_blocks == 0) {
        int dev = 0, cus = 0, per_cu = 0;
        hipGetDevice(&dev);
        hipDeviceGetAttribute(&cus, hipDeviceAttributeMultiprocessorCount, dev);
        if (hipFuncSetAttribute((const void*)hybrid_fwd, hipFuncAttributeMaxDynamicSharedMemorySize, LDS_BYTES) != hipSuccess) fprintf(stderr, "hipFuncSetAttribute failed\n");
        if (hipOccupancyMaxActiveBlocksPerMultiprocessor(&per_cu, (const void*)hybrid_fwd, 512, LDS_BYTES) != hipSuccess || per_cu < 1) { fprintf(stderr, "occupancy query: %d\n", per_cu); per_cu = 1; }
        (void)hipGetLastError();
        grid_blocks = cus * 1;
        if (grid_blocks <= 0) grid_blocks = 256;
    }
    Params p{};
    const float* const* in = (const float* const*)d_in;
    p.x = in[0]; p.c = in[1]; p.ctx = in[2]; p.c_ctx = in[3]; p.w_mod = in[4]; p.b_mod = in[5]; p.norm_gains = in[6]; p.w_in = in[7]; p.a_sink = in[8]; p.b_rel_bias = in[9];
    p.c_lb = in[10]; p.c_norm = in[11]; p.d_gate_up = in[12]; p.d_gate_bias = in[13]; p.d_norm = in[14]; p.w_branch = in[15]; p.w_out = in[16]; p.w_ff1 = in[17]; p.w_ff2 = in[18];
    p.out = (float*)d_out; p.ws = (unsigned char*)d_ws;
    auto al = [](unsigned long long v) { return (v + 255ull) & ~255ull; };
    unsigned long long off = 32768;
    p.o_mod = off; off = al(off + 4ull * 17 * 6144 * 4);
    p.o_lb = off; off = al(off + 4ull * 512 * 4);
    p.o_rope = off; off = al(off + 2048ull * 4);
    p.o_xc = off; off = al(off + 4096ull * 1024 * 4);
    p.o_win = off; off = al(off + (unsigned long long)ZW * 1024 * 2);
    p.o_wb = off; off = al(off + 4096ull * 512 * 2);
    p.o_wo = off; off = al(off + 1024ull * 1024 * 2);
    p.o_w1 = off; off = al(off + 4096ull * 1024 * 2);
    p.o_w2 = off; off = al(off + 1024ull * 4096 * 2);
    p.o_wo4 = off; off = al(off + 1024ull * 4096 * 2);
    const unsigned long long fixed = off;
    int GB = 8;
    for (; GB > 2; GB >>= 1) {
        const unsigned long long MGt = (unsigned long long)GB * 2304;
        const unsigned long long need = fixed + MGt * (2048ull + (unsigned long long)ZW * 2 + 4096ull + 2048ull) + (unsigned long long)GB * 10 * 64 * VTS * 2 + 8 * 256;
        if (need <= (unsigned long long)ws_size) break;
    }
    p.GB = GB; p.NGRP = 16 / GB; p.MG = GB * 2304;
    const unsigned long long MGu = (unsigned long long)p.MG;
    p.o_h = off; off = al(off + MGu * 1024 * 2);
    p.o_z = off; off = al(off + MGu * ZW * 2);
    p.o_y4 = off; off = al(off + MGu * 2048 * 2);
    p.o_ob = off; off = al(off + MGu * 1024 * 2);
    p.o_vta = off; off = al(off + (unsigned long long)GB * 2 * 64 * VTS * 2);
    p.o_vtb = off; off = al(off + (unsigned long long)GB * 8 * 64 * VTS * 2);
    hipMemsetAsync(d_ws, 0, 32768, stream);
    void* args[] = {&p};
    hipError_t e = hipLaunchCooperativeKernel((const void*)hybrid_fwd, dim3(grid_blocks), dim3(512), args, LDS_BYTES, stream);
    if (e != hipSuccess) fprintf(stderr, "cooperative launch failed: %s (grid %d)\n", hipGetErrorString(e), grid_blocks);
}
```
